# Optimizing an MI355X kernel written in HIP

```python
import math
import jax, jax.numpy as jnp
from jax import lax
import numpy as np

D_MODEL = 2048
BATCH = 4
SEQ = 8192
DEPTH = 4

CHUNK = 64
Q_BLOCK = 128
N_MIXERS = 3
FFN_DIM = 5632
ATTN_HEADS = 16
ATTN_QK_DIM = D_MODEL // ATTN_HEADS // 2
ATTN_V_DIM = 2 * ATTN_QK_DIM
CONV_WIDTH = 3
HGRN_HEADS = 16
HGRN_HEAD_DIM = D_MODEL // HGRN_HEADS
N_SUBLAYERS = 3
N_MOD = 3 * N_SUBLAYERS
N_ATTN_LAYERS = (DEPTH + 2) // 3
N_CONV_LAYERS = (DEPTH + 1) // 3
N_HGRN_LAYERS = DEPTH // 3
RMS_EPS = 1e-6

kernel_name = "hybrid_diffattn_shortconv_hgrn2_macaron"


def rms_norm(x, g):
    xf = x.astype(jnp.float32)
    y = xf * lax.rsqrt(jnp.mean(xf * xf, axis=-1, keepdims=True) + RMS_EPS)
    return (y * g.astype(jnp.float32)).astype(x.dtype)


def modulate(h, shift, scale):
    return h * (1 + scale[:, None, :]) + shift[:, None, :]


def swiglu(h, w_gate, w_up, w_down):
    return (jax.nn.silu(h @ w_gate) * (h @ w_up)) @ w_down


def alibi_slopes(n_heads):
    return jnp.asarray(np.array([2.0 ** (-8.0 * (h + 1) / n_heads) for h in range(n_heads)], dtype=np.float32))


def diff_attention(h, w_in, w_out, q_gain, k_gain, lam_vecs, subln_g, lambda_init):
    B, S, _ = h.shape
    H, dh, dv = ATTN_HEADS, ATTN_QK_DIM, ATTN_V_DIM
    q, k, v = jnp.split(h @ w_in, 3, axis=-1)
    q = rms_norm(q.reshape(B, S, H, 2, dh), q_gain)
    k = rms_norm(k.reshape(B, S, H, 2, dh), k_gain)
    v = v.reshape(B, S, H, dv)
    lam = (jnp.exp(jnp.sum(lam_vecs[0].astype(jnp.float32) * lam_vecs[1].astype(jnp.float32)))
           - jnp.exp(jnp.sum(lam_vecs[2].astype(jnp.float32) * lam_vecs[3].astype(jnp.float32)))
           + lambda_init)
    slopes = alibi_slopes(H)
    k_pos = jnp.arange(S)
    n_blk = S // Q_BLOCK
    q_blocks = q.reshape(B, n_blk, Q_BLOCK, H, 2, dh).transpose(1, 0, 2, 3, 4, 5)
    scale = dh ** -0.5

    def attend(args):
        q_blk, blk = args
        q_pos = blk * Q_BLOCK + jnp.arange(Q_BLOCK)
        s = jnp.einsum('bqhjd,bkhjd->bhjqk', q_blk, k, preferred_element_type=jnp.float32) * scale
        dist = jnp.abs(q_pos[:, None] - k_pos[None, :]).astype(jnp.float32)
        s = s - (slopes[:, None, None] * dist)[None, :, None]
        mask = (k_pos[None, :] // CHUNK) <= (q_pos[:, None] // CHUNK)
        p = jax.nn.softmax(jnp.where(mask, s, -jnp.inf), axis=-1)
        a = p[:, :, 0] - lam * p[:, :, 1]
        return jnp.einsum('bhqk,bkhv->bqhv', a.astype(v.dtype), v)

    o = lax.map(attend, (q_blocks, jnp.arange(n_blk)))
    o = o.transpose(1, 0, 2, 3, 4).reshape(B, S, H, dv)
    o = rms_norm(o, subln_g) * (1.0 - lambda_init)
    return o.reshape(B, S, H * dv) @ w_out


def short_conv_mixer(h, w_in, conv_w, w_out):
    b_gate, c_gate, u = jnp.split(h @ w_in, 3, axis=-1)
    v = c_gate * u
    y = lax.conv_general_dilated(
        v, conv_w[:, None, :].astype(v.dtype), window_strides=(1,),
        padding=[(CONV_WIDTH - 1, 0)], dimension_numbers=('NWC', 'WIO', 'NWC'),
        feature_group_count=D_MODEL)
    return (b_gate * y) @ w_out


def hgrn2_mixer(h, w_in, w_out, o_norm_g, lower_bound):
    B, S, _ = h.shape
    H, dk = HGRN_HEADS, HGRN_HEAD_DIM
    q, f_logit, i, g = jnp.split(h @ w_in, 4, axis=-1)
    lb = lower_bound.astype(jnp.float32).reshape(H, dk)
    f = lb + (1.0 - lb) * jax.nn.sigmoid(f_logit.reshape(B, S, H, dk).astype(jnp.float32))
    log_f = jnp.log(f)
    k = 1.0 - f
    n_chunks = S // CHUNK

    def to_chunks(t):
        return t.reshape(B, n_chunks, CHUNK, H, dk).transpose(1, 0, 3, 2, 4).astype(jnp.float32)

    causal = jnp.tril(jnp.ones((CHUNK, CHUNK), dtype=bool))

    def step(state, xs):
        q_c, k_c, i_c, lf_c = xs
        b = jnp.cumsum(lf_c, axis=-2)
        inter = jnp.einsum('bhtk,bhkv->bhtv', q_c * jnp.exp(b), state)
        diff = b[:, :, :, None, :] - b[:, :, None, :, :]
        decay = jnp.exp(jnp.where(causal[:, :, None], diff, -jnp.inf))
        scores = jnp.einsum('bhtsk,bhsk->bhts', q_c[:, :, :, None, :] * decay, k_c)
        intra = jnp.einsum('bhts,bhsv->bhtv', scores, i_c)
        b_last = b[:, :, -1:, :]
        state = (jnp.exp(b_last[:, :, 0, :, None]) * state
                 + jnp.einsum('bhsk,bhsv->bhkv', k_c * jnp.exp(b_last - b), i_c))
        return state, inter + intra

    state0 = jnp.zeros((B, H, dk, dk), jnp.float32)
    _, o = lax.scan(step, state0, (to_chunks(q), to_chunks(k), to_chunks(i), to_chunks(log_f)))
    o = o.transpose(1, 0, 3, 2, 4).reshape(B, S, H, dk)
    o = rms_norm(o, o_norm_g) * jax.nn.silu(g.reshape(B, S, H, dk).astype(jnp.float32))
    return o.reshape(B, S, H * dk).astype(h.dtype) @ w_out


def setup_inputs(seed: int = 0) -> dict:
    key = jax.random.key(seed)
    ks = jax.random.split(key, 24)
    D, F = D_MODEL, FFN_DIM

    def nrm(k, shape, scale):
        return jax.random.normal(k, shape, jnp.float32) * scale

    return {
        "x": nrm(ks[0], (BATCH, SEQ, D), 1.0),
        "c": nrm(ks[1], (BATCH, D), 1.0),
        "ada_w": nrm(ks[2], (DEPTH, D, N_MOD * D), 0.5 * D ** -0.5),
        "ada_b": nrm(ks[3], (DEPTH, N_MOD * D), 0.02),
        "norm_g": 1.0 + nrm(ks[4], (DEPTH, N_SUBLAYERS, D), 0.02),
        "ffn_w_gate": nrm(ks[5], (DEPTH, 2, D, F), D ** -0.5),
        "ffn_w_up": nrm(ks[6], (DEPTH, 2, D, F), D ** -0.5),
        "ffn_w_down": nrm(ks[7], (DEPTH, 2, F, D), F ** -0.5),
        "attn_w_in": nrm(ks[8], (N_ATTN_LAYERS, D, 3 * D), D ** -0.5),
        "attn_w_out": nrm(ks[9], (N_ATTN_LAYERS, D, D), D ** -0.5),
        "attn_q_gain": 1.0 + nrm(ks[10], (N_ATTN_LAYERS, ATTN_QK_DIM), 0.02),
        "attn_k_gain": 1.0 + nrm(ks[11], (N_ATTN_LAYERS, ATTN_QK_DIM), 0.02),
        "attn_lambda": nrm(ks[12], (N_ATTN_LAYERS, 4, ATTN_QK_DIM), 0.1),
        "attn_subln_g": 1.0 + nrm(ks[13], (N_ATTN_LAYERS, ATTN_V_DIM), 0.02),
        "conv_w_in": nrm(ks[14], (N_CONV_LAYERS, D, 3 * D), D ** -0.5),
        "conv_w": nrm(ks[15], (N_CONV_LAYERS, CONV_WIDTH, D), CONV_WIDTH ** -0.5),
        "conv_w_out": nrm(ks[16], (N_CONV_LAYERS, D, D), D ** -0.5),
        "hgrn_w_in": nrm(ks[17], (N_HGRN_LAYERS, D, 4 * D), D ** -0.5),
        "hgrn_w_out": nrm(ks[18], (N_HGRN_LAYERS, D, D), D ** -0.5),
        "hgrn_o_norm_g": 1.0 + nrm(ks[19], (N_HGRN_LAYERS, HGRN_HEAD_DIM), 0.02),
        "hgrn_lb_logits": nrm(ks[20], (DEPTH, D), 0.1),
    }


def reference(x, c, ada_w, ada_b, norm_g, ffn_w_gate, ffn_w_up, ffn_w_down,
              attn_w_in, attn_w_out, attn_q_gain, attn_k_gain, attn_lambda, attn_subln_g,
              conv_w_in, conv_w, conv_w_out,
              hgrn_w_in, hgrn_w_out, hgrn_o_norm_g, hgrn_lb_logits):
    cond = jax.nn.silu(c)
    lb_cum = jnp.cumsum(jax.nn.softmax(hgrn_lb_logits.astype(jnp.float32), axis=0), axis=0)
    lb_all = lb_cum - lb_cum[0:1]
    for layer in range(DEPTH):
        mod = (cond @ ada_w[layer] + ada_b[layer]).reshape(-1, N_MOD, D_MODEL)
        sh1, sc1, g1, sh2, sc2, g2, sh3, sc3, g3 = [mod[:, j] for j in range(N_MOD)]
        h = modulate(rms_norm(x, norm_g[layer, 0]), sh1, sc1)
        x = x + 0.5 * g1[:, None, :] * swiglu(h, ffn_w_gate[layer, 0], ffn_w_up[layer, 0], ffn_w_down[layer, 0])
        h = modulate(rms_norm(x, norm_g[layer, 1]), sh2, sc2)
        kind, slot = layer % N_MIXERS, layer // N_MIXERS
        if kind == 0:
            y = diff_attention(h, attn_w_in[slot], attn_w_out[slot], attn_q_gain[slot], attn_k_gain[slot],
                               attn_lambda[slot], attn_subln_g[slot], 0.8 - 0.6 * math.exp(-0.3 * layer))
        elif kind == 1:
            y = short_conv_mixer(h, conv_w_in[slot], conv_w[slot], conv_w_out[slot])
        else:
            y = hgrn2_mixer(h, hgrn_w_in[slot], hgrn_w_out[slot], hgrn_o_norm_g[slot], lb_all[layer])
        x = x + g2[:, None, :] * y
        h = modulate(rms_norm(x, norm_g[layer, 2]), sh3, sc3)
        x = x + 0.5 * g3[:, None, :] * swiglu(h, ffn_w_gate[layer, 1], ffn_w_up[layer, 1], ffn_w_down[layer, 1])
    return x
```

```cpp
#include <hip/hip_runtime.h>
#include <cstdio>
#include <cstdint>
namespace pg8 {
#define PG8_LAS __attribute__((address_space(3)))
typedef unsigned short bf16_t;
typedef short bf16x8 __attribute__((ext_vector_type(8)));
typedef float f32x4 __attribute__((ext_vector_type(4)));
typedef unsigned u32x4 __attribute__((ext_vector_type(4)));
constexpr int BM = 256, BK = 64, HALF = 128, HTB = HALF * BK * 2  , STAGE_BYTES = 8 * HTB, NXCD = 8, WGM = 8;

__host__ __device__ __forceinline__ int lds_byte(int r, int c) { const int st = (r >> 4) * 2 + (c >> 5), rr = r & 15, cc = c & 31, ob = rr * 64 + cc * 2; return st * 1024 + (ob ^ (((ob >> 9) & 1) << 5)); }
__host__ __device__ __forceinline__ void stage_rc(int b, int& R, int& C) { const int st = b / 1024, sb = b % 1024, swz = sb ^ (((sb >> 9) & 1) << 5); R = (st >> 1) * 16 + swz / 64; C = (st & 1) * 32 + (swz % 64) / 2; }
__host__ __device__ __forceinline__ int perm32(int rho) { const int n = rho >> 4, i = rho & 15; return 8 * (i >> 2) + 4 * n + (i & 3); }

struct Unit { int pm, pn; };
struct Gemm { const bf16_t* A; const bf16_t* Bt; int M, N, K; };

struct StaticOrder {
    int nM, nN, nwg, G, c;
    __host__ __device__ void init(int M, int N, int G_, int c_) { nM = M / BM; nN = N / BM; nwg = nM * nN; G = G_; c = c_; }
    __host__ __device__ bool next(int i, Unit& u) const {
        const long L = (long)i * G + c; if (L >= nwg) return false;
        int wgid = (int)L; { const int q = nwg / NXCD, r = nwg % NXCD, xcd = wgid % NXCD, off = wgid / NXCD; wgid = (xcd < r ? xcd * (q + 1) : r * (q + 1) + (xcd - r) * q) + off; }
        const int nig = WGM * nN, gid = wgid / nig, fm = gid * WGM, gsz = (nM - fm) < WGM ? (nM - fm) : WGM;
        u.pm = fm + ((wgid % nig) % gsz); u.pn = (wgid % nig) / gsz; return true;
    }
    __device__ __forceinline__ void a_ready(const Unit&) const {}
    __device__ __forceinline__ void done(const Unit&) const {}
};

__device__ __forceinline__ unsigned cvt_pk_bf16(float lo, float hi) { unsigned r; asm volatile("v_cvt_pk_bf16_f32 %0, %1, %2" : "=v"(r) : "v"(lo), "v"(hi)); return r; }
typedef float f32x2 __attribute__((ext_vector_type(2)));
struct EpiStore {
    static constexpr bool PERM = true, AFTER_DRAIN = false;
    bf16_t* O; int ldc;
    __device__ __forceinline__ void operator()(const f32x4 (&acc)[2][2][4][2], const Unit& u, int wr, int wc, int fr, int fq) const {
        const int row0 = u.pm * BM + wr * 64 + fr, col0 = u.pn * BM + wc * 32 + 8 * fq;
#pragma unroll
        for (int ai = 0; ai < 2; ++ai)
#pragma unroll
            for (int m = 0; m < 4; ++m) { bf16_t* rowp = O + (size_t)(row0 + ai * HALF + m * 16) * ldc + col0;
#pragma unroll
                for (int bj = 0; bj < 2; ++bj) { const f32x4 v0 = acc[ai][bj][m][0], v1 = acc[ai][bj][m][1];
                    u32x4 w; w.x = cvt_pk_bf16(v0[0], v0[1]); w.y = cvt_pk_bf16(v0[2], v0[3]); w.z = cvt_pk_bf16(v1[0], v1[1]); w.w = cvt_pk_bf16(v1[2], v1[3]);
                    *(u32x4*)(rowp + bj * HALF) = w; } }
    }
};
__device__ __forceinline__ float swiglu1(float g, float u) { const float e = __builtin_amdgcn_exp2f(g * -1.4426950408889634f); return g * u * __builtin_amdgcn_rcpf(1.0f + e); }
struct EpiSwiglu {
    static constexpr bool PERM = true, AFTER_DRAIN = false;
    bf16_t* O; int ldc;
    __device__ __forceinline__ void operator()(const f32x4 (&acc)[2][2][4][2], const Unit& u, int wr, int wc, int fr, int fq) const {
        const int row0 = u.pm * BM + wr * 64 + fr, col0 = u.pn * HALF + wc * 32 + 8 * fq;
#pragma unroll
        for (int ai = 0; ai < 2; ++ai)
#pragma unroll
            for (int m = 0; m < 4; ++m) { bf16_t* rowp = O + (size_t)(row0 + ai * HALF + m * 16) * ldc + col0;
                const f32x4 g0 = acc[ai][0][m][0], g1 = acc[ai][0][m][1], u0 = acc[ai][1][m][0], u1 = acc[ai][1][m][1];
                u32x4 w;
                w.x = cvt_pk_bf16(swiglu1(g0[0], u0[0]), swiglu1(g0[1], u0[1])); w.y = cvt_pk_bf16(swiglu1(g0[2], u0[2]), swiglu1(g0[3], u0[3]));
                w.z = cvt_pk_bf16(swiglu1(g1[0], u1[0]), swiglu1(g1[1], u1[1])); w.w = cvt_pk_bf16(swiglu1(g1[2], u1[2]), swiglu1(g1[3], u1[3]));
                *(u32x4*)rowp = w; }
    }
};
struct EpiRes {
    static constexpr bool PERM = false, AFTER_DRAIN = false;
    const float* base; float* out; int ldc; const float* gate; int gstride; float coef; int rows_per_batch;
    __device__ __forceinline__ void operator()(const f32x4 (&acc)[2][2][4][2], const Unit& u, int wr, int wc, int fr, int fq) const {
        const int row0 = u.pm * BM + wr * 64 + fr, col0 = u.pn * BM + wc * 32 + 4 * fq;
        const float* gp = gate + (size_t)((u.pm * BM) / rows_per_batch) * gstride + col0;
        f32x4 gv[2][2];
#pragma unroll
        for (int bj = 0; bj < 2; ++bj)
#pragma unroll
            for (int n = 0; n < 2; ++n) gv[bj][n] = *(const f32x4*)(gp + bj * HALF + n * 16) * coef;
#pragma unroll
        for (int ai = 0; ai < 2; ++ai)
#pragma unroll
            for (int m = 0; m < 4; ++m) { const size_t off = (size_t)(row0 + ai * HALF + m * 16) * ldc + col0;
#pragma unroll
                for (int bj = 0; bj < 2; ++bj)
#pragma unroll
                    for (int n = 0; n < 2; ++n) { const f32x4 bs = *(const f32x4*)(base + off + bj * HALF + n * 16); *(f32x4*)(out + off + bj * HALF + n * 16) = bs + gv[bj][n] * acc[ai][bj][m][n]; }
                if (m & 1) asm volatile("" ::: "memory"); }
    }
};
template <class Epi, class Sched, bool ALIGN_EPI = false, bool SP2 = false>
__device__ __forceinline__ void gemm_phase(PG8_LAS unsigned char* lds, const Gemm g, const Sched& S, const Epi& E) {
    int tid_o = threadIdx.x; asm volatile("" : "+v"(tid_o));
    const int tid = tid_o, wid = __builtin_amdgcn_readfirstlane(tid >> 6), lane = tid & 63, wr = wid >> 2, wc = wid & 3, fr = lane & 15, fq = lane >> 4;
    const int K = g.K, nt = K / BK;
    unsigned voffA[2], voffB[2];
#pragma unroll
    for (int i = 0; i < 2; ++i) { int R, C; stage_rc(tid * 16 + i * 8192, R, C); const int Rb = Epi::PERM ? ((R & ~31) + perm32(R & 31)) : R;
        voffA[i] = (unsigned)(R * K + C) * 2u; voffB[i] = (unsigned)(Rb * K + C) * 2u; }
    const size_t kstep = (size_t)(BK * 2);
    const size_t hstep = (size_t)HALF * K * 2;
    const size_t tstep = 2 * hstep;
    const unsigned ldsw = (unsigned)wid * 1024u;
    const int aoff = lds_byte(wr * 64 + fr, fq * 8), boff = lds_byte(wc * 32 + fr, fq * 8);
#define PG8_SA(b, h) (((b) * 2 + (h)) * HTB)
#define PG8_SB(b, h) ((4 + (b) * 2 + (h)) * HTB)
#define PG8_STAGE(bufoff, gbase, voff) do { _Pragma("unroll") for (int _i = 0; _i < 2; ++_i) \
        __builtin_amdgcn_global_load_lds((const unsigned*)((const char*)(gbase) + (voff)[_i]), (PG8_LAS unsigned*)(lds + (bufoff) + ldsw + _i * 8192), 16, 0, 0); } while (0)
#define PG8_LDA(dst, b, h) do { _Pragma("unroll") for (int m = 0; m < 4; ++m) _Pragma("unroll") for (int k = 0; k < 2; ++k) dst[m][k] = *(const PG8_LAS bf16x8*)(lds + PG8_SA(b, h) + aoff + m * 2048 + k * 1024); } while (0)
#define PG8_LDB(dst, b, h) do { _Pragma("unroll") for (int n = 0; n < 2; ++n) _Pragma("unroll") for (int k = 0; k < 2; ++k) dst[n][k] = *(const PG8_LAS bf16x8*)(lds + PG8_SB(b, h) + boff + n * 2048 + k * 1024); } while (0)
#define PG8_MMA(ai, bj, At, Bt) do { __builtin_amdgcn_s_setprio(1); _Pragma("unroll") for (int m = 0; m < 4; ++m) _Pragma("unroll") for (int n = 0; n < 2; ++n) _Pragma("unroll") for (int k = 0; k < 2; ++k) \
        acc[ai][bj][m][n] = __builtin_amdgcn_mfma_f32_16x16x32_bf16(Bt[n][k], At[m][k], acc[ai][bj][m][n], 0, 0, 0); __builtin_amdgcn_s_setprio(0); } while (0)
#define PG8_WAIT_V(n) asm volatile("s_waitcnt vmcnt(" #n ")" ::: "memory")
#define PG8_WAIT_L(n) asm volatile("s_waitcnt lgkmcnt(" #n ")" ::: "memory")
#define PG8_BAR __builtin_amdgcn_s_barrier()
#define PG8_SCHED __builtin_amdgcn_sched_barrier(0)
    Unit cur, nxt; int ui = 0;
    if (!S.next(0, cur)) return;
    f32x4 acc[2][2][4][2];
#pragma unroll
    for (int a = 0; a < 2; ++a)
#pragma unroll
        for (int b = 0; b < 2; ++b)
#pragma unroll
            for (int m = 0; m < 4; ++m)
#pragma unroll
                for (int n = 0; n < 2; ++n) acc[a][b][m][n] = (f32x4){0.f, 0.f, 0.f, 0.f};
    bf16x8 At[4][2], B0[2][2], B1[2][2];
    const char* cA = (const char*)g.A + (size_t)cur.pm * tstep; const char* cB = (const char*)g.Bt + (size_t)cur.pn * tstep;
    S.a_ready(cur);
    if constexpr (SP2) {
        PG8_STAGE(PG8_SB(0, 0), cB, voffB); PG8_STAGE(PG8_SB(0, 1), cB + hstep, voffB); PG8_STAGE(PG8_SA(0, 0), cA, voffA); PG8_STAGE(PG8_SA(0, 1), cA + hstep, voffA);
        if (wr == 1) PG8_BAR;
        PG8_WAIT_V(2); PG8_BAR;
        PG8_STAGE(PG8_SB(1, 0), cB + kstep, voffB); PG8_STAGE(PG8_SA(1, 0), cA + kstep, voffA); PG8_STAGE(PG8_SB(1, 1), cB + hstep + kstep, voffB);
        PG8_WAIT_V(6); PG8_BAR;
    } else {
        PG8_STAGE(PG8_SB(0, 0), cB, voffB); PG8_STAGE(PG8_SA(0, 0), cA, voffA); PG8_STAGE(PG8_SB(0, 1), cB + hstep, voffB); PG8_STAGE(PG8_SA(0, 1), cA + hstep, voffA);
        if (wr == 1) PG8_BAR;
        PG8_WAIT_V(4); PG8_BAR;
        PG8_STAGE(PG8_SB(1, 0), cB + kstep, voffB); PG8_STAGE(PG8_SA(1, 0), cA + kstep, voffA); PG8_STAGE(PG8_SB(1, 1), cB + hstep + kstep, voffB);
        PG8_WAIT_V(6); PG8_BAR;
    }
    for (;;) {
        const bool has_next = S.next(ui + 1, nxt);
        const char* nA = has_next ? (const char*)g.A + (size_t)nxt.pm * tstep : cA; const char* nB = has_next ? (const char*)g.Bt + (size_t)nxt.pn * tstep : cB;
        for (int t = 0; t < nt; t += 2) {
            const bool last = (t == nt - 2);
            const char* a1 = cA + (size_t)(t + 1) * kstep;
            const char* a2 = last ? nA : cA + (size_t)(t + 2) * kstep; const char* b2 = last ? nB : cB + (size_t)(t + 2) * kstep;
            const char* a3 = a2 + kstep; const char* b3 = b2 + kstep;
            if (last && has_next) S.a_ready(nxt);
            if constexpr (SP2) {
            PG8_LDB(B0, 0, 0); PG8_LDB(B1, 0, 1); PG8_SCHED; PG8_LDA(At, 0, 0); PG8_STAGE(PG8_SA(1, 1), a1 + hstep, voffA);
            PG8_WAIT_V(8); PG8_WAIT_L(0); PG8_BAR; PG8_MMA(0, 0, At, B0); PG8_MMA(0, 1, At, B1); PG8_BAR; PG8_SCHED;
            PG8_LDA(At, 0, 1); PG8_STAGE(PG8_SB(0, 0), b2, voffB); PG8_STAGE(PG8_SB(0, 1), b2 + hstep, voffB); PG8_STAGE(PG8_SA(0, 0), a2, voffA);
            PG8_WAIT_V(8); PG8_WAIT_L(0); PG8_BAR; PG8_MMA(1, 0, At, B0); PG8_MMA(1, 1, At, B1); PG8_BAR; PG8_SCHED;
            PG8_LDB(B0, 1, 0); PG8_LDB(B1, 1, 1); PG8_SCHED; PG8_LDA(At, 1, 0); PG8_STAGE(PG8_SA(0, 1), a2 + hstep, voffA);
            PG8_WAIT_V(8); PG8_WAIT_L(0); PG8_BAR; PG8_MMA(0, 0, At, B0); PG8_MMA(0, 1, At, B1); PG8_BAR; PG8_SCHED;
            PG8_LDA(At, 1, 1); PG8_STAGE(PG8_SB(1, 0), b3, voffB); PG8_STAGE(PG8_SB(1, 1), b3 + hstep, voffB); PG8_STAGE(PG8_SA(1, 0), a3, voffA);
            PG8_WAIT_V(8); PG8_WAIT_L(0); PG8_BAR; PG8_MMA(1, 0, At, B0); PG8_MMA(1, 1, At, B1); PG8_BAR; PG8_SCHED;
            } else {
            PG8_LDB(B0, 0, 0); PG8_SCHED; PG8_LDA(At, 0, 0); PG8_STAGE(PG8_SA(1, 1), a1 + hstep, voffA);
            PG8_WAIT_L(8); PG8_BAR; PG8_WAIT_L(0); PG8_MMA(0, 0, At, B0); PG8_BAR; PG8_SCHED;
            PG8_LDB(B1, 0, 1); PG8_STAGE(PG8_SB(0, 0), b2, voffB);
            PG8_BAR; PG8_WAIT_L(0); PG8_MMA(0, 1, At, B1); PG8_BAR;
            PG8_LDA(At, 0, 1); PG8_STAGE(PG8_SA(0, 0), a2, voffA);
            PG8_BAR; PG8_WAIT_L(0); PG8_MMA(1, 0, At, B0); PG8_BAR; PG8_SCHED;
            PG8_STAGE(PG8_SB(0, 1), b2 + hstep, voffB);
            PG8_WAIT_V(6); PG8_BAR; PG8_MMA(1, 1, At, B1); PG8_BAR;
            PG8_LDB(B0, 1, 0); PG8_SCHED; PG8_LDA(At, 1, 0); PG8_STAGE(PG8_SA(0, 1), a2 + hstep, voffA);
            PG8_WAIT_L(8); PG8_BAR; PG8_WAIT_L(0); PG8_MMA(0, 0, At, B0); PG8_BAR; PG8_SCHED;
            PG8_LDB(B1, 1, 1); PG8_STAGE(PG8_SB(1, 0), b3, voffB);
            PG8_BAR; PG8_WAIT_L(0); PG8_MMA(0, 1, At, B1); PG8_BAR;
            PG8_LDA(At, 1, 1); PG8_STAGE(PG8_SA(1, 0), a3, voffA);
            PG8_BAR; PG8_WAIT_L(0); PG8_MMA(1, 0, At, B0); PG8_BAR; PG8_SCHED;
            PG8_STAGE(PG8_SB(1, 1), b3 + hstep, voffB);
            PG8_WAIT_V(6); PG8_BAR; PG8_MMA(1, 1, At, B1); PG8_BAR;
            }
        }
        if constexpr (ALIGN_EPI) { if (wr == 0) PG8_BAR; }
        if constexpr (!Epi::AFTER_DRAIN) { E(acc, cur, wr, wc, fr, fq); S.done(cur); }
        if (!has_next) break;
#pragma unroll
        for (int a = 0; a < 2; ++a)
#pragma unroll
            for (int b = 0; b < 2; ++b)
#pragma unroll
                for (int m = 0; m < 4; ++m)
#pragma unroll
                    for (int n = 0; n < 2; ++n) acc[a][b][m][n] = (f32x4){0.f, 0.f, 0.f, 0.f};
        cur = nxt; cA = nA; cB = nB; ++ui;
        if constexpr (ALIGN_EPI) { if (wr == 1) PG8_BAR; }
    }
    PG8_WAIT_V(0);
    if constexpr (!ALIGN_EPI) { if (wr == 0) PG8_BAR; }
    PG8_BAR;
    if constexpr (Epi::AFTER_DRAIN) { E.fused(acc, cur, wr, wc, fr, fq, lds, wid, lane); S.done(cur); }
#undef PG8_SA
#undef PG8_SB
#undef PG8_STAGE
#undef PG8_LDA
#undef PG8_LDB
#undef PG8_MMA
#undef PG8_WAIT_V
#undef PG8_WAIT_L
#undef PG8_BAR
#undef PG8_SCHED
}
}
#define GAS __attribute__((address_space(1)))
#define LAS __attribute__((address_space(3)))
typedef unsigned short bf16;
typedef unsigned v4u __attribute__((ext_vector_type(4)));
typedef float f32x4 __attribute__((ext_vector_type(4)));
typedef short bf16x8 __attribute__((ext_vector_type(8)));
typedef GAS unsigned gu32;
typedef GAS unsigned long long gu64;
#define RLX_AGENT __ATOMIC_RELAXED, __HIP_MEMORY_SCOPE_AGENT
#define LDS_WAIT() asm volatile("s_waitcnt lgkmcnt(0)" ::: "memory")
#define VM_WAIT() asm volatile("s_waitcnt vmcnt(0)" ::: "memory")
__device__ __forceinline__ unsigned long long rt() { return __builtin_amdgcn_s_memrealtime(); }
__device__ __forceinline__ unsigned f2bf(float f) { unsigned u = __builtin_bit_cast(unsigned, f); return (u + 0x7fffu + ((u >> 16) & 1u)) >> 16; }
__device__ __forceinline__ unsigned pk2(float lo, float hi) { return f2bf(lo) | (f2bf(hi) << 16); }
#define XB_TMO      128
#define XB_XCNT(j)  (256  + 64 * (j))
#define XB_XSUB(j)  (1280 + 64 * (j))
#define XB_XGEN(j)  (2304 + 64 * (j))
#define XB_TOP      3328
#define XB_TOPGEN   3392
#define XCD_BAR_WORDS 3456
#define XB_SPIN_CAP (1u << 18)

__device__ __forceinline__ unsigned xb_ld(unsigned* p)              { return __hip_atomic_load(p, __ATOMIC_RELAXED, __HIP_MEMORY_SCOPE_AGENT); }
__device__ __forceinline__ unsigned xb_add(unsigned* p, unsigned v) { return __hip_atomic_fetch_add(p, v, __ATOMIC_RELAXED, __HIP_MEMORY_SCOPE_AGENT); }
__device__ __forceinline__ unsigned xb_xcc_id() { return (unsigned)__builtin_amdgcn_s_getreg((3 << 11) | 20) & 0xFu; }
#define XB_SPIN(cond, bar) do { unsigned _sp = 0; while (cond) { __builtin_amdgcn_s_sleep(1); \
    if ((++_sp & 255u) == 0u) { if (xb_ld(&(bar)[XB_TMO])) break; if (_sp > XB_SPIN_CAP) { atomicAdd(&(bar)[XB_TMO], 1u); break; } } } } while (0)

struct XcdBarrier {
    unsigned* bar; unsigned x;
    volatile LAS unsigned* st;
};

__device__ __forceinline__ XcdBarrier xcd_barrier_post(unsigned* bar, volatile LAS unsigned* st) {
    XcdBarrier b; b.bar = bar; b.x = xb_xcc_id(); b.st = st;
    if (threadIdx.x == 0) (void)xb_add(&bar[XB_XCNT(b.x)], 1u);
    return b;
}
__device__ __forceinline__ void xcd_barrier_complete(unsigned* bar, unsigned x, unsigned& nloc, unsigned& nx) {
    const unsigned G = gridDim.x * gridDim.y * gridDim.z;
    unsigned sum, cnt, mine, sp = 0u;
    for (;;) {
        sum = 0u; cnt = 0u; mine = 0u;
#pragma unroll
        for (unsigned j = 0; j < 16; ++j) { const unsigned c = xb_ld(&bar[XB_XCNT(j)]); sum += c; cnt += (c > 0u) ? 1u : 0u; mine = (j == x) ? c : mine; }
        if (sum == G) break;
        __builtin_amdgcn_s_sleep(1);
        if ((++sp & 255u) == 0u) { if (xb_ld(&bar[XB_TMO])) break; if (sp > XB_SPIN_CAP) { atomicAdd(&bar[XB_TMO], 1u); break; } }
    }
    nloc = mine > 0u ? mine : 1u; nx = cnt > 0u ? cnt : 1u;
}

__device__ __forceinline__ void xcd_barrier(const XcdBarrier& b) {
    asm volatile("s_waitcnt vmcnt(0)" ::: "memory");
    __syncthreads();
    if (threadIdx.x == 0) {
        unsigned* bar = b.bar;
        __builtin_amdgcn_s_waitcnt(0);
        unsigned nloc = b.st[0], nx = b.st[1];
        if (nloc == 0u) { xcd_barrier_complete(bar, b.x, nloc, nx); b.st[0] = nloc; b.st[1] = nx; }
        const unsigned old = xb_add(&bar[XB_XSUB(b.x)], 1u);
        const unsigned gen = old / nloc;
        if (old + 1u == (gen + 1u) * nloc) {
            __builtin_amdgcn_fence(__ATOMIC_RELEASE, "agent");
            asm volatile("s_waitcnt vmcnt(0)" ::: "memory");
            const unsigned og = xb_add(&bar[XB_TOP], 1u);
            const unsigned tg = og / nx;
            if (og + 1u == (tg + 1u) * nx) xb_add(&bar[XB_TOPGEN], 1u);
            else XB_SPIN(xb_ld(&bar[XB_TOPGEN]) == tg, bar);
            __builtin_amdgcn_fence(__ATOMIC_ACQUIRE, "agent");
            xb_add(&bar[XB_XGEN(b.x)], 1u);
            asm volatile("s_waitcnt vmcnt(0)" ::: "memory");
        } else {
            XB_SPIN(xb_ld(&bar[XB_XGEN(b.x)]) == gen, bar);
            __builtin_amdgcn_fence(__ATOMIC_ACQUIRE, "agent");
            asm volatile("s_waitcnt vmcnt(0)" ::: "memory");
        }
    }
    __syncthreads();
}
namespace att {
using bf16x8 = __attribute__((ext_vector_type(8))) short;
using s16x4  = __attribute__((ext_vector_type(4))) short;
using f32x16 = __attribute__((ext_vector_type(16))) float;
using u32x4  = __attribute__((ext_vector_type(4))) unsigned;
constexpr int SEQ_ = 8192, LDQ = 6144; constexpr size_t SHM_V = 16384, SHM_K = 16384;
#define KSWZ(row, colB) ((row) * 256 + ((colB) ^ (((row) & 7) << 4)))
#define SBAR() __builtin_amdgcn_sched_barrier(0)
__device__ __forceinline__ int crow(int r, int hi) { return (r & 3) + 8 * (r >> 2) + 4 * hi; }
__device__ __forceinline__ unsigned cvtpk(float lo, float hi) {
  unsigned r; asm volatile("v_cvt_pk_bf16_f32 %0, %1, %2" : "=v"(r) : "v"(lo), "v"(hi)); return r;
}
__device__ __forceinline__ void qkt(f32x16& p0, f32x16& p1, const bf16* Ks, const bf16x8* qr, int r32, int hi, int jmap, float dbase, float nslope2, float negm) {
#pragma unroll
  for (int r = 0; r < 16; ++r) { const float d = (float)((r & 3) + 8 * (r >> 2)) + dbase;
    p0[r] = fmaf(nslope2, fabsf(d), negm); p1[r] = fmaf(nslope2, fabsf(d + 32.f), negm); }
#pragma unroll
  for (int d0 = 0; d0 < 4; ++d0) { const int cb = (jmap * 64 + d0 * 16 + hi * 8) * 2;
    bf16x8 b0 = *reinterpret_cast<const bf16x8*>((const char*)Ks + KSWZ(r32, cb));
    bf16x8 b1 = *reinterpret_cast<const bf16x8*>((const char*)Ks + KSWZ(32 + r32, cb));
    p0 = __builtin_amdgcn_mfma_f32_32x32x16_bf16(b0, qr[d0], p0, 0, 0, 0);
    p1 = __builtin_amdgcn_mfma_f32_32x32x16_bf16(b1, qr[d0], p1, 0, 0, 0); }
}
constexpr float ATT_THR = 8.f;
__device__ __forceinline__ void partialSM(f32x16& p0, f32x16& p1, float& m_ref, float& alpha, bool first) {
  float pmax = p0[0];
#pragma unroll
  for (int r = 1; r < 16; ++r) pmax = fmaxf(pmax, p0[r]);
#pragma unroll
  for (int r = 0; r < 16; ++r) pmax = fmaxf(pmax, p1[r]);
  { auto rr = __builtin_amdgcn_permlane32_swap(__float_as_uint(pmax), __float_as_uint(pmax), false, false);
    pmax = fmaxf(__uint_as_float(rr[0]), __uint_as_float(rr[1])); }
  if (!first && __all(pmax <= ATT_THR)) { alpha = 1.f; }
  else { const float dl = first ? pmax : fmaxf(pmax, 0.f); m_ref += dl; alpha = first ? 1.f : __builtin_amdgcn_exp2f(-dl);
#pragma unroll
    for (int r = 0; r < 16; ++r) { p0[r] -= dl; p1[r] -= dl; } }
#pragma unroll
  for (int r = 0; r < 16; ++r) p0[r] = __builtin_amdgcn_exp2f(p0[r]);
}
__device__ __forceinline__ void finishSM(f32x16& p0, f32x16& p1, float alpha, float& l_reg, bf16x8& pa0, bf16x8& pa1, bf16x8& pa2, bf16x8& pa3) {
  for (int r = 0; r < 16; ++r) p1[r] = __builtin_amdgcn_exp2f(p1[r]);
  float ps = 0; for (int r = 0; r < 16; ++r) ps += p0[r]; for (int r = 0; r < 16; ++r) ps += p1[r];
  { auto rr = __builtin_amdgcn_permlane32_swap(__float_as_uint(ps), __float_as_uint(ps), false, false);
    ps = __uint_as_float(rr[0]) + __uint_as_float(rr[1]); }
  l_reg = l_reg * alpha + ps;
#define PK4(P, BASE, OUT) do { unsigned a0 = cvtpk(P[BASE + 0], P[BASE + 1]), a1 = cvtpk(P[BASE + 2], P[BASE + 3]);   \
    unsigned b0 = cvtpk(P[BASE + 4], P[BASE + 5]), b1 = cvtpk(P[BASE + 6], P[BASE + 7]);                              \
    auto r0 = __builtin_amdgcn_permlane32_swap(a0, b0, false, false); auto r1 = __builtin_amdgcn_permlane32_swap(a1, b1, false, false); \
    u32x4 w = {r0[0], r1[0], r0[1], r1[1]}; OUT = *reinterpret_cast<bf16x8*>(&w); } while (0)
  PK4(p0, 0, pa0); PK4(p0, 8, pa1); PK4(p1, 0, pa2); PK4(p1, 8, pa3);
#undef PK4
}
__device__ __forceinline__ int v_st(int k, int c) { const int kk = (k & ~0xC) | ((k & 4) << 1) | ((k & 8) >> 1); return ((kk >> 3) * 4 + (c >> 5)) * 512 + ((kk & 7) * 32 + (c & 31)) * 2; }
__device__ __forceinline__ int v_rd_base(int lane) { return ((lane & 3) << 3) | (((lane >> 2) & 3) << 6) | (((lane >> 4) & 1) << 5) | (((lane >> 5) & 1) << 8); }
constexpr int v_rd_off(int d0, int ks, int half) { return d0 * 512 + ks * 4096 + half * 2048; }
template <int OFF> __device__ __forceinline__ s16x4 tr_read(int vb) {
  s16x4 r; asm volatile("ds_read_b64_tr_b16 %0, %1 offset:%2" : "=&v"(r) : "v"(vb), "i"(OFF) : "memory"); return r;
}
template <int D0> __device__ __forceinline__ void pv_one(f32x16& od, int vb, bf16x8 pa0, bf16x8 pa1, bf16x8 pa2, bf16x8 pa3) {
  const s16x4 l0 = tr_read<v_rd_off(D0, 0, 0)>(vb), h0 = tr_read<v_rd_off(D0, 0, 1)>(vb), l1 = tr_read<v_rd_off(D0, 1, 0)>(vb), h1 = tr_read<v_rd_off(D0, 1, 1)>(vb);
  const s16x4 l2 = tr_read<v_rd_off(D0, 2, 0)>(vb), h2 = tr_read<v_rd_off(D0, 2, 1)>(vb), l3 = tr_read<v_rd_off(D0, 3, 0)>(vb), h3 = tr_read<v_rd_off(D0, 3, 1)>(vb);
  asm volatile("s_waitcnt lgkmcnt(0)" ::: "memory"); SBAR();
#define PK(L, H) (bf16x8){L[0], L[1], L[2], L[3], H[0], H[1], H[2], H[3]}
  od = __builtin_amdgcn_mfma_f32_32x32x16_bf16(pa0, PK(l0, h0), od, 0, 0, 0);
  od = __builtin_amdgcn_mfma_f32_32x32x16_bf16(pa1, PK(l1, h1), od, 0, 0, 0);
  od = __builtin_amdgcn_mfma_f32_32x32x16_bf16(pa2, PK(l2, h2), od, 0, 0, 0);
  od = __builtin_amdgcn_mfma_f32_32x32x16_bf16(pa3, PK(l3, h3), od, 0, 0, 0);
#undef PK
}
__device__ __forceinline__ void pv_d0(f32x16* o, int vb, bf16x8 pa0, bf16x8 pa1, bf16x8 pa2, bf16x8 pa3) {
  pv_one<0>(o[0], vb, pa0, pa1, pa2, pa3); pv_one<1>(o[1], vb, pa0, pa1, pa2, pa3); pv_one<2>(o[2], vb, pa0, pa1, pa2, pa3); pv_one<3>(o[3], vb, pa0, pa1, pa2, pa3);
}
__device__ __forceinline__ void attn_unit(int b, int h, int qb, const bf16* __restrict__ QKV, bf16* __restrict__ OB, float lam, float omli, float slope2, const float* __restrict__ subg, char* lds) {
  int tid_o = threadIdx.x; asm volatile("" : "+v"(tid_o));
  const int tid = tid_o, wid = __builtin_amdgcn_readfirstlane(tid >> 6), lane = tid & 63, r32 = lane & 31, hi = lane >> 5;
  const int jmap = wid >> 2, wq = wid & 3;
  bf16* V_lds = (bf16*)lds; bf16* K_lds = (bf16*)(lds + 2 * SHM_V);
  float* ws = (float*)(lds + 2 * SHM_V + 2 * SHM_K) + wid * 64; float* li_l = ws; float* al_l = ws + 32;
  const long rowbase = (long)b * SEQ_; const int q0 = qb * 128 + wq * 32;
  float m_ref = 0.f, l_reg = 0.f; f32x16 o[4] = {}; bf16x8 qr[4];
  const bf16* Qw = QKV + (rowbase + q0 + r32) * LDQ + h * 128 + jmap * 64 + hi * 8;
#pragma unroll
  for (int d0 = 0; d0 < 4; ++d0) qr[d0] = *reinterpret_cast<const bf16x8*>(Qw + d0 * 16);
  const char* KVmid = (const char*)(QKV + rowbase * LDQ + 2048 + h * 128 + 1024);
  const int sr = tid >> 4, sc = (tid & 15) * 8, vst0 = v_st(sr, sc), vst1 = v_st(32 + sr, sc);
  const unsigned so0 = (unsigned)(sr * LDQ + sc) * 2u, so1 = so0 + 32u * LDQ * 2u;
  const int vb0 = (int)(uintptr_t)V_lds + v_rd_base(lane);
  struct { bf16x8 vs0, vs1, ks0, ks1; } sr_[2];
#define SLOAD(i, k0) do { const char* t_ = KVmid + (size_t)(k0) * (LDQ * 2); \
    sr_[i].vs0 = *reinterpret_cast<const bf16x8*>(t_ + so0 + 2048); sr_[i].vs1 = *reinterpret_cast<const bf16x8*>(t_ + so1 + 2048); \
    sr_[i].ks0 = *reinterpret_cast<const bf16x8*>(t_ + so0 - 2048); sr_[i].ks1 = *reinterpret_cast<const bf16x8*>(t_ + so1 - 2048); } while (0)
#define SWRITE(bb, i) do { *(bf16x8*)((char*)V_lds + (bb) * SHM_V + vst0) = sr_[i].vs0;          \
    *(bf16x8*)((char*)V_lds + (bb) * SHM_V + vst1) = sr_[i].vs1; int kc = sc * 2;               \
    *(bf16x8*)((char*)K_lds + (bb) * SHM_K + KSWZ(sr, kc)) = sr_[i].ks0;                       \
    *(bf16x8*)((char*)K_lds + (bb) * SHM_K + KSWZ(32 + sr, kc)) = sr_[i].ks1; } while (0)
#define SWAIT() asm volatile("s_waitcnt vmcnt(4)" ::: "memory")
#define RESC(a) do { if (__any((a) < 1.f)) { if (hi == 0) al_l[r32] = (a); asm volatile("s_waitcnt lgkmcnt(0)" ::: "memory"); \
    _Pragma("unroll") for (int d = 0; d < 4; ++d) _Pragma("unroll") for (int r = 0; r < 16; ++r) o[d][r] *= al_l[crow(r, hi)]; } } while (0)
  f32x16 pA0, pA1, pB0, pB1; float alA, alB; bf16x8 pa0, pa1, pa2, pa3;
  const int NT = 2 * qb + 2, cq = 2 * qb + (wq >> 1);
  const float nslope2 = -slope2, dq = (float)(4 * hi - (q0 + r32));
#define QKT(P0, P1, KB, t) qkt(P0, P1, KB, qr, r32, hi, jmap, (float)(64 * (t)) + dq, nslope2, ((t) > cq) ? -1e30f : -m_ref)
  constexpr int SE = 0, SO = 1;
  SLOAD(SE, 0); asm volatile("s_waitcnt vmcnt(0)" ::: "memory"); SWRITE(0, SE); __syncthreads();
  QKT(pA0, pA1, K_lds, 0); partialSM(pA0, pA1, m_ref, alA, true);
  SLOAD(SO, 64); if (2 < NT) SLOAD(SE, 128);
  SWAIT(); SWRITE(1, SO); __syncthreads();
  for (int j = 1; j + 1 < NT; j += 2) {
    SBAR(); QKT(pB0, pB1, (bf16*)((char*)K_lds + SHM_K), j);
    finishSM(pA0, pA1, alA, l_reg, pa0, pa1, pa2, pa3); SBAR();
    SLOAD(SO, (j + 2) * 64); SBAR();
    pv_d0(o, vb0, pa0, pa1, pa2, pa3); partialSM(pB0, pB1, m_ref, alB, false);
    __syncthreads(); SWAIT(); SWRITE(0, SE);
    RESC(alB); __syncthreads();
    SBAR(); QKT(pA0, pA1, K_lds, j + 1);
    finishSM(pB0, pB1, alB, l_reg, pa0, pa1, pa2, pa3); SBAR();
    if (j + 3 < NT) SLOAD(SE, (j + 3) * 64); SBAR();
    pv_d0(o, vb0 + (int)SHM_V, pa0, pa1, pa2, pa3); partialSM(pA0, pA1, m_ref, alA, false);
    __syncthreads(); SWAIT(); SWRITE(1, SO);
    RESC(alA); __syncthreads();
  }
  SBAR(); QKT(pB0, pB1, (bf16*)((char*)K_lds + SHM_K), NT - 1);
  finishSM(pA0, pA1, alA, l_reg, pa0, pa1, pa2, pa3); SBAR();
  pv_d0(o, vb0, pa0, pa1, pa2, pa3); partialSM(pB0, pB1, m_ref, alB, false);
  __syncthreads(); RESC(alB);
  finishSM(pB0, pB1, alB, l_reg, pa0, pa1, pa2, pa3); SBAR();
  pv_d0(o, vb0 + (int)SHM_V, pa0, pa1, pa2, pa3);
  if (hi == 0) li_l[r32] = l_reg; asm volatile("s_waitcnt lgkmcnt(0)" ::: "memory");
#pragma unroll
  for (int r = 0; r < 16; ++r) { const float rl = __builtin_amdgcn_rcpf(li_l[crow(r, hi)]);
#pragma unroll
    for (int d0 = 0; d0 < 4; ++d0) o[d0][r] *= rl; }
  float* xch = (float*)lds + (size_t)wq * 4096 + lane;
  __syncthreads();
  if (jmap == 1) {
#pragma unroll
    for (int d0 = 0; d0 < 4; ++d0)
#pragma unroll
      for (int r = 0; r < 16; ++r) xch[(d0 * 16 + r) * 64] = o[d0][r];
  }
  __syncthreads();
  if (jmap == 0) {
    float ss[16];
#pragma unroll
    for (int r = 0; r < 16; ++r) { float s = 0.f;
#pragma unroll
      for (int d0 = 0; d0 < 4; ++d0) { const float df = o[d0][r] - lam * xch[(d0 * 16 + r) * 64]; o[d0][r] = df; s += df * df; }
      ss[r] = s; }
#pragma unroll
    for (int r = 0; r < 16; ++r) { float s = ss[r]; s += __shfl_xor(s, 1); s += __shfl_xor(s, 2); s += __shfl_xor(s, 4); s += __shfl_xor(s, 8); s += __shfl_xor(s, 16);
      ss[r] = rsqrtf(s * (1.0f / 128.0f) + 1e-6f) * omli; }
    float gs[4]; int r32o = r32; asm volatile("" : "+v"(r32o));
#pragma unroll
    for (int d0 = 0; d0 < 4; ++d0) gs[d0] = subg[d0 * 32 + r32o];
    unsigned ooff = (unsigned)((q0 + 4 * hi) * 2048 + r32); asm volatile("" : "+v"(ooff));
    bf16* Ow = OB + rowbase * 2048 + h * 128 + ooff;
#pragma unroll
    for (int r = 0; r < 16; ++r) { const int orow = (r & 3) + 8 * (r >> 2);
#pragma unroll
      for (int d0 = 0; d0 < 4; ++d0) Ow[orow * 2048 + d0 * 32] = (bf16)f2bf(o[d0][r] * ss[r] * gs[d0]); }
  }
  __syncthreads();
#undef SLOAD
#undef SWRITE
#undef SWAIT
#undef RESC
#undef QKT
}
#undef KSWZ
#undef SBAR
}
constexpr int DM = 2048, NB = 4, SEQ = 8192, MT = NB * SEQ, FF = 5632, NLAYER = 4, NH = 16, NMOD = 9 * DM;
constexpr float RMS_EPS = 1e-6f;
constexpr int NWAVES = 8;
#ifndef MK_PER_PHASE
#define MK_PER_PHASE 0
#endif
constexpr int N_PHASES = 45;
constexpr size_t MiB = 1u << 20;
constexpr size_t WS_CTL = 0, CTL_ZERO_BYTES = 1 * MiB;
constexpr size_t WS_MOD = 1 * MiB;
constexpr size_t WS_EBL = 3 * MiB;
constexpr size_t WS_WGU = 8 * MiB;
constexpr size_t WS_WD  = 360 * MiB;
constexpr size_t WS_WAI = 536 * MiB;
constexpr size_t WS_WAO = 584 * MiB;
constexpr size_t WS_WCI = 600 * MiB, WS_WCO = 624 * MiB;
constexpr size_t WS_WHI = 632 * MiB, WS_WHO = 664 * MiB;
constexpr size_t WS_XN  = 672 * MiB;
constexpr size_t WS_BIG = 800 * MiB;
constexpr size_t WS_OB  = 1312 * MiB;
constexpr size_t WS_KLT = 1440 * MiB;
constexpr size_t WS_IT  = 1568 * MiB;
constexpr size_t WS_END = 1696 * MiB;
constexpr int CW_BAR = 4096;
constexpr int RING_OFF = 0, RING_BYTES = 131072;
constexpr int LDSCTL_OFF = RING_BYTES, MISC_OFF = LDSCTL_OFF + 320;
constexpr int LDS_BYTES = 147456;

struct Args { const float* in[21]; float* out; unsigned char* ws; int ph_lo, ph_hi; };
struct Frame {
    LAS unsigned char* lds;
    volatile LAS unsigned* MISC;
    gu32* ctl;
    int tid, lane, wave, vcu, G;
    const struct Args* a; float* out; unsigned char* ws;
};
__device__ __forceinline__ float wave_sum(float v) {
#pragma unroll
    for (int o = 1; o < 64; o <<= 1) v += __shfl_xor(v, o);
    return v;
}
__device__ __forceinline__ float bf_lo(unsigned w) { return __uint_as_float(w << 16); }
__device__ __forceinline__ float bf_hi(unsigned w) { return __uint_as_float(w & 0xffff0000u); }
__device__ __forceinline__ float bf_f(bf16 x) { return __uint_as_float((unsigned)x << 16); }

__device__ __forceinline__ void p0_mod(Frame& F) {
    LAS float* cond = (LAS float*)(F.lds);
    LAS float* part = (LAS float*)(F.lds + 32768);
    const float* c = F.a->in[1]; const float* aw = F.a->in[2]; const float* ab = F.a->in[3]; float* mod = (float*)(F.ws + WS_MOD);
    for (int i = F.tid; i < NB * DM; i += NWAVES * 64) { const float v = c[i]; cond[i] = v / (1.0f + __expf(-v)); }
    __syncthreads();
    const int cg = F.tid & 15, ks = F.tid >> 4;
    for (int it = F.vcu; it < NLAYER * (NMOD / 64); it += F.G) {
        const int L = it / (NMOD / 64), n0 = (it % (NMOD / 64)) * 64;
        f32x4 a0 = {0.f, 0.f, 0.f, 0.f}, a1 = a0, a2 = a0, a3 = a0;
        const float* wp = aw + ((size_t)L * DM + ks * 64) * NMOD + n0 + 4 * cg;
#pragma unroll 8
        for (int k = 0; k < 64; ++k) { const f32x4 w = *(const f32x4*)(wp + (size_t)k * NMOD); const int kk = ks * 64 + k;
            a0 += w * cond[kk]; a1 += w * cond[DM + kk]; a2 += w * cond[2 * DM + kk]; a3 += w * cond[3 * DM + kk]; }
        *(LAS f32x4*)(part + (ks * 4 + 0) * 64 + 4 * cg) = a0; *(LAS f32x4*)(part + (ks * 4 + 1) * 64 + 4 * cg) = a1;
        *(LAS f32x4*)(part + (ks * 4 + 2) * 64 + 4 * cg) = a2; *(LAS f32x4*)(part + (ks * 4 + 3) * 64 + 4 * cg) = a3;
        __syncthreads();
        if (F.tid < 256) { const int b = F.tid >> 6, col = F.tid & 63; float s = 0.f;
#pragma unroll 8
            for (int k2 = 0; k2 < 32; ++k2) s += part[(k2 * 4 + b) * 64 + col];
            mod[((size_t)L * NB + b) * NMOD + n0 + col] = s + ab[(size_t)L * NMOD + n0 + col]; }
        __syncthreads();
    }
}
__device__ __forceinline__ void p0_transpose_item(const float* W, int K, int N, bf16* WT, int mode, LAS float* scr, int item, int lane) {
    const int nblk = N / 32, kb = item / nblk, nb = item % nblk, k0 = 64 * kb, n0 = 32 * nb;
    const int drow0 = (mode == 0) ? n0 : ((n0 >> 7) * 256 + (mode - 1) * 128 + (n0 & 127));
#pragma unroll 8
    for (int i = 0; i < 32; ++i) { const int kk = 2 * i + (lane >> 5); scr[kk * 33 + (lane & 31)] = W[(size_t)(k0 + kk) * N + n0 + (lane & 31)]; }
    LDS_WAIT(); asm volatile("" ::: "memory");
    const int c = lane & 7;
#pragma unroll
    for (int j = 0; j < 4; ++j) { const int n = (lane >> 3) + 8 * j; const LAS float* s = scr + (8 * c) * 33 + n;
        v4u o; o.x = pk2(s[0 * 33], s[1 * 33]); o.y = pk2(s[2 * 33], s[3 * 33]); o.z = pk2(s[4 * 33], s[5 * 33]); o.w = pk2(s[6 * 33], s[7 * 33]);
        *(GAS v4u*)(WT + (size_t)(drow0 + n) * K + k0 + 8 * c) = o; }
    LDS_WAIT(); asm volatile("" ::: "memory");
}
__device__ __forceinline__ void p0_convert(Frame& F) {
    LAS float* scr = (LAS float*)(F.lds + RING_OFF + F.wave * 16384);
    const int gw = F.vcu * NWAVES + F.wave, NGW = F.G * NWAVES;
    constexpr int I_FFN = (DM / 64) * (FF / 32);
    constexpr int I_IN3 = (DM / 64) * (3 * DM / 32), I_SQ = (DM / 64) * (DM / 32), I_IN4 = (DM / 64) * (4 * DM / 32);
    constexpr int NITEMS = 24 * I_FFN + 2 * I_IN3 + 2 * I_SQ + I_IN3 + I_SQ + I_IN4 + I_SQ;
    for (int it = gw; it < NITEMS; it += NGW) {
        int r = it;
        if (r < 24 * I_FFN) { const int m = r / I_FFN, ls = m / 3, which = m % 3; r -= m * I_FFN;
            if (which == 0)      p0_transpose_item(F.a->in[5] + (size_t)ls * DM * FF, DM, FF, (bf16*)(F.ws + WS_WGU) + (size_t)ls * 2 * FF * DM, 1, scr, r, F.lane);
            else if (which == 1) p0_transpose_item(F.a->in[6] + (size_t)ls * DM * FF, DM, FF, (bf16*)(F.ws + WS_WGU) + (size_t)ls * 2 * FF * DM, 2, scr, r, F.lane);
            else                 p0_transpose_item(F.a->in[7] + (size_t)ls * FF * DM, FF, DM, (bf16*)(F.ws + WS_WD) + (size_t)ls * DM * FF, 0, scr, r, F.lane);
            continue; }
        r -= 24 * I_FFN;
        if (r < 2 * I_IN3) { const int s = r / I_IN3; p0_transpose_item(F.a->in[8] + (size_t)s * DM * 3 * DM, DM, 3 * DM, (bf16*)(F.ws + WS_WAI) + (size_t)s * 3 * DM * DM, 0, scr, r - s * I_IN3, F.lane); continue; } r -= 2 * I_IN3;
        if (r < 2 * I_SQ) { const int s = r / I_SQ; p0_transpose_item(F.a->in[9] + (size_t)s * DM * DM, DM, DM, (bf16*)(F.ws + WS_WAO) + (size_t)s * DM * DM, 0, scr, r - s * I_SQ, F.lane); continue; } r -= 2 * I_SQ;
        if (r < I_IN3) { p0_transpose_item(F.a->in[14], DM, 3 * DM, (bf16*)(F.ws + WS_WCI), 0, scr, r, F.lane); continue; } r -= I_IN3;
        if (r < I_SQ) { p0_transpose_item(F.a->in[16], DM, DM, (bf16*)(F.ws + WS_WCO), 0, scr, r, F.lane); continue; } r -= I_SQ;
        if (r < I_IN4) { p0_transpose_item(F.a->in[17], DM, 4 * DM, (bf16*)(F.ws + WS_WHI), 0, scr, r, F.lane); continue; } r -= I_IN4;
        p0_transpose_item(F.a->in[18], DM, DM, (bf16*)(F.ws + WS_WHO), 0, scr, r, F.lane);
    }
}
__device__ __forceinline__ void norm_phase(Frame& F, const float* xsrc, const float* g, const float* modL  , int sub) {
    bf16* XN = (bf16*)(F.ws + WS_XN);
    const int gw = F.vcu * NWAVES + F.wave, NGW = F.G * NWAVES;
    for (int r0 = gw * 16; r0 < MT; r0 += NGW * 16) {
        const int b = r0 / SEQ;
        const float* sh = modL + (size_t)b * NMOD + (3 * sub) * DM; const float* sc = sh + DM;
        f32x4 a[8], bb[8];
#pragma unroll
        for (int j = 0; j < 8; ++j) { const int col = 4 * F.lane + 256 * j; const f32x4 gv = *(const f32x4*)(g + col), sv = *(const f32x4*)(sc + col); a[j] = gv * (sv + 1.0f); bb[j] = *(const f32x4*)(sh + col); }
#pragma unroll 2
        for (int r = 0; r < 16; ++r) {
            const GAS f32x4* xr = (const GAS f32x4*)(xsrc + (size_t)(r0 + r) * DM) + F.lane;
            f32x4 v[8]; float s = 0.f;
#pragma unroll
            for (int j = 0; j < 8; ++j) { v[j] = xr[64 * j]; s += (v[j].x * v[j].x + v[j].y * v[j].y) + (v[j].z * v[j].z + v[j].w * v[j].w); }
            const float rstd = rsqrtf(wave_sum(s) * (1.0f / DM) + RMS_EPS);
            GAS unsigned long long* o8 = (GAS unsigned long long*)(XN + (size_t)(r0 + r) * DM) + F.lane;
#pragma unroll
            for (int j = 0; j < 8; ++j) { const f32x4 h = v[j] * rstd * a[j] + bb[j];
                o8[64 * j] = (unsigned long long)pk2(h.x, h.y) | ((unsigned long long)pk2(h.z, h.w) << 32); }
        }
    }
}
__device__ __forceinline__ void qknorm_phase(Frame& F, const float* gq, const float* gk) {
    bf16* QKV = (bf16*)(F.ws + WS_BIG);
    const int gw = F.vcu * NWAVES + F.wave, NGW = F.G * NWAVES;
    const int d = (F.lane & 7) * 8;
    f32x4 q0 = *(const f32x4*)(gq + d) * (0.125f * 1.4426950408889634f), q1 = *(const f32x4*)(gq + d + 4) * (0.125f * 1.4426950408889634f);
    f32x4 k0 = *(const f32x4*)(gk + d), k1 = *(const f32x4*)(gk + d + 4);
    for (int row = gw; row < MT; row += NGW) {
        GAS v4u* p = (GAS v4u*)(QKV + (size_t)row * 6144) + F.lane;
        v4u w[8];
#pragma unroll
        for (int it = 0; it < 8; ++it) w[it] = p[64 * it];
#pragma unroll
        for (int it = 0; it < 8; ++it) {
            f32x4 x0 = {bf_lo(w[it].x), bf_hi(w[it].x), bf_lo(w[it].y), bf_hi(w[it].y)}, x1 = {bf_lo(w[it].z), bf_hi(w[it].z), bf_lo(w[it].w), bf_hi(w[it].w)};
            float ss = (x0.x * x0.x + x0.y * x0.y) + (x0.z * x0.z + x0.w * x0.w) + (x1.x * x1.x + x1.y * x1.y) + (x1.z * x1.z + x1.w * x1.w);
            ss += __shfl_xor(ss, 1); ss += __shfl_xor(ss, 2); ss += __shfl_xor(ss, 4);
            const float rstd = rsqrtf(ss * (1.0f / 64.0f) + RMS_EPS);
            const bool isq = it < 4;
            x0 = x0 * rstd * (isq ? q0 : k0); x1 = x1 * rstd * (isq ? q1 : k1);
            v4u o; o.x = pk2(x0.x, x0.y); o.y = pk2(x0.z, x0.w); o.z = pk2(x1.x, x1.y); o.w = pk2(x1.z, x1.w);
            p[64 * it] = o;
        }
    }
}
__device__ __forceinline__ void attn_phase(Frame& F, int L, int slot) {
    const bf16* QKV = (const bf16*)(F.ws + WS_BIG); bf16* OB = (bf16*)(F.ws + WS_OB);
    const float* lv = F.a->in[12] + (size_t)slot * 4 * 64;
    int ln = F.lane; asm volatile("" : "+v"(ln));
    const float sa = wave_sum(lv[ln] * lv[64 + ln]), sb = wave_sum(lv[128 + ln] * lv[192 + ln]);
    asm volatile("" : "+s"(L));
    const float lambda_init = (L == 0) ? 0.2f : (L == 1) ? 0.35550906f : (L == 2) ? 0.47071302f : 0.55605822f;
    const float lam = expf(sa) - expf(sb) + lambda_init;
    const float* subg = F.a->in[13] + (size_t)slot * 128;
    for (int n = F.vcu; n < NB * NH * (SEQ / 128); n += F.G) {
        const int vc = n & 255, ii = n >> 8, bh = vc >> 2, p = (vc & 3) + 4 * (ii >> 1), qb = (ii & 1) ? 63 - p : p;
        const int h = bh & 15;
        const float slope2 = exp2f(-0.5f * (float)(h + 1)) * 1.4426950408889634f;
        att::attn_unit(bh >> 4, h, qb, QKV, OB, lam, 1.0f - lambda_init, slope2, subg, (char*)(F.lds + RING_OFF));
    }
}
__device__ __forceinline__ void unpack8(const v4u w, float (&x)[8]) { x[0] = bf_lo(w.x); x[1] = bf_hi(w.x); x[2] = bf_lo(w.y); x[3] = bf_hi(w.y); x[4] = bf_lo(w.z); x[5] = bf_hi(w.z); x[6] = bf_lo(w.w); x[7] = bf_hi(w.w); }
__device__ __forceinline__ void conv_phase(Frame& F) {
    const bf16* U = (const bf16*)(F.ws + WS_BIG); bf16* OB = (bf16*)(F.ws + WS_OB); const float* cw = F.a->in[15];
    const int gt = F.vcu * (NWAVES * 64) + F.tid, NT = F.G * NWAVES * 64;
    for (int item = gt; item < 256 * (MT / 16); item += NT) {
        const int dg = item & 255, run = item >> 8, row0 = run * 16, d = dg * 8;
        float w0[8], w1[8], w2[8];
#pragma unroll
        for (int i = 0; i < 8; ++i) { w0[i] = cw[d + i]; w1[i] = cw[DM + d + i]; w2[i] = cw[2 * DM + d + i]; }
        float vm2[8], vm1[8];
        if ((row0 % SEQ) == 0) {
#pragma unroll
            for (int i = 0; i < 8; ++i) { vm2[i] = 0.f; vm1[i] = 0.f; }
        } else {
            float a[8], b[8];
            unpack8(*(const GAS v4u*)(U + (size_t)(row0 - 2) * 6144 + 2048 + d), a); unpack8(*(const GAS v4u*)(U + (size_t)(row0 - 2) * 6144 + 4096 + d), b);
#pragma unroll
            for (int i = 0; i < 8; ++i) vm2[i] = a[i] * b[i];
            unpack8(*(const GAS v4u*)(U + (size_t)(row0 - 1) * 6144 + 2048 + d), a); unpack8(*(const GAS v4u*)(U + (size_t)(row0 - 1) * 6144 + 4096 + d), b);
#pragma unroll
            for (int i = 0; i < 8; ++i) vm1[i] = a[i] * b[i];
        }
#pragma unroll 4
        for (int t = 0; t < 16; ++t) {
            const bf16* rp = U + (size_t)(row0 + t) * 6144 + d;
            float bg[8], cg[8], uu[8], y[8];
            unpack8(*(const GAS v4u*)(rp), bg); unpack8(*(const GAS v4u*)(rp + 2048), cg); unpack8(*(const GAS v4u*)(rp + 4096), uu);
#pragma unroll
            for (int i = 0; i < 8; ++i) { const float v = cg[i] * uu[i]; y[i] = bg[i] * (w0[i] * vm2[i] + w1[i] * vm1[i] + w2[i] * v); vm2[i] = vm1[i]; vm1[i] = v; }
            v4u o; o.x = pk2(y[0], y[1]); o.y = pk2(y[2], y[3]); o.z = pk2(y[4], y[5]); o.w = pk2(y[6], y[7]);
            *(GAS v4u*)(OB + (size_t)(row0 + t) * DM + d) = o;
        }
    }
}
typedef short s16x4 __attribute__((ext_vector_type(4)));
typedef float f32x16 __attribute__((ext_vector_type(16)));
__device__ __forceinline__ int crow16(int r, int hi) { return (r & 3) + 8 * (r >> 2) + 4 * hi; }
constexpr int H_P256 = 272, H_P128 = 144;
__device__ __forceinline__ void hgrn_prep_phase(Frame& F, int layer) {
    bf16* BIG = (bf16*)(F.ws + WS_BIG); bf16* KLT = (bf16*)(F.ws + WS_KLT); bf16* ITG = (bf16*)(F.ws + WS_IT); float* EBL = (float*)(F.ws + WS_EBL); bf16* OB = (bf16*)(F.ws + WS_OB);
    const float* lbl = F.a->in[20];
    LAS unsigned char* QS = F.lds; LAS unsigned char* KS = F.lds + 64 * H_P256; LAS unsigned char* ITL = F.lds + 2 * 64 * H_P256; LAS float* TOT = (LAS float*)(F.lds + 2 * 64 * H_P256 + 128 * H_P128);
    const int kp = F.lane, seg = F.wave, r32 = F.lane & 31, hi = F.lane >> 5;
    for (int unit = F.vcu; unit < NB * NH * (SEQ / 64); unit += F.G) {
        const int bh = unit >> 7, c = unit & 127, b = bh >> 4, h = bh & 15; const size_t rowbase = (size_t)b * SEQ + (size_t)c * 64;
        float lb[2];
#pragma unroll
        for (int kk = 0; kk < 2; ++kk) { const int dch = h * 128 + 2 * kp + kk; const float l0 = lbl[dch], l1 = lbl[DM + dch], l2 = lbl[2 * DM + dch], l3 = lbl[3 * DM + dch];
            const float mx = fmaxf(fmaxf(l0, l1), fmaxf(l2, l3)); const float e0 = __expf(l0 - mx), e1 = __expf(l1 - mx), e2 = __expf(l2 - mx), e3 = __expf(l3 - mx);
            float cumv = 0.f; if (layer >= 1) cumv += e1; if (layer >= 2) cumv += e2; if (layer >= 3) cumv += e3;
            lb[kk] = cumv / (e0 + e1 + e2 + e3); }
        unsigned qw[8], fw[8], iw[8];
#pragma unroll
        for (int tt = 0; tt < 8; ++tt) { const bf16* pq = BIG + (rowbase + 8 * seg + tt) * 8192 + h * 128 + 2 * kp;
            qw[tt] = *(const GAS unsigned*)pq; fw[tt] = *(const GAS unsigned*)(pq + 2048); iw[tt] = *(const GAS unsigned*)(pq + 4096); }
        float bcs[8][2], kv[8][2]; float cum[2] = {0.f, 0.f};
#pragma unroll
        for (int tt = 0; tt < 8; ++tt)
#pragma unroll
            for (int kk = 0; kk < 2; ++kk) { const float x = kk ? bf_hi(fw[tt]) : bf_lo(fw[tt]); const float sig = 1.0f / (1.0f + __expf(-x));
                const float f = lb[kk] + (1.0f - lb[kk]) * sig; cum[kk] += __logf(f); bcs[tt][kk] = cum[kk]; kv[tt][kk] = 1.0f - f; }
        TOT[seg * 128 + 2 * kp] = cum[0]; TOT[seg * 128 + 2 * kp + 1] = cum[1];
        __syncthreads();
        float off[2] = {0.f, 0.f}, rb[2] = {0.f, 0.f}, bl[2] = {0.f, 0.f};
#pragma unroll
        for (int s = 0; s < 8; ++s)
#pragma unroll
            for (int kk = 0; kk < 2; ++kk) { const float tv = TOT[s * 128 + 2 * kp + kk]; if (s < seg) off[kk] += tv; if (s < 4) rb[kk] += tv; bl[kk] += tv; }
        unsigned klw[2][4], itw[2][4];
#pragma unroll
        for (int tt = 0; tt < 8; ++tt) { float qb_[2], qs_[2], ks_[2], kl_[2];
#pragma unroll
            for (int kk = 0; kk < 2; ++kk) { const float bb = bcs[tt][kk] + off[kk]; const float q = kk ? bf_hi(qw[tt]) : bf_lo(qw[tt]);
                qb_[kk] = q * __expf(bb); qs_[kk] = q * __expf(bb - rb[kk]); ks_[kk] = kv[tt][kk] * __expf(rb[kk] - bb); kl_[kk] = kv[tt][kk] * __expf(bl[kk] - bb); }
            *(GAS unsigned*)(BIG + (rowbase + 8 * seg + tt) * 8192 + h * 128 + 2 * kp) = pk2(qb_[0], qb_[1]);
            *(LAS unsigned*)(QS + (8 * seg + tt) * H_P256 + 4 * kp) = pk2(qs_[0], qs_[1]);
            *(LAS unsigned*)(KS + (8 * seg + tt) * H_P256 + 4 * kp) = pk2(ks_[0], ks_[1]);
            if (tt & 1) { klw[0][tt >> 1] |= f2bf(kl_[0]) << 16; klw[1][tt >> 1] |= f2bf(kl_[1]) << 16; itw[0][tt >> 1] |= (iw[tt] & 0xffffu) << 16; itw[1][tt >> 1] |= (iw[tt] >> 16) << 16; }
            else { klw[0][tt >> 1] = f2bf(kl_[0]); klw[1][tt >> 1] = f2bf(kl_[1]); itw[0][tt >> 1] = iw[tt] & 0xffffu; itw[1][tt >> 1] = iw[tt] >> 16; }
        }
#pragma unroll
        for (int kk = 0; kk < 2; ++kk) { const v4u kw = {klw[kk][0], klw[kk][1], klw[kk][2], klw[kk][3]}, tw = {itw[kk][0], itw[kk][1], itw[kk][2], itw[kk][3]};
            *(GAS v4u*)(KLT + (size_t)unit * 8192 + (2 * kp + kk) * 64 + 8 * seg) = kw;
            *(GAS v4u*)(ITG + (size_t)unit * 8192 + (2 * kp + kk) * 64 + 8 * seg) = tw;
            *(LAS v4u*)(ITL + (2 * kp + kk) * H_P128 + 16 * seg) = tw; }
        if (seg == 0) { EBL[(size_t)unit * 128 + 2 * kp] = __expf(bl[0]); EBL[(size_t)unit * 128 + 2 * kp + 1] = __expf(bl[1]); }
        __syncthreads();
        const int tt_ = F.wave & 1, vt = F.wave >> 1;
        f32x16 z = {};
        for (int st = 0; st <= tt_; ++st) {
            f32x16 x = {};
#pragma unroll
            for (int step = 0; step < 8; ++step) { const bf16x8 a = *(const LAS bf16x8*)(KS + (32 * st + r32) * H_P256 + (16 * step + 8 * hi) * 2);
                const bf16x8 bq = *(const LAS bf16x8*)(QS + (32 * tt_ + r32) * H_P256 + (16 * step + 8 * hi) * 2);
                x = __builtin_amdgcn_mfma_f32_32x32x16_bf16(a, bq, x, 0, 0, 0); }
            if (st == tt_) {
#pragma unroll
                for (int r = 0; r < 16; ++r) if (crow16(r, hi) > r32) x[r] = 0.f;
            }
#pragma unroll
            for (int sp = 0; sp < 2; ++sp) {
                v4u pw; pw.x = pk2(x[8 * sp + 0], x[8 * sp + 1]); pw.y = pk2(x[8 * sp + 2], x[8 * sp + 3]); pw.z = pk2(x[8 * sp + 4], x[8 * sp + 5]); pw.w = pk2(x[8 * sp + 6], x[8 * sp + 7]);
                const bf16x8 xs = __builtin_bit_cast(bf16x8, pw);
                const LAS unsigned char* ip = ITL + (32 * vt + r32) * H_P128 + (32 * st + 16 * sp + 4 * hi) * 2;
                const s16x4 lo = *(const LAS s16x4*)ip, hh = *(const LAS s16x4*)(ip + 16);
                const bf16x8 pb = __builtin_shufflevector(lo, hh, 0, 1, 2, 3, 4, 5, 6, 7);
                z = __builtin_amdgcn_mfma_f32_32x32x16_bf16(xs, pb, z, 0, 0, 0);
            }
        }
        bf16* op = OB + (rowbase + 32 * tt_) * DM + h * 128 + 32 * vt + r32;
#pragma unroll
        for (int r = 0; r < 16; ++r) op[(size_t)crow16(r, hi) * DM] = (bf16)f2bf(z[r]);
        __syncthreads();
    }
}
__device__ __forceinline__ void hgrn_scan_phase(Frame& F) {
    if (blockIdx.x >= NB * NH) return;
    const int bh = blockIdx.x, b = bh >> 4, h = bh & 15;
    const bf16* BIG = (const bf16*)(F.ws + WS_BIG); const bf16* KLT = (const bf16*)(F.ws + WS_KLT); const bf16* ITG = (const bf16*)(F.ws + WS_IT); const float* EBL = (const float*)(F.ws + WS_EBL); bf16* OB = (bf16*)(F.ws + WS_OB);
    LAS unsigned char* QBL = F.lds; LAS unsigned char* KLL = F.lds + 64 * H_P256; LAS unsigned char* ITL = KLL + 128 * H_P128; LAS unsigned char* STL = ITL + 128 * H_P128; LAS float* EBLL = (LAS float*)(STL + 128 * H_P256);
    const int tid = F.tid, r32 = F.lane & 31, hi = F.lane >> 5, w = F.wave;
    const int kt = w & 3, vt0 = 2 * (w >> 2);
    const int itt = w & 1, ivt = w >> 1;
    f32x16 acc0 = {}, acc1 = {};
    for (int i = tid; i < 128 * H_P256 / 16; i += NWAVES * 64) *(LAS v4u*)(STL + 16 * i) = (v4u){0u, 0u, 0u, 0u};
    v4u pq[2], pk[2], pi[2]; f32x4 pe = {0.f, 0.f, 0.f, 0.f};
#define H2_LOAD(c) do { const size_t rb_ = (size_t)b * SEQ + (size_t)(c) * 64; const size_t un_ = (size_t)bh * 128 + (c); \
        _Pragma("unroll") for (int i_ = 0; i_ < 2; ++i_) { const int p_ = tid + 512 * i_; \
            pq[i_] = *(const GAS v4u*)(BIG + (rb_ + (p_ >> 4)) * 8192 + h * 128 + (p_ & 15) * 8); \
            pk[i_] = *(const GAS v4u*)(KLT + un_ * 8192 + (size_t)p_ * 8); pi[i_] = *(const GAS v4u*)(ITG + un_ * 8192 + (size_t)p_ * 8); } \
        if (tid < 32) pe = *(const GAS f32x4*)(EBL + un_ * 128 + 4 * tid); } while (0)
#define H2_WRITE() do { _Pragma("unroll") for (int i_ = 0; i_ < 2; ++i_) { const int p_ = tid + 512 * i_; \
            *(LAS v4u*)(QBL + (p_ >> 4) * H_P256 + (p_ & 15) * 16) = pq[i_]; \
            *(LAS v4u*)(KLL + (p_ >> 3) * H_P128 + (p_ & 7) * 16) = pk[i_]; *(LAS v4u*)(ITL + (p_ >> 3) * H_P128 + (p_ & 7) * 16) = pi[i_]; } \
        if (tid < 32) *(LAS f32x4*)(EBLL + 4 * tid) = pe; } while (0)
    H2_LOAD(0); H2_WRITE();
    __syncthreads();
    for (int c = 0; c < SEQ / 64; ++c) {
        if (c + 1 < SEQ / 64) H2_LOAD(c + 1);
        bf16* op = OB + ((size_t)b * SEQ + (size_t)c * 64 + 32 * itt) * DM + h * 128 + 32 * ivt + r32;
        bf16 iv[16];
#pragma unroll
        for (int r = 0; r < 16; ++r) iv[r] = op[(size_t)crow16(r, hi) * DM];
        f32x16 o = {};
#pragma unroll
        for (int step = 0; step < 8; ++step) { const bf16x8 a = *(const LAS bf16x8*)(QBL + (32 * itt + r32) * H_P256 + (16 * step + 8 * hi) * 2);
            const bf16x8 bs = *(const LAS bf16x8*)(STL + (32 * ivt + r32) * H_P256 + (16 * step + 8 * hi) * 2);
            o = __builtin_amdgcn_mfma_f32_32x32x16_bf16(a, bs, o, 0, 0, 0); }
#pragma unroll
        for (int r = 0; r < 16; ++r) op[(size_t)crow16(r, hi) * DM] = (bf16)f2bf(o[r] + bf_f(iv[r]));
#pragma unroll
        for (int r = 0; r < 16; ++r) { const float e = EBLL[32 * kt + crow16(r, hi)]; acc0[r] *= e; acc1[r] *= e; }
#pragma unroll
        for (int step = 0; step < 4; ++step) { const bf16x8 a = *(const LAS bf16x8*)(KLL + (32 * kt + r32) * H_P128 + (16 * step + 8 * hi) * 2);
            const bf16x8 b0 = *(const LAS bf16x8*)(ITL + (32 * vt0 + r32) * H_P128 + (16 * step + 8 * hi) * 2);
            const bf16x8 b1 = *(const LAS bf16x8*)(ITL + (32 * vt0 + 32 + r32) * H_P128 + (16 * step + 8 * hi) * 2);
            acc0 = __builtin_amdgcn_mfma_f32_32x32x16_bf16(a, b0, acc0, 0, 0, 0); acc1 = __builtin_amdgcn_mfma_f32_32x32x16_bf16(a, b1, acc1, 0, 0, 0); }
        __syncthreads();
#pragma unroll
        for (int g = 0; g < 4; ++g) {
            *(LAS unsigned long long*)(STL + (32 * vt0 + r32) * H_P256 + (32 * kt + 8 * g + 4 * hi) * 2) = (unsigned long long)pk2(acc0[4 * g], acc0[4 * g + 1]) | ((unsigned long long)pk2(acc0[4 * g + 2], acc0[4 * g + 3]) << 32);
            *(LAS unsigned long long*)(STL + (32 * vt0 + 32 + r32) * H_P256 + (32 * kt + 8 * g + 4 * hi) * 2) = (unsigned long long)pk2(acc1[4 * g], acc1[4 * g + 1]) | ((unsigned long long)pk2(acc1[4 * g + 2], acc1[4 * g + 3]) << 32); }
        if (c + 1 < SEQ / 64) H2_WRITE();
        __syncthreads();
    }
#undef H2_LOAD
#undef H2_WRITE
}
__device__ __forceinline__ void hgrn_final_phase(Frame& F) {
    const bf16* BIG = (const bf16*)(F.ws + WS_BIG); bf16* OB = (bf16*)(F.ws + WS_OB); const float* gn = F.a->in[19];
    const int gw = F.vcu * NWAVES + F.wave, NGW = F.G * NWAVES;
    const int dv = (F.lane & 15) * 8;
    const f32x4 g0 = *(const f32x4*)(gn + dv), g1 = *(const f32x4*)(gn + dv + 4);
    for (int row = gw; row < MT; row += NGW) {
        GAS v4u* po = (GAS v4u*)(OB + (size_t)row * DM) + F.lane; const GAS v4u* pg = (const GAS v4u*)(BIG + (size_t)row * 8192 + 6144) + F.lane;
        v4u wo[4], wg[4];
#pragma unroll
        for (int it = 0; it < 4; ++it) { wo[it] = po[64 * it]; wg[it] = pg[64 * it]; }
#pragma unroll
        for (int it = 0; it < 4; ++it) { float x[8], gg[8]; unpack8(wo[it], x); unpack8(wg[it], gg);
            float ss = 0.f;
#pragma unroll
            for (int i = 0; i < 8; ++i) ss += x[i] * x[i];
            ss += __shfl_xor(ss, 1); ss += __shfl_xor(ss, 2); ss += __shfl_xor(ss, 4); ss += __shfl_xor(ss, 8);
            const float rstd = rsqrtf(ss * (1.0f / 128.0f) + RMS_EPS);
            float y[8];
#pragma unroll
            for (int i = 0; i < 8; ++i) { const float gi = (i < 4) ? g0[i] : g1[i - 4]; y[i] = x[i] * rstd * gi * (gg[i] / (1.0f + __expf(-gg[i]))); }
            v4u o; o.x = pk2(y[0], y[1]); o.y = pk2(y[2], y[3]); o.z = pk2(y[4], y[5]); o.w = pk2(y[6], y[7]);
            po[64 * it] = o; }
    }
}
__device__ __forceinline__ bool ph_refresh(Frame& F) { int t = threadIdx.x; asm volatile("" : "+v"(t)); F.tid = t; F.lane = t & 63; F.wave = __builtin_amdgcn_readfirstlane(t >> 6); return true; }
__global__ void __launch_bounds__(NWAVES * 64, 2) trunk_fwd(Args args) {
    extern __shared__ __attribute__((aligned(16))) unsigned char lds[];
    Frame F;
    F.lds = (LAS unsigned char*)lds;
    F.MISC = (volatile LAS unsigned*)(F.lds + MISC_OFF);
    F.tid = threadIdx.x; F.lane = F.tid & 63; F.wave = __builtin_amdgcn_readfirstlane(F.tid >> 6);
    F.G = gridDim.x; { const int bx = blockIdx.x; F.vcu = (F.G % 8 == 0) ? (bx % 8) * (F.G / 8) + bx / 8 : bx; }
    F.ws = args.ws; F.ctl = (gu32*)(args.ws + WS_CTL); F.out = args.out;
    F.a = &args;
    for (int u = F.tid; u < (LDS_BYTES - LDSCTL_OFF) / 4; u += NWAVES * 64) ((LAS unsigned*)(F.lds + LDSCTL_OFF))[u] = 0u;
    __syncthreads();
    XcdBarrier bar; bar.bar = (unsigned*)(F.ctl + CW_BAR); bar.x = 0; bar.st = nullptr;
    if (!MK_PER_PHASE) bar = xcd_barrier_post((unsigned*)(F.ctl + CW_BAR), F.MISC + 8);
    const int lo = args.ph_lo, hi = args.ph_hi;
    int pc = 0;
#define PH_ON (pc >= lo && pc < hi && ph_refresh(F))
#define PH_END do { if (!MK_PER_PHASE && pc >= lo && pc + 1 < hi) xcd_barrier(bar); ++pc; } while (0)
    float* mod = (float*)(F.ws + WS_MOD);
    bf16* XN = (bf16*)(F.ws + WS_XN); bf16* BIG = (bf16*)(F.ws + WS_BIG); bf16* OB = (bf16*)(F.ws + WS_OB);
    #ifndef NO_P0
    if (PH_ON) { p0_mod(F); __syncthreads(); p0_convert(F); }
#endif
    PH_END;
#pragma unroll 1
    for (int L = 0; L < NLAYER; ++L) {
        const int kind = L % 3, slot = L / 3;
        const float* modL = mod + (size_t)L * NB * NMOD;
#pragma unroll 1
        for (int sub = 0; sub < 3; ++sub) {
            const float* xsrc = (L == 0 && sub == 0) ? F.a->in[0] : (const float*)F.out;
#ifndef NO_NORM
            if (PH_ON) norm_phase(F, xsrc, F.a->in[4] + ((size_t)L * 3 + sub) * DM, modL, sub);
#endif
            PH_END;
            const bf16* outA; const bf16* outB; int outK;
            if (sub != 1) {
                const int ls = L * 2 + (sub >> 1);
#ifndef NO_GU
                if (PH_ON) { pg8::Gemm g{XN, (const bf16*)(F.ws + WS_WGU) + (size_t)ls * 2 * FF * DM, MT, 2 * FF, DM}; pg8::StaticOrder S; S.init(MT, 2 * FF, F.G, (int)blockIdx.x);
                    pg8::EpiSwiglu E{BIG, FF};
                    pg8::gemm_phase<pg8::EpiSwiglu, pg8::StaticOrder, true, true>(F.lds + RING_OFF, g, S, E); }
#endif
                PH_END;
                outA = BIG; outB = (const bf16*)(F.ws + WS_WD) + (size_t)ls * DM * FF; outK = FF;
            } else {
                const int nin = (kind == 2) ? 4 * DM : 3 * DM;
                const bf16* win = (kind == 0) ? (const bf16*)(F.ws + WS_WAI) + (size_t)slot * 3 * DM * DM : (kind == 1) ? (const bf16*)(F.ws + WS_WCI) : (const bf16*)(F.ws + WS_WHI);
#ifndef NO_INP
                if (PH_ON) { pg8::Gemm g{XN, win, MT, nin, DM}; pg8::StaticOrder S; S.init(MT, nin, F.G, (int)blockIdx.x);
                    pg8::EpiStore E{BIG, nin};
                    pg8::gemm_phase<pg8::EpiStore, pg8::StaticOrder, true, true>(F.lds + RING_OFF, g, S, E); }
#endif
                PH_END;
                if (kind == 0) {
#ifndef NO_QKN
                    if (PH_ON) qknorm_phase(F, F.a->in[10] + (size_t)slot * 64, F.a->in[11] + (size_t)slot * 64);
#endif
                    PH_END;
#ifndef NO_ATTN
                    if (PH_ON) attn_phase(F, L, slot);
#endif
                    PH_END;
                } else if (kind == 1) {
#ifndef NO_CONV
                    if (PH_ON) conv_phase(F);
#endif
                    PH_END;
                } else {
#ifndef NO_H1
                    if (PH_ON) hgrn_prep_phase(F, L);
#endif
                    PH_END;
#ifndef NO_H2
                    if (PH_ON) hgrn_scan_phase(F);
#endif
                    PH_END;
#ifndef NO_H3
                    if (PH_ON) hgrn_final_phase(F);
#endif
                    PH_END;
                }
                outA = OB; outB = (kind == 0) ? (const bf16*)(F.ws + WS_WAO) + (size_t)slot * DM * DM : (kind == 1) ? (const bf16*)(F.ws + WS_WCO) : (const bf16*)(F.ws + WS_WHO); outK = DM;
            }
#ifndef NO_OUT
            if (PH_ON) { pg8::Gemm g{outA, outB, MT, DM, outK}; pg8::StaticOrder S; S.init(MT, DM, F.G, (int)blockIdx.x);
                pg8::EpiRes E{xsrc, F.out, DM, modL + (size_t)(3 * sub + 2) * DM, NMOD, (sub == 1) ? 1.0f : 0.5f, SEQ};
                pg8::gemm_phase<pg8::EpiRes, pg8::StaticOrder, true, true>(F.lds + RING_OFF, g, S, E); }
#endif
            PH_END;
        }
    }
#undef PH_ON
#undef PH_END
}
extern "C" void kernel_launch(void* const* d_in, const int* in_sizes, int n_in, void* d_out, int out_size, void* d_ws, size_t ws_size, hipStream_t stream) {
    static int grid = 0;
    if (grid == 0) {
        if (n_in != 21 || in_sizes[0] != MT * DM || out_size != MT * DM || ws_size < WS_END) { fprintf(stderr, "kernel_launch: shape/workspace mismatch (n_in %d, in0 %d, out %d, ws %zu, need %zu); nothing launched\n", n_in, n_in > 0 ? in_sizes[0] : -1, out_size, ws_size, (size_t)WS_END); grid = -1; return; }
        int dev = 0, cus = 0, per_cu = 0;
        if (hipGetDevice(&dev) != hipSuccess || hipDeviceGetAttribute(&cus, hipDeviceAttributeMultiprocessorCount, dev) != hipSuccess) { fprintf(stderr, "kernel_launch: device query failed\n"); grid = -1; return; }
        if (hipFuncSetAttribute((const void*)trunk_fwd, hipFuncAttributeMaxDynamicSharedMemorySize, LDS_BYTES) != hipSuccess) { fprintf(stderr, "kernel_launch: hipFuncSetAttribute failed\n"); grid = -1; return; }
        if (hipOccupancyMaxActiveBlocksPerMultiprocessor(&per_cu, (const void*)trunk_fwd, NWAVES * 64, LDS_BYTES) != hipSuccess || per_cu < 1) fprintf(stderr, "kernel_launch: note: occupancy query reports %d workgroups per CU\n", per_cu);
        (void)hipGetLastError();
        grid = cus;
    }
    if (grid < 0) return;
    if (hipMemsetAsync((char*)d_ws + WS_CTL, 0, CTL_ZERO_BYTES, stream) != hipSuccess) { fprintf(stderr, "kernel_launch: memset failed\n"); return; }
    Args a{};
    for (int i = 0; i < 21; ++i) a.in[i] = (const float*)d_in[i];
    a.out = (float*)d_out; a.ws = (unsigned char*)d_ws;
#if MK_PER_PHASE
    for (int p = 0; p < N_PHASES; ++p) { a.ph_lo = p; a.ph_hi = p + 1; hipLaunchKernelGGL(trunk_fwd, dim3(grid), dim3(NWAVES * 64), LDS_BYTES, stream, a); }
#else
    a.ph_lo = 0; a.ph_hi = N_PHASES;
    hipLaunchKernelGGL(trunk_fwd, dim3(grid), dim3(NWAVES * 64), LDS_BYTES, stream, a);
#endif
    const hipError_t le = hipPeekAtLastError();
    if (le != hipSuccess) fprintf(stderr, "kernel_launch: launch failed: %s\n", hipGetErrorName(le));
}
```

```cpp
#include <hip/hip_runtime.h>
#include <cstdio>
#include <cstdint>
template <int X> __device__ __forceinline__ float sx(float v) { return __int_as_float(__builtin_amdgcn_ds_swizzle(__float_as_int(v), (X << 10) | 0x1f)); }
__device__ __forceinline__ float sum32(float v) { auto rr = __builtin_amdgcn_permlane32_swap(__float_as_uint(v), __float_as_uint(v), false, false); return __uint_as_float(rr[0]) + __uint_as_float(rr[1]); }
__device__ __forceinline__ float max32(float v) { auto rr = __builtin_amdgcn_permlane32_swap(__float_as_uint(v), __float_as_uint(v), false, false); return fmaxf(__uint_as_float(rr[0]), __uint_as_float(rr[1])); }
__device__ __forceinline__ float wave_sum(float v) { v += sx<1>(v); v += sx<2>(v); v += sx<4>(v); v += sx<8>(v); v += sx<16>(v); return sum32(v); }
__device__ __forceinline__ float wave_max(float v) { v = fmaxf(v, sx<1>(v)); v = fmaxf(v, sx<2>(v)); v = fmaxf(v, sx<4>(v)); v = fmaxf(v, sx<8>(v)); v = fmaxf(v, sx<16>(v)); return max32(v); }
typedef float f32x2_cv __attribute__((ext_vector_type(2))); typedef __bf16 bf16x2_cv __attribute__((ext_vector_type(2)));
__device__ __forceinline__ unsigned pk2(float lo, float hi) { const f32x2_cv v = {lo, hi}; const bf16x2_cv b = __builtin_convertvector(v, bf16x2_cv); return __builtin_bit_cast(unsigned, b); }
__device__ __forceinline__ unsigned f2bf(float f) { return pk2(f, 0.f) & 0xffffu; }
namespace pg8 {
#define PG8_LAS __attribute__((address_space(3)))
typedef unsigned short bf16_t;
typedef short bf16x8 __attribute__((ext_vector_type(8)));
typedef float f32x4 __attribute__((ext_vector_type(4)));
typedef unsigned u32x4 __attribute__((ext_vector_type(4)));
constexpr int BM = 256, BK = 64, HALF = 128, HTB = HALF * BK * 2  , STAGE_BYTES = 8 * HTB, NXCD = 8, WGM = 8;

__host__ __device__ __forceinline__ int lds_byte(int r, int c) { const int st = (r >> 4) * 2 + (c >> 5), rr = r & 15, cc = c & 31, ob = rr * 64 + cc * 2; return st * 1024 + (ob ^ (((ob >> 9) & 1) << 5)); }
__host__ __device__ __forceinline__ void stage_rc(int b, int& R, int& C) { const int st = b / 1024, sb = b % 1024, swz = sb ^ (((sb >> 9) & 1) << 5); R = (st >> 1) * 16 + swz / 64; C = (st & 1) * 32 + (swz % 64) / 2; }
__host__ __device__ __forceinline__ int perm32(int rho) { const int n = rho >> 4, i = rho & 15; return 8 * (i >> 2) + 4 * n + (i & 3); }

struct Unit { int pm, pn; };
struct Gemm { const bf16_t* A; const bf16_t* Bt; int M, N, K; int a_tiled = 0, b_tiled = 0; };

struct StaticOrder {
    int nM, nN, nwg, G, c, wgm, pm_off;
    __host__ __device__ void init(int M, int N, int G_, int c_, int wgm_ = WGM, int pm_off_ = 0) { nM = M / BM; nN = N / BM; nwg = nM * nN; G = G_; c = c_; wgm = wgm_; pm_off = pm_off_; }
    __host__ __device__ bool next(int i, Unit& u) const {
        const long L = (long)i * G + c; if (L >= nwg) return false;
        int wgid = (int)L; { const int q = nwg / NXCD, r = nwg % NXCD, xcd = wgid % NXCD, off = wgid / NXCD; wgid = (xcd < r ? xcd * (q + 1) : r * (q + 1) + (xcd - r) * q) + off; }
        const int nig = wgm * nN, gid = wgid / nig, fm = gid * wgm, gsz = (nM - fm) < wgm ? (nM - fm) : wgm;
        u.pm = pm_off + fm + ((wgid % nig) % gsz); u.pn = (wgid % nig) / gsz; return true;
    }
    __device__ __forceinline__ void a_ready(const Unit&) const {}
    __device__ __forceinline__ void done(const Unit&) const {}
};

__device__ __forceinline__ unsigned cvt_pk_bf16(float lo, float hi) { unsigned r; asm volatile("v_cvt_pk_bf16_f32 %0, %1, %2" : "=v"(r) : "v"(lo), "v"(hi)); return r; }
typedef float f32x2 __attribute__((ext_vector_type(2)));
typedef unsigned u32x2 __attribute__((ext_vector_type(2)));
struct EpiStore {
    static constexpr bool HAS_PRE = false;
    static constexpr bool PERM = true, AFTER_DRAIN = false;
    bf16_t* O; int ldc;
    __device__ __forceinline__ void operator()(const f32x4 (&acc)[2][2][4][2], const Unit& u, int wr, int wc, int fr, int fq) const {
        const int row0 = u.pm * BM + wr * 64 + fr, col0 = u.pn * BM + wc * 32 + 8 * fq;
#pragma unroll
        for (int ai = 0; ai < 2; ++ai)
#pragma unroll
            for (int m = 0; m < 4; ++m) { bf16_t* rowp = O + (size_t)(row0 + ai * HALF + m * 16) * ldc + col0;
#pragma unroll
                for (int bj = 0; bj < 2; ++bj) { const f32x4 v0 = acc[ai][bj][m][0], v1 = acc[ai][bj][m][1];
                    u32x4 w; w.x = cvt_pk_bf16(v0[0], v0[1]); w.y = cvt_pk_bf16(v0[2], v0[3]); w.z = cvt_pk_bf16(v1[0], v1[1]); w.w = cvt_pk_bf16(v1[2], v1[3]);
                    *(u32x4*)(rowp + bj * HALF) = w; } }
    }
};
__device__ __forceinline__ float swiglu1(float g, float u) { const float e = __builtin_amdgcn_exp2f(g * -1.4426950408889634f); return g * u * __builtin_amdgcn_rcpf(1.0f + e); }
struct EpiSwiglu {
    static constexpr bool HAS_PRE = false;
    static constexpr bool PERM = true, AFTER_DRAIN = false;
    bf16_t* O; int ldc;
    __device__ __forceinline__ void operator()(const f32x4 (&acc)[2][2][4][2], const Unit& u, int wr, int wc, int fr, int fq) const {
        const int row0 = u.pm * BM + wr * 64 + fr, col0 = u.pn * HALF + wc * 32 + 8 * fq;
#pragma unroll
        for (int ai = 0; ai < 2; ++ai)
#pragma unroll
            for (int m = 0; m < 4; ++m) { bf16_t* rowp = O + (size_t)(row0 + ai * HALF + m * 16) * ldc + col0;
                const f32x4 g0 = acc[ai][0][m][0], g1 = acc[ai][0][m][1], u0 = acc[ai][1][m][0], u1 = acc[ai][1][m][1];
                u32x4 w;
                w.x = cvt_pk_bf16(swiglu1(g0[0], u0[0]), swiglu1(g0[1], u0[1])); w.y = cvt_pk_bf16(swiglu1(g0[2], u0[2]), swiglu1(g0[3], u0[3]));
                w.z = cvt_pk_bf16(swiglu1(g1[0], u1[0]), swiglu1(g1[1], u1[1])); w.w = cvt_pk_bf16(swiglu1(g1[2], u1[2]), swiglu1(g1[3], u1[3]));
                *(u32x4*)rowp = w; }
    }
};
struct EpiRes {
    static constexpr bool HAS_PRE = false;
    static constexpr bool PERM = false, AFTER_DRAIN = false;
    const float* base; float* out; int ldc; const float* gate; int gstride; float coef; int rows_per_batch;
    __device__ __forceinline__ void operator()(const f32x4 (&acc)[2][2][4][2], const Unit& u, int wr, int wc, int fr, int fq) const {
        const int row0 = u.pm * BM + wr * 64 + fr, col0 = u.pn * BM + wc * 32 + 4 * fq;
        const float* gp = gate + (size_t)((u.pm * BM) / rows_per_batch) * gstride + col0;
        f32x4 gv[2][2];
#pragma unroll
        for (int bj = 0; bj < 2; ++bj)
#pragma unroll
            for (int n = 0; n < 2; ++n) gv[bj][n] = *(const f32x4*)(gp + bj * HALF + n * 16) * coef;
#pragma unroll
        for (int ai = 0; ai < 2; ++ai)
#pragma unroll
            for (int m = 0; m < 4; ++m) { const size_t off = (size_t)(row0 + ai * HALF + m * 16) * ldc + col0;
#pragma unroll
                for (int bj = 0; bj < 2; ++bj)
#pragma unroll
                    for (int n = 0; n < 2; ++n) { const f32x4 bs = *(const f32x4*)(base + off + bj * HALF + n * 16); *(f32x4*)(out + off + bj * HALF + n * 16) = bs + gv[bj][n] * acc[ai][bj][m][n]; }
                if (m & 1) asm volatile("" ::: "memory"); }
    }
};
__device__ __forceinline__ float rstd_of(const float* rss, int row) { return rsqrtf(rss[row] * (1.0f / 2048.0f) + 1e-6f); }
struct EpiSwigluN {
    static constexpr bool HAS_PRE = true;
    static constexpr bool PERM = true, AFTER_DRAIN = false;
    bf16_t* O; int ldc; const float* rss; const float* cb; int cbstride; int rows_per_batch; PG8_LAS unsigned char* pre_lds;
    __device__ __forceinline__ void pre(const Unit& u, int lane) const {
        __builtin_amdgcn_global_load_lds((const unsigned*)(cb + (size_t)((u.pm * BM) / rows_per_batch) * cbstride + u.pn * BM + 4 * lane), (PG8_LAS unsigned*)pre_lds, 16, 0, 0);
        __builtin_amdgcn_global_load_lds((const unsigned*)(rss + u.pm * BM + 4 * lane), (PG8_LAS unsigned*)(pre_lds + 1024), 16, 0, 0); }
    __device__ __forceinline__ void operator()(const f32x4 (&acc)[2][2][4][2], const Unit& u, int wr, int wc, int fr, int fq) const {
        const int col0 = u.pn * HALF + wc * 32 + 8 * fq;
        const PG8_LAS float* cbp = (const PG8_LAS float*)pre_lds + wc * 32 + 8 * fq; const PG8_LAS float* rp = (const PG8_LAS float*)(pre_lds + 1024) + wr * 64 + fr;
        const f32x4 cg0 = *(const PG8_LAS f32x4*)(cbp), cg1 = *(const PG8_LAS f32x4*)(cbp + 4), cu0 = *(const PG8_LAS f32x4*)(cbp + HALF), cu1 = *(const PG8_LAS f32x4*)(cbp + HALF + 4);
#pragma unroll
        for (int ai = 0; ai < 2; ++ai)
#pragma unroll
            for (int m = 0; m < 4; ++m) { const float rs = rsqrtf(rp[ai * HALF + m * 16] * (1.0f / 2048.0f) + 1e-6f);
                bf16_t* rowp = O + ((size_t)(u.pm * (ldc >> 6) + (col0 >> 6)) * BM + (wr * 64 + fr + ai * HALF + m * 16)) * 64 + (col0 & 63);
                const f32x4 g0 = acc[ai][0][m][0] * rs + cg0, g1 = acc[ai][0][m][1] * rs + cg1, u0 = acc[ai][1][m][0] * rs + cu0, u1 = acc[ai][1][m][1] * rs + cu1;
                u32x4 w;
                w.x = pk2(swiglu1(g0[0], u0[0]), swiglu1(g0[1], u0[1])); w.y = pk2(swiglu1(g0[2], u0[2]), swiglu1(g0[3], u0[3]));
                w.z = pk2(swiglu1(g1[0], u1[0]), swiglu1(g1[1], u1[1])); w.w = pk2(swiglu1(g1[2], u1[2]), swiglu1(g1[3], u1[3]));
                __builtin_nontemporal_store(w, (u32x4*)rowp); }
    }
};
struct EpiInN {
    static constexpr bool HAS_PRE = true;
    static constexpr bool PERM = true, AFTER_DRAIN = false;
    bf16_t* O; int ldc; const float* rss; const float* cb; int cbstride; int rows_per_batch; int nqk; const float* gq; const float* gk; PG8_LAS unsigned char* pre_lds;
    __device__ __forceinline__ void pre(const Unit& u, int lane) const {
        __builtin_amdgcn_global_load_lds((const unsigned*)(cb + (size_t)((u.pm * BM) / rows_per_batch) * cbstride + u.pn * BM + 4 * lane), (PG8_LAS unsigned*)pre_lds, 16, 0, 0);
        __builtin_amdgcn_global_load_lds((const unsigned*)(rss + u.pm * BM + 4 * lane), (PG8_LAS unsigned*)(pre_lds + 1024), 16, 0, 0); }
    __device__ __forceinline__ void operator()(const f32x4 (&acc)[2][2][4][2], const Unit& u, int wr, int wc, int fr, int fq) const {
        const int row0 = u.pm * BM + wr * 64 + fr, pc0 = u.pn * BM + wc * 32 + 8 * fq;
        const PG8_LAS float* cbp = (const PG8_LAS float*)pre_lds + wc * 32 + 8 * fq; const PG8_LAS float* rp = (const PG8_LAS float*)(pre_lds + 1024) + wr * 64 + fr;
        f32x4 cv[2][2];
#pragma unroll
        for (int bj = 0; bj < 2; ++bj)
#pragma unroll
            for (int n = 0; n < 2; ++n) cv[bj][n] = *(const PG8_LAS f32x4*)(cbp + bj * HALF + 4 * n);
        if (u.pn < nqk) {
            const bool isq = u.pn < (nqk >> 1); const float* gp = (isq ? gq : gk) + 8 * fq; const float gs = isq ? 0.125f * 1.4426950408889634f : 1.0f;
            f32x4 gv[2][2];
#pragma unroll
            for (int bj = 0; bj < 2; ++bj)
#pragma unroll
                for (int n = 0; n < 2; ++n) gv[bj][n] = *(const f32x4*)(gp + 32 * bj + 4 * n) * gs;
            const int lc0 = u.pn * BM + wc * 64 + 8 * fq;
#pragma unroll
            for (int ai = 0; ai < 2; ++ai)
#pragma unroll
                for (int m = 0; m < 4; ++m) { const int row = row0 + ai * HALF + m * 16; const float rs = rsqrtf(rp[ai * HALF + m * 16] * (1.0f / 2048.0f) + 1e-6f); bf16_t* rowp = O + (size_t)row * ldc + lc0;
                    f32x4 v[2][2]; float ss = 0.f;
#pragma unroll
                    for (int bj = 0; bj < 2; ++bj)
#pragma unroll
                        for (int n = 0; n < 2; ++n) { v[bj][n] = acc[ai][bj][m][n] * rs + cv[bj][n]; ss += (v[bj][n][0] * v[bj][n][0] + v[bj][n][1] * v[bj][n][1]) + (v[bj][n][2] * v[bj][n][2] + v[bj][n][3] * v[bj][n][3]); }
                    ss += sx<16>(ss); ss = sum32(ss);
                    const float rg = rsqrtf(ss * (1.0f / 64.0f) + 1e-6f);
#pragma unroll
                    for (int bj = 0; bj < 2; ++bj) { const f32x4 v0 = v[bj][0] * rg * gv[bj][0], v1 = v[bj][1] * rg * gv[bj][1];
                        u32x4 w; w.x = pk2(v0[0], v0[1]); w.y = pk2(v0[2], v0[3]); w.z = pk2(v1[0], v1[1]); w.w = pk2(v1[2], v1[3]);
                        if (isq) __builtin_nontemporal_store(w, (u32x4*)(rowp + 32 * bj)); else *(u32x4*)(rowp + 32 * bj) = w; } }
        } else {
#pragma unroll
            for (int ai = 0; ai < 2; ++ai)
#pragma unroll
                for (int m = 0; m < 4; ++m) { const int row = row0 + ai * HALF + m * 16; const float rs = rsqrtf(rp[ai * HALF + m * 16] * (1.0f / 2048.0f) + 1e-6f); bf16_t* rowp = O + (size_t)row * ldc + pc0;
#pragma unroll
                    for (int bj = 0; bj < 2; ++bj) { const f32x4 v0 = acc[ai][bj][m][0] * rs + cv[bj][0], v1 = acc[ai][bj][m][1] * rs + cv[bj][1];
                        u32x4 w; w.x = pk2(v0[0], v0[1]); w.y = pk2(v0[2], v0[3]); w.z = pk2(v1[0], v1[1]); w.w = pk2(v1[2], v1[3]);
                        *(u32x4*)(rowp + bj * HALF) = w; } }
        }
    }
};
typedef _Float16 f16x4 __attribute__((ext_vector_type(4)));
struct EpiResN {
    static constexpr bool HAS_PRE = true;
    static constexpr bool PERM = false, AFTER_DRAIN = false;
    const void* base; void* out; int base_f32, out_f32;
    int ldc; const float* gvt; const float* ant; int tstride; int rows_per_batch;
    bf16_t* xs; float* rssn; PG8_LAS unsigned char* pre_lds;
    float gscale;
    __device__ __forceinline__ void pre(const Unit& u, int lane) const {
        const size_t o = (size_t)((u.pm * BM) / rows_per_batch) * tstride + u.pn * BM + 4 * lane;
        __builtin_amdgcn_global_load_lds((const unsigned*)(gvt + o), (PG8_LAS unsigned*)pre_lds, 16, 0, 0);
        __builtin_amdgcn_global_load_lds((const unsigned*)(ant + o), (PG8_LAS unsigned*)(pre_lds + 1024), 16, 0, 0); }
    __device__ __forceinline__ void operator()(const f32x4 (&acc)[2][2][4][2], const Unit& u, int wr, int wc, int fr, int fq) const {
        const int col0 = u.pn * BM + wc * 32 + 4 * fq;
        const PG8_LAS float* gp = (const PG8_LAS float*)pre_lds + wc * 32 + 4 * fq;
        f32x4 gv[2][2], an[2][2];
#pragma unroll
        for (int bj = 0; bj < 2; ++bj)
#pragma unroll
            for (int n = 0; n < 2; ++n) { gv[bj][n] = *(const PG8_LAS f32x4*)(gp + bj * HALF + n * 16) * gscale; an[bj][n] = *(const PG8_LAS f32x4*)(gp + 256 + bj * HALF + n * 16); }
        if (base_f32) {
#pragma unroll
            for (int ai = 0; ai < 2; ++ai)
#pragma unroll
                for (int m = 0; m < 4; ++m) { const int rr = wr * 64 + fr + ai * HALF + m * 16; const unsigned off = (unsigned)((u.pm * BM + rr) * ldc + col0); float ss = 0.f;
                    const unsigned xso = ((unsigned)(u.pm * (ldc >> 6) + 4 * u.pn) * BM + rr) * 64u + 4u * fq;
#pragma unroll
                    for (int bj = 0; bj < 2; ++bj)
#pragma unroll
                        for (int n = 0; n < 2; ++n) { const unsigned o2 = off + bj * HALF + n * 16;
                            const f32x4 xn = *(const f32x4*)((const char*)base + 4u * o2) + gv[bj][n] * acc[ai][bj][m][n];
                            *(f16x4*)((char*)out + 2u * o2) = __builtin_convertvector(xn, f16x4);
                            ss += (xn[0] * xn[0] + xn[1] * xn[1]) + (xn[2] * xn[2] + xn[3] * xn[3]); const f32x4 h = xn * an[bj][n];
                            u32x2 w; w.x = pk2(h[0], h[1]); w.y = pk2(h[2], h[3]); *(u32x2*)((char*)xs + 2u * (xso + (unsigned)(2 * bj + (wc >> 1)) * (BM * 64) + (wc & 1) * 32 + n * 16)) = w; }
                    ss += sx<16>(ss); ss = sum32(ss); if (fq == 0) __hip_atomic_fetch_add(rssn + (u.pm * BM + rr), ss, __ATOMIC_RELAXED, __HIP_MEMORY_SCOPE_AGENT);
                    if (m & 1) asm volatile("" ::: "memory"); }
        } else {
            f16x4 bsv[2][4][2][2];
#pragma unroll
            for (int ai = 0; ai < 2; ++ai)
#pragma unroll
                for (int m = 0; m < 4; ++m)
#pragma unroll
                    for (int bj = 0; bj < 2; ++bj)
#pragma unroll
                        for (int n = 0; n < 2; ++n) bsv[ai][m][bj][n] = *(const f16x4*)((const char*)base + 2u * (unsigned)((u.pm * BM + wr * 64 + fr + ai * HALF + m * 16) * ldc + col0 + bj * HALF + n * 16));
            asm volatile("" ::: "memory");
#pragma unroll
            for (int ai = 0; ai < 2; ++ai) {
#pragma unroll
                for (int m = 0; m < 4; ++m) { const int rr = wr * 64 + fr + ai * HALF + m * 16; const unsigned off = (unsigned)((u.pm * BM + rr) * ldc + col0); float ss = 0.f;
                    const unsigned xso = ((unsigned)(u.pm * (ldc >> 6) + 4 * u.pn) * BM + rr) * 64u + 4u * fq;
#pragma unroll
                    for (int bj = 0; bj < 2; ++bj)
#pragma unroll
                        for (int n = 0; n < 2; ++n) { const unsigned o2 = off + bj * HALF + n * 16;
                            const f32x4 xn = __builtin_convertvector(bsv[ai][m][bj][n], f32x4) + gv[bj][n] * acc[ai][bj][m][n];
                            if (out_f32) *(f32x4*)((char*)out + 4u * o2) = xn; else *(f16x4*)((char*)out + 2u * o2) = __builtin_convertvector(xn, f16x4);
                            if (xs) { ss += (xn[0] * xn[0] + xn[1] * xn[1]) + (xn[2] * xn[2] + xn[3] * xn[3]); const f32x4 h = xn * *(const PG8_LAS f32x4*)(gp + 256 + bj * HALF + n * 16);
                                u32x2 w; w.x = pk2(h[0], h[1]); w.y = pk2(h[2], h[3]); *(u32x2*)((char*)xs + 2u * (xso + (unsigned)(2 * bj + (wc >> 1)) * (BM * 64) + (wc & 1) * 32 + n * 16)) = w; } }
                    if (xs) { ss += sx<16>(ss); ss = sum32(ss); if (fq == 0) __hip_atomic_fetch_add(rssn + (u.pm * BM + rr), ss, __ATOMIC_RELAXED, __HIP_MEMORY_SCOPE_AGENT); } }
                asm volatile("" ::: "memory"); }
        }
    }
};
template <class Epi, class Sched, bool ALIGN_EPI = false, bool SP2 = false, int A_AUX = 0>
__device__ __forceinline__ void gemm_phase(PG8_LAS unsigned char* lds, const Gemm g, const Sched& S, const Epi& E, int tid_in) {
    int tid_o = tid_in; asm volatile("" : "+v"(tid_o));
    const int tid = tid_o, wid = __builtin_amdgcn_readfirstlane(tid >> 6), lane = tid & 63, wr = wid >> 2, wc = wid & 3, fr = lane & 15, fq = lane >> 4;
    const int K = g.K, nt = K / BK;
    unsigned voffA[2], voffB[2];
#pragma unroll
    for (int i = 0; i < 2; ++i) { int R, C; stage_rc(tid * 16 + i * 8192, R, C); const int Rb = Epi::PERM ? ((R & ~31) + perm32(R & 31)) : R;
        voffA[i] = (unsigned)(R * (g.a_tiled ? BK : K) + C) * 2u; voffB[i] = (unsigned)(Rb * (g.b_tiled ? BK : K) + C) * 2u; }
    const size_t kstepA = g.a_tiled ? (size_t)(BM * BK * 2) : (size_t)(BK * 2), kstepB = g.b_tiled ? (size_t)(BM * BK * 2) : (size_t)(BK * 2);
    const size_t hstepA = g.a_tiled ? (size_t)(HALF * BK * 2) : (size_t)HALF * K * 2, hstepB = g.b_tiled ? (size_t)(HALF * BK * 2) : (size_t)HALF * K * 2;
    const size_t tstepA = (size_t)BM * K * 2, tstepB = tstepA;
    const unsigned ldsw = (unsigned)wid * 1024u;
    const int aoff = lds_byte(wr * 64 + fr, fq * 8), boff = lds_byte(wc * 32 + fr, fq * 8);
#define PG8_SA(b, h) (((b) * 2 + (h)) * HTB)
#define PG8_SB(b, h) ((4 + (b) * 2 + (h)) * HTB)
#define PG8_STAGE(bufoff, gbase, voff) do { _Pragma("unroll") for (int _i = 0; _i < 2; ++_i) \
        __builtin_amdgcn_global_load_lds((const unsigned*)((const char*)(gbase) + (voff)[_i]), (PG8_LAS unsigned*)(lds + (bufoff) + ldsw + _i * 8192), 16, 0, 0); } while (0)
#define PG8_STAGE_A(bufoff, gbase, voff) do { _Pragma("unroll") for (int _i = 0; _i < 2; ++_i) \
        __builtin_amdgcn_global_load_lds((const unsigned*)((const char*)(gbase) + (voff)[_i]), (PG8_LAS unsigned*)(lds + (bufoff) + ldsw + _i * 8192), 16, 0, A_AUX); } while (0)
#define PG8_LDA(dst, b, h) do { _Pragma("unroll") for (int m = 0; m < 4; ++m) _Pragma("unroll") for (int k = 0; k < 2; ++k) dst[m][k] = *(const PG8_LAS bf16x8*)(lds + PG8_SA(b, h) + aoff + m * 2048 + k * 1024); } while (0)
#define PG8_LDB(dst, b, h) do { _Pragma("unroll") for (int n = 0; n < 2; ++n) _Pragma("unroll") for (int k = 0; k < 2; ++k) dst[n][k] = *(const PG8_LAS bf16x8*)(lds + PG8_SB(b, h) + boff + n * 2048 + k * 1024); } while (0)
#define PG8_MMA(ai, bj, At, Bt) do { __builtin_amdgcn_s_setprio(1); _Pragma("unroll") for (int m = 0; m < 4; ++m) _Pragma("unroll") for (int n = 0; n < 2; ++n) _Pragma("unroll") for (int k = 0; k < 2; ++k) \
        acc[ai][bj][m][n] = __builtin_amdgcn_mfma_f32_16x16x32_bf16(Bt[n][k], At[m][k], acc[ai][bj][m][n], 0, 0, 0); __builtin_amdgcn_s_setprio(0); } while (0)
#define PG8_WAIT_V(n) asm volatile("s_waitcnt vmcnt(" #n ")" ::: "memory")
#define PG8_WAIT_L(n) asm volatile("s_waitcnt lgkmcnt(" #n ")" ::: "memory")
#define PG8_BAR __builtin_amdgcn_s_barrier()
#define PG8_SCHED __builtin_amdgcn_sched_barrier(0)
    Unit cur, nxt; int ui = 0;
    if (!S.next(0, cur)) return;
    f32x4 acc[2][2][4][2];
#pragma unroll
    for (int a = 0; a < 2; ++a)
#pragma unroll
        for (int b = 0; b < 2; ++b)
#pragma unroll
            for (int m = 0; m < 4; ++m)
#pragma unroll
                for (int n = 0; n < 2; ++n) acc[a][b][m][n] = (f32x4){0.f, 0.f, 0.f, 0.f};
    bf16x8 At[4][2], B0[2][2], B1[2][2];
    const char* cA = (const char*)g.A + (size_t)cur.pm * tstepA; const char* cB = (const char*)g.Bt + (size_t)cur.pn * tstepB;
    S.a_ready(cur);
    if constexpr (SP2) {
        PG8_STAGE(PG8_SB(0, 0), cB, voffB); PG8_STAGE(PG8_SB(0, 1), cB + hstepB, voffB); PG8_STAGE_A(PG8_SA(0, 0), cA, voffA); PG8_STAGE_A(PG8_SA(0, 1), cA + hstepA, voffA);
        if (wr == 1) PG8_BAR;
        PG8_WAIT_V(2); PG8_BAR;
        PG8_STAGE(PG8_SB(1, 0), cB + kstepB, voffB); PG8_STAGE_A(PG8_SA(1, 0), cA + kstepA, voffA); PG8_STAGE(PG8_SB(1, 1), cB + hstepB + kstepB, voffB);
        PG8_WAIT_V(6); PG8_BAR;
    } else {
        PG8_STAGE(PG8_SB(0, 0), cB, voffB); PG8_STAGE_A(PG8_SA(0, 0), cA, voffA); PG8_STAGE(PG8_SB(0, 1), cB + hstepB, voffB); PG8_STAGE_A(PG8_SA(0, 1), cA + hstepA, voffA);
        if (wr == 1) PG8_BAR;
        PG8_WAIT_V(4); PG8_BAR;
        PG8_STAGE(PG8_SB(1, 0), cB + kstepB, voffB); PG8_STAGE_A(PG8_SA(1, 0), cA + kstepA, voffA); PG8_STAGE(PG8_SB(1, 1), cB + hstepB + kstepB, voffB);
        PG8_WAIT_V(6); PG8_BAR;
    }
    for (;;) {
        const bool has_next = S.next(ui + 1, nxt);
        const char* nA = has_next ? (const char*)g.A + (size_t)nxt.pm * tstepA : cA; const char* nB = has_next ? (const char*)g.Bt + (size_t)nxt.pn * tstepB : cB;
        for (int t = 0; t < nt; t += 2) {
            const bool last = (t == nt - 2);
            const char* a1 = cA + (size_t)(t + 1) * kstepA;
            const char* a2 = last ? nA : cA + (size_t)(t + 2) * kstepA; const char* b2 = last ? nB : cB + (size_t)(t + 2) * kstepB;
            const char* a3 = a2 + kstepA; const char* b3 = b2 + kstepB;
            if (last && has_next) S.a_ready(nxt);
            if constexpr (SP2) {
            if constexpr (Epi::HAS_PRE) { if (last && wid == 0) { int ln = fr | (fq << 4); asm volatile("" : "+v"(ln)); E.pre(cur, ln); } }
            PG8_LDB(B0, 0, 0); PG8_LDB(B1, 0, 1); PG8_SCHED; PG8_LDA(At, 0, 0); PG8_STAGE_A(PG8_SA(1, 1), a1 + hstepA, voffA);
            PG8_WAIT_V(8); PG8_WAIT_L(0); PG8_BAR; PG8_MMA(0, 0, At, B0); PG8_MMA(0, 1, At, B1); PG8_BAR; PG8_SCHED;
            PG8_LDA(At, 0, 1); PG8_STAGE(PG8_SB(0, 0), b2, voffB); PG8_STAGE(PG8_SB(0, 1), b2 + hstepB, voffB); PG8_STAGE_A(PG8_SA(0, 0), a2, voffA);
            PG8_WAIT_V(8); PG8_WAIT_L(0); PG8_BAR; PG8_MMA(1, 0, At, B0); PG8_MMA(1, 1, At, B1); PG8_BAR; PG8_SCHED;
            PG8_LDB(B0, 1, 0); PG8_LDB(B1, 1, 1); PG8_SCHED; PG8_LDA(At, 1, 0); PG8_STAGE_A(PG8_SA(0, 1), a2 + hstepA, voffA);
            PG8_WAIT_V(8); PG8_WAIT_L(0); PG8_BAR; PG8_MMA(0, 0, At, B0); PG8_MMA(0, 1, At, B1); PG8_BAR; PG8_SCHED;
            PG8_LDA(At, 1, 1); PG8_STAGE(PG8_SB(1, 0), b3, voffB); PG8_STAGE(PG8_SB(1, 1), b3 + hstepB, voffB); PG8_STAGE_A(PG8_SA(1, 0), a3, voffA);
            PG8_WAIT_V(8); PG8_WAIT_L(0); PG8_BAR; PG8_MMA(1, 0, At, B0); PG8_MMA(1, 1, At, B1); PG8_BAR; PG8_SCHED;
            } else {
            PG8_LDB(B0, 0, 0); PG8_SCHED; PG8_LDA(At, 0, 0); PG8_STAGE_A(PG8_SA(1, 1), a1 + hstepA, voffA);
            PG8_WAIT_L(8); PG8_BAR; PG8_WAIT_L(0); PG8_MMA(0, 0, At, B0); PG8_BAR; PG8_SCHED;
            PG8_LDB(B1, 0, 1); PG8_STAGE(PG8_SB(0, 0), b2, voffB);
            PG8_BAR; PG8_WAIT_L(0); PG8_MMA(0, 1, At, B1); PG8_BAR;
            PG8_LDA(At, 0, 1); PG8_STAGE_A(PG8_SA(0, 0), a2, voffA);
            PG8_BAR; PG8_WAIT_L(0); PG8_MMA(1, 0, At, B0); PG8_BAR; PG8_SCHED;
            PG8_STAGE(PG8_SB(0, 1), b2 + hstepB, voffB);
            PG8_WAIT_V(6); PG8_BAR; PG8_MMA(1, 1, At, B1); PG8_BAR;
            PG8_LDB(B0, 1, 0); PG8_SCHED; PG8_LDA(At, 1, 0); PG8_STAGE_A(PG8_SA(0, 1), a2 + hstepA, voffA);
            PG8_WAIT_L(8); PG8_BAR; PG8_WAIT_L(0); PG8_MMA(0, 0, At, B0); PG8_BAR; PG8_SCHED;
            PG8_LDB(B1, 1, 1); PG8_STAGE(PG8_SB(1, 0), b3, voffB);
            PG8_BAR; PG8_WAIT_L(0); PG8_MMA(0, 1, At, B1); PG8_BAR;
            PG8_LDA(At, 1, 1); PG8_STAGE_A(PG8_SA(1, 0), a3, voffA);
            PG8_BAR; PG8_WAIT_L(0); PG8_MMA(1, 0, At, B0); PG8_BAR; PG8_SCHED;
            PG8_STAGE(PG8_SB(1, 1), b3 + hstepB, voffB);
            PG8_WAIT_V(6); PG8_BAR; PG8_MMA(1, 1, At, B1); PG8_BAR;
            }
        }
        if constexpr (ALIGN_EPI) { if (wr == 0) PG8_BAR; }
        if constexpr (!Epi::AFTER_DRAIN) { E(acc, cur, wr, wc, fr, fq); S.done(cur); }
        if (!has_next) break;
#pragma unroll
        for (int a = 0; a < 2; ++a)
#pragma unroll
            for (int b = 0; b < 2; ++b)
#pragma unroll
                for (int m = 0; m < 4; ++m)
#pragma unroll
                    for (int n = 0; n < 2; ++n) acc[a][b][m][n] = (f32x4){0.f, 0.f, 0.f, 0.f};
        cur = nxt; cA = nA; cB = nB; ++ui;
        if constexpr (ALIGN_EPI) { if (wr == 1) PG8_BAR; }
    }
    PG8_WAIT_V(0);
    if constexpr (!ALIGN_EPI) { if (wr == 0) PG8_BAR; }
    PG8_BAR;
    if constexpr (Epi::AFTER_DRAIN) { E.fused(acc, cur, wr, wc, fr, fq, lds, wid, lane); S.done(cur); }
#undef PG8_SA
#undef PG8_SB
#undef PG8_STAGE
#undef PG8_STAGE_A
#undef PG8_LDA
#undef PG8_LDB
#undef PG8_MMA
#undef PG8_WAIT_V
#undef PG8_WAIT_L
#undef PG8_BAR
#undef PG8_SCHED
}
}
#define GAS __attribute__((address_space(1)))
#define LAS __attribute__((address_space(3)))
typedef unsigned short bf16;
typedef unsigned v4u __attribute__((ext_vector_type(4)));
typedef float f32x4 __attribute__((ext_vector_type(4)));
typedef short bf16x8 __attribute__((ext_vector_type(8)));
typedef GAS unsigned gu32;
typedef GAS unsigned long long gu64;
#define RLX_AGENT __ATOMIC_RELAXED, __HIP_MEMORY_SCOPE_AGENT
#define LDS_WAIT() asm volatile("s_waitcnt lgkmcnt(0)" ::: "memory")
#define VM_WAIT() asm volatile("s_waitcnt vmcnt(0)" ::: "memory")
__device__ __forceinline__ unsigned long long rt() { return __builtin_amdgcn_s_memrealtime(); }
#define XB_TMO      128
#define XB_XCNT(j)  (256  + 64 * (j))
#define XB_XSUB(j)  (1280 + 64 * (j))
#define XB_XGEN(j)  (2304 + 64 * (j))
#define XB_TOP      3328
#define XB_TOPGEN   3392
#define XCD_BAR_WORDS 3456
#define XB_SPIN_CAP (1u << 18)

__device__ __forceinline__ unsigned xb_ld(unsigned* p)              { return __hip_atomic_load(p, __ATOMIC_RELAXED, __HIP_MEMORY_SCOPE_AGENT); }
__device__ __forceinline__ unsigned xb_add(unsigned* p, unsigned v) { return __hip_atomic_fetch_add(p, v, __ATOMIC_RELAXED, __HIP_MEMORY_SCOPE_AGENT); }
__device__ __forceinline__ unsigned xb_xcc_id() { return (unsigned)__builtin_amdgcn_s_getreg((3 << 11) | 20) & 0xFu; }
#define XB_SPIN(cond, bar) do { unsigned _sp = 0; while (cond) { __builtin_amdgcn_s_sleep(1); \
    if ((++_sp & 255u) == 0u) { if (xb_ld(&(bar)[XB_TMO])) break; if (_sp > XB_SPIN_CAP) { atomicAdd(&(bar)[XB_TMO], 1u); break; } } } } while (0)

struct XcdBarrier {
    unsigned* bar; unsigned x;
    volatile LAS unsigned* st;
};

__device__ __forceinline__ XcdBarrier xcd_barrier_post(unsigned* bar, volatile LAS unsigned* st) {
    XcdBarrier b; b.bar = bar; b.x = xb_xcc_id(); b.st = st;
    if (threadIdx.x == 0) (void)xb_add(&bar[XB_XCNT(b.x)], 1u);
    return b;
}
__device__ __forceinline__ void xcd_barrier_complete(unsigned* bar, unsigned x, unsigned& nloc, unsigned& nx) {
    const unsigned G = gridDim.x * gridDim.y * gridDim.z;
    unsigned sum, cnt, mine, sp = 0u;
    for (;;) {
        sum = 0u; cnt = 0u; mine = 0u;
#pragma unroll
        for (unsigned j = 0; j < 16; ++j) { const unsigned c = xb_ld(&bar[XB_XCNT(j)]); sum += c; cnt += (c > 0u) ? 1u : 0u; mine = (j == x) ? c : mine; }
        if (sum == G) break;
        __builtin_amdgcn_s_sleep(1);
        if ((++sp & 255u) == 0u) { if (xb_ld(&bar[XB_TMO])) break; if (sp > XB_SPIN_CAP) { atomicAdd(&bar[XB_TMO], 1u); break; } }
    }
    nloc = mine > 0u ? mine : 1u; nx = cnt > 0u ? cnt : 1u;
}

__device__ __forceinline__ void xcd_barrier(const XcdBarrier& b) {
    asm volatile("s_waitcnt vmcnt(0)" ::: "memory");
    __syncthreads();
    if (threadIdx.x == 0) {
        unsigned* bar = b.bar;
        __builtin_amdgcn_s_waitcnt(0);
        unsigned nloc = b.st[0], nx = b.st[1];
        if (nloc == 0u) { xcd_barrier_complete(bar, b.x, nloc, nx); b.st[0] = nloc; b.st[1] = nx; }
        const unsigned old = xb_add(&bar[XB_XSUB(b.x)], 1u);
        const unsigned gen = old / nloc;
        if (old + 1u == (gen + 1u) * nloc) {
            __builtin_amdgcn_fence(__ATOMIC_RELEASE, "agent");
            asm volatile("s_waitcnt vmcnt(0)" ::: "memory");
            const unsigned og = xb_add(&bar[XB_TOP], 1u);
            const unsigned tg = og / nx;
            if (og + 1u == (tg + 1u) * nx) xb_add(&bar[XB_TOPGEN], 1u);
            else XB_SPIN(xb_ld(&bar[XB_TOPGEN]) == tg, bar);
            __builtin_amdgcn_fence(__ATOMIC_ACQUIRE, "agent");
            xb_add(&bar[XB_XGEN(b.x)], 1u);
            asm volatile("s_waitcnt vmcnt(0)" ::: "memory");
        } else {
            XB_SPIN(xb_ld(&bar[XB_XGEN(b.x)]) == gen, bar);
            __builtin_amdgcn_fence(__ATOMIC_ACQUIRE, "agent");
            asm volatile("s_waitcnt vmcnt(0)" ::: "memory");
        }
    }
    __syncthreads();
}
namespace att {
using bf16x8 = __attribute__((ext_vector_type(8))) short;
using s16x4  = __attribute__((ext_vector_type(4))) short;
using f32x16 = __attribute__((ext_vector_type(16))) float;
using u32x4  = __attribute__((ext_vector_type(4))) unsigned;
constexpr int SEQ_ = 8192, LDQ = 6144; constexpr size_t SHM_V = 16384, SHM_K = 16384;
#define KSWZ(row, colB) ((row) * 256 + ((colB) ^ (((row) & 7) << 4)))
#define SBAR() __builtin_amdgcn_sched_barrier(0)
__device__ __forceinline__ int crow(int r, int hi) { return (r & 3) + 8 * (r >> 2) + 4 * hi; }
__device__ __forceinline__ unsigned cvtpk(float lo, float hi) {
  unsigned r; asm volatile("v_cvt_pk_bf16_f32 %0, %1, %2" : "=v"(r) : "v"(lo), "v"(hi)); return r;
}
__device__ __forceinline__ void qkt(f32x16& p0, f32x16& p1, const bf16* Ks, const bf16x8* qr, int r32, int hi, int jmap, float dbase, float slope2, float negm, bool diag) {
  asm volatile("" : "+v"(negm));
  if (diag) {
#pragma unroll
    for (int r = 0; r < 16; ++r) { const float d = (float)((r & 3) + 8 * (r >> 2)) + dbase;
      p0[r] = fmaf(-slope2, fabsf(d), negm); p1[r] = fmaf(-slope2, fabsf(d + 32.f), negm); }
  } else {
    const float u0 = fmaf(slope2, dbase, negm), u1 = fmaf(slope2, dbase + 32.f, negm);
#pragma unroll
    for (int r = 0; r < 16; ++r) { p0[r] = fmaf(slope2, (float)((r & 3) + 8 * (r >> 2)), u0); p1[r] = fmaf(slope2, (float)((r & 3) + 8 * (r >> 2)), u1); }
  }
#pragma unroll
  for (int d0 = 0; d0 < 4; ++d0) { const int cb = (jmap * 64 + d0 * 16 + hi * 8) * 2;
    bf16x8 b0 = *reinterpret_cast<const bf16x8*>((const char*)Ks + KSWZ(r32, cb));
    bf16x8 b1 = *reinterpret_cast<const bf16x8*>((const char*)Ks + KSWZ(32 + r32, cb));
    p0 = __builtin_amdgcn_mfma_f32_32x32x16_bf16(b0, qr[d0], p0, 0, 0, 0);
    p1 = __builtin_amdgcn_mfma_f32_32x32x16_bf16(b1, qr[d0], p1, 0, 0, 0); }
}
__device__ __forceinline__ void partialSM(f32x16& p0, f32x16& p1) {
#pragma unroll
  for (int r = 0; r < 16; ++r) p0[r] = __builtin_amdgcn_exp2f(p0[r]);
}
__device__ __forceinline__ void finishSM(f32x16& p0, f32x16& p1, float alpha, float& l_reg, bf16x8& pa0, bf16x8& pa1, bf16x8& pa2, bf16x8& pa3) {
  for (int r = 0; r < 16; ++r) p1[r] = __builtin_amdgcn_exp2f(p1[r]);
  float ps = 0; for (int r = 0; r < 16; ++r) ps += p0[r]; for (int r = 0; r < 16; ++r) ps += p1[r];
  { auto rr = __builtin_amdgcn_permlane32_swap(__float_as_uint(ps), __float_as_uint(ps), false, false);
    ps = __uint_as_float(rr[0]) + __uint_as_float(rr[1]); }
  l_reg = l_reg * alpha + ps;
#define PK4(P, BASE, OUT) do { unsigned a0 = cvtpk(P[BASE + 0], P[BASE + 1]), a1 = cvtpk(P[BASE + 2], P[BASE + 3]);   \
    unsigned b0 = cvtpk(P[BASE + 4], P[BASE + 5]), b1 = cvtpk(P[BASE + 6], P[BASE + 7]);                              \
    auto r0 = __builtin_amdgcn_permlane32_swap(a0, b0, false, false); auto r1 = __builtin_amdgcn_permlane32_swap(a1, b1, false, false); \
    u32x4 w = {r0[0], r1[0], r0[1], r1[1]}; OUT = *reinterpret_cast<bf16x8*>(&w); } while (0)
  PK4(p0, 0, pa0); PK4(p0, 8, pa1); PK4(p1, 0, pa2); PK4(p1, 8, pa3);
#undef PK4
}
__device__ __forceinline__ int v_st(int k, int c) { const int kk = (k & ~0xC) | ((k & 4) << 1) | ((k & 8) >> 1); return ((kk >> 3) * 4 + (c >> 5)) * 512 + ((kk & 7) * 32 + (c & 31)) * 2; }
__device__ __forceinline__ int v_rd_base(int lane) { return ((lane & 3) << 3) | (((lane >> 2) & 3) << 6) | (((lane >> 4) & 1) << 5) | (((lane >> 5) & 1) << 8); }
constexpr int v_rd_off(int d0, int ks, int half) { return d0 * 512 + ks * 4096 + half * 2048; }
template <int OFF> __device__ __forceinline__ s16x4 tr_read(int vb) {
  s16x4 r; asm volatile("ds_read_b64_tr_b16 %0, %1 offset:%2" : "=&v"(r) : "v"(vb), "i"(OFF) : "memory"); return r;
}
template <int D0> __device__ __forceinline__ void pv_one(f32x16& od, int vb, bf16x8 pa0, bf16x8 pa1, bf16x8 pa2, bf16x8 pa3) {
  const s16x4 l0 = tr_read<v_rd_off(D0, 0, 0)>(vb), h0 = tr_read<v_rd_off(D0, 0, 1)>(vb), l1 = tr_read<v_rd_off(D0, 1, 0)>(vb), h1 = tr_read<v_rd_off(D0, 1, 1)>(vb);
  const s16x4 l2 = tr_read<v_rd_off(D0, 2, 0)>(vb), h2 = tr_read<v_rd_off(D0, 2, 1)>(vb), l3 = tr_read<v_rd_off(D0, 3, 0)>(vb), h3 = tr_read<v_rd_off(D0, 3, 1)>(vb);
  asm volatile("s_waitcnt lgkmcnt(0)" ::: "memory"); SBAR();
#define PK(L, H) (bf16x8){L[0], L[1], L[2], L[3], H[0], H[1], H[2], H[3]}
  od = __builtin_amdgcn_mfma_f32_32x32x16_bf16(pa0, PK(l0, h0), od, 0, 0, 0);
  od = __builtin_amdgcn_mfma_f32_32x32x16_bf16(pa1, PK(l1, h1), od, 0, 0, 0);
  od = __builtin_amdgcn_mfma_f32_32x32x16_bf16(pa2, PK(l2, h2), od, 0, 0, 0);
  od = __builtin_amdgcn_mfma_f32_32x32x16_bf16(pa3, PK(l3, h3), od, 0, 0, 0);
#undef PK
}
#define PV_RD(S, D0) const s16x4 S##l0 = tr_read<v_rd_off(D0, 0, 0)>(vb), S##h0 = tr_read<v_rd_off(D0, 0, 1)>(vb), S##l1 = tr_read<v_rd_off(D0, 1, 0)>(vb), S##h1 = tr_read<v_rd_off(D0, 1, 1)>(vb), \
    S##l2 = tr_read<v_rd_off(D0, 2, 0)>(vb), S##h2 = tr_read<v_rd_off(D0, 2, 1)>(vb), S##l3 = tr_read<v_rd_off(D0, 3, 0)>(vb), S##h3 = tr_read<v_rd_off(D0, 3, 1)>(vb)
#define PV_PK(L, H) (bf16x8){L[0], L[1], L[2], L[3], H[0], H[1], H[2], H[3]}
#define PV_MM(S, OD) do { OD = __builtin_amdgcn_mfma_f32_32x32x16_bf16(pa0, PV_PK(S##l0, S##h0), OD, 0, 0, 0); OD = __builtin_amdgcn_mfma_f32_32x32x16_bf16(pa1, PV_PK(S##l1, S##h1), OD, 0, 0, 0); \
    OD = __builtin_amdgcn_mfma_f32_32x32x16_bf16(pa2, PV_PK(S##l2, S##h2), OD, 0, 0, 0); OD = __builtin_amdgcn_mfma_f32_32x32x16_bf16(pa3, PV_PK(S##l3, S##h3), OD, 0, 0, 0); } while (0)
__device__ __forceinline__ void pv_d0(f32x16* o, int vb, bf16x8 pa0, bf16x8 pa1, bf16x8 pa2, bf16x8 pa3) {
  PV_RD(a, 0); PV_RD(b, 1);
  asm volatile("s_waitcnt lgkmcnt(8)" ::: "memory"); SBAR();
  PV_MM(a, o[0]);
  PV_RD(c, 2);
  asm volatile("s_waitcnt lgkmcnt(8)" ::: "memory"); SBAR();
  PV_MM(b, o[1]);
  PV_RD(d, 3);
  asm volatile("s_waitcnt lgkmcnt(8)" ::: "memory"); SBAR();
  PV_MM(c, o[2]);
  asm volatile("s_waitcnt lgkmcnt(0)" ::: "memory"); SBAR();
  PV_MM(d, o[3]);
}
#undef PV_RD
#undef PV_PK
#undef PV_MM
__device__ __forceinline__ void attn_unit(int tid_in, int b, int h, int qb, int tb, const bf16* __restrict__ QKV, bf16* __restrict__ OB, float lam, float omli, float slope2, float m_ref, const float* __restrict__ subg, char* lds, gu32* qhead, volatile LAS unsigned* qslot) {
  int tid_o = tid_in; asm volatile("" : "+v"(tid_o));
  const int tid = tid_o, wid = __builtin_amdgcn_readfirstlane(tid >> 6), lane = tid & 63, r32 = lane & 31, hi = lane >> 5;
  const int jmap = wid >> 2, wq = wid & 3;
  constexpr int KR = 0, VR = 3 * 16384, WSO = 6 * 16384;
  float* ws = (float*)(lds + WSO) + wid * 64; float* li_l = ws;
  const long rowbase = (long)b * SEQ_; const int q0 = qb * 128 + wq * 32;
  float l_reg = 0.f; f32x16 o[4] = {}; bf16x8 qr[4];
  const bf16* Qw = QKV + (rowbase + q0 + r32) * LDQ + h * 128 + jmap * 64 + hi * 8;
#pragma unroll
  for (int d0 = 0; d0 < 4; ++d0) qr[d0] = *reinterpret_cast<const bf16x8*>(Qw + d0 * 16);
  const char* KVmid = (const char*)(QKV + (rowbase + 64 * tb) * LDQ + 2048 + h * 128 + 1024);
  unsigned koff[2], voff[2];
#pragma unroll
  for (int jb = 0; jb < 2; ++jb) { const int blk = 2 * wid + jb;
    { const int row = 4 * blk + (lane >> 4), chunk = (lane & 15) ^ (row & 7);
      koff[jb] = (unsigned)(row * LDQ * 2 + chunk * 16); }
    { const int sl = 64 * blk + lane, kk = 8 * (sl >> 7) + ((sl & 31) >> 2), c = 32 * ((sl >> 5) & 3) + 8 * (sl & 3);
      const int k = (kk & ~0xC) | ((kk & 4) << 1) | ((kk & 8) >> 1);
      voff[jb] = (unsigned)(k * LDQ * 2 + c * 2); } }
  const unsigned lds0 = (unsigned)(uintptr_t)lds;
  const int vb0 = (int)(lds0 + VR) + v_rd_base(lane);
  typedef __attribute__((address_space(3))) unsigned lds_u32;
#define DMA_K(t, slot) do { const char* t_ = KVmid + (size_t)(t) * (64 * LDQ * 2) - 2048; \
    __builtin_amdgcn_global_load_lds((const unsigned*)(t_ + koff[0]), (lds_u32*)(lds0 + KR + (slot) * 16384 + (2 * wid) * 1024), 16, 0, 0); \
    __builtin_amdgcn_global_load_lds((const unsigned*)(t_ + koff[1]), (lds_u32*)(lds0 + KR + (slot) * 16384 + (2 * wid + 1) * 1024), 16, 0, 0); } while (0)
#define DMA_V(t, slot) do { const char* t_ = KVmid + (size_t)(t) * (64 * LDQ * 2) + 2048; \
    __builtin_amdgcn_global_load_lds((const unsigned*)(t_ + voff[0]), (lds_u32*)(lds0 + VR + (slot) * 16384 + (2 * wid) * 1024), 16, 0, 0); \
    __builtin_amdgcn_global_load_lds((const unsigned*)(t_ + voff[1]), (lds_u32*)(lds0 + VR + (slot) * 16384 + (2 * wid + 1) * 1024), 16, 0, 0); } while (0)
#define WAIT_BAR(N) asm volatile("s_waitcnt vmcnt(" #N ") lgkmcnt(0)\n\ts_barrier" ::: "memory")
  f32x16 pA0, pA1, pB0, pB1; bf16x8 pa0, pa1, pa2, pa3;
  const int NT = 2 * qb + 2 - tb, cq = 2 * qb + (wq >> 1) - tb;
  const float dq = (float)(4 * hi - (q0 + r32) + 64 * tb);
#define QKT(P0, P1, kslot, t) qkt(P0, P1, (const bf16*)(lds + KR + (kslot) * 16384), qr, r32, hi, jmap, (float)(64 * (t)) + dq, slope2, ((t) > cq) ? -1e30f : -m_ref, (t) == cq)
  int sc = 0, sp = 2;
#define ROT() do { sp = sc; sc = (sc == 2) ? 0 : sc + 1; } while (0)
  asm volatile("s_waitcnt vmcnt(0)" : "+v"(qr[0]), "+v"(qr[1]), "+v"(qr[2]), "+v"(qr[3]) :: "memory");
  DMA_K(0, 0); DMA_V(0, 0); DMA_K(1, 1);
  WAIT_BAR(4);
  if (2 < NT) DMA_K(2, 2);
  DMA_V(1, 1);
  QKT(pA0, pA1, 0, 0); partialSM(pA0, pA1);
#define STEP(PX0, PX1, PY0, PY1, t) do { ROT(); \
    if ((t) + 1 < NT) { WAIT_BAR(4); } else { WAIT_BAR(2); } \
    { const int sn_ = (sp == 0) ? 2 : sp - 1;        \
      if ((t) + 2 < NT) DMA_K((t) + 2, sp); \
      if ((t) + 1 < NT) DMA_V((t) + 1, (3 - sc - sp)); (void)sn_; } \
    SBAR(); QKT(PX0, PX1, sc, t); \
    finishSM(PY0, PY1, 1.f, l_reg, pa0, pa1, pa2, pa3); SBAR(); \
    pv_d0(o, vb0 + sp * 16384, pa0, pa1, pa2, pa3); partialSM(PX0, PX1); } while (0)
  for (int t = 1; t + 1 < NT; t += 2) {
    STEP(pB0, pB1, pA0, pA1, t);
    STEP(pA0, pA1, pB0, pB1, t + 1);
  }
  STEP(pB0, pB1, pA0, pA1, NT - 1);
  WAIT_BAR(0);
  finishSM(pB0, pB1, 1.f, l_reg, pa0, pa1, pa2, pa3); SBAR();
  pv_d0(o, vb0 + sc * 16384, pa0, pa1, pa2, pa3);
  unsigned nxt_unit = 0u; if (tid == 0) nxt_unit = __hip_atomic_fetch_add(qhead, 1u, __ATOMIC_RELAXED, __HIP_MEMORY_SCOPE_AGENT);
  if (hi == 0) li_l[r32] = l_reg; asm volatile("s_waitcnt lgkmcnt(0)" ::: "memory");
#pragma unroll
  for (int r = 0; r < 16; ++r) { const float rl = __builtin_amdgcn_rcpf(li_l[crow(r, hi)]);
#pragma unroll
    for (int d0 = 0; d0 < 4; ++d0) o[d0][r] *= rl; }
  float* xch = (float*)lds + (size_t)wq * 4096 + lane;
  __syncthreads();
  if (jmap == 1) {
#pragma unroll
    for (int d0 = 0; d0 < 4; ++d0)
#pragma unroll
      for (int r = 0; r < 16; ++r) xch[(d0 * 16 + r) * 64] = o[d0][r];
  }
  __syncthreads();
  if (jmap == 0) {
    float ss[16];
#pragma unroll
    for (int r = 0; r < 16; ++r) { float s = 0.f;
#pragma unroll
      for (int d0 = 0; d0 < 4; ++d0) { const float df = o[d0][r] - lam * xch[(d0 * 16 + r) * 64]; o[d0][r] = df; s += df * df; }
      ss[r] = s; }
#pragma unroll
    for (int r = 0; r < 16; ++r) { float s = ss[r]; s += sx<1>(s); s += sx<2>(s); s += sx<4>(s); s += sx<8>(s); s += sx<16>(s);
      ss[r] = rsqrtf(s * (1.0f / 128.0f) + 1e-6f) * omli; }
    float gs[4]; int r32o = r32; asm volatile("" : "+v"(r32o));
#pragma unroll
    for (int d0 = 0; d0 < 4; ++d0) gs[d0] = subg[d0 * 32 + r32o];
    bf16* stg = (bf16*)(lds + 65536) + wq * 4096;
    int sto = 4 * hi * 128 + r32; asm volatile("" : "+v"(sto));
#pragma unroll
    for (int r = 0; r < 16; ++r) { const int orow = (r & 3) + 8 * (r >> 2);
#pragma unroll
      for (int d0 = 0; d0 < 4; ++d0) stg[sto + orow * 128 + d0 * 32] = (bf16)f2bf(o[d0][r] * ss[r] * gs[d0]); }
    asm volatile("s_waitcnt lgkmcnt(0)" ::: "memory");
    unsigned ooff = (unsigned)((q0 + (lane >> 4)) * 2048 + (lane & 15) * 8); asm volatile("" : "+v"(ooff));
    bf16* Ow = OB + rowbase * 2048 + h * 128 + ooff;
#pragma unroll
    for (int i = 0; i < 8; ++i) { const u32x4 v = *(const u32x4*)(stg + (4 * i + (lane >> 4)) * 128 + (lane & 15) * 8); *(u32x4*)(Ow + (4 * i) * 2048) = v; }
  }
  if (tid == 0) *qslot = nxt_unit;
  __syncthreads();
#undef DMA_K
#undef DMA_V
#undef WAIT_BAR
#undef ROT
#undef STEP
#undef QKT
}
#undef KSWZ
#undef SBAR
}
constexpr int DM = 2048, NB = 4, SEQ = 8192, MT = NB * SEQ, FF = 5632, NLAYER = 4, NH = 16, NMOD = 9 * DM;
constexpr float RMS_EPS = 1e-6f;
constexpr int NWAVES = 8;
#ifndef PROBE_MASK
#define PROBE_MASK 0
#endif
#ifndef PROBE_IDLE
#define PROBE_IDLE 0
#endif
#ifndef PROBE_ECHO
#define PROBE_ECHO 0
#endif
#ifndef FFN_SPLIT
#define FFN_SPLIT 1
#endif
#ifndef GU_WGM
#define GU_WGM 8
#endif
#ifndef OUT_A_AUX
#define OUT_A_AUX 0
#endif
#ifndef OUT_WGM
#define OUT_WGM 4
#endif
#ifndef MK_PER_PHASE
#define MK_PER_PHASE 0
#endif
constexpr int N_PHASES = 32 + 8 * 2 * (FFN_SPLIT - 1);
constexpr size_t MiB = 1u << 20;
constexpr size_t WS_CTL = 0, CTL_ZERO_BYTES = 3 * MiB;
constexpr size_t WS_MOD = 1696 * MiB;
constexpr size_t WS_EBL = 3 * MiB;
constexpr size_t WS_WGU = 8 * MiB;
constexpr size_t WS_WD  = 360 * MiB;
constexpr size_t WS_WAI = 536 * MiB;
constexpr size_t WS_WAO = 584 * MiB;
constexpr size_t WS_WCI = 600 * MiB, WS_WCO = 624 * MiB;
constexpr size_t WS_WHI = 632 * MiB, WS_WHO = 664 * MiB;
constexpr size_t WS_XN  = 672 * MiB;
constexpr size_t WS_BIG = 800 * MiB;
constexpr size_t WS_OB  = 1312 * MiB;
constexpr size_t WS_KLT = 1440 * MiB;
constexpr size_t WS_IT  = 1568 * MiB;
constexpr size_t WS_RSS = 1 * MiB, RSS_BYTES = 2 * MiB;
constexpr size_t WS_CB  = 1698 * MiB;
constexpr int CB_LD = 2 * 5632;
constexpr size_t WS_TAB = 1701 * MiB;
constexpr size_t WS_XH  = 1702 * MiB;
constexpr size_t WS_END = 1830 * MiB;
constexpr int CW_BAR = 4096;
constexpr int RING_OFF = 0, RING_BYTES = 131072;
constexpr int LDSCTL_OFF = RING_BYTES, MISC_OFF = LDSCTL_OFF + 320;
constexpr int PRE_OFF = LDSCTL_OFF + 1024;
constexpr int LDS_BYTES = 147456;

struct Args { const float* in[21]; float* out; unsigned char* ws; int ph_lo, ph_hi; };
struct Frame {
    LAS unsigned char* lds;
    volatile LAS unsigned* MISC;
    gu32* ctl;
    int tid, lane, wave, vcu, G;
    const struct Args* a; float* out; unsigned char* ws;
};
__device__ __forceinline__ float bf_lo(unsigned w) { return __uint_as_float(w << 16); }
__device__ __forceinline__ float bf_hi(unsigned w) { return __uint_as_float(w & 0xffff0000u); }
__device__ __forceinline__ float bf_f(bf16 x) { return __uint_as_float((unsigned)x << 16); }

__device__ __forceinline__ void unpack8(const v4u w, float (&x)[8]) { x[0] = bf_lo(w.x); x[1] = bf_hi(w.x); x[2] = bf_lo(w.y); x[3] = bf_hi(w.y); x[4] = bf_lo(w.z); x[5] = bf_hi(w.z); x[6] = bf_lo(w.w); x[7] = bf_hi(w.w); }
__device__ __forceinline__ void p0_mod(Frame& F) {
    LAS float* cond = (LAS float*)(F.lds);
    LAS float* part = (LAS float*)(F.lds + 32768);
    const float* c = F.a->in[1]; const float* aw = F.a->in[2]; const float* ab = F.a->in[3]; float* mod = (float*)(F.ws + WS_MOD);
    for (int i = F.tid; i < NB * DM; i += NWAVES * 64) { const float v = c[i]; cond[i] = v / (1.0f + __expf(-v)); }
    __syncthreads();
    const int cg = F.tid & 15, ks = F.tid >> 4;
    for (int it = F.vcu; it < NLAYER * (NMOD / 64); it += F.G) {
        const int L = it / (NMOD / 64), n0 = (it % (NMOD / 64)) * 64;
        f32x4 a0 = {0.f, 0.f, 0.f, 0.f}, a1 = a0, a2 = a0, a3 = a0;
        const float* wp = aw + ((size_t)L * DM + ks * 64) * NMOD + n0 + 4 * cg;
#pragma unroll 8
        for (int k = 0; k < 64; ++k) { const f32x4 w = *(const f32x4*)(wp + (size_t)k * NMOD); const int kk = ks * 64 + k;
            a0 += w * cond[kk]; a1 += w * cond[DM + kk]; a2 += w * cond[2 * DM + kk]; a3 += w * cond[3 * DM + kk]; }
        *(LAS f32x4*)(part + (ks * 4 + 0) * 64 + 4 * cg) = a0; *(LAS f32x4*)(part + (ks * 4 + 1) * 64 + 4 * cg) = a1;
        *(LAS f32x4*)(part + (ks * 4 + 2) * 64 + 4 * cg) = a2; *(LAS f32x4*)(part + (ks * 4 + 3) * 64 + 4 * cg) = a3;
        __syncthreads();
        if (F.tid < 256) { const int b = F.tid >> 6, col = F.tid & 63; float s = 0.f;
#pragma unroll 8
            for (int k2 = 0; k2 < 32; ++k2) s += part[(k2 * 4 + b) * 64 + col];
            mod[((size_t)L * NB + b) * NMOD + n0 + col] = s + ab[(size_t)L * NMOD + n0 + col]; }
        __syncthreads();
    }
}
struct CvItem { const float* W; bf16* WT; int K, N, mode, item; };
__device__ __forceinline__ CvItem cv_decode(Frame& F, int it) {
    constexpr int I_FFN = (DM / 64) * (FF / 32);
    constexpr int I_IN3 = (DM / 64) * (3 * DM / 32), I_SQ = (DM / 64) * (DM / 32), I_IN4 = (DM / 64) * (4 * DM / 32);
    int r = it;
    if (r < 24 * I_FFN) { const int m = r / I_FFN, ls = m / 3, which = m % 3; r -= m * I_FFN;
        if (which == 0) return CvItem{F.a->in[5] + (size_t)ls * DM * FF, (bf16*)(F.ws + WS_WGU) + (size_t)ls * 2 * FF * DM, DM, FF, 1, r};
        if (which == 1) return CvItem{F.a->in[6] + (size_t)ls * DM * FF, (bf16*)(F.ws + WS_WGU) + (size_t)ls * 2 * FF * DM, DM, FF, 2, r};
        return CvItem{F.a->in[7] + (size_t)ls * FF * DM, (bf16*)(F.ws + WS_WD) + (size_t)ls * DM * FF, FF, DM, 0, r}; }
    r -= 24 * I_FFN;
    if (r < 2 * I_IN3) { const int s = r / I_IN3; return CvItem{F.a->in[8] + (size_t)s * DM * 3 * DM, (bf16*)(F.ws + WS_WAI) + (size_t)s * 3 * DM * DM, DM, 3 * DM, 3, r - s * I_IN3}; } r -= 2 * I_IN3;
    if (r < 2 * I_SQ) { const int s = r / I_SQ; return CvItem{F.a->in[9] + (size_t)s * DM * DM, (bf16*)(F.ws + WS_WAO) + (size_t)s * DM * DM, DM, DM, 0, r - s * I_SQ}; } r -= 2 * I_SQ;
    if (r < I_IN3) return CvItem{F.a->in[14], (bf16*)(F.ws + WS_WCI), DM, 3 * DM, 0, r}; r -= I_IN3;
    if (r < I_SQ) return CvItem{F.a->in[16], (bf16*)(F.ws + WS_WCO), DM, DM, 0, r}; r -= I_SQ;
    if (r < I_IN4) return CvItem{F.a->in[17], (bf16*)(F.ws + WS_WHI), DM, 4 * DM, 0, r}; r -= I_IN4;
    return CvItem{F.a->in[18], (bf16*)(F.ws + WS_WHO), DM, DM, 0, r};
}
__device__ __forceinline__ void cv_load(const CvItem& c, float (&wv)[32], int lane) {
    const int nblk = c.N / 32, kb = c.item / nblk, nb = c.item % nblk;
    const float* wp = c.W + (size_t)(64 * kb + (lane >> 5)) * c.N + 32 * nb + (lane & 31);
#pragma unroll
    for (int i = 0; i < 32; ++i) wv[i] = wp[(size_t)(2 * i) * c.N];
}
__device__ __forceinline__ void cv_finish(const CvItem& c, const float (&wv)[32], LAS float* scr, int lane) {
    const int K = c.K, mode = c.mode, nblk = c.N / 32, kb = c.item / nblk, nb = c.item % nblk, n0 = 32 * nb;
    const int drow0 = (mode == 0 || (mode == 3 && n0 >= 2 * DM)) ? n0 : (mode == 3) ? ((n0 & ~255) + 128 * ((n0 >> 5) & 1) + 32 * ((n0 >> 6) & 3)) : ((n0 >> 7) * 256 + (mode - 1) * 128 + (n0 & 127));
#pragma unroll
    for (int i = 0; i < 32; ++i) scr[(2 * i + (lane >> 5)) * 33 + (lane & 31)] = wv[i];
    LDS_WAIT(); asm volatile("" ::: "memory");
    const int cc = lane & 7;
#pragma unroll
    for (int j = 0; j < 4; ++j) { const int n = (lane >> 3) + 8 * j; const LAS float* s = scr + (8 * cc) * 33 + n;
        v4u o; o.x = pk2(s[0 * 33], s[1 * 33]); o.y = pk2(s[2 * 33], s[3 * 33]); o.z = pk2(s[4 * 33], s[5 * 33]); o.w = pk2(s[6 * 33], s[7 * 33]);
        const int dr = drow0 + n;
        *(GAS v4u*)(c.WT + ((size_t)((dr >> 8) * (K >> 6) + kb) * 256 + (dr & 255)) * 64 + 8 * cc) = o; }
    LDS_WAIT(); asm volatile("" ::: "memory");
}
__device__ __forceinline__ void p0_convert(Frame& F) {
    LAS float* scr = (LAS float*)(F.lds + RING_OFF + F.wave * 16384);
    const int gw = F.vcu * NWAVES + F.wave, NGW = F.G * NWAVES;
    constexpr int NITEMS = 24 * ((DM / 64) * (FF / 32)) + 3 * ((DM / 64) * (3 * DM / 32)) + 4 * ((DM / 64) * (DM / 32)) + (DM / 64) * (4 * DM / 32);
    CvItem A, B; float wa[32], wb[32];
    int it = gw;
    if (it < NITEMS) { A = cv_decode(F, it); cv_load(A, wa, F.lane); }
    while (it < NITEMS) {
        int nx = it + NGW;
        if (nx < NITEMS) { B = cv_decode(F, nx); cv_load(B, wb, F.lane); }
        cv_finish(A, wa, scr, F.lane);
        it = nx; if (it >= NITEMS) break;
        nx = it + NGW;
        if (nx < NITEMS) { A = cv_decode(F, nx); cv_load(A, wa, F.lane); }
        cv_finish(B, wb, scr, F.lane);
        it = nx;
    }
}
__device__ __forceinline__ void xs0_phase(Frame& F, const float* xsrc, const float* g, const float* modL) {
    bf16* XN = (bf16*)(F.ws + WS_XN); float* rss = (float*)(F.ws + WS_RSS);
    const int gw = F.vcu * NWAVES + F.wave, NGW = F.G * NWAVES;
    for (int r0 = gw * 16; r0 < MT; r0 += NGW * 16) {
        const int b = r0 / SEQ;
        const float* sc = modL + (size_t)b * NMOD + DM;
        f32x4 a[8];
#pragma unroll
        for (int j = 0; j < 8; ++j) { const int col = 4 * F.lane + 256 * j; a[j] = *(const f32x4*)(g + col) * (*(const f32x4*)(sc + col) + 1.0f); }
#pragma unroll 2
        for (int r = 0; r < 16; ++r) {
            const GAS f32x4* xr = (const GAS f32x4*)(xsrc + (size_t)(r0 + r) * DM) + F.lane;
            f32x4 v[8]; float s = 0.f;
#pragma unroll
            for (int j = 0; j < 8; ++j) { v[j] = xr[64 * j]; s += (v[j].x * v[j].x + v[j].y * v[j].y) + (v[j].z * v[j].z + v[j].w * v[j].w); }
            s = wave_sum(s);
            if (F.lane == 0) rss[r0 + r] = s;
            bf16* o8 = XN + ((size_t)((r0 + r) >> 8) * 32 * 256 + ((r0 + r) & 255)) * 64 + (size_t)(F.lane >> 4) * (256 * 64) + 4 * (F.lane & 15);
#pragma unroll
            for (int j = 0; j < 8; ++j) { const f32x4 h = v[j] * a[j];
                *(GAS unsigned long long*)(o8 + (size_t)(4 * j) * (256 * 64)) = (unsigned long long)pk2(h.x, h.y) | ((unsigned long long)pk2(h.z, h.w) << 32); }
        }
    }
}
__device__ __forceinline__ void tables_phase(Frame& F) {
    const float* mod = (const float*)(F.ws + WS_MOD); float* TAB = (float*)(F.ws + WS_TAB); const float* ng = F.a->in[4];
    const int gt = F.vcu * (NWAVES * 64) + F.tid, NT = F.G * NWAVES * 64;
    for (int i = gt; i < 3 * NLAYER * NB * DM; i += NT) {
        const int col = i % DM, b = (i / DM) % NB, s = i / (DM * NB), L = s / 3, sub = s % 3, sn = s + 1, Ln = sn / 3, subn = sn % 3;
        TAB[((size_t)(s * 2 + 0) * NB + b) * DM + col] = ((sub == 1) ? 1.0f : 0.5f) * mod[((size_t)L * NB + b) * NMOD + (3 * sub + 2) * DM + col];
        TAB[((size_t)(s * 2 + 1) * NB + b) * DM + col] = (sn < 3 * NLAYER) ? ng[((size_t)Ln * 3 + subn) * DM + col] * (1.0f + mod[((size_t)Ln * NB + b) * NMOD + (3 * subn + 1) * DM + col]) : 0.f;
    }
}
__device__ __forceinline__ void bias_phase(Frame& F) {
    const float* mod = (const float*)(F.ws + WS_MOD); float* CB = (float*)(F.ws + WS_CB);
    const int gw = F.vcu * NWAVES + F.wave, NGW = F.G * NWAVES;
#pragma unroll 1
    for (int s = 0; s < 3 * NLAYER; ++s) {
        const int L = s / 3, sub = s % 3, kind = L % 3, slot = L / 3;
        const bf16* W; int N;
        if (sub != 1) { W = (const bf16*)(F.ws + WS_WGU) + (size_t)(L * 2 + (sub >> 1)) * 2 * FF * DM; N = 2 * FF; }
        else if (kind == 0) { W = (const bf16*)(F.ws + WS_WAI) + (size_t)slot * 3 * DM * DM; N = 3 * DM; }
        else if (kind == 1) { W = (const bf16*)(F.ws + WS_WCI); N = 3 * DM; }
        else { W = (const bf16*)(F.ws + WS_WHI); N = 4 * DM; }
        float sh[4][4][8];
#pragma unroll
        for (int b = 0; b < NB; ++b)
#pragma unroll
            for (int it = 0; it < 4; ++it) { const float* sp = mod + ((size_t)L * NB + b) * NMOD + (3 * sub) * DM + 8 * (64 * it + F.lane);
                const f32x4 s0 = *(const f32x4*)sp, s1 = *(const f32x4*)(sp + 4);
                sh[b][it][0] = s0.x; sh[b][it][1] = s0.y; sh[b][it][2] = s0.z; sh[b][it][3] = s0.w; sh[b][it][4] = s1.x; sh[b][it][5] = s1.y; sh[b][it][6] = s1.z; sh[b][it][7] = s1.w; }
        for (int n = gw; n < N; n += NGW) {
            const bf16* wrow = W + ((size_t)(n >> 8) * (DM >> 6) * 256 + (n & 255)) * 64 + (F.lane & 7) * 8;
            float d0 = 0.f, d1 = 0.f, d2 = 0.f, d3 = 0.f;
#pragma unroll
            for (int it = 0; it < 4; ++it) { float w[8]; unpack8(*(const GAS v4u*)(wrow + (size_t)(8 * it + (F.lane >> 3)) * 256 * 64), w);
#pragma unroll
                for (int i = 0; i < 8; ++i) { d0 += w[i] * sh[0][it][i]; d1 += w[i] * sh[1][it][i]; d2 += w[i] * sh[2][it][i]; d3 += w[i] * sh[3][it][i]; } }
            d0 = wave_sum(d0); d1 = wave_sum(d1); d2 = wave_sum(d2); d3 = wave_sum(d3);
            if (F.lane == 0) { float* cp = CB + (size_t)s * NB * CB_LD + n; cp[0] = d0; cp[CB_LD] = d1; cp[2 * CB_LD] = d2; cp[3 * CB_LD] = d3; }
        }
    }
}
constexpr int CW_ATTNQ = 8192;
__device__ __forceinline__ void attn_phase(Frame& F, int L, int slot, int qword = 0) {
    const bf16* QKV = (const bf16*)(F.ws + WS_BIG); bf16* OB = (bf16*)(F.ws + WS_OB);
    const float* lv = F.a->in[12] + (size_t)slot * 4 * 64;
    int ln = F.lane; asm volatile("" : "+v"(ln));
    const float sa = wave_sum(lv[ln] * lv[64 + ln]), sb = wave_sum(lv[128 + ln] * lv[192 + ln]);
    asm volatile("" : "+s"(L));
    const float lambda_init = (L == 0) ? 0.2f : (L == 1) ? 0.35550906f : (L == 2) ? 0.47071302f : 0.55605822f;
    const float lam = expf(sa) - expf(sb) + lambda_init;
    const float* subg = F.a->in[13] + (size_t)slot * 128;
    float gm = fabsf(F.a->in[10][slot * 64 + ln] * F.a->in[11][slot * 64 + ln]);
    gm = wave_max(gm);
    const float twoB24 = 16.0f * gm + 24.0f;
    const float m_ref = (8.0f * gm) * 1.4426950408889634f * 1.02f + 0.5f;
    gu32* qhead = F.ctl + CW_ATTNQ + 64 * slot + 256 * qword;
    if (F.tid == 0) F.MISC[16] = __hip_atomic_fetch_add(qhead, 1u, RLX_AGENT);
    __syncthreads();
    int n = (int)F.MISC[16];
    while (n < NB * NH * (SEQ / 128)) {
        const int qb = 63 - (n >> 6), bhq = n & 63, h = 15 - (bhq >> 2), b = bhq & 3;
        const float slope = exp2f(-0.5f * (float)(h + 1));
        const float W = (twoB24 - __logf(1.0f - __expf(-slope))) / slope;
        int tb = (int)floorf(((float)(128 * qb) - W) * (1.0f / 64.0f)); tb = (tb < 0 ? 0 : tb) & ~1;
        att::attn_unit(F.tid, b, h, qb, tb, QKV, OB, lam, 1.0f - lambda_init, slope * 1.4426950408889634f, m_ref, subg, (char*)(F.lds + RING_OFF), qhead, F.MISC + 16);
        n = (int)F.MISC[16];
    }
}
__device__ __forceinline__ void conv_phase(Frame& F) {
    const bf16* U = (const bf16*)(F.ws + WS_BIG); bf16* OB = (bf16*)(F.ws + WS_OB); const float* cw = F.a->in[15];
    const int gt = F.vcu * (NWAVES * 64) + F.tid, NT = F.G * NWAVES * 64;
    for (int item = gt; item < 256 * (MT / 16); item += NT) {
        int dg = item & 255; asm volatile("" : "+v"(dg));
        const int run = item >> 8, row0 = run * 16, d = dg * 8;
        float w0[8], w1[8], w2[8];
#pragma unroll
        for (int i = 0; i < 8; ++i) { w0[i] = cw[d + i]; w1[i] = cw[DM + d + i]; w2[i] = cw[2 * DM + d + i]; }
        float vm2[8], vm1[8];
        if ((row0 % SEQ) == 0) {
#pragma unroll
            for (int i = 0; i < 8; ++i) { vm2[i] = 0.f; vm1[i] = 0.f; }
        } else {
            float a[8], b[8];
            unpack8(*(const GAS v4u*)(U + (size_t)(row0 - 2) * 6144 + 2048 + d), a); unpack8(*(const GAS v4u*)(U + (size_t)(row0 - 2) * 6144 + 4096 + d), b);
#pragma unroll
            for (int i = 0; i < 8; ++i) vm2[i] = a[i] * b[i];
            unpack8(*(const GAS v4u*)(U + (size_t)(row0 - 1) * 6144 + 2048 + d), a); unpack8(*(const GAS v4u*)(U + (size_t)(row0 - 1) * 6144 + 4096 + d), b);
#pragma unroll
            for (int i = 0; i < 8; ++i) vm1[i] = a[i] * b[i];
        }
#pragma unroll 4
        for (int t = 0; t < 16; ++t) {
            const bf16* rp = U + (size_t)(row0 + t) * 6144 + d;
            float bg[8], cg[8], uu[8], y[8];
            unpack8(*(const GAS v4u*)(rp), bg); unpack8(*(const GAS v4u*)(rp + 2048), cg); unpack8(*(const GAS v4u*)(rp + 4096), uu);
#pragma unroll
            for (int i = 0; i < 8; ++i) { const float v = cg[i] * uu[i]; y[i] = bg[i] * (w0[i] * vm2[i] + w1[i] * vm1[i] + w2[i] * v); vm2[i] = vm1[i]; vm1[i] = v; }
            v4u o; o.x = pk2(y[0], y[1]); o.y = pk2(y[2], y[3]); o.z = pk2(y[4], y[5]); o.w = pk2(y[6], y[7]);
            *(GAS v4u*)(OB + (size_t)(row0 + t) * DM + d) = o;
        }
    }
}
#define LDS_BAR() asm volatile("s_waitcnt lgkmcnt(0)\n\ts_barrier" ::: "memory")
typedef short s16x4 __attribute__((ext_vector_type(4)));
typedef float f32x16 __attribute__((ext_vector_type(16)));
__device__ __forceinline__ int crow16(int r, int hi) { return (r & 3) + 8 * (r >> 2) + 4 * hi; }
constexpr int H_P256 = 272, H_P128 = 144;
__device__ __forceinline__ void hgrn_prep_phase(Frame& F, int layer, bf16* QBO, int qbld, bf16* OBO) {
    bf16* BIG = (bf16*)(F.ws + WS_BIG); bf16* KLT = (bf16*)(F.ws + WS_KLT); bf16* ITG = (bf16*)(F.ws + WS_IT); float* EBL = (float*)(F.ws + WS_EBL); bf16* OB = (bf16*)(F.ws + WS_OB);
    const float* lbl = F.a->in[20];
    LAS unsigned char* QS = F.lds; LAS unsigned char* KS = F.lds + 64 * H_P256; LAS unsigned char* ITL = F.lds + 2 * 64 * H_P256; LAS float* TOT = (LAS float*)(F.lds + 2 * 64 * H_P256 + 128 * H_P128);
    const int kp = F.lane, seg = F.wave, r32 = F.lane & 31, hi = F.lane >> 5;
    unsigned qw[8], fw[8], iw[8]; f32x2_cv lgt[4];
#define H1_LOAD(un) do { const int bh_ = (un) >> 7, c_ = (un) & 127; const size_t rb_ = (size_t)(bh_ >> 4) * SEQ + (size_t)c_ * 64; \
        _Pragma("unroll") for (int L_ = 0; L_ < 4; ++L_) lgt[L_] = *(const GAS f32x2_cv*)(lbl + L_ * DM + (bh_ & 15) * 128 + 2 * kp); \
        _Pragma("unroll") for (int tt = 0; tt < 8; ++tt) { const bf16* pq = BIG + (rb_ + 8 * seg + tt) * 8192 + (bh_ & 15) * 128 + 2 * kp; \
            qw[tt] = *(const GAS unsigned*)pq; fw[tt] = *(const GAS unsigned*)(pq + 2048); iw[tt] = *(const GAS unsigned*)(pq + 4096); } } while (0)
    for (int unit = F.vcu; unit < NB * NH * (SEQ / 64); unit += F.G) {
        const int bh = unit >> 7, c = unit & 127, b = bh >> 4, h = bh & 15; const size_t rowbase = (size_t)b * SEQ + (size_t)c * 64;
        if (unit == F.vcu) H1_LOAD(unit);
        float lb[2];
#pragma unroll
        for (int kk = 0; kk < 2; ++kk) { const float l0 = lgt[0][kk], l1 = lgt[1][kk], l2 = lgt[2][kk], l3 = lgt[3][kk];
            const float mx = fmaxf(fmaxf(l0, l1), fmaxf(l2, l3)); const float e0 = __expf(l0 - mx), e1 = __expf(l1 - mx), e2 = __expf(l2 - mx), e3 = __expf(l3 - mx);
            float cumv = 0.f; if (layer >= 1) cumv += e1; if (layer >= 2) cumv += e2; if (layer >= 3) cumv += e3;
            lb[kk] = cumv * __builtin_amdgcn_rcpf(e0 + e1 + e2 + e3); }
        float bcs[8][2], kv[8][2]; float cum[2] = {0.f, 0.f};
#pragma unroll
        for (int tt = 0; tt < 8; ++tt)
#pragma unroll
            for (int kk = 0; kk < 2; ++kk) { const float x = kk ? bf_hi(fw[tt]) : bf_lo(fw[tt]); const float sig = __builtin_amdgcn_rcpf(1.0f + __expf(-x));
                const float f = lb[kk] + (1.0f - lb[kk]) * sig; cum[kk] += __builtin_amdgcn_logf(f) * 0.6931471805599453f;     bcs[tt][kk] = cum[kk]; kv[tt][kk] = 1.0f - f; }
        TOT[seg * 128 + 2 * kp] = cum[0]; TOT[seg * 128 + 2 * kp + 1] = cum[1];
        LDS_BAR();
        float off[2] = {0.f, 0.f}, rb[2] = {0.f, 0.f}, bl[2] = {0.f, 0.f};
#pragma unroll
        for (int s = 0; s < 8; ++s)
#pragma unroll
            for (int kk = 0; kk < 2; ++kk) { const float tv = TOT[s * 128 + 2 * kp + kk]; if (s < seg) off[kk] += tv; if (s < 4) rb[kk] += tv; bl[kk] += tv; }
        float erb[2], enrb[2], ebl[2];
#pragma unroll
        for (int kk = 0; kk < 2; ++kk) { erb[kk] = __expf(rb[kk]); enrb[kk] = __expf(-rb[kk]); ebl[kk] = __expf(bl[kk]); }
        unsigned klw[2][4], itw[2][4];
#pragma unroll
        for (int tt = 0; tt < 8; ++tt) { float qb_[2], qs_[2], ks_[2], kl_[2];
#pragma unroll
            for (int kk = 0; kk < 2; ++kk) { const float bb = bcs[tt][kk] + off[kk]; const float q = kk ? bf_hi(qw[tt]) : bf_lo(qw[tt]);
                const float eb = __expf(bb), enb = __builtin_amdgcn_rcpf(eb);
                qb_[kk] = q * eb; qs_[kk] = qb_[kk] * enrb[kk]; ks_[kk] = kv[tt][kk] * (erb[kk] * enb); kl_[kk] = kv[tt][kk] * (ebl[kk] * enb); }
            *(GAS unsigned*)(QBO + (rowbase + 8 * seg + tt) * qbld + h * 128 + 2 * kp) = pk2(qb_[0], qb_[1]);
            *(LAS unsigned*)(QS + (8 * seg + tt) * H_P256 + 4 * kp) = pk2(qs_[0], qs_[1]);
            *(LAS unsigned*)(KS + (8 * seg + tt) * H_P256 + 4 * kp) = pk2(ks_[0], ks_[1]);
            if (tt & 1) { klw[0][tt >> 1] |= f2bf(kl_[0]) << 16; klw[1][tt >> 1] |= f2bf(kl_[1]) << 16; itw[0][tt >> 1] |= (iw[tt] & 0xffffu) << 16; itw[1][tt >> 1] |= (iw[tt] >> 16) << 16; }
            else { klw[0][tt >> 1] = f2bf(kl_[0]); klw[1][tt >> 1] = f2bf(kl_[1]); itw[0][tt >> 1] = iw[tt] & 0xffffu; itw[1][tt >> 1] = iw[tt] >> 16; }
        }
#pragma unroll
        for (int kk = 0; kk < 2; ++kk) { const v4u kw = {klw[kk][0], klw[kk][1], klw[kk][2], klw[kk][3]}, tw = {itw[kk][0], itw[kk][1], itw[kk][2], itw[kk][3]};
            *(GAS v4u*)(KLT + (size_t)unit * 8192 + (2 * kp + kk) * 64 + 8 * seg) = kw;
            *(GAS v4u*)(ITG + (size_t)unit * 8192 + (2 * kp + kk) * 64 + 8 * seg) = tw;
            *(LAS v4u*)(ITL + (2 * kp + kk) * H_P128 + 16 * seg) = tw; }
        if (seg == 0) { EBL[(size_t)unit * 128 + 2 * kp] = ebl[0]; EBL[(size_t)unit * 128 + 2 * kp + 1] = ebl[1]; }
        LDS_BAR();
        if (unit + F.G < NB * NH * (SEQ / 64)) H1_LOAD(unit + F.G);
        const int tt_ = F.wave & 1, vt = F.wave >> 1;
        f32x16 z = {};
        for (int st = 0; st <= tt_; ++st) {
            f32x16 x = {};
#pragma unroll
            for (int step = 0; step < 8; ++step) { const bf16x8 a = *(const LAS bf16x8*)(KS + (32 * st + r32) * H_P256 + (16 * step + 8 * hi) * 2);
                const bf16x8 bq = *(const LAS bf16x8*)(QS + (32 * tt_ + r32) * H_P256 + (16 * step + 8 * hi) * 2);
                x = __builtin_amdgcn_mfma_f32_32x32x16_bf16(a, bq, x, 0, 0, 0); }
            if (st == tt_) {
#pragma unroll
                for (int r = 0; r < 16; ++r) if (crow16(r, hi) > r32) x[r] = 0.f;
            }
#pragma unroll
            for (int sp = 0; sp < 2; ++sp) {
                v4u pw; pw.x = pk2(x[8 * sp + 0], x[8 * sp + 1]); pw.y = pk2(x[8 * sp + 2], x[8 * sp + 3]); pw.z = pk2(x[8 * sp + 4], x[8 * sp + 5]); pw.w = pk2(x[8 * sp + 6], x[8 * sp + 7]);
                const bf16x8 xs = __builtin_bit_cast(bf16x8, pw);
                const LAS unsigned char* ip = ITL + (32 * vt + r32) * H_P128 + (32 * st + 16 * sp + 4 * hi) * 2;
                const s16x4 lo = *(const LAS s16x4*)ip, hh = *(const LAS s16x4*)(ip + 16);
                const bf16x8 pb = __builtin_shufflevector(lo, hh, 0, 1, 2, 3, 4, 5, 6, 7);
                z = __builtin_amdgcn_mfma_f32_32x32x16_bf16(xs, pb, z, 0, 0, 0);
            }
        }
        bf16* op = OBO + (rowbase + 32 * tt_) * DM + h * 128 + 32 * vt + r32;
#pragma unroll
        for (int r = 0; r < 16; ++r) op[(size_t)crow16(r, hi) * DM] = (bf16)f2bf(z[r]);
        LDS_BAR();
    }
}
#undef H1_LOAD
__device__ __forceinline__ void hgrn_scan_phase(Frame& F, bf16* OBO) {
    const bf16* BIG = (const bf16*)(F.ws + WS_BIG); const bf16* KLT = (const bf16*)(F.ws + WS_KLT); const bf16* ITG = (const bf16*)(F.ws + WS_IT); const float* EBL = (const float*)(F.ws + WS_EBL); const bf16* OB = (const bf16*)(F.ws + WS_OB);
    constexpr int TB = 64 * H_P256 + 128 * H_P128 + 32 * H_P128 + 512;
    constexpr int STB = 32 * H_P256;
    constexpr int IOB = 64 * 64;
    LAS unsigned char* TL = F.lds; LAS unsigned char* STL = F.lds + 2 * TB; LAS unsigned char* ISL = STL + 2 * STB; LAS unsigned char* OSL = ISL + 2 * IOB;
    const int tid = F.tid, r32 = F.lane & 31, hi = F.lane >> 5, w = F.wave;
    for (int unit = F.vcu; unit < NB * NH * 4; unit += F.G) {
        const int bh = unit >> 2, vq = unit & 3, b = bh >> 4, h = bh & 15;
        f32x16 acc = {};
        v4u q0[2], k0[2], i0, e0, q1[2], k1[2], i1, e1, ivr[2];
        i0 = i1 = e0 = e1 = ivr[0] = ivr[1] = (v4u){(unsigned)tid >> 31, 0u, 0u, 0u};
        const int ioq = (F.lane + 64 * (w & 1));
#define H2_LOAD(Q, K, I, E, c) do { const size_t rb_ = (size_t)b * SEQ + (size_t)(c) * 64; const size_t un_ = (size_t)bh * 128 + (c); \
        _Pragma("unroll") for (int i_ = 0; i_ < 2; ++i_) { const int p_ = tid + 512 * i_; \
            Q[i_] = *(const GAS v4u*)(BIG + (rb_ + (p_ >> 4)) * 8192 + h * 128 + (p_ & 15) * 8); K[i_] = *(const GAS v4u*)(KLT + un_ * 8192 + (size_t)p_ * 8); } \
        if (tid < 256) I = *(const GAS v4u*)(ITG + un_ * 8192 + (size_t)(32 * vq) * 64 + (size_t)tid * 8); \
        if (tid < 32) E = *(const GAS v4u*)(EBL + un_ * 128 + 4 * tid); } while (0)
#define H2_WRITE(Q, K, I, E, bufo) do { LAS unsigned char* tb_ = TL + (bufo); _Pragma("unroll") for (int i_ = 0; i_ < 2; ++i_) { const int p_ = tid + 512 * i_; \
            *(LAS v4u*)(tb_ + (p_ >> 4) * H_P256 + (p_ & 15) * 16) = Q[i_]; *(LAS v4u*)(tb_ + 64 * H_P256 + (p_ >> 3) * H_P128 + (p_ & 7) * 16) = K[i_]; } \
        if (tid < 256) *(LAS v4u*)(tb_ + 64 * H_P256 + 128 * H_P128 + (tid >> 3) * H_P128 + (tid & 7) * 16) = I; \
        if (tid < 32) *(LAS v4u*)(tb_ + 64 * H_P256 + 128 * H_P128 + 32 * H_P128 + 16 * tid) = E; } while (0)
#define H2_IVLD(c) do { _Pragma("unroll") for (int j_ = 0; j_ < 2; ++j_) { const int q_ = ioq + 128 * j_; \
            ivr[j_] = *(const GAS v4u*)(OB + ((size_t)b * SEQ + (size_t)(c) * 64 + (q_ >> 2)) * DM + h * 128 + 32 * vq + (q_ & 3) * 8); } } while (0)
#define H2_IVST(slot) do { _Pragma("unroll") for (int j_ = 0; j_ < 2; ++j_) { const int q_ = ioq + 128 * j_; *(LAS v4u*)(ISL + (slot) * IOB + (q_ >> 2) * 64 + (q_ & 3) * 16) = ivr[j_]; } } while (0)
#define H2_OST(c, slot) do { _Pragma("unroll") for (int j_ = 0; j_ < 2; ++j_) { const int q_ = ioq + 128 * j_; const v4u v_ = *(const LAS v4u*)(OSL + (slot) * IOB + (q_ >> 2) * 64 + (q_ & 3) * 16); \
            *(GAS v4u*)(OBO + ((size_t)b * SEQ + (size_t)(c) * 64 + (q_ >> 2)) * DM + h * 128 + 32 * vq + (q_ & 3) * 8) = v_; } } while (0)
#define H2_STEP(c, cur, Qn, Kn, In, En) do { LAS unsigned char* tb_ = TL + (cur) * TB; LAS unsigned char* st_ = STL + (cur) * STB; \
          \
          \
        if (w >= 6 && (c) + 1 < SEQ / 64) H2_IVST((cur) ^ 1);      \
        if ((c) + 1 < SEQ / 64) H2_WRITE(Qn, Kn, In, En, ((cur) ^ 1) * TB); \
        if (w >= 6) { if ((c) + 2 < SEQ / 64) H2_IVLD((c) + 2); \
            if ((c) >= 1) H2_OST((c) - 1, (cur) ^ 1); }             \
        if ((c) + 3 < SEQ / 64) H2_LOAD(Qn, Kn, In, En, (c) + 3); \
        if (w < 4) { const LAS float* eb_ = (const LAS float*)(tb_ + 64 * H_P256 + 128 * H_P128 + 32 * H_P128); \
            _Pragma("unroll") for (int r = 0; r < 16; ++r) acc[r] *= eb_[32 * w + crow16(r, hi)]; \
            _Pragma("unroll") for (int step = 0; step < 4; ++step) { const bf16x8 a_ = *(const LAS bf16x8*)(tb_ + 64 * H_P256 + (32 * w + r32) * H_P128 + (16 * step + 8 * hi) * 2); \
                const bf16x8 b_ = *(const LAS bf16x8*)(tb_ + 64 * H_P256 + 128 * H_P128 + r32 * H_P128 + (16 * step + 8 * hi) * 2); acc = __builtin_amdgcn_mfma_f32_32x32x16_bf16(a_, b_, acc, 0, 0, 0); } \
            LAS unsigned char* sn_ = STL + ((cur) ^ 1) * STB + r32 * H_P256 + (32 * w + 4 * hi) * 2; \
            _Pragma("unroll") for (int g = 0; g < 4; ++g) *(LAS unsigned long long*)(sn_ + 16 * g) = (unsigned long long)pk2(acc[4 * g], acc[4 * g + 1]) | ((unsigned long long)pk2(acc[4 * g + 2], acc[4 * g + 3]) << 32); \
        } else if (w < 6) { f32x16 o_ = {}; \
            _Pragma("unroll") for (int step = 0; step < 8; ++step) { const bf16x8 a_ = *(const LAS bf16x8*)(tb_ + (32 * (w - 4) + r32) * H_P256 + (16 * step + 8 * hi) * 2); \
                const bf16x8 b_ = *(const LAS bf16x8*)(st_ + r32 * H_P256 + (16 * step + 8 * hi) * 2); o_ = __builtin_amdgcn_mfma_f32_32x32x16_bf16(a_, b_, o_, 0, 0, 0); } \
            const int so_ = (32 * (w - 4) + 4 * hi) * 64 + r32 * 2; bf16 iv_[16]; \
            _Pragma("unroll") for (int r = 0; r < 16; ++r) iv_[r] = *(const LAS bf16*)(ISL + (cur) * IOB + so_ + ((r & 3) + 8 * (r >> 2)) * 64);     \
            _Pragma("unroll") for (int r = 0; r < 16; ++r) *(LAS bf16*)(OSL + (cur) * IOB + so_ + ((r & 3) + 8 * (r >> 2)) * 64) = (bf16)f2bf(o_[r] + bf_f(iv_[r])); } \
        LDS_BAR(); } while (0)
        { const unsigned zz = (unsigned)tid >> 31;
          for (int i = tid; i < STB / 16; i += NWAVES * 64) *(LAS v4u*)(STL + 16 * i) = (v4u){zz, zz, zz, zz}; }
        H2_LOAD(q0, k0, i0, e0, 0); H2_WRITE(q0, k0, i0, e0, 0);
        H2_LOAD(q1, k1, i1, e1, 1); H2_LOAD(q0, k0, i0, e0, 2);
        if (w >= 6) { H2_IVLD(0); H2_IVST(0); H2_IVLD(1); }
        LDS_BAR();
#pragma unroll 1
        for (int c = 0; c < SEQ / 64; c += 2) {
            H2_STEP(c, 0, q1, k1, i1, e1);
            H2_STEP(c + 1, 1, q0, k0, i0, e0);
        }
        if (w >= 6) H2_OST(SEQ / 64 - 1, 1);
        LDS_BAR();
#undef H2_LOAD
#undef H2_WRITE
#undef H2_IVLD
#undef H2_IVST
#undef H2_OST
#undef H2_STEP
    }
}
__device__ __forceinline__ void hgrn_final_phase(Frame& F, bf16* OBO) {
    const bf16* BIG = (const bf16*)(F.ws + WS_BIG); bf16* OB = (bf16*)(F.ws + WS_OB); const float* gn = F.a->in[19];
    const int gw = F.vcu * NWAVES + F.wave, NGW = F.G * NWAVES;
    const int dv = (F.lane & 15) * 8;
    const f32x4 g0 = *(const f32x4*)(gn + dv), g1 = *(const f32x4*)(gn + dv + 4);
    for (int row = gw; row < MT; row += NGW) {
        GAS v4u* po = (GAS v4u*)(OB + (size_t)row * DM) + F.lane; const GAS v4u* pg = (const GAS v4u*)(BIG + (size_t)row * 8192 + 6144) + F.lane;
        v4u wo[4], wg[4];
#pragma unroll
        for (int it = 0; it < 4; ++it) { wo[it] = po[64 * it]; wg[it] = pg[64 * it]; }
#pragma unroll
        for (int it = 0; it < 4; ++it) { float x[8], gg[8]; unpack8(wo[it], x); unpack8(wg[it], gg);
            float ss = 0.f;
#pragma unroll
            for (int i = 0; i < 8; ++i) ss += x[i] * x[i];
            ss += sx<1>(ss); ss += sx<2>(ss); ss += sx<4>(ss); ss += sx<8>(ss);
            const float rstd = rsqrtf(ss * (1.0f / 128.0f) + RMS_EPS);
            float y[8];
#pragma unroll
            for (int i = 0; i < 8; ++i) { const float gi = (i < 4) ? g0[i] : g1[i - 4]; y[i] = x[i] * rstd * gi * (gg[i] * __builtin_amdgcn_rcpf(1.0f + __expf(-gg[i]))); }
            v4u o; o.x = pk2(y[0], y[1]); o.y = pk2(y[2], y[3]); o.z = pk2(y[4], y[5]); o.w = pk2(y[6], y[7]);
            ((GAS v4u*)(OBO + (size_t)row * DM) + F.lane)[64 * it] = o; }
    }
}
__device__ __forceinline__ bool ph_refresh(Frame& F) { unsigned m = ~0u; asm volatile("" : "+s"(m));
    const int t = (F.wave << 6) | (int)__builtin_amdgcn_mbcnt_hi(m, __builtin_amdgcn_mbcnt_lo(m, 0u));
    F.tid = t; F.lane = t & 63; return true; }
__global__ void __launch_bounds__(NWAVES * 64, 2) trunk_fwd(Args args) {
    extern __shared__ __attribute__((aligned(16))) unsigned char lds[];
    Frame F;
    F.lds = (LAS unsigned char*)lds;
    F.MISC = (volatile LAS unsigned*)(F.lds + MISC_OFF);
    F.tid = threadIdx.x; F.lane = F.tid & 63; F.wave = __builtin_amdgcn_readfirstlane(F.tid >> 6);
    F.G = gridDim.x; { const int bx = blockIdx.x; F.vcu = (F.G % 8 == 0) ? (bx % 8) * (F.G / 8) + bx / 8 : bx; }
    F.ws = args.ws; F.ctl = (gu32*)(args.ws + WS_CTL); F.out = args.out;
    F.a = &args;
    for (int u = F.tid; u < (LDS_BYTES - LDSCTL_OFF) / 4; u += NWAVES * 64) ((LAS unsigned*)(F.lds + LDSCTL_OFF))[u] = 0u;
    __syncthreads();
    XcdBarrier bar; bar.bar = (unsigned*)(F.ctl + CW_BAR); bar.x = 0; bar.st = nullptr;
    if (!MK_PER_PHASE) bar = xcd_barrier_post((unsigned*)(F.ctl + CW_BAR), F.MISC + 8);
    const int lo = args.ph_lo, hi = args.ph_hi;
    int pc = 0;
    unsigned long long t_ph = PROBE_ECHO ? __builtin_amdgcn_s_memrealtime() : 0ull;
#define PH_ON (pc >= lo && pc < hi && ph_refresh(F))
#define PH_END_C(cls) do { if (!MK_PER_PHASE && pc >= lo && pc + 1 < hi) { const unsigned long long ta_ = (PROBE_IDLE && (PROBE_IDLE == 100 || PROBE_IDLE == (cls))) ? __builtin_amdgcn_s_memrealtime() : 0ull; xcd_barrier(bar); if (PROBE_MASK & 32) xcd_barrier(bar); \
        if (PROBE_IDLE && (PROBE_IDLE == 100 || PROBE_IDLE == (cls))) { const unsigned long long t1_ = __builtin_amdgcn_s_memrealtime(), d_ = t1_ - ta_; while (__builtin_amdgcn_s_memrealtime() - t1_ < d_) __builtin_amdgcn_s_sleep(8); xcd_barrier(bar); } \
        if (PROBE_ECHO == (cls)) { const unsigned long long t1_ = __builtin_amdgcn_s_memrealtime(), d_ = t1_ - t_ph; while (__builtin_amdgcn_s_memrealtime() - t1_ < d_) __builtin_amdgcn_s_sleep(8); xcd_barrier(bar); } \
        if (PROBE_ECHO) t_ph = __builtin_amdgcn_s_memrealtime(); } ++pc; } while (0)
#define PH_END PH_END_C(0)
    float* mod = (float*)(F.ws + WS_MOD);
    bf16* XN = (bf16*)(F.ws + WS_XN); bf16* BIG = (bf16*)(F.ws + WS_BIG); bf16* OB = (bf16*)(F.ws + WS_OB);
    float* RSS = (float*)(F.ws + WS_RSS); const float* CB = (const float*)(F.ws + WS_CB);
    if (PH_ON) { p0_mod(F); __syncthreads(); p0_convert(F); }
#if PROBE_MASK & 16
    if (PH_ON) { __syncthreads(); p0_mod(F); __syncthreads(); p0_convert(F); }
#endif
    PH_END_C(1);
    if (PH_ON) { tables_phase(F); bias_phase(F); xs0_phase(F, F.a->in[0], F.a->in[4], mod); }
#if PROBE_MASK & 16384
    if (PH_ON) { tables_phase(F); bias_phase(F); xs0_phase(F, F.a->in[0], F.a->in[4], mod); }
#endif
    PH_END_C(2);
#pragma unroll 1
    for (int L = 0; L < NLAYER; ++L) {
        const int kind = L % 3, slot = L / 3;
        const float* modL = mod + (size_t)L * NB * NMOD;
#pragma unroll 1
        for (int sub = 0; sub < 3; ++sub) {
            const int s = 3 * L + sub;
            const float* rss = RSS + (size_t)s * MT; const float* cb = CB + (size_t)s * NB * CB_LD;
            const bf16* outA; const bf16* outB; int outK;
            const int nhalf = (sub != 1) ? FFN_SPLIT : 1;
#pragma unroll 1
            for (int hf = 0; hf < nhalf; ++hf) {
            const int Mpart = MT / nhalf, pm_off = hf * (Mpart / 256);
            if (sub != 1) {
                const int ls = L * 2 + (sub >> 1);
                if (PH_ON) { pg8::Gemm g{XN, (const bf16*)(F.ws + WS_WGU) + (size_t)ls * 2 * FF * DM, Mpart, 2 * FF, DM, 1, 1}; pg8::StaticOrder S; S.init(Mpart, 2 * FF, F.G, (int)blockIdx.x, GU_WGM, pm_off);
                    pg8::EpiSwigluN E{BIG, FF, rss, cb, CB_LD, SEQ, F.lds + PRE_OFF};
#pragma unroll 1
                    for (int rep = 0; rep < ((PROBE_MASK & 1) ? 2 : 1); ++rep) { if (rep) __syncthreads(); pg8::gemm_phase<pg8::EpiSwigluN, pg8::StaticOrder, true, true>(F.lds + RING_OFF, g, S, E, F.tid); }
                    }
                PH_END_C(3);
                outA = BIG; outB = (const bf16*)(F.ws + WS_WD) + (size_t)ls * DM * FF; outK = FF;
            } else {
                const int nin = (kind == 2) ? 4 * DM : 3 * DM;
                const bf16* win = (kind == 0) ? (const bf16*)(F.ws + WS_WAI) + (size_t)slot * 3 * DM * DM : (kind == 1) ? (const bf16*)(F.ws + WS_WCI) : (const bf16*)(F.ws + WS_WHI);
                if (PH_ON) { pg8::Gemm g{XN, win, MT, nin, DM, 1, 1}; pg8::StaticOrder S; S.init(MT, nin, F.G, (int)blockIdx.x, GU_WGM);
                    pg8::EpiInN E{BIG, nin, rss, cb, CB_LD, SEQ, (kind == 0) ? 16 : 0, F.a->in[10] + (size_t)slot * 64, F.a->in[11] + (size_t)slot * 64, F.lds + PRE_OFF};
#pragma unroll 1
                    for (int rep = 0; rep < ((PROBE_MASK & 4) ? 2 : 1); ++rep) { if (rep) __syncthreads(); pg8::gemm_phase<pg8::EpiInN, pg8::StaticOrder, true, true>(F.lds + RING_OFF, g, S, E, F.tid); }
                    }
                PH_END_C(5);
                if (kind == 0) {
#if PROBE_MASK & 8192
                    if (PH_ON) { attn_phase(F, L, slot, 1); __syncthreads(); }
#endif
                    if (PH_ON) attn_phase(F, L, slot);
                    PH_END_C(7);
                } else if (kind == 1) {
                    if (PH_ON) conv_phase(F);
                    PH_END_C(8);
                } else {
#if PROBE_MASK & 64
                    if (PH_ON) { hgrn_prep_phase(F, L, XN, DM, XN); __syncthreads(); }
#endif
                    if (PH_ON) hgrn_prep_phase(F, L, BIG, 8192, OB);
                    PH_END_C(9);
#if PROBE_MASK & 128
                    if (PH_ON) { hgrn_scan_phase(F, XN); __syncthreads(); }
#endif
                    if (PH_ON) hgrn_scan_phase(F, OB);
                    PH_END_C(10);
                    if (PH_ON) hgrn_final_phase(F, OB);
                    PH_END_C(11);
                }
                outA = OB; outB = (kind == 0) ? (const bf16*)(F.ws + WS_WAO) + (size_t)slot * DM * DM : (kind == 1) ? (const bf16*)(F.ws + WS_WCO) : (const bf16*)(F.ws + WS_WHO); outK = DM;
            }
            if (PH_ON) { pg8::Gemm g{outA, outB, Mpart, DM, outK, (sub != 1) ? 1 : 0, 1};     pg8::StaticOrder S; S.init(Mpart, DM, F.G, (int)blockIdx.x, OUT_WGM, pm_off);
                const int sn = s + 1; const bool last = (s == 3 * NLAYER - 1);
                const float* TAB = (const float*)(F.ws + WS_TAB);
                pg8::EpiResN E{(s == 0) ? (const void*)F.a->in[0] : (const void*)(F.ws + WS_XH), last ? (void*)F.out : (void*)(F.ws + WS_XH), (s == 0) ? 1 : 0, last ? 1 : 0, DM, TAB + (size_t)(s * 2 + 0) * NB * DM, TAB + (size_t)(s * 2 + 1) * NB * DM, DM, SEQ, last ? (bf16*)nullptr : XN, RSS + (size_t)sn * MT, F.lds + PRE_OFF, 1.0f};
#pragma unroll 1
                for (int rep = (((PROBE_MASK & 2) || ((PROBE_MASK & 2048) && sub != 1) || ((PROBE_MASK & 4096) && sub == 1)) ? 0 : 1); rep < 2; ++rep) {
                    pg8::EpiResN E2 = E;
#if PROBE_MASK & (2 | 2048 | 4096)
                    { const bool dbl = (PROBE_MASK & 2) || ((PROBE_MASK & 2048) && sub != 1) || ((PROBE_MASK & 4096) && sub == 1);
                      if (dbl) { E2.gscale = 0.5f; if (rep == 0) { E2.rssn = RSS + (size_t)12 * MT; if (last) { E2.out = (void*)(F.ws + WS_XH); E2.out_f32 = 0; } } else if (s == 0) { E2.base = (const void*)(F.ws + WS_XH); E2.base_f32 = 0; } } }
#endif
                    if (rep == 0) __syncthreads();
                    pg8::gemm_phase<pg8::EpiResN, pg8::StaticOrder, true, true, OUT_A_AUX>(F.lds + RING_OFF, g, S, E2, F.tid); if (rep == 0) __syncthreads(); } }
            PH_END_C((sub != 1) ? 4 : 6);
            }
        }
    }
#undef PH_ON
#undef PH_END
#undef PH_END_C
}
extern "C" void kernel_launch(void* const* d_in, const int* in_sizes, int n_in, void* d_out, int out_size, void* d_ws, size_t ws_size, hipStream_t stream) {
    static int grid = 0;
    if (grid == 0) {
        if (n_in != 21 || in_sizes[0] != MT * DM || out_size != MT * DM || ws_size < WS_END) { fprintf(stderr, "kernel_launch: shape/workspace mismatch (n_in %d, in0 %d, out %d, ws %zu, need %zu); nothing launched\n", n_in, n_in > 0 ? in_sizes[0] : -1, out_size, ws_size, (size_t)WS_END); grid = -1; return; }
        int dev = 0, cus = 0, per_cu = 0;
        if (hipGetDevice(&dev) != hipSuccess || hipDeviceGetAttribute(&cus, hipDeviceAttributeMultiprocessorCount, dev) != hipSuccess) { fprintf(stderr, "kernel_launch: device query failed\n"); grid = -1; return; }
        if (hipFuncSetAttribute((const void*)trunk_fwd, hipFuncAttributeMaxDynamicSharedMemorySize, LDS_BYTES) != hipSuccess) { fprintf(stderr, "kernel_launch: hipFuncSetAttribute failed\n"); grid = -1; return; }
        if (hipOccupancyMaxActiveBlocksPerMultiprocessor(&per_cu, (const void*)trunk_fwd, NWAVES * 64, LDS_BYTES) != hipSuccess || per_cu < 1) fprintf(stderr, "kernel_launch: note: occupancy query reports %d workgroups per CU\n", per_cu);
        (void)hipGetLastError();
        grid = cus;
    }
    if (grid < 0) return;
    if (hipMemsetAsync((char*)d_ws + WS_CTL, 0, CTL_ZERO_BYTES, stream) != hipSuccess) { fprintf(stderr, "kernel_launch: memset failed\n"); return; }
    Args a{};
    for (int i = 0; i < 21; ++i) a.in[i] = (const float*)d_in[i];
    a.out = (float*)d_out; a.ws = (unsigned char*)d_ws;
#if MK_PER_PHASE
    for (int p = 0; p < N_PHASES; ++p) { a.ph_lo = p; a.ph_hi = p + 1; hipLaunchKernelGGL(trunk_fwd, dim3(grid), dim3(NWAVES * 64), LDS_BYTES, stream, a); }
#else
    a.ph_lo = 0; a.ph_hi = N_PHASES;
    hipLaunchKernelGGL(trunk_fwd, dim3(grid), dim3(NWAVES * 64), LDS_BYTES, stream, a);
#endif
    const hipError_t le = hipPeekAtLastError();
    if (le != hipSuccess) fprintf(stderr, "kernel_launch: launch failed: %s\n", hipGetErrorName(le));
}
```

```cpp
#include <hip/hip_runtime.h>
#include <cstdio>
#include <cstdint>
template <int X> __device__ __forceinline__ float sx(float v) { return __int_as_float(__builtin_amdgcn_ds_swizzle(__float_as_int(v), (X << 10) | 0x1f)); }
__device__ __forceinline__ float sum32(float v) { auto rr = __builtin_amdgcn_permlane32_swap(__float_as_uint(v), __float_as_uint(v), false, false); return __uint_as_float(rr[0]) + __uint_as_float(rr[1]); }
__device__ __forceinline__ float max32(float v) { auto rr = __builtin_amdgcn_permlane32_swap(__float_as_uint(v), __float_as_uint(v), false, false); return fmaxf(__uint_as_float(rr[0]), __uint_as_float(rr[1])); }
__device__ __forceinline__ float wave_sum(float v) { v += sx<1>(v); v += sx<2>(v); v += sx<4>(v); v += sx<8>(v); v += sx<16>(v); return sum32(v); }
__device__ __forceinline__ float wave_max(float v) { v = fmaxf(v, sx<1>(v)); v = fmaxf(v, sx<2>(v)); v = fmaxf(v, sx<4>(v)); v = fmaxf(v, sx<8>(v)); v = fmaxf(v, sx<16>(v)); return max32(v); }
typedef float f32x2_cv __attribute__((ext_vector_type(2))); typedef __bf16 bf16x2_cv __attribute__((ext_vector_type(2)));
__device__ __forceinline__ unsigned pk2(float lo, float hi) { const f32x2_cv v = {lo, hi}; const bf16x2_cv b = __builtin_convertvector(v, bf16x2_cv); return __builtin_bit_cast(unsigned, b); }
__device__ __forceinline__ unsigned f2bf(float f) { return pk2(f, 0.f) & 0xffffu; }
namespace pg8 {
#define PG8_LAS __attribute__((address_space(3)))
typedef unsigned short bf16_t;
typedef short bf16x8 __attribute__((ext_vector_type(8)));
typedef float f32x4 __attribute__((ext_vector_type(4)));
typedef unsigned u32x4 __attribute__((ext_vector_type(4)));
constexpr int BM = 256, BK = 64, HALF = 128, HTB = HALF * BK * 2  , STAGE_BYTES = 8 * HTB, NXCD = 8, WGM = 8;

__host__ __device__ __forceinline__ int lds_byte(int r, int c) { const int st = (r >> 4) * 2 + (c >> 5), rr = r & 15, cc = c & 31, ob = rr * 64 + cc * 2; return st * 1024 + (ob ^ (((ob >> 9) & 1) << 5)); }
__host__ __device__ __forceinline__ void stage_rc(int b, int& R, int& C) { const int st = b / 1024, sb = b % 1024, swz = sb ^ (((sb >> 9) & 1) << 5); R = (st >> 1) * 16 + swz / 64; C = (st & 1) * 32 + (swz % 64) / 2; }
__host__ __device__ __forceinline__ int perm32(int rho) { const int n = rho >> 4, i = rho & 15; return 8 * (i >> 2) + 4 * n + (i & 3); }

struct Unit { int pm, pn; };
struct Gemm { const bf16_t* A; const bf16_t* Bt; int M, N, K; int a_tiled = 0, b_tiled = 0; };

struct StaticOrder {
    int nM, nN, nwg, G, c, wgm, pm_off;
    __host__ __device__ void init(int M, int N, int G_, int c_, int wgm_ = WGM, int pm_off_ = 0) { nM = M / BM; nN = N / BM; nwg = nM * nN; G = G_; c = c_; wgm = wgm_; pm_off = pm_off_; }
    __host__ __device__ bool next(int i, Unit& u) const {
        const long L = (long)i * G + c; if (L >= nwg) return false;
        int wgid = (int)L; { const int q = nwg / NXCD, r = nwg % NXCD, xcd = wgid % NXCD, off = wgid / NXCD; wgid = (xcd < r ? xcd * (q + 1) : r * (q + 1) + (xcd - r) * q) + off; }
        const int nig = wgm * nN, gid = wgid / nig, fm = gid * wgm, gsz = (nM - fm) < wgm ? (nM - fm) : wgm;
        u.pm = pm_off + fm + ((wgid % nig) % gsz); u.pn = (wgid % nig) / gsz; return true;
    }
    __device__ __forceinline__ void a_ready(const Unit&) const {}
    __device__ __forceinline__ void done(const Unit&) const {}
};

__device__ __forceinline__ unsigned cvt_pk_bf16(float lo, float hi) { unsigned r; asm volatile("v_cvt_pk_bf16_f32 %0, %1, %2" : "=v"(r) : "v"(lo), "v"(hi)); return r; }
typedef float f32x2 __attribute__((ext_vector_type(2)));
typedef unsigned u32x2 __attribute__((ext_vector_type(2)));
struct EpiStore {
    static constexpr bool HAS_PRE = false;
    static constexpr bool PERM = true, AFTER_DRAIN = false;
    bf16_t* O; int ldc;
    __device__ __forceinline__ void operator()(const f32x4 (&acc)[2][2][4][2], const Unit& u, int wr, int wc, int fr, int fq) const {
        const int row0 = u.pm * BM + wr * 64 + fr, col0 = u.pn * BM + wc * 32 + 8 * fq;
#pragma unroll
        for (int ai = 0; ai < 2; ++ai)
#pragma unroll
            for (int m = 0; m < 4; ++m) { bf16_t* rowp = O + (size_t)(row0 + ai * HALF + m * 16) * ldc + col0;
#pragma unroll
                for (int bj = 0; bj < 2; ++bj) { const f32x4 v0 = acc[ai][bj][m][0], v1 = acc[ai][bj][m][1];
                    u32x4 w; w.x = cvt_pk_bf16(v0[0], v0[1]); w.y = cvt_pk_bf16(v0[2], v0[3]); w.z = cvt_pk_bf16(v1[0], v1[1]); w.w = cvt_pk_bf16(v1[2], v1[3]);
                    *(u32x4*)(rowp + bj * HALF) = w; } }
    }
};
__device__ __forceinline__ float swiglu1(float g, float u) { const float e = __builtin_amdgcn_exp2f(g * -1.4426950408889634f); return g * u * __builtin_amdgcn_rcpf(1.0f + e); }
struct EpiSwiglu {
    static constexpr bool HAS_PRE = false;
    static constexpr bool PERM = true, AFTER_DRAIN = false;
    bf16_t* O; int ldc;
    __device__ __forceinline__ void operator()(const f32x4 (&acc)[2][2][4][2], const Unit& u, int wr, int wc, int fr, int fq) const {
        const int row0 = u.pm * BM + wr * 64 + fr, col0 = u.pn * HALF + wc * 32 + 8 * fq;
#pragma unroll
        for (int ai = 0; ai < 2; ++ai)
#pragma unroll
            for (int m = 0; m < 4; ++m) { bf16_t* rowp = O + (size_t)(row0 + ai * HALF + m * 16) * ldc + col0;
                const f32x4 g0 = acc[ai][0][m][0], g1 = acc[ai][0][m][1], u0 = acc[ai][1][m][0], u1 = acc[ai][1][m][1];
                u32x4 w;
                w.x = cvt_pk_bf16(swiglu1(g0[0], u0[0]), swiglu1(g0[1], u0[1])); w.y = cvt_pk_bf16(swiglu1(g0[2], u0[2]), swiglu1(g0[3], u0[3]));
                w.z = cvt_pk_bf16(swiglu1(g1[0], u1[0]), swiglu1(g1[1], u1[1])); w.w = cvt_pk_bf16(swiglu1(g1[2], u1[2]), swiglu1(g1[3], u1[3]));
                *(u32x4*)rowp = w; }
    }
};
struct EpiRes {
    static constexpr bool HAS_PRE = false;
    static constexpr bool PERM = false, AFTER_DRAIN = false;
    const float* base; float* out; int ldc; const float* gate; int gstride; float coef; int rows_per_batch;
    __device__ __forceinline__ void operator()(const f32x4 (&acc)[2][2][4][2], const Unit& u, int wr, int wc, int fr, int fq) const {
        const int row0 = u.pm * BM + wr * 64 + fr, col0 = u.pn * BM + wc * 32 + 4 * fq;
        const float* gp = gate + (size_t)((u.pm * BM) / rows_per_batch) * gstride + col0;
        f32x4 gv[2][2];
#pragma unroll
        for (int bj = 0; bj < 2; ++bj)
#pragma unroll
            for (int n = 0; n < 2; ++n) gv[bj][n] = *(const f32x4*)(gp + bj * HALF + n * 16) * coef;
#pragma unroll
        for (int ai = 0; ai < 2; ++ai)
#pragma unroll
            for (int m = 0; m < 4; ++m) { const size_t off = (size_t)(row0 + ai * HALF + m * 16) * ldc + col0;
#pragma unroll
                for (int bj = 0; bj < 2; ++bj)
#pragma unroll
                    for (int n = 0; n < 2; ++n) { const f32x4 bs = *(const f32x4*)(base + off + bj * HALF + n * 16); *(f32x4*)(out + off + bj * HALF + n * 16) = bs + gv[bj][n] * acc[ai][bj][m][n]; }
                if (m & 1) asm volatile("" ::: "memory"); }
    }
};
__device__ __forceinline__ float rstd_of(const float* rss, int row) { return rsqrtf(rss[row] * (1.0f / 2048.0f) + 1e-6f); }
struct EpiSwigluN {
    static constexpr bool HAS_PRE = true;
    static constexpr bool PERM = true, AFTER_DRAIN = false;
    bf16_t* O; int ldc; const float* rss; const float* cb; int cbstride; int rows_per_batch; PG8_LAS unsigned char* pre_lds;
    __device__ __forceinline__ void pre(const Unit& u, int lane) const {
        __builtin_amdgcn_global_load_lds((const unsigned*)(cb + (size_t)((u.pm * BM) / rows_per_batch) * cbstride + u.pn * BM + 4 * lane), (PG8_LAS unsigned*)pre_lds, 16, 0, 0);
        __builtin_amdgcn_global_load_lds((const unsigned*)(rss + u.pm * BM + 4 * lane), (PG8_LAS unsigned*)(pre_lds + 1024), 16, 0, 0); }
    __device__ __forceinline__ void operator()(const f32x4 (&acc)[2][2][4][2], const Unit& u, int wr, int wc, int fr, int fq) const {
        const int col0 = u.pn * HALF + wc * 32 + 8 * fq;
        const PG8_LAS float* cbp = (const PG8_LAS float*)pre_lds + wc * 32 + 8 * fq; const PG8_LAS float* rp = (const PG8_LAS float*)(pre_lds + 1024) + wr * 64 + fr;
        const f32x4 cg0 = *(const PG8_LAS f32x4*)(cbp), cg1 = *(const PG8_LAS f32x4*)(cbp + 4), cu0 = *(const PG8_LAS f32x4*)(cbp + HALF), cu1 = *(const PG8_LAS f32x4*)(cbp + HALF + 4);
#pragma unroll
        for (int ai = 0; ai < 2; ++ai)
#pragma unroll
            for (int m = 0; m < 4; ++m) { const float rs = rsqrtf(rp[ai * HALF + m * 16] * (1.0f / 2048.0f) + 1e-6f);
                bf16_t* rowp = O + ((size_t)(u.pm * (ldc >> 6) + (col0 >> 6)) * BM + (wr * 64 + fr + ai * HALF + m * 16)) * 64 + (col0 & 63);
                const f32x4 g0 = acc[ai][0][m][0] * rs + cg0, g1 = acc[ai][0][m][1] * rs + cg1, u0 = acc[ai][1][m][0] * rs + cu0, u1 = acc[ai][1][m][1] * rs + cu1;
                u32x4 w;
                w.x = pk2(swiglu1(g0[0], u0[0]), swiglu1(g0[1], u0[1])); w.y = pk2(swiglu1(g0[2], u0[2]), swiglu1(g0[3], u0[3]));
                w.z = pk2(swiglu1(g1[0], u1[0]), swiglu1(g1[1], u1[1])); w.w = pk2(swiglu1(g1[2], u1[2]), swiglu1(g1[3], u1[3]));
                __builtin_nontemporal_store(w, (u32x4*)rowp); }
    }
};
struct EpiInN {
    static constexpr bool HAS_PRE = true;
    static constexpr bool PERM = true, AFTER_DRAIN = false;
    bf16_t* O; int ldc; const float* rss; const float* cb; int cbstride; int rows_per_batch; int nqk; const float* gq; const float* gk; PG8_LAS unsigned char* pre_lds;
    __device__ __forceinline__ void pre(const Unit& u, int lane) const {
        __builtin_amdgcn_global_load_lds((const unsigned*)(cb + (size_t)((u.pm * BM) / rows_per_batch) * cbstride + u.pn * BM + 4 * lane), (PG8_LAS unsigned*)pre_lds, 16, 0, 0);
        __builtin_amdgcn_global_load_lds((const unsigned*)(rss + u.pm * BM + 4 * lane), (PG8_LAS unsigned*)(pre_lds + 1024), 16, 0, 0); }
    __device__ __forceinline__ void operator()(const f32x4 (&acc)[2][2][4][2], const Unit& u, int wr, int wc, int fr, int fq) const {
        const int row0 = u.pm * BM + wr * 64 + fr, pc0 = u.pn * BM + wc * 32 + 8 * fq;
        const PG8_LAS float* cbp = (const PG8_LAS float*)pre_lds + wc * 32 + 8 * fq; const PG8_LAS float* rp = (const PG8_LAS float*)(pre_lds + 1024) + wr * 64 + fr;
        f32x4 cv[2][2];
#pragma unroll
        for (int bj = 0; bj < 2; ++bj)
#pragma unroll
            for (int n = 0; n < 2; ++n) cv[bj][n] = *(const PG8_LAS f32x4*)(cbp + bj * HALF + 4 * n);
        if (u.pn < nqk) {
            const bool isq = u.pn < (nqk >> 1); const float* gp = (isq ? gq : gk) + 8 * fq; const float gs = isq ? 0.125f * 1.4426950408889634f : 1.0f;
            f32x4 gv[2][2];
#pragma unroll
            for (int bj = 0; bj < 2; ++bj)
#pragma unroll
                for (int n = 0; n < 2; ++n) gv[bj][n] = *(const f32x4*)(gp + 32 * bj + 4 * n) * gs;
            const int lc0 = u.pn * BM + wc * 64 + 8 * fq;
#pragma unroll
            for (int ai = 0; ai < 2; ++ai)
#pragma unroll
                for (int m = 0; m < 4; ++m) { const int row = row0 + ai * HALF + m * 16; const float rs = rsqrtf(rp[ai * HALF + m * 16] * (1.0f / 2048.0f) + 1e-6f); bf16_t* rowp = O + (size_t)row * ldc + lc0;
                    f32x4 v[2][2]; float ss = 0.f;
#pragma unroll
                    for (int bj = 0; bj < 2; ++bj)
#pragma unroll
                        for (int n = 0; n < 2; ++n) { v[bj][n] = acc[ai][bj][m][n] * rs + cv[bj][n]; ss += (v[bj][n][0] * v[bj][n][0] + v[bj][n][1] * v[bj][n][1]) + (v[bj][n][2] * v[bj][n][2] + v[bj][n][3] * v[bj][n][3]); }
                    ss += sx<16>(ss); ss = sum32(ss);
                    const float rg = rsqrtf(ss * (1.0f / 64.0f) + 1e-6f);
#pragma unroll
                    for (int bj = 0; bj < 2; ++bj) { const f32x4 v0 = v[bj][0] * rg * gv[bj][0], v1 = v[bj][1] * rg * gv[bj][1];
                        u32x4 w; w.x = pk2(v0[0], v0[1]); w.y = pk2(v0[2], v0[3]); w.z = pk2(v1[0], v1[1]); w.w = pk2(v1[2], v1[3]);
                        if (isq) __builtin_nontemporal_store(w, (u32x4*)(rowp + 32 * bj)); else *(u32x4*)(rowp + 32 * bj) = w; } }
        } else {
#pragma unroll
            for (int ai = 0; ai < 2; ++ai)
#pragma unroll
                for (int m = 0; m < 4; ++m) { const int row = row0 + ai * HALF + m * 16; const float rs = rsqrtf(rp[ai * HALF + m * 16] * (1.0f / 2048.0f) + 1e-6f); bf16_t* rowp = O + (size_t)row * ldc + pc0;
#pragma unroll
                    for (int bj = 0; bj < 2; ++bj) { const f32x4 v0 = acc[ai][bj][m][0] * rs + cv[bj][0], v1 = acc[ai][bj][m][1] * rs + cv[bj][1];
                        u32x4 w; w.x = pk2(v0[0], v0[1]); w.y = pk2(v0[2], v0[3]); w.z = pk2(v1[0], v1[1]); w.w = pk2(v1[2], v1[3]);
                        *(u32x4*)(rowp + bj * HALF) = w; } }
        }
    }
};
typedef _Float16 f16x4 __attribute__((ext_vector_type(4)));
struct EpiResN {
    static constexpr bool HAS_PRE = true;
    static constexpr bool PERM = false, AFTER_DRAIN = false;
    const void* base; void* out; int base_f32, out_f32;
    int ldc; const float* gvt; const float* ant; int tstride; int rows_per_batch;
    bf16_t* xs; float* rssn; PG8_LAS unsigned char* pre_lds;
    float gscale;
    __device__ __forceinline__ void pre(const Unit& u, int lane) const {
        const size_t o = (size_t)((u.pm * BM) / rows_per_batch) * tstride + u.pn * BM + 4 * lane;
        __builtin_amdgcn_global_load_lds((const unsigned*)(gvt + o), (PG8_LAS unsigned*)pre_lds, 16, 0, 0);
        __builtin_amdgcn_global_load_lds((const unsigned*)(ant + o), (PG8_LAS unsigned*)(pre_lds + 1024), 16, 0, 0); }
    __device__ __forceinline__ void operator()(const f32x4 (&acc)[2][2][4][2], const Unit& u, int wr, int wc, int fr, int fq) const {
        const int col0 = u.pn * BM + wc * 32 + 4 * fq;
        const PG8_LAS float* gp = (const PG8_LAS float*)pre_lds + wc * 32 + 4 * fq;
        f32x4 gv[2][2], an[2][2];
#pragma unroll
        for (int bj = 0; bj < 2; ++bj)
#pragma unroll
            for (int n = 0; n < 2; ++n) { gv[bj][n] = *(const PG8_LAS f32x4*)(gp + bj * HALF + n * 16) * gscale; an[bj][n] = *(const PG8_LAS f32x4*)(gp + 256 + bj * HALF + n * 16); }
        if (base_f32) {
#pragma unroll
            for (int ai = 0; ai < 2; ++ai)
#pragma unroll
                for (int m = 0; m < 4; ++m) { const int rr = wr * 64 + fr + ai * HALF + m * 16; const unsigned off = (unsigned)((u.pm * BM + rr) * ldc + col0); float ss = 0.f;
                    const unsigned xso = ((unsigned)(u.pm * (ldc >> 6) + 4 * u.pn) * BM + rr) * 64u + 4u * fq;
#pragma unroll
                    for (int bj = 0; bj < 2; ++bj)
#pragma unroll
                        for (int n = 0; n < 2; ++n) { const unsigned o2 = off + bj * HALF + n * 16;
                            const f32x4 xn = *(const f32x4*)((const char*)base + 4u * o2) + gv[bj][n] * acc[ai][bj][m][n];
                            *(f16x4*)((char*)out + 2u * o2) = __builtin_convertvector(xn, f16x4);
                            ss += (xn[0] * xn[0] + xn[1] * xn[1]) + (xn[2] * xn[2] + xn[3] * xn[3]); const f32x4 h = xn * an[bj][n];
                            u32x2 w; w.x = pk2(h[0], h[1]); w.y = pk2(h[2], h[3]); *(u32x2*)((char*)xs + 2u * (xso + (unsigned)(2 * bj + (wc >> 1)) * (BM * 64) + (wc & 1) * 32 + n * 16)) = w; }
                    ss += sx<16>(ss); ss = sum32(ss); if (fq == 0) __hip_atomic_fetch_add(rssn + (u.pm * BM + rr), ss, __ATOMIC_RELAXED, __HIP_MEMORY_SCOPE_AGENT);
                    if (m & 1) asm volatile("" ::: "memory"); }
        } else {
            f16x4 bsv[2][4][2][2];
#pragma unroll
            for (int ai = 0; ai < 2; ++ai)
#pragma unroll
                for (int m = 0; m < 4; ++m)
#pragma unroll
                    for (int bj = 0; bj < 2; ++bj)
#pragma unroll
                        for (int n = 0; n < 2; ++n) bsv[ai][m][bj][n] = *(const f16x4*)((const char*)base + 2u * (unsigned)((u.pm * BM + wr * 64 + fr + ai * HALF + m * 16) * ldc + col0 + bj * HALF + n * 16));
            asm volatile("" ::: "memory");
#pragma unroll
            for (int ai = 0; ai < 2; ++ai) {
#pragma unroll
                for (int m = 0; m < 4; ++m) { const int rr = wr * 64 + fr + ai * HALF + m * 16; const unsigned off = (unsigned)((u.pm * BM + rr) * ldc + col0); float ss = 0.f;
                    const unsigned xso = ((unsigned)(u.pm * (ldc >> 6) + 4 * u.pn) * BM + rr) * 64u + 4u * fq;
#pragma unroll
                    for (int bj = 0; bj < 2; ++bj)
#pragma unroll
                        for (int n = 0; n < 2; ++n) { const unsigned o2 = off + bj * HALF + n * 16;
                            const f32x4 xn = __builtin_convertvector(bsv[ai][m][bj][n], f32x4) + gv[bj][n] * acc[ai][bj][m][n];
                            if (out_f32) *(f32x4*)((char*)out + 4u * o2) = xn; else *(f16x4*)((char*)out + 2u * o2) = __builtin_convertvector(xn, f16x4);
                            if (xs) { ss += (xn[0] * xn[0] + xn[1] * xn[1]) + (xn[2] * xn[2] + xn[3] * xn[3]); const f32x4 h = xn * *(const PG8_LAS f32x4*)(gp + 256 + bj * HALF + n * 16);
                                u32x2 w; w.x = pk2(h[0], h[1]); w.y = pk2(h[2], h[3]); *(u32x2*)((char*)xs + 2u * (xso + (unsigned)(2 * bj + (wc >> 1)) * (BM * 64) + (wc & 1) * 32 + n * 16)) = w; } }
                    if (xs) { ss += sx<16>(ss); ss = sum32(ss); if (fq == 0) __hip_atomic_fetch_add(rssn + (u.pm * BM + rr), ss, __ATOMIC_RELAXED, __HIP_MEMORY_SCOPE_AGENT); } }
                asm volatile("" ::: "memory"); }
        }
    }
};
template <class Epi, class Sched, bool ALIGN_EPI = false, bool SP2 = false, int A_AUX = 0>
__device__ __forceinline__ void gemm_phase(PG8_LAS unsigned char* lds, const Gemm g, const Sched& S, const Epi& E, int tid_in) {
    int tid_o = tid_in; asm volatile("" : "+v"(tid_o));
    const int tid = tid_o, wid = __builtin_amdgcn_readfirstlane(tid >> 6), lane = tid & 63, wr = wid >> 2, wc = wid & 3, fr = lane & 15, fq = lane >> 4;
    const int K = g.K, nt = K / BK;
    unsigned voffA[2], voffB[2];
#pragma unroll
    for (int i = 0; i < 2; ++i) { int R, C; stage_rc(tid * 16 + i * 8192, R, C); const int Rb = Epi::PERM ? ((R & ~31) + perm32(R & 31)) : R;
        voffA[i] = (unsigned)(R * (g.a_tiled ? BK : K) + C) * 2u; voffB[i] = (unsigned)(Rb * (g.b_tiled ? BK : K) + C) * 2u; }
    const size_t kstepA = g.a_tiled ? (size_t)(BM * BK * 2) : (size_t)(BK * 2), kstepB = g.b_tiled ? (size_t)(BM * BK * 2) : (size_t)(BK * 2);
    const size_t hstepA = g.a_tiled ? (size_t)(HALF * BK * 2) : (size_t)HALF * K * 2, hstepB = g.b_tiled ? (size_t)(HALF * BK * 2) : (size_t)HALF * K * 2;
    const size_t tstepA = (size_t)BM * K * 2, tstepB = tstepA;
    const unsigned ldsw = (unsigned)wid * 1024u;
    const int aoff = lds_byte(wr * 64 + fr, fq * 8), boff = lds_byte(wc * 32 + fr, fq * 8);
#define PG8_SA(b, h) (((b) * 2 + (h)) * HTB)
#define PG8_SB(b, h) ((4 + (b) * 2 + (h)) * HTB)
#define PG8_STAGE(bufoff, gbase, voff) do { _Pragma("unroll") for (int _i = 0; _i < 2; ++_i) \
        __builtin_amdgcn_global_load_lds((const unsigned*)((const char*)(gbase) + (voff)[_i]), (PG8_LAS unsigned*)(lds + (bufoff) + ldsw + _i * 8192), 16, 0, 0); } while (0)
#define PG8_STAGE_A(bufoff, gbase, voff) do { _Pragma("unroll") for (int _i = 0; _i < 2; ++_i) \
        __builtin_amdgcn_global_load_lds((const unsigned*)((const char*)(gbase) + (voff)[_i]), (PG8_LAS unsigned*)(lds + (bufoff) + ldsw + _i * 8192), 16, 0, A_AUX); } while (0)
#define PG8_LDA(dst, b, h) do { _Pragma("unroll") for (int m = 0; m < 4; ++m) _Pragma("unroll") for (int k = 0; k < 2; ++k) dst[m][k] = *(const PG8_LAS bf16x8*)(lds + PG8_SA(b, h) + aoff + m * 2048 + k * 1024); } while (0)
#define PG8_LDB(dst, b, h) do { _Pragma("unroll") for (int n = 0; n < 2; ++n) _Pragma("unroll") for (int k = 0; k < 2; ++k) dst[n][k] = *(const PG8_LAS bf16x8*)(lds + PG8_SB(b, h) + boff + n * 2048 + k * 1024); } while (0)
#define PG8_MMA(ai, bj, At, Bt) do { __builtin_amdgcn_s_setprio(1); _Pragma("unroll") for (int m = 0; m < 4; ++m) _Pragma("unroll") for (int n = 0; n < 2; ++n) _Pragma("unroll") for (int k = 0; k < 2; ++k) \
        acc[ai][bj][m][n] = __builtin_amdgcn_mfma_f32_16x16x32_bf16(Bt[n][k], At[m][k], acc[ai][bj][m][n], 0, 0, 0); __builtin_amdgcn_s_setprio(0); } while (0)
#define PG8_WAIT_V(n) asm volatile("s_waitcnt vmcnt(" #n ")" ::: "memory")
#define PG8_WAIT_L(n) asm volatile("s_waitcnt lgkmcnt(" #n ")" ::: "memory")
#define PG8_BAR __builtin_amdgcn_s_barrier()
#define PG8_SCHED __builtin_amdgcn_sched_barrier(0)
    Unit cur, nxt; int ui = 0;
    if (!S.next(0, cur)) return;
    f32x4 acc[2][2][4][2];
#pragma unroll
    for (int a = 0; a < 2; ++a)
#pragma unroll
        for (int b = 0; b < 2; ++b)
#pragma unroll
            for (int m = 0; m < 4; ++m)
#pragma unroll
                for (int n = 0; n < 2; ++n) acc[a][b][m][n] = (f32x4){0.f, 0.f, 0.f, 0.f};
    bf16x8 At[4][2], B0[2][2], B1[2][2];
    const char* cA = (const char*)g.A + (size_t)cur.pm * tstepA; const char* cB = (const char*)g.Bt + (size_t)cur.pn * tstepB;
    S.a_ready(cur);
    if constexpr (SP2) {
        PG8_STAGE(PG8_SB(0, 0), cB, voffB); PG8_STAGE(PG8_SB(0, 1), cB + hstepB, voffB); PG8_STAGE_A(PG8_SA(0, 0), cA, voffA); PG8_STAGE_A(PG8_SA(0, 1), cA + hstepA, voffA);
        if (wr == 1) PG8_BAR;
        PG8_WAIT_V(2); PG8_BAR;
        PG8_STAGE(PG8_SB(1, 0), cB + kstepB, voffB); PG8_STAGE_A(PG8_SA(1, 0), cA + kstepA, voffA); PG8_STAGE(PG8_SB(1, 1), cB + hstepB + kstepB, voffB);
        PG8_WAIT_V(6); PG8_BAR;
    } else {
        PG8_STAGE(PG8_SB(0, 0), cB, voffB); PG8_STAGE_A(PG8_SA(0, 0), cA, voffA); PG8_STAGE(PG8_SB(0, 1), cB + hstepB, voffB); PG8_STAGE_A(PG8_SA(0, 1), cA + hstepA, voffA);
        if (wr == 1) PG8_BAR;
        PG8_WAIT_V(4); PG8_BAR;
        PG8_STAGE(PG8_SB(1, 0), cB + kstepB, voffB); PG8_STAGE_A(PG8_SA(1, 0), cA + kstepA, voffA); PG8_STAGE(PG8_SB(1, 1), cB + hstepB + kstepB, voffB);
        PG8_WAIT_V(6); PG8_BAR;
    }
    for (;;) {
        const bool has_next = S.next(ui + 1, nxt);
        const char* nA = has_next ? (const char*)g.A + (size_t)nxt.pm * tstepA : cA; const char* nB = has_next ? (const char*)g.Bt + (size_t)nxt.pn * tstepB : cB;
        for (int t = 0; t < nt; t += 2) {
            const bool last = (t == nt - 2);
            const char* a1 = cA + (size_t)(t + 1) * kstepA;
            const char* a2 = last ? nA : cA + (size_t)(t + 2) * kstepA; const char* b2 = last ? nB : cB + (size_t)(t + 2) * kstepB;
            const char* a3 = a2 + kstepA; const char* b3 = b2 + kstepB;
            if (last && has_next) S.a_ready(nxt);
            if constexpr (SP2) {
            if constexpr (Epi::HAS_PRE) { if (last && wid == 0) { int ln = fr | (fq << 4); asm volatile("" : "+v"(ln)); E.pre(cur, ln); } }
            PG8_LDB(B0, 0, 0); PG8_LDB(B1, 0, 1); PG8_SCHED; PG8_LDA(At, 0, 0); PG8_STAGE_A(PG8_SA(1, 1), a1 + hstepA, voffA);
            PG8_WAIT_V(8); PG8_WAIT_L(0); PG8_BAR; PG8_MMA(0, 0, At, B0); PG8_MMA(0, 1, At, B1); PG8_BAR; PG8_SCHED;
            PG8_LDA(At, 0, 1); PG8_STAGE(PG8_SB(0, 0), b2, voffB); PG8_STAGE(PG8_SB(0, 1), b2 + hstepB, voffB); PG8_STAGE_A(PG8_SA(0, 0), a2, voffA);
            PG8_WAIT_V(8); PG8_WAIT_L(0); PG8_BAR; PG8_MMA(1, 0, At, B0); PG8_MMA(1, 1, At, B1); PG8_BAR; PG8_SCHED;
            PG8_LDB(B0, 1, 0); PG8_LDB(B1, 1, 1); PG8_SCHED; PG8_LDA(At, 1, 0); PG8_STAGE_A(PG8_SA(0, 1), a2 + hstepA, voffA);
            PG8_WAIT_V(8); PG8_WAIT_L(0); PG8_BAR; PG8_MMA(0, 0, At, B0); PG8_MMA(0, 1, At, B1); PG8_BAR; PG8_SCHED;
            PG8_LDA(At, 1, 1); PG8_STAGE(PG8_SB(1, 0), b3, voffB); PG8_STAGE(PG8_SB(1, 1), b3 + hstepB, voffB); PG8_STAGE_A(PG8_SA(1, 0), a3, voffA);
            PG8_WAIT_V(8); PG8_WAIT_L(0); PG8_BAR; PG8_MMA(1, 0, At, B0); PG8_MMA(1, 1, At, B1); PG8_BAR; PG8_SCHED;
            } else {
            PG8_LDB(B0, 0, 0); PG8_SCHED; PG8_LDA(At, 0, 0); PG8_STAGE_A(PG8_SA(1, 1), a1 + hstepA, voffA);
            PG8_WAIT_L(8); PG8_BAR; PG8_WAIT_L(0); PG8_MMA(0, 0, At, B0); PG8_BAR; PG8_SCHED;
            PG8_LDB(B1, 0, 1); PG8_STAGE(PG8_SB(0, 0), b2, voffB);
            PG8_BAR; PG8_WAIT_L(0); PG8_MMA(0, 1, At, B1); PG8_BAR;
            PG8_LDA(At, 0, 1); PG8_STAGE_A(PG8_SA(0, 0), a2, voffA);
            PG8_BAR; PG8_WAIT_L(0); PG8_MMA(1, 0, At, B0); PG8_BAR; PG8_SCHED;
            PG8_STAGE(PG8_SB(0, 1), b2 + hstepB, voffB);
            PG8_WAIT_V(6); PG8_BAR; PG8_MMA(1, 1, At, B1); PG8_BAR;
            PG8_LDB(B0, 1, 0); PG8_SCHED; PG8_LDA(At, 1, 0); PG8_STAGE_A(PG8_SA(0, 1), a2 + hstepA, voffA);
            PG8_WAIT_L(8); PG8_BAR; PG8_WAIT_L(0); PG8_MMA(0, 0, At, B0); PG8_BAR; PG8_SCHED;
            PG8_LDB(B1, 1, 1); PG8_STAGE(PG8_SB(1, 0), b3, voffB);
            PG8_BAR; PG8_WAIT_L(0); PG8_MMA(0, 1, At, B1); PG8_BAR;
            PG8_LDA(At, 1, 1); PG8_STAGE_A(PG8_SA(1, 0), a3, voffA);
            PG8_BAR; PG8_WAIT_L(0); PG8_MMA(1, 0, At, B0); PG8_BAR; PG8_SCHED;
            PG8_STAGE(PG8_SB(1, 1), b3 + hstepB, voffB);
            PG8_WAIT_V(6); PG8_BAR; PG8_MMA(1, 1, At, B1); PG8_BAR;
            }
        }
        if constexpr (ALIGN_EPI) { if (wr == 0) PG8_BAR; }
        if constexpr (!Epi::AFTER_DRAIN) { E(acc, cur, wr, wc, fr, fq); S.done(cur); }
        if (!has_next) break;
#pragma unroll
        for (int a = 0; a < 2; ++a)
#pragma unroll
            for (int b = 0; b < 2; ++b)
#pragma unroll
                for (int m = 0; m < 4; ++m)
#pragma unroll
                    for (int n = 0; n < 2; ++n) acc[a][b][m][n] = (f32x4){0.f, 0.f, 0.f, 0.f};
        cur = nxt; cA = nA; cB = nB; ++ui;
        if constexpr (ALIGN_EPI) { if (wr == 1) PG8_BAR; }
    }
    PG8_WAIT_V(0);
    if constexpr (!ALIGN_EPI) { if (wr == 0) PG8_BAR; }
    PG8_BAR;
    if constexpr (Epi::AFTER_DRAIN) { E.fused(acc, cur, wr, wc, fr, fq, lds, wid, lane); S.done(cur); }
#undef PG8_SA
#undef PG8_SB
#undef PG8_STAGE
#undef PG8_STAGE_A
#undef PG8_LDA
#undef PG8_LDB
#undef PG8_MMA
#undef PG8_WAIT_V
#undef PG8_WAIT_L
#undef PG8_BAR
#undef PG8_SCHED
}
}
#define GAS __attribute__((address_space(1)))
#define LAS __attribute__((address_space(3)))
typedef unsigned short bf16;
typedef unsigned v4u __attribute__((ext_vector_type(4)));
typedef float f32x4 __attribute__((ext_vector_type(4)));
typedef short bf16x8 __attribute__((ext_vector_type(8)));
typedef GAS unsigned gu32;
typedef GAS unsigned long long gu64;
#define RLX_AGENT __ATOMIC_RELAXED, __HIP_MEMORY_SCOPE_AGENT
#define LDS_WAIT() asm volatile("s_waitcnt lgkmcnt(0)" ::: "memory")
#define VM_WAIT() asm volatile("s_waitcnt vmcnt(0)" ::: "memory")
__device__ __forceinline__ unsigned long long rt() { return __builtin_amdgcn_s_memrealtime(); }
#define XB_TMO      128
#define XB_XCNT(j)  (256  + 64 * (j))
#define XB_XSUB(j)  (1280 + 64 * (j))
#define XB_XGEN(j)  (2304 + 64 * (j))
#define XB_TOP      3328
#define XB_TOPGEN   3392
#define XCD_BAR_WORDS 3456
#define XB_SPIN_CAP (1u << 18)

__device__ __forceinline__ unsigned xb_ld(unsigned* p)              { return __hip_atomic_load(p, __ATOMIC_RELAXED, __HIP_MEMORY_SCOPE_AGENT); }
__device__ __forceinline__ unsigned xb_add(unsigned* p, unsigned v) { return __hip_atomic_fetch_add(p, v, __ATOMIC_RELAXED, __HIP_MEMORY_SCOPE_AGENT); }
__device__ __forceinline__ unsigned xb_xcc_id() { return (unsigned)__builtin_amdgcn_s_getreg((3 << 11) | 20) & 0xFu; }
#define XB_SPIN(cond, bar) do { unsigned _sp = 0; while (cond) { __builtin_amdgcn_s_sleep(1); \
    if ((++_sp & 255u) == 0u) { if (xb_ld(&(bar)[XB_TMO])) break; if (_sp > XB_SPIN_CAP) { atomicAdd(&(bar)[XB_TMO], 1u); break; } } } } while (0)

struct XcdBarrier {
    unsigned* bar; unsigned x;
    volatile LAS unsigned* st;
};

__device__ __forceinline__ XcdBarrier xcd_barrier_post(unsigned* bar, volatile LAS unsigned* st) {
    XcdBarrier b; b.bar = bar; b.x = xb_xcc_id(); b.st = st;
    if (threadIdx.x == 0) (void)xb_add(&bar[XB_XCNT(b.x)], 1u);
    return b;
}
__device__ __forceinline__ void xcd_barrier_complete(unsigned* bar, unsigned x, unsigned& nloc, unsigned& nx) {
    const unsigned G = gridDim.x * gridDim.y * gridDim.z;
    unsigned sum, cnt, mine, sp = 0u;
    for (;;) {
        sum = 0u; cnt = 0u; mine = 0u;
#pragma unroll
        for (unsigned j = 0; j < 16; ++j) { const unsigned c = xb_ld(&bar[XB_XCNT(j)]); sum += c; cnt += (c > 0u) ? 1u : 0u; mine = (j == x) ? c : mine; }
        if (sum == G) break;
        __builtin_amdgcn_s_sleep(1);
        if ((++sp & 255u) == 0u) { if (xb_ld(&bar[XB_TMO])) break; if (sp > XB_SPIN_CAP) { atomicAdd(&bar[XB_TMO], 1u); break; } }
    }
    nloc = mine > 0u ? mine : 1u; nx = cnt > 0u ? cnt : 1u;
}

__device__ __forceinline__ void xcd_barrier(const XcdBarrier& b) {
    asm volatile("s_waitcnt vmcnt(0)" ::: "memory");
    __syncthreads();
    if (threadIdx.x == 0) {
        unsigned* bar = b.bar;
        __builtin_amdgcn_s_waitcnt(0);
        unsigned nloc = b.st[0], nx = b.st[1];
        if (nloc == 0u) { xcd_barrier_complete(bar, b.x, nloc, nx); b.st[0] = nloc; b.st[1] = nx; }
        const unsigned old = xb_add(&bar[XB_XSUB(b.x)], 1u);
        const unsigned gen = old / nloc;
        if (old + 1u == (gen + 1u) * nloc) {
            __builtin_amdgcn_fence(__ATOMIC_RELEASE, "agent");
            asm volatile("s_waitcnt vmcnt(0)" ::: "memory");
            const unsigned og = xb_add(&bar[XB_TOP], 1u);
            const unsigned tg = og / nx;
            if (og + 1u == (tg + 1u) * nx) xb_add(&bar[XB_TOPGEN], 1u);
            else XB_SPIN(xb_ld(&bar[XB_TOPGEN]) == tg, bar);
            __builtin_amdgcn_fence(__ATOMIC_ACQUIRE, "agent");
            xb_add(&bar[XB_XGEN(b.x)], 1u);
            asm volatile("s_waitcnt vmcnt(0)" ::: "memory");
        } else {
            XB_SPIN(xb_ld(&bar[XB_XGEN(b.x)]) == gen, bar);
            __builtin_amdgcn_fence(__ATOMIC_ACQUIRE, "agent");
            asm volatile("s_waitcnt vmcnt(0)" ::: "memory");
        }
    }
    __syncthreads();
}
namespace att {
using bf16x8 = __attribute__((ext_vector_type(8))) short;
using s16x4  = __attribute__((ext_vector_type(4))) short;
using f32x16 = __attribute__((ext_vector_type(16))) float;
using u32x4  = __attribute__((ext_vector_type(4))) unsigned;
constexpr int SEQ_ = 8192, LDQ = 6144; constexpr size_t SHM_V = 16384, SHM_K = 16384;
#define KSWZ(row, colB) ((row) * 256 + ((colB) ^ (((row) & 7) << 4)))
#define SBAR() __builtin_amdgcn_sched_barrier(0)
__device__ __forceinline__ int crow(int r, int hi) { return (r & 3) + 8 * (r >> 2) + 4 * hi; }
__device__ __forceinline__ unsigned cvtpk(float lo, float hi) {
  unsigned r; asm volatile("v_cvt_pk_bf16_f32 %0, %1, %2" : "=v"(r) : "v"(lo), "v"(hi)); return r;
}
__device__ __forceinline__ void qkt(f32x16& p0, f32x16& p1, const bf16* Ks, const bf16x8* qr, int r32, int hi, int jmap, float dbase, float slope2, float negm, bool diag) {
  asm volatile("" : "+v"(negm));
  if (diag) {
#pragma unroll
    for (int r = 0; r < 16; ++r) { const float d = (float)((r & 3) + 8 * (r >> 2)) + dbase;
      p0[r] = fmaf(-slope2, fabsf(d), negm); p1[r] = fmaf(-slope2, fabsf(d + 32.f), negm); }
  } else {
    const float u0 = fmaf(slope2, dbase, negm), u1 = fmaf(slope2, dbase + 32.f, negm);
#pragma unroll
    for (int r = 0; r < 16; ++r) { p0[r] = fmaf(slope2, (float)((r & 3) + 8 * (r >> 2)), u0); p1[r] = fmaf(slope2, (float)((r & 3) + 8 * (r >> 2)), u1); }
  }
#pragma unroll
  for (int d0 = 0; d0 < 4; ++d0) { const int cb = (jmap * 64 + d0 * 16 + hi * 8) * 2;
    bf16x8 b0 = *reinterpret_cast<const bf16x8*>((const char*)Ks + KSWZ(r32, cb));
    bf16x8 b1 = *reinterpret_cast<const bf16x8*>((const char*)Ks + KSWZ(32 + r32, cb));
    p0 = __builtin_amdgcn_mfma_f32_32x32x16_bf16(b0, qr[d0], p0, 0, 0, 0);
    p1 = __builtin_amdgcn_mfma_f32_32x32x16_bf16(b1, qr[d0], p1, 0, 0, 0); }
}
__device__ __forceinline__ void partialSM(f32x16& p0, f32x16& p1) {
#pragma unroll
  for (int r = 0; r < 16; ++r) p0[r] = __builtin_amdgcn_exp2f(p0[r]);
}
__device__ __forceinline__ void finishSM(f32x16& p0, f32x16& p1, float alpha, float& l_reg, bf16x8& pa0, bf16x8& pa1, bf16x8& pa2, bf16x8& pa3) {
  for (int r = 0; r < 16; ++r) p1[r] = __builtin_amdgcn_exp2f(p1[r]);
  float ps = 0; for (int r = 0; r < 16; ++r) ps += p0[r]; for (int r = 0; r < 16; ++r) ps += p1[r];
  { auto rr = __builtin_amdgcn_permlane32_swap(__float_as_uint(ps), __float_as_uint(ps), false, false);
    ps = __uint_as_float(rr[0]) + __uint_as_float(rr[1]); }
  l_reg = l_reg * alpha + ps;
#define PK4(P, BASE, OUT) do { unsigned a0 = cvtpk(P[BASE + 0], P[BASE + 1]), a1 = cvtpk(P[BASE + 2], P[BASE + 3]);   \
    unsigned b0 = cvtpk(P[BASE + 4], P[BASE + 5]), b1 = cvtpk(P[BASE + 6], P[BASE + 7]);                              \
    auto r0 = __builtin_amdgcn_permlane32_swap(a0, b0, false, false); auto r1 = __builtin_amdgcn_permlane32_swap(a1, b1, false, false); \
    u32x4 w = {r0[0], r1[0], r0[1], r1[1]}; OUT = *reinterpret_cast<bf16x8*>(&w); } while (0)
  PK4(p0, 0, pa0); PK4(p0, 8, pa1); PK4(p1, 0, pa2); PK4(p1, 8, pa3);
#undef PK4
}
__device__ __forceinline__ int v_st(int k, int c) { const int kk = (k & ~0xC) | ((k & 4) << 1) | ((k & 8) >> 1); return ((kk >> 3) * 4 + (c >> 5)) * 512 + ((kk & 7) * 32 + (c & 31)) * 2; }
__device__ __forceinline__ int v_rd_base(int lane) { return ((lane & 3) << 3) | (((lane >> 2) & 3) << 6) | (((lane >> 4) & 1) << 5) | (((lane >> 5) & 1) << 8); }
constexpr int v_rd_off(int d0, int ks, int half) { return d0 * 512 + ks * 4096 + half * 2048; }
template <int OFF> __device__ __forceinline__ s16x4 tr_read(int vb) {
  s16x4 r; asm volatile("ds_read_b64_tr_b16 %0, %1 offset:%2" : "=&v"(r) : "v"(vb), "i"(OFF) : "memory"); return r;
}
template <int D0> __device__ __forceinline__ void pv_one(f32x16& od, int vb, bf16x8 pa0, bf16x8 pa1, bf16x8 pa2, bf16x8 pa3) {
  const s16x4 l0 = tr_read<v_rd_off(D0, 0, 0)>(vb), h0 = tr_read<v_rd_off(D0, 0, 1)>(vb), l1 = tr_read<v_rd_off(D0, 1, 0)>(vb), h1 = tr_read<v_rd_off(D0, 1, 1)>(vb);
  const s16x4 l2 = tr_read<v_rd_off(D0, 2, 0)>(vb), h2 = tr_read<v_rd_off(D0, 2, 1)>(vb), l3 = tr_read<v_rd_off(D0, 3, 0)>(vb), h3 = tr_read<v_rd_off(D0, 3, 1)>(vb);
  asm volatile("s_waitcnt lgkmcnt(0)" ::: "memory"); SBAR();
#define PK(L, H) (bf16x8){L[0], L[1], L[2], L[3], H[0], H[1], H[2], H[3]}
  od = __builtin_amdgcn_mfma_f32_32x32x16_bf16(pa0, PK(l0, h0), od, 0, 0, 0);
  od = __builtin_amdgcn_mfma_f32_32x32x16_bf16(pa1, PK(l1, h1), od, 0, 0, 0);
  od = __builtin_amdgcn_mfma_f32_32x32x16_bf16(pa2, PK(l2, h2), od, 0, 0, 0);
  od = __builtin_amdgcn_mfma_f32_32x32x16_bf16(pa3, PK(l3, h3), od, 0, 0, 0);
#undef PK
}
#define PV_RD(S, D0) const s16x4 S##l0 = tr_read<v_rd_off(D0, 0, 0)>(vb), S##h0 = tr_read<v_rd_off(D0, 0, 1)>(vb), S##l1 = tr_read<v_rd_off(D0, 1, 0)>(vb), S##h1 = tr_read<v_rd_off(D0, 1, 1)>(vb), \
    S##l2 = tr_read<v_rd_off(D0, 2, 0)>(vb), S##h2 = tr_read<v_rd_off(D0, 2, 1)>(vb), S##l3 = tr_read<v_rd_off(D0, 3, 0)>(vb), S##h3 = tr_read<v_rd_off(D0, 3, 1)>(vb)
#define PV_PK(L, H) (bf16x8){L[0], L[1], L[2], L[3], H[0], H[1], H[2], H[3]}
#define PV_MM(S, OD) do { OD = __builtin_amdgcn_mfma_f32_32x32x16_bf16(pa0, PV_PK(S##l0, S##h0), OD, 0, 0, 0); OD = __builtin_amdgcn_mfma_f32_32x32x16_bf16(pa1, PV_PK(S##l1, S##h1), OD, 0, 0, 0); \
    OD = __builtin_amdgcn_mfma_f32_32x32x16_bf16(pa2, PV_PK(S##l2, S##h2), OD, 0, 0, 0); OD = __builtin_amdgcn_mfma_f32_32x32x16_bf16(pa3, PV_PK(S##l3, S##h3), OD, 0, 0, 0); } while (0)
__device__ __forceinline__ void pv_d0(f32x16* o, int vb, bf16x8 pa0, bf16x8 pa1, bf16x8 pa2, bf16x8 pa3) {
  PV_RD(a, 0); PV_RD(b, 1);
  asm volatile("s_waitcnt lgkmcnt(8)" ::: "memory"); SBAR();
  PV_MM(a, o[0]);
  PV_RD(c, 2);
  asm volatile("s_waitcnt lgkmcnt(8)" ::: "memory"); SBAR();
  PV_MM(b, o[1]);
  PV_RD(d, 3);
  asm volatile("s_waitcnt lgkmcnt(8)" ::: "memory"); SBAR();
  PV_MM(c, o[2]);
  asm volatile("s_waitcnt lgkmcnt(0)" ::: "memory"); SBAR();
  PV_MM(d, o[3]);
}
#undef PV_RD
#undef PV_PK
#undef PV_MM
__device__ __forceinline__ void attn_unit(int tid_in, int b, int h, int qb, int tb, const bf16* __restrict__ QKV, bf16* __restrict__ OB, float lam, float omli, float slope2, float m_ref, const float* __restrict__ subg, char* lds, gu32* qhead, volatile LAS unsigned* qslot) {
  int tid_o = tid_in; asm volatile("" : "+v"(tid_o));
  const int tid = tid_o, wid = __builtin_amdgcn_readfirstlane(tid >> 6), lane = tid & 63, r32 = lane & 31, hi = lane >> 5;
  const int jmap = wid >> 2, wq = wid & 3;
  constexpr int KR = 0, VR = 3 * 16384, WSO = 6 * 16384;
  float* ws = (float*)(lds + WSO) + wid * 64; float* li_l = ws;
  const long rowbase = (long)b * SEQ_; const int q0 = qb * 128 + wq * 32;
  float l_reg = 0.f; f32x16 o[4] = {}; bf16x8 qr[4];
  const bf16* Qw = QKV + (rowbase + q0 + r32) * LDQ + h * 128 + jmap * 64 + hi * 8;
#pragma unroll
  for (int d0 = 0; d0 < 4; ++d0) qr[d0] = *reinterpret_cast<const bf16x8*>(Qw + d0 * 16);
  const char* KVmid = (const char*)(QKV + (rowbase + 64 * tb) * LDQ + 2048 + h * 128 + 1024);
  unsigned koff[2], voff[2];
#pragma unroll
  for (int jb = 0; jb < 2; ++jb) { const int blk = 2 * wid + jb;
    { const int row = 4 * blk + (lane >> 4), chunk = (lane & 15) ^ (row & 7);
      koff[jb] = (unsigned)(row * LDQ * 2 + chunk * 16); }
    { const int sl = 64 * blk + lane, kk = 8 * (sl >> 7) + ((sl & 31) >> 2), c = 32 * ((sl >> 5) & 3) + 8 * (sl & 3);
      const int k = (kk & ~0xC) | ((kk & 4) << 1) | ((kk & 8) >> 1);
      voff[jb] = (unsigned)(k * LDQ * 2 + c * 2); } }
  const unsigned lds0 = (unsigned)(uintptr_t)lds;
  const int vb0 = (int)(lds0 + VR) + v_rd_base(lane);
  typedef __attribute__((address_space(3))) unsigned lds_u32;
#define DMA_K(t, slot) do { const char* t_ = KVmid + (size_t)(t) * (64 * LDQ * 2) - 2048; \
    __builtin_amdgcn_global_load_lds((const unsigned*)(t_ + koff[0]), (lds_u32*)(lds0 + KR + (slot) * 16384 + (2 * wid) * 1024), 16, 0, 0); \
    __builtin_amdgcn_global_load_lds((const unsigned*)(t_ + koff[1]), (lds_u32*)(lds0 + KR + (slot) * 16384 + (2 * wid + 1) * 1024), 16, 0, 0); } while (0)
#define DMA_V(t, slot) do { const char* t_ = KVmid + (size_t)(t) * (64 * LDQ * 2) + 2048; \
    __builtin_amdgcn_global_load_lds((const unsigned*)(t_ + voff[0]), (lds_u32*)(lds0 + VR + (slot) * 16384 + (2 * wid) * 1024), 16, 0, 0); \
    __builtin_amdgcn_global_load_lds((const unsigned*)(t_ + voff[1]), (lds_u32*)(lds0 + VR + (slot) * 16384 + (2 * wid + 1) * 1024), 16, 0, 0); } while (0)
#define WAIT_BAR(N) asm volatile("s_waitcnt vmcnt(" #N ") lgkmcnt(0)\n\ts_barrier" ::: "memory")
  f32x16 pA0, pA1, pB0, pB1; bf16x8 pa0, pa1, pa2, pa3;
  const int NT = 2 * qb + 2 - tb, cq = 2 * qb + (wq >> 1) - tb;
  const float dq = (float)(4 * hi - (q0 + r32) + 64 * tb);
#define QKT(P0, P1, kslot, t) qkt(P0, P1, (const bf16*)(lds + KR + (kslot) * 16384), qr, r32, hi, jmap, (float)(64 * (t)) + dq, slope2, ((t) > cq) ? -1e30f : -m_ref, (t) == cq)
  int sc = 0, sp = 2;
#define ROT() do { sp = sc; sc = (sc == 2) ? 0 : sc + 1; } while (0)
  asm volatile("s_waitcnt vmcnt(0)" : "+v"(qr[0]), "+v"(qr[1]), "+v"(qr[2]), "+v"(qr[3]) :: "memory");
  DMA_K(0, 0); DMA_V(0, 0); DMA_K(1, 1);
  WAIT_BAR(4);
  if (2 < NT) DMA_K(2, 2);
  DMA_V(1, 1);
  QKT(pA0, pA1, 0, 0); partialSM(pA0, pA1);
#define STEP(PX0, PX1, PY0, PY1, t) do { ROT(); \
    if ((t) + 1 < NT) { WAIT_BAR(4); } else { WAIT_BAR(2); } \
    { const int sn_ = (sp == 0) ? 2 : sp - 1;        \
      if ((t) + 2 < NT) DMA_K((t) + 2, sp); \
      if ((t) + 1 < NT) DMA_V((t) + 1, (3 - sc - sp)); (void)sn_; } \
    SBAR(); QKT(PX0, PX1, sc, t); \
    finishSM(PY0, PY1, 1.f, l_reg, pa0, pa1, pa2, pa3); SBAR(); \
    pv_d0(o, vb0 + sp * 16384, pa0, pa1, pa2, pa3); partialSM(PX0, PX1); } while (0)
  for (int t = 1; t + 1 < NT; t += 2) {
    STEP(pB0, pB1, pA0, pA1, t);
    STEP(pA0, pA1, pB0, pB1, t + 1);
  }
  STEP(pB0, pB1, pA0, pA1, NT - 1);
  WAIT_BAR(0);
  finishSM(pB0, pB1, 1.f, l_reg, pa0, pa1, pa2, pa3); SBAR();
  pv_d0(o, vb0 + sc * 16384, pa0, pa1, pa2, pa3);
  unsigned nxt_unit = 0u; if (tid == 0) nxt_unit = __hip_atomic_fetch_add(qhead, 1u, __ATOMIC_RELAXED, __HIP_MEMORY_SCOPE_AGENT);
  if (hi == 0) li_l[r32] = l_reg; asm volatile("s_waitcnt lgkmcnt(0)" ::: "memory");
#pragma unroll
  for (int r = 0; r < 16; ++r) { const float rl = __builtin_amdgcn_rcpf(li_l[crow(r, hi)]);
#pragma unroll
    for (int d0 = 0; d0 < 4; ++d0) o[d0][r] *= rl; }
  float* xch = (float*)lds + (size_t)wq * 4096 + lane;
  __syncthreads();
  if (jmap == 1) {
#pragma unroll
    for (int d0 = 0; d0 < 4; ++d0)
#pragma unroll
      for (int r = 0; r < 16; ++r) xch[(d0 * 16 + r) * 64] = o[d0][r];
  }
  __syncthreads();
  if (jmap == 0) {
    float ss[16];
#pragma unroll
    for (int r = 0; r < 16; ++r) { float s = 0.f;
#pragma unroll
      for (int d0 = 0; d0 < 4; ++d0) { const float df = o[d0][r] - lam * xch[(d0 * 16 + r) * 64]; o[d0][r] = df; s += df * df; }
      ss[r] = s; }
#pragma unroll
    for (int r = 0; r < 16; ++r) { float s = ss[r]; s += sx<1>(s); s += sx<2>(s); s += sx<4>(s); s += sx<8>(s); s += sx<16>(s);
      ss[r] = rsqrtf(s * (1.0f / 128.0f) + 1e-6f) * omli; }
    float gs[4]; int r32o = r32; asm volatile("" : "+v"(r32o));
#pragma unroll
    for (int d0 = 0; d0 < 4; ++d0) gs[d0] = subg[d0 * 32 + r32o];
    bf16* stg = (bf16*)(lds + 65536) + wq * 4096;
    int sto = 4 * hi * 128 + r32; asm volatile("" : "+v"(sto));
#pragma unroll
    for (int r = 0; r < 16; ++r) { const int orow = (r & 3) + 8 * (r >> 2);
#pragma unroll
      for (int d0 = 0; d0 < 4; ++d0) stg[sto + orow * 128 + d0 * 32] = (bf16)f2bf(o[d0][r] * ss[r] * gs[d0]); }
    asm volatile("s_waitcnt lgkmcnt(0)" ::: "memory");
    unsigned ooff = (unsigned)((q0 + (lane >> 4)) * 2048 + (lane & 15) * 8); asm volatile("" : "+v"(ooff));
    bf16* Ow = OB + rowbase * 2048 + h * 128 + ooff;
#pragma unroll
    for (int i = 0; i < 8; ++i) { const u32x4 v = *(const u32x4*)(stg + (4 * i + (lane >> 4)) * 128 + (lane & 15) * 8); *(u32x4*)(Ow + (4 * i) * 2048) = v; }
  }
  if (tid == 0) *qslot = nxt_unit;
  __syncthreads();
#undef DMA_K
#undef DMA_V
#undef WAIT_BAR
#undef ROT
#undef STEP
#undef QKT
}
#undef KSWZ
#undef SBAR
}
constexpr int DM = 2048, NB = 4, SEQ = 8192, MT = NB * SEQ, FF = 5632, NLAYER = 4, NH = 16, NMOD = 9 * DM;
constexpr float RMS_EPS = 1e-6f;
constexpr int NWAVES = 8;
#ifndef PROBE_MASK
#define PROBE_MASK 0
#endif
#ifndef PROBE_IDLE
#define PROBE_IDLE 0
#endif
#ifndef PROBE_ECHO
#define PROBE_ECHO 0
#endif
#ifndef FFN_SPLIT
#define FFN_SPLIT 1
#endif
#ifndef GU_WGM
#define GU_WGM 8
#endif
#ifndef OUT_A_AUX
#define OUT_A_AUX 0
#endif
#ifndef OUT_WGM
#define OUT_WGM 4
#endif
#ifndef MK_PER_PHASE
#define MK_PER_PHASE 0
#endif
constexpr int N_PHASES = 32 + 8 * 2 * (FFN_SPLIT - 1);
constexpr size_t MiB = 1u << 20;
constexpr size_t WS_CTL = 0, CTL_ZERO_BYTES = 3 * MiB;
constexpr size_t WS_MOD = 1696 * MiB;
constexpr size_t WS_EBL = 3 * MiB;
constexpr size_t WS_WGU = 8 * MiB;
constexpr size_t WS_WD  = 360 * MiB;
constexpr size_t WS_WAI = 536 * MiB;
constexpr size_t WS_WAO = 584 * MiB;
constexpr size_t WS_WCI = 600 * MiB, WS_WCO = 624 * MiB;
constexpr size_t WS_WHI = 632 * MiB, WS_WHO = 664 * MiB;
constexpr size_t WS_XN  = 672 * MiB;
constexpr size_t WS_BIG = 800 * MiB;
constexpr size_t WS_OB  = 1312 * MiB;
constexpr size_t WS_KLT = 1440 * MiB;
constexpr size_t WS_IT  = 1568 * MiB;
constexpr size_t WS_RSS = 1 * MiB, RSS_BYTES = 2 * MiB;
constexpr size_t WS_CB  = 1698 * MiB;
constexpr int CB_LD = 2 * 5632;
constexpr size_t WS_TAB = 1701 * MiB;
constexpr size_t WS_XH  = 1702 * MiB;
constexpr size_t WS_END = 1830 * MiB;
constexpr int CW_BAR = 4096;
constexpr int RING_OFF = 0, RING_BYTES = 131072;
constexpr int LDSCTL_OFF = RING_BYTES, MISC_OFF = LDSCTL_OFF + 320;
constexpr int PRE_OFF = LDSCTL_OFF + 1024;
constexpr int LDS_BYTES = 147456;

struct Args { const float* in[21]; float* out; unsigned char* ws; int ph_lo, ph_hi; };
struct Frame {
    LAS unsigned char* lds;
    volatile LAS unsigned* MISC;
    gu32* ctl;
    int tid, lane, wave, vcu, G;
    const struct Args* a; float* out; unsigned char* ws;
};
__device__ __forceinline__ float bf_lo(unsigned w) { return __uint_as_float(w << 16); }
__device__ __forceinline__ float bf_hi(unsigned w) { return __uint_as_float(w & 0xffff0000u); }
__device__ __forceinline__ float bf_f(bf16 x) { return __uint_as_float((unsigned)x << 16); }

__device__ __forceinline__ void unpack8(const v4u w, float (&x)[8]) { x[0] = bf_lo(w.x); x[1] = bf_hi(w.x); x[2] = bf_lo(w.y); x[3] = bf_hi(w.y); x[4] = bf_lo(w.z); x[5] = bf_hi(w.z); x[6] = bf_lo(w.w); x[7] = bf_hi(w.w); }
__device__ __forceinline__ void p0_mod(Frame& F) {
    LAS float* cond = (LAS float*)(F.lds);
    LAS float* part = (LAS float*)(F.lds + 32768);
    const float* c = F.a->in[1]; const float* aw = F.a->in[2]; const float* ab = F.a->in[3]; float* mod = (float*)(F.ws + WS_MOD);
    for (int i = F.tid; i < NB * DM; i += NWAVES * 64) { const float v = c[i]; cond[i] = v / (1.0f + __expf(-v)); }
    __syncthreads();
    const int cg = F.tid & 15, ks = F.tid >> 4;
    for (int it = F.vcu; it < NLAYER * (NMOD / 64); it += F.G) {
        const int L = it / (NMOD / 64), n0 = (it % (NMOD / 64)) * 64;
        f32x4 a0 = {0.f, 0.f, 0.f, 0.f}, a1 = a0, a2 = a0, a3 = a0;
        const float* wp = aw + ((size_t)L * DM + ks * 64) * NMOD + n0 + 4 * cg;
#pragma unroll 8
        for (int k = 0; k < 64; ++k) { const f32x4 w = *(const f32x4*)(wp + (size_t)k * NMOD); const int kk = ks * 64 + k;
            a0 += w * cond[kk]; a1 += w * cond[DM + kk]; a2 += w * cond[2 * DM + kk]; a3 += w * cond[3 * DM + kk]; }
        *(LAS f32x4*)(part + (ks * 4 + 0) * 64 + 4 * cg) = a0; *(LAS f32x4*)(part + (ks * 4 + 1) * 64 + 4 * cg) = a1;
        *(LAS f32x4*)(part + (ks * 4 + 2) * 64 + 4 * cg) = a2; *(LAS f32x4*)(part + (ks * 4 + 3) * 64 + 4 * cg) = a3;
        __syncthreads();
        if (F.tid < 256) { const int b = F.tid >> 6, col = F.tid & 63; float s = 0.f;
#pragma unroll 8
            for (int k2 = 0; k2 < 32; ++k2) s += part[(k2 * 4 + b) * 64 + col];
            mod[((size_t)L * NB + b) * NMOD + n0 + col] = s + ab[(size_t)L * NMOD + n0 + col]; }
        __syncthreads();
    }
}
struct CvItem { const float* W; bf16* WT; int K, N, mode, item; };
__device__ __forceinline__ CvItem cv_decode(Frame& F, int it) {
    constexpr int I_FFN = (DM / 64) * (FF / 32);
    constexpr int I_IN3 = (DM / 64) * (3 * DM / 32), I_SQ = (DM / 64) * (DM / 32), I_IN4 = (DM / 64) * (4 * DM / 32);
    int r = it;
    if (r < 24 * I_FFN) { const int m = r / I_FFN, ls = m / 3, which = m % 3; r -= m * I_FFN;
        if (which == 0) return CvItem{F.a->in[5] + (size_t)ls * DM * FF, (bf16*)(F.ws + WS_WGU) + (size_t)ls * 2 * FF * DM, DM, FF, 1, r};
        if (which == 1) return CvItem{F.a->in[6] + (size_t)ls * DM * FF, (bf16*)(F.ws + WS_WGU) + (size_t)ls * 2 * FF * DM, DM, FF, 2, r};
        return CvItem{F.a->in[7] + (size_t)ls * FF * DM, (bf16*)(F.ws + WS_WD) + (size_t)ls * DM * FF, FF, DM, 0, r}; }
    r -= 24 * I_FFN;
    if (r < 2 * I_IN3) { const int s = r / I_IN3; return CvItem{F.a->in[8] + (size_t)s * DM * 3 * DM, (bf16*)(F.ws + WS_WAI) + (size_t)s * 3 * DM * DM, DM, 3 * DM, 3, r - s * I_IN3}; } r -= 2 * I_IN3;
    if (r < 2 * I_SQ) { const int s = r / I_SQ; return CvItem{F.a->in[9] + (size_t)s * DM * DM, (bf16*)(F.ws + WS_WAO) + (size_t)s * DM * DM, DM, DM, 0, r - s * I_SQ}; } r -= 2 * I_SQ;
    if (r < I_IN3) return CvItem{F.a->in[14], (bf16*)(F.ws + WS_WCI), DM, 3 * DM, 0, r}; r -= I_IN3;
    if (r < I_SQ) return CvItem{F.a->in[16], (bf16*)(F.ws + WS_WCO), DM, DM, 0, r}; r -= I_SQ;
    if (r < I_IN4) return CvItem{F.a->in[17], (bf16*)(F.ws + WS_WHI), DM, 4 * DM, 0, r}; r -= I_IN4;
    return CvItem{F.a->in[18], (bf16*)(F.ws + WS_WHO), DM, DM, 0, r};
}
__device__ __forceinline__ void cv_load(const CvItem& c, float (&wv)[32], int lane) {
    const int nblk = c.N / 32, kb = c.item / nblk, nb = c.item % nblk;
    const float* wp = c.W + (size_t)(64 * kb + (lane >> 5)) * c.N + 32 * nb + (lane & 31);
#pragma unroll
    for (int i = 0; i < 32; ++i) wv[i] = wp[(size_t)(2 * i) * c.N];
}
__device__ __forceinline__ void cv_finish(const CvItem& c, const float (&wv)[32], LAS float* scr, int lane) {
    const int K = c.K, mode = c.mode, nblk = c.N / 32, kb = c.item / nblk, nb = c.item % nblk, n0 = 32 * nb;
    const int drow0 = (mode == 0 || (mode == 3 && n0 >= 2 * DM)) ? n0 : (mode == 3) ? ((n0 & ~255) + 128 * ((n0 >> 5) & 1) + 32 * ((n0 >> 6) & 3)) : ((n0 >> 7) * 256 + (mode - 1) * 128 + (n0 & 127));
#pragma unroll
    for (int i = 0; i < 32; ++i) scr[(2 * i + (lane >> 5)) * 33 + (lane & 31)] = wv[i];
    LDS_WAIT(); asm volatile("" ::: "memory");
    const int cc = lane & 7;
#pragma unroll
    for (int j = 0; j < 4; ++j) { const int n = (lane >> 3) + 8 * j; const LAS float* s = scr + (8 * cc) * 33 + n;
        v4u o; o.x = pk2(s[0 * 33], s[1 * 33]); o.y = pk2(s[2 * 33], s[3 * 33]); o.z = pk2(s[4 * 33], s[5 * 33]); o.w = pk2(s[6 * 33], s[7 * 33]);
        const int dr = drow0 + n;
        *(GAS v4u*)(c.WT + ((size_t)((dr >> 8) * (K >> 6) + kb) * 256 + (dr & 255)) * 64 + 8 * cc) = o; }
    LDS_WAIT(); asm volatile("" ::: "memory");
}
__device__ __forceinline__ void p0_convert(Frame& F) {
    LAS float* scr = (LAS float*)(F.lds + RING_OFF + F.wave * 16384);
    const int gw = F.vcu * NWAVES + F.wave, NGW = F.G * NWAVES;
    constexpr int NITEMS = 24 * ((DM / 64) * (FF / 32)) + 3 * ((DM / 64) * (3 * DM / 32)) + 4 * ((DM / 64) * (DM / 32)) + (DM / 64) * (4 * DM / 32);
    CvItem A, B; float wa[32], wb[32];
    int it = gw;
    if (it < NITEMS) { A = cv_decode(F, it); cv_load(A, wa, F.lane); }
    while (it < NITEMS) {
        int nx = it + NGW;
        if (nx < NITEMS) { B = cv_decode(F, nx); cv_load(B, wb, F.lane); }
        cv_finish(A, wa, scr, F.lane);
        it = nx; if (it >= NITEMS) break;
        nx = it + NGW;
        if (nx < NITEMS) { A = cv_decode(F, nx); cv_load(A, wa, F.lane); }
        cv_finish(B, wb, scr, F.lane);
        it = nx;
    }
}
__device__ __forceinline__ void xs0_phase(Frame& F, const float* xsrc, const float* g, const float* modL) {
    bf16* XN = (bf16*)(F.ws + WS_XN); float* rss = (float*)(F.ws + WS_RSS);
    const int gw = F.vcu * NWAVES + F.wave, NGW = F.G * NWAVES;
    for (int r0 = gw * 16; r0 < MT; r0 += NGW * 16) {
        const int b = r0 / SEQ;
        const float* sc = modL + (size_t)b * NMOD + DM;
        f32x4 a[8];
#pragma unroll
        for (int j = 0; j < 8; ++j) { const int col = 4 * F.lane + 256 * j; a[j] = *(const f32x4*)(g + col) * (*(const f32x4*)(sc + col) + 1.0f); }
#pragma unroll 2
        for (int r = 0; r < 16; ++r) {
            const GAS f32x4* xr = (const GAS f32x4*)(xsrc + (size_t)(r0 + r) * DM) + F.lane;
            f32x4 v[8]; float s = 0.f;
#pragma unroll
            for (int j = 0; j < 8; ++j) { v[j] = xr[64 * j]; s += (v[j].x * v[j].x + v[j].y * v[j].y) + (v[j].z * v[j].z + v[j].w * v[j].w); }
            s = wave_sum(s);
            if (F.lane == 0) rss[r0 + r] = s;
            bf16* o8 = XN + ((size_t)((r0 + r) >> 8) * 32 * 256 + ((r0 + r) & 255)) * 64 + (size_t)(F.lane >> 4) * (256 * 64) + 4 * (F.lane & 15);
#pragma unroll
            for (int j = 0; j < 8; ++j) { const f32x4 h = v[j] * a[j];
                *(GAS unsigned long long*)(o8 + (size_t)(4 * j) * (256 * 64)) = (unsigned long long)pk2(h.x, h.y) | ((unsigned long long)pk2(h.z, h.w) << 32); }
        }
    }
}
__device__ __forceinline__ void tables_phase(Frame& F) {
    const float* mod = (const float*)(F.ws + WS_MOD); float* TAB = (float*)(F.ws + WS_TAB); const float* ng = F.a->in[4];
    const int gt = F.vcu * (NWAVES * 64) + F.tid, NT = F.G * NWAVES * 64;
    for (int i = gt; i < 3 * NLAYER * NB * DM; i += NT) {
        const int col = i % DM, b = (i / DM) % NB, s = i / (DM * NB), L = s / 3, sub = s % 3, sn = s + 1, Ln = sn / 3, subn = sn % 3;
        TAB[((size_t)(s * 2 + 0) * NB + b) * DM + col] = ((sub == 1) ? 1.0f : 0.5f) * mod[((size_t)L * NB + b) * NMOD + (3 * sub + 2) * DM + col];
        TAB[((size_t)(s * 2 + 1) * NB + b) * DM + col] = (sn < 3 * NLAYER) ? ng[((size_t)Ln * 3 + subn) * DM + col] * (1.0f + mod[((size_t)Ln * NB + b) * NMOD + (3 * subn + 1) * DM + col]) : 0.f;
    }
}
__device__ __forceinline__ void bias_phase(Frame& F) {
    const float* mod = (const float*)(F.ws + WS_MOD); float* CB = (float*)(F.ws + WS_CB);
    const int gw = F.vcu * NWAVES + F.wave, NGW = F.G * NWAVES;
#pragma unroll 1
    for (int s = 0; s < 3 * NLAYER; ++s) {
        const int L = s / 3, sub = s % 3, kind = L % 3, slot = L / 3;
        const bf16* W; int N;
        if (sub != 1) { W = (const bf16*)(F.ws + WS_WGU) + (size_t)(L * 2 + (sub >> 1)) * 2 * FF * DM; N = 2 * FF; }
        else if (kind == 0) { W = (const bf16*)(F.ws + WS_WAI) + (size_t)slot * 3 * DM * DM; N = 3 * DM; }
        else if (kind == 1) { W = (const bf16*)(F.ws + WS_WCI); N = 3 * DM; }
        else { W = (const bf16*)(F.ws + WS_WHI); N = 4 * DM; }
        float sh[4][4][8];
#pragma unroll
        for (int b = 0; b < NB; ++b)
#pragma unroll
            for (int it = 0; it < 4; ++it) { const float* sp = mod + ((size_t)L * NB + b) * NMOD + (3 * sub) * DM + 8 * (64 * it + F.lane);
                const f32x4 s0 = *(const f32x4*)sp, s1 = *(const f32x4*)(sp + 4);
                sh[b][it][0] = s0.x; sh[b][it][1] = s0.y; sh[b][it][2] = s0.z; sh[b][it][3] = s0.w; sh[b][it][4] = s1.x; sh[b][it][5] = s1.y; sh[b][it][6] = s1.z; sh[b][it][7] = s1.w; }
        for (int n = gw; n < N; n += NGW) {
            const bf16* wrow = W + ((size_t)(n >> 8) * (DM >> 6) * 256 + (n & 255)) * 64 + (F.lane & 7) * 8;
            float d0 = 0.f, d1 = 0.f, d2 = 0.f, d3 = 0.f;
#pragma unroll
            for (int it = 0; it < 4; ++it) { float w[8]; unpack8(*(const GAS v4u*)(wrow + (size_t)(8 * it + (F.lane >> 3)) * 256 * 64), w);
#pragma unroll
                for (int i = 0; i < 8; ++i) { d0 += w[i] * sh[0][it][i]; d1 += w[i] * sh[1][it][i]; d2 += w[i] * sh[2][it][i]; d3 += w[i] * sh[3][it][i]; } }
            d0 = wave_sum(d0); d1 = wave_sum(d1); d2 = wave_sum(d2); d3 = wave_sum(d3);
            if (F.lane == 0) { float* cp = CB + (size_t)s * NB * CB_LD + n; cp[0] = d0; cp[CB_LD] = d1; cp[2 * CB_LD] = d2; cp[3 * CB_LD] = d3; }
        }
    }
}
constexpr int CW_ATTNQ = 8192;
__device__ __forceinline__ void attn_phase(Frame& F, int L, int slot, int qword = 0) {
    const bf16* QKV = (const bf16*)(F.ws + WS_BIG); bf16* OB = (bf16*)(F.ws + WS_OB);
    const float* lv = F.a->in[12] + (size_t)slot * 4 * 64;
    int ln = F.lane; asm volatile("" : "+v"(ln));
    const float sa = wave_sum(lv[ln] * lv[64 + ln]), sb = wave_sum(lv[128 + ln] * lv[192 + ln]);
    asm volatile("" : "+s"(L));
    const float lambda_init = (L == 0) ? 0.2f : (L == 1) ? 0.35550906f : (L == 2) ? 0.47071302f : 0.55605822f;
    const float lam = expf(sa) - expf(sb) + lambda_init;
    const float* subg = F.a->in[13] + (size_t)slot * 128;
    float gm = fabsf(F.a->in[10][slot * 64 + ln] * F.a->in[11][slot * 64 + ln]);
    gm = wave_max(gm);
    const float twoB24 = 16.0f * gm + 24.0f;
    const float m_ref = (8.0f * gm) * 1.4426950408889634f * 1.02f + 0.5f;
    gu32* qhead = F.ctl + CW_ATTNQ + 64 * slot + 256 * qword;
    if (F.tid == 0) F.MISC[16] = __hip_atomic_fetch_add(qhead, 1u, RLX_AGENT);
    __syncthreads();
    int n = (int)F.MISC[16];
    while (n < NB * NH * (SEQ / 128)) {
        const int qb = 63 - (n >> 6), bhq = n & 63, h = 15 - (bhq >> 2), b = bhq & 3;
        const float slope = exp2f(-0.5f * (float)(h + 1));
        const float W = (twoB24 - __logf(1.0f - __expf(-slope))) / slope;
        int tb = (int)floorf(((float)(128 * qb) - W) * (1.0f / 64.0f)); tb = (tb < 0 ? 0 : tb) & ~1;
        att::attn_unit(F.tid, b, h, qb, tb, QKV, OB, lam, 1.0f - lambda_init, slope * 1.4426950408889634f, m_ref, subg, (char*)(F.lds + RING_OFF), qhead, F.MISC + 16);
        n = (int)F.MISC[16];
    }
}
__device__ __forceinline__ void conv_phase(Frame& F) {
    const bf16* U = (const bf16*)(F.ws + WS_BIG); bf16* OB = (bf16*)(F.ws + WS_OB); const float* cw = F.a->in[15];
    const int gt = F.vcu * (NWAVES * 64) + F.tid, NT = F.G * NWAVES * 64;
    for (int item = gt; item < 256 * (MT / 16); item += NT) {
        int dg = item & 255; asm volatile("" : "+v"(dg));
        const int run = item >> 8, row0 = run * 16, d = dg * 8;
        float w0[8], w1[8], w2[8];
#pragma unroll
        for (int i = 0; i < 8; ++i) { w0[i] = cw[d + i]; w1[i] = cw[DM + d + i]; w2[i] = cw[2 * DM + d + i]; }
        float vm2[8], vm1[8];
        if ((row0 % SEQ) == 0) {
#pragma unroll
            for (int i = 0; i < 8; ++i) { vm2[i] = 0.f; vm1[i] = 0.f; }
        } else {
            float a[8], b[8];
            unpack8(*(const GAS v4u*)(U + (size_t)(row0 - 2) * 6144 + 2048 + d), a); unpack8(*(const GAS v4u*)(U + (size_t)(row0 - 2) * 6144 + 4096 + d), b);
#pragma unroll
            for (int i = 0; i < 8; ++i) vm2[i] = a[i] * b[i];
            unpack8(*(const GAS v4u*)(U + (size_t)(row0 - 1) * 6144 + 2048 + d), a); unpack8(*(const GAS v4u*)(U + (size_t)(row0 - 1) * 6144 + 4096 + d), b);
#pragma unroll
            for (int i = 0; i < 8; ++i) vm1[i] = a[i] * b[i];
        }
#pragma unroll 4
        for (int t = 0; t < 16; ++t) {
            const bf16* rp = U + (size_t)(row0 + t) * 6144 + d;
            float bg[8], cg[8], uu[8], y[8];
            unpack8(*(const GAS v4u*)(rp), bg); unpack8(*(const GAS v4u*)(rp + 2048), cg); unpack8(*(const GAS v4u*)(rp + 4096), uu);
#pragma unroll
            for (int i = 0; i < 8; ++i) { const float v = cg[i] * uu[i]; y[i] = bg[i] * (w0[i] * vm2[i] + w1[i] * vm1[i] + w2[i] * v); vm2[i] = vm1[i]; vm1[i] = v; }
            v4u o; o.x = pk2(y[0], y[1]); o.y = pk2(y[2], y[3]); o.z = pk2(y[4], y[5]); o.w = pk2(y[6], y[7]);
            *(GAS v4u*)(OB + (size_t)(row0 + t) * DM + d) = o;
        }
    }
}
#define LDS_BAR() asm volatile("s_waitcnt lgkmcnt(0)\n\ts_barrier" ::: "memory")
typedef short s16x4 __attribute__((ext_vector_type(4)));
typedef float f32x16 __attribute__((ext_vector_type(16)));
__device__ __forceinline__ int crow16(int r, int hi) { return (r & 3) + 8 * (r >> 2) + 4 * hi; }
constexpr int H_P256 = 272, H_P128 = 144;
__device__ __forceinline__ void hgrn_prep_phase(Frame& F, int layer, bf16* QBO, int qbld, bf16* OBO) {
    bf16* BIG = (bf16*)(F.ws + WS_BIG); bf16* KLT = (bf16*)(F.ws + WS_KLT); bf16* ITG = (bf16*)(F.ws + WS_IT); float* EBL = (float*)(F.ws + WS_EBL); bf16* OB = (bf16*)(F.ws + WS_OB);
    const float* lbl = F.a->in[20];
    LAS unsigned char* QS = F.lds; LAS unsigned char* KS = F.lds + 64 * H_P256; LAS unsigned char* ITL = F.lds + 2 * 64 * H_P256; LAS float* TOT = (LAS float*)(F.lds + 2 * 64 * H_P256 + 128 * H_P128);
    const int kp = F.lane, seg = F.wave, r32 = F.lane & 31, hi = F.lane >> 5;
    unsigned qw[8], fw[8], iw[8]; f32x2_cv lgt[4];
#define H1_LOAD(un) do { const int bh_ = (un) >> 7, c_ = (un) & 127; const size_t rb_ = (size_t)(bh_ >> 4) * SEQ + (size_t)c_ * 64; \
        _Pragma("unroll") for (int L_ = 0; L_ < 4; ++L_) lgt[L_] = *(const GAS f32x2_cv*)(lbl + L_ * DM + (bh_ & 15) * 128 + 2 * kp); \
        _Pragma("unroll") for (int tt = 0; tt < 8; ++tt) { const bf16* pq = BIG + (rb_ + 8 * seg + tt) * 8192 + (bh_ & 15) * 128 + 2 * kp; \
            qw[tt] = *(const GAS unsigned*)pq; fw[tt] = *(const GAS unsigned*)(pq + 2048); iw[tt] = *(const GAS unsigned*)(pq + 4096); } } while (0)
    for (int unit = F.vcu; unit < NB * NH * (SEQ / 64); unit += F.G) {
        const int bh = unit >> 7, c = unit & 127, b = bh >> 4, h = bh & 15; const size_t rowbase = (size_t)b * SEQ + (size_t)c * 64;
        if (unit == F.vcu) H1_LOAD(unit);
        float lb[2];
#pragma unroll
        for (int kk = 0; kk < 2; ++kk) { const float l0 = lgt[0][kk], l1 = lgt[1][kk], l2 = lgt[2][kk], l3 = lgt[3][kk];
            const float mx = fmaxf(fmaxf(l0, l1), fmaxf(l2, l3)); const float e0 = __expf(l0 - mx), e1 = __expf(l1 - mx), e2 = __expf(l2 - mx), e3 = __expf(l3 - mx);
            float cumv = 0.f; if (layer >= 1) cumv += e1; if (layer >= 2) cumv += e2; if (layer >= 3) cumv += e3;
            lb[kk] = cumv * __builtin_amdgcn_rcpf(e0 + e1 + e2 + e3); }
        float bcs[8][2], kv[8][2]; float cum[2] = {0.f, 0.f};
#pragma unroll
        for (int tt = 0; tt < 8; ++tt)
#pragma unroll
            for (int kk = 0; kk < 2; ++kk) { const float x = kk ? bf_hi(fw[tt]) : bf_lo(fw[tt]); const float sig = __builtin_amdgcn_rcpf(1.0f + __expf(-x));
                const float f = lb[kk] + (1.0f - lb[kk]) * sig; cum[kk] += __builtin_amdgcn_logf(f) * 0.6931471805599453f;     bcs[tt][kk] = cum[kk]; kv[tt][kk] = 1.0f - f; }
        TOT[seg * 128 + 2 * kp] = cum[0]; TOT[seg * 128 + 2 * kp + 1] = cum[1];
        LDS_BAR();
        float off[2] = {0.f, 0.f}, rb[2] = {0.f, 0.f}, bl[2] = {0.f, 0.f};
#pragma unroll
        for (int s = 0; s < 8; ++s)
#pragma unroll
            for (int kk = 0; kk < 2; ++kk) { const float tv = TOT[s * 128 + 2 * kp + kk]; if (s < seg) off[kk] += tv; if (s < 4) rb[kk] += tv; bl[kk] += tv; }
        float erb[2], enrb[2], ebl[2];
#pragma unroll
        for (int kk = 0; kk < 2; ++kk) { erb[kk] = __expf(rb[kk]); enrb[kk] = __expf(-rb[kk]); ebl[kk] = __expf(bl[kk]); }
        unsigned klw[2][4], itw[2][4];
#pragma unroll
        for (int tt = 0; tt < 8; ++tt) { float qb_[2], qs_[2], ks_[2], kl_[2];
#pragma unroll
            for (int kk = 0; kk < 2; ++kk) { const float bb = bcs[tt][kk] + off[kk]; const float q = kk ? bf_hi(qw[tt]) : bf_lo(qw[tt]);
                const float eb = __expf(bb), enb = __builtin_amdgcn_rcpf(eb);
                qb_[kk] = q * eb; qs_[kk] = qb_[kk] * enrb[kk]; ks_[kk] = kv[tt][kk] * (erb[kk] * enb); kl_[kk] = kv[tt][kk] * (ebl[kk] * enb); }
            *(GAS unsigned*)(QBO + (rowbase + 8 * seg + tt) * qbld + h * 128 + 2 * kp) = pk2(qb_[0], qb_[1]);
            *(LAS unsigned*)(QS + (8 * seg + tt) * H_P256 + 4 * kp) = pk2(qs_[0], qs_[1]);
            *(LAS unsigned*)(KS + (8 * seg + tt) * H_P256 + 4 * kp) = pk2(ks_[0], ks_[1]);
            if (tt & 1) { klw[0][tt >> 1] |= f2bf(kl_[0]) << 16; klw[1][tt >> 1] |= f2bf(kl_[1]) << 16; itw[0][tt >> 1] |= (iw[tt] & 0xffffu) << 16; itw[1][tt >> 1] |= (iw[tt] >> 16) << 16; }
            else { klw[0][tt >> 1] = f2bf(kl_[0]); klw[1][tt >> 1] = f2bf(kl_[1]); itw[0][tt >> 1] = iw[tt] & 0xffffu; itw[1][tt >> 1] = iw[tt] >> 16; }
        }
#pragma unroll
        for (int kk = 0; kk < 2; ++kk) { const v4u kw = {klw[kk][0], klw[kk][1], klw[kk][2], klw[kk][3]}, tw = {itw[kk][0], itw[kk][1], itw[kk][2], itw[kk][3]};
            *(GAS v4u*)(KLT + (size_t)unit * 8192 + (2 * kp + kk) * 64 + 8 * seg) = kw;
            *(GAS v4u*)(ITG + (size_t)unit * 8192 + (2 * kp + kk) * 64 + 8 * seg) = tw;
            *(LAS v4u*)(ITL + (2 * kp + kk) * H_P128 + 16 * seg) = tw; }
        if (seg == 0) { EBL[(size_t)unit * 128 + 2 * kp] = ebl[0]; EBL[(size_t)unit * 128 + 2 * kp + 1] = ebl[1]; }
        LDS_BAR();
        if (unit + F.G < NB * NH * (SEQ / 64)) H1_LOAD(unit + F.G);
        const int tt_ = F.wave & 1, vt = F.wave >> 1;
        f32x16 z = {};
        for (int st = 0; st <= tt_; ++st) {
            f32x16 x = {};
            bf16x8 af[8], bqf[8];
#pragma unroll
            for (int step = 0; step < 8; ++step) { af[step] = *(const LAS bf16x8*)(KS + (32 * st + r32) * H_P256 + (16 * step + 8 * hi) * 2);
                bqf[step] = *(const LAS bf16x8*)(QS + (32 * tt_ + r32) * H_P256 + (16 * step + 8 * hi) * 2); }
#pragma unroll
            for (int step = 0; step < 8; ++step) x = __builtin_amdgcn_mfma_f32_32x32x16_bf16(af[step], bqf[step], x, 0, 0, 0);
            if (st == tt_) {
#pragma unroll
                for (int r = 0; r < 16; ++r) if (crow16(r, hi) > r32) x[r] = 0.f;
            }
#pragma unroll
            for (int sp = 0; sp < 2; ++sp) {
                v4u pw; pw.x = pk2(x[8 * sp + 0], x[8 * sp + 1]); pw.y = pk2(x[8 * sp + 2], x[8 * sp + 3]); pw.z = pk2(x[8 * sp + 4], x[8 * sp + 5]); pw.w = pk2(x[8 * sp + 6], x[8 * sp + 7]);
                const bf16x8 xs = __builtin_bit_cast(bf16x8, pw);
                const LAS unsigned char* ip = ITL + (32 * vt + r32) * H_P128 + (32 * st + 16 * sp + 4 * hi) * 2;
                const s16x4 lo = *(const LAS s16x4*)ip, hh = *(const LAS s16x4*)(ip + 16);
                const bf16x8 pb = __builtin_shufflevector(lo, hh, 0, 1, 2, 3, 4, 5, 6, 7);
                z = __builtin_amdgcn_mfma_f32_32x32x16_bf16(xs, pb, z, 0, 0, 0);
            }
        }
        bf16* op = OBO + (rowbase + 32 * tt_) * DM + h * 128 + 32 * vt + r32;
#pragma unroll
        for (int r = 0; r < 16; ++r) op[(size_t)crow16(r, hi) * DM] = (bf16)f2bf(z[r]);
        LDS_BAR();
    }
}
#undef H1_LOAD
__device__ __forceinline__ void hgrn_scan_phase(Frame& F, bf16* OBO) {
    const bf16* BIG = (const bf16*)(F.ws + WS_BIG); const bf16* KLT = (const bf16*)(F.ws + WS_KLT); const bf16* ITG = (const bf16*)(F.ws + WS_IT); const float* EBL = (const float*)(F.ws + WS_EBL); const bf16* OB = (const bf16*)(F.ws + WS_OB);
    constexpr int TB = 64 * H_P256 + 128 * H_P128 + 32 * H_P128 + 512;
    constexpr int STB = 32 * H_P256;
    constexpr int IOB = 64 * 64;
    LAS unsigned char* TL = F.lds; LAS unsigned char* STL = F.lds + 2 * TB; LAS unsigned char* ISL = STL + 2 * STB; LAS unsigned char* OSL = ISL + 2 * IOB;
    const int tid = F.tid, r32 = F.lane & 31, hi = F.lane >> 5, w = F.wave;
    for (int unit = F.vcu; unit < NB * NH * 4; unit += F.G) {
        const int bh = unit >> 2, vq = unit & 3, b = bh >> 4, h = bh & 15;
        f32x16 acc = {};
        v4u q0[2], k0[2], i0, e0, q1[2], k1[2], i1, e1, ivr[2];
        i0 = i1 = e0 = e1 = ivr[0] = ivr[1] = (v4u){(unsigned)tid >> 31, 0u, 0u, 0u};
        const int ioq = (F.lane + 64 * (w & 1));
#define H2_LOAD(Q, K, I, E, c) do { const size_t rb_ = (size_t)b * SEQ + (size_t)(c) * 64; const size_t un_ = (size_t)bh * 128 + (c); \
        _Pragma("unroll") for (int i_ = 0; i_ < 2; ++i_) { const int p_ = tid + 512 * i_; \
            Q[i_] = *(const GAS v4u*)(BIG + (rb_ + (p_ >> 4)) * 8192 + h * 128 + (p_ & 15) * 8); K[i_] = *(const GAS v4u*)(KLT + un_ * 8192 + (size_t)p_ * 8); } \
        if (tid < 256) I = *(const GAS v4u*)(ITG + un_ * 8192 + (size_t)(32 * vq) * 64 + (size_t)tid * 8); \
        if (tid < 32) E = *(const GAS v4u*)(EBL + un_ * 128 + 4 * tid); } while (0)
#define H2_WRITE(Q, K, I, E, bufo) do { LAS unsigned char* tb_ = TL + (bufo); _Pragma("unroll") for (int i_ = 0; i_ < 2; ++i_) { const int p_ = tid + 512 * i_; \
            *(LAS v4u*)(tb_ + (p_ >> 4) * H_P256 + (p_ & 15) * 16) = Q[i_]; *(LAS v4u*)(tb_ + 64 * H_P256 + (p_ >> 3) * H_P128 + (p_ & 7) * 16) = K[i_]; } \
        if (tid < 256) *(LAS v4u*)(tb_ + 64 * H_P256 + 128 * H_P128 + (tid >> 3) * H_P128 + (tid & 7) * 16) = I; \
        if (tid < 32) *(LAS v4u*)(tb_ + 64 * H_P256 + 128 * H_P128 + 32 * H_P128 + 16 * tid) = E; } while (0)
#define H2_IVLD(c) do { _Pragma("unroll") for (int j_ = 0; j_ < 2; ++j_) { const int q_ = ioq + 128 * j_; \
            ivr[j_] = *(const GAS v4u*)(OB + ((size_t)b * SEQ + (size_t)(c) * 64 + (q_ >> 2)) * DM + h * 128 + 32 * vq + (q_ & 3) * 8); } } while (0)
#define H2_IVST(slot) do { _Pragma("unroll") for (int j_ = 0; j_ < 2; ++j_) { const int q_ = ioq + 128 * j_; *(LAS v4u*)(ISL + (slot) * IOB + (q_ >> 2) * 64 + (q_ & 3) * 16) = ivr[j_]; } } while (0)
#define H2_OST(c, slot) do { _Pragma("unroll") for (int j_ = 0; j_ < 2; ++j_) { const int q_ = ioq + 128 * j_; const v4u v_ = *(const LAS v4u*)(OSL + (slot) * IOB + (q_ >> 2) * 64 + (q_ & 3) * 16); \
            *(GAS v4u*)(OBO + ((size_t)b * SEQ + (size_t)(c) * 64 + (q_ >> 2)) * DM + h * 128 + 32 * vq + (q_ & 3) * 8) = v_; } } while (0)
#define H2_STEP(c, cur, Qn, Kn, In, En) do { LAS unsigned char* tb_ = TL + (cur) * TB; LAS unsigned char* st_ = STL + (cur) * STB; \
          \
          \
        if (w >= 6 && (c) + 1 < SEQ / 64) H2_IVST((cur) ^ 1);      \
        if ((c) + 1 < SEQ / 64) H2_WRITE(Qn, Kn, In, En, ((cur) ^ 1) * TB); \
        if (w >= 6) { if ((c) + 2 < SEQ / 64) H2_IVLD((c) + 2); \
            if ((c) >= 1) H2_OST((c) - 1, (cur) ^ 1); }             \
        if ((c) + 3 < SEQ / 64) H2_LOAD(Qn, Kn, In, En, (c) + 3); \
        if (w < 4) { const LAS float* eb_ = (const LAS float*)(tb_ + 64 * H_P256 + 128 * H_P128 + 32 * H_P128); \
            _Pragma("unroll") for (int r = 0; r < 16; ++r) acc[r] *= eb_[32 * w + crow16(r, hi)]; \
            _Pragma("unroll") for (int step = 0; step < 4; ++step) { const bf16x8 a_ = *(const LAS bf16x8*)(tb_ + 64 * H_P256 + (32 * w + r32) * H_P128 + (16 * step + 8 * hi) * 2); \
                const bf16x8 b_ = *(const LAS bf16x8*)(tb_ + 64 * H_P256 + 128 * H_P128 + r32 * H_P128 + (16 * step + 8 * hi) * 2); acc = __builtin_amdgcn_mfma_f32_32x32x16_bf16(a_, b_, acc, 0, 0, 0); } \
            LAS unsigned char* sn_ = STL + ((cur) ^ 1) * STB + r32 * H_P256 + (32 * w + 4 * hi) * 2; \
            _Pragma("unroll") for (int g = 0; g < 4; ++g) *(LAS unsigned long long*)(sn_ + 16 * g) = (unsigned long long)pk2(acc[4 * g], acc[4 * g + 1]) | ((unsigned long long)pk2(acc[4 * g + 2], acc[4 * g + 3]) << 32); \
        } else if (w < 6) { f32x16 o_ = {}; \
            _Pragma("unroll") for (int step = 0; step < 8; ++step) { const bf16x8 a_ = *(const LAS bf16x8*)(tb_ + (32 * (w - 4) + r32) * H_P256 + (16 * step + 8 * hi) * 2); \
                const bf16x8 b_ = *(const LAS bf16x8*)(st_ + r32 * H_P256 + (16 * step + 8 * hi) * 2); o_ = __builtin_amdgcn_mfma_f32_32x32x16_bf16(a_, b_, o_, 0, 0, 0); } \
            const int so_ = (32 * (w - 4) + 4 * hi) * 64 + r32 * 2; bf16 iv_[16]; \
            _Pragma("unroll") for (int r = 0; r < 16; ++r) iv_[r] = *(const LAS bf16*)(ISL + (cur) * IOB + so_ + ((r & 3) + 8 * (r >> 2)) * 64);     \
            _Pragma("unroll") for (int r = 0; r < 16; ++r) *(LAS bf16*)(OSL + (cur) * IOB + so_ + ((r & 3) + 8 * (r >> 2)) * 64) = (bf16)f2bf(o_[r] + bf_f(iv_[r])); } \
        LDS_BAR(); } while (0)
        { const unsigned zz = (unsigned)tid >> 31;
          for (int i = tid; i < STB / 16; i += NWAVES * 64) *(LAS v4u*)(STL + 16 * i) = (v4u){zz, zz, zz, zz}; }
        H2_LOAD(q0, k0, i0, e0, 0); H2_WRITE(q0, k0, i0, e0, 0);
        H2_LOAD(q1, k1, i1, e1, 1); H2_LOAD(q0, k0, i0, e0, 2);
        if (w >= 6) { H2_IVLD(0); H2_IVST(0); H2_IVLD(1); }
        LDS_BAR();
#pragma unroll 1
        for (int c = 0; c < SEQ / 64; c += 2) {
            H2_STEP(c, 0, q1, k1, i1, e1);
            H2_STEP(c + 1, 1, q0, k0, i0, e0);
        }
        if (w >= 6) H2_OST(SEQ / 64 - 1, 1);
        LDS_BAR();
#undef H2_LOAD
#undef H2_WRITE
#undef H2_IVLD
#undef H2_IVST
#undef H2_OST
#undef H2_STEP
    }
}
__device__ __forceinline__ void hgrn_final_phase(Frame& F, bf16* OBO) {
    const bf16* BIG = (const bf16*)(F.ws + WS_BIG); bf16* OB = (bf16*)(F.ws + WS_OB); const float* gn = F.a->in[19];
    const int gw = F.vcu * NWAVES + F.wave, NGW = F.G * NWAVES;
    const int dv = (F.lane & 15) * 8;
    const f32x4 g0 = *(const f32x4*)(gn + dv), g1 = *(const f32x4*)(gn + dv + 4);
    for (int row = gw; row < MT; row += NGW) {
        GAS v4u* po = (GAS v4u*)(OB + (size_t)row * DM) + F.lane; const GAS v4u* pg = (const GAS v4u*)(BIG + (size_t)row * 8192 + 6144) + F.lane;
        v4u wo[4], wg[4];
#pragma unroll
        for (int it = 0; it < 4; ++it) { wo[it] = po[64 * it]; wg[it] = pg[64 * it]; }
#pragma unroll
        for (int it = 0; it < 4; ++it) { float x[8], gg[8]; unpack8(wo[it], x); unpack8(wg[it], gg);
            float ss = 0.f;
#pragma unroll
            for (int i = 0; i < 8; ++i) ss += x[i] * x[i];
            ss += sx<1>(ss); ss += sx<2>(ss); ss += sx<4>(ss); ss += sx<8>(ss);
            const float rstd = rsqrtf(ss * (1.0f / 128.0f) + RMS_EPS);
            float y[8];
#pragma unroll
            for (int i = 0; i < 8; ++i) { const float gi = (i < 4) ? g0[i] : g1[i - 4]; y[i] = x[i] * rstd * gi * (gg[i] * __builtin_amdgcn_rcpf(1.0f + __expf(-gg[i]))); }
            v4u o; o.x = pk2(y[0], y[1]); o.y = pk2(y[2], y[3]); o.z = pk2(y[4], y[5]); o.w = pk2(y[6], y[7]);
            ((GAS v4u*)(OBO + (size_t)row * DM) + F.lane)[64 * it] = o; }
    }
}
__device__ __forceinline__ bool ph_refresh(Frame& F) { unsigned m = ~0u; asm volatile("" : "+s"(m));
    const int t = (F.wave << 6) | (int)__builtin_amdgcn_mbcnt_hi(m, __builtin_amdgcn_mbcnt_lo(m, 0u));
    F.tid = t; F.lane = t & 63; return true; }
__global__ void __launch_bounds__(NWAVES * 64, 2) trunk_fwd(Args args) {
    extern __shared__ __attribute__((aligned(16))) unsigned char lds[];
    Frame F;
    F.lds = (LAS unsigned char*)lds;
    F.MISC = (volatile LAS unsigned*)(F.lds + MISC_OFF);
    F.tid = threadIdx.x; F.lane = F.tid & 63; F.wave = __builtin_amdgcn_readfirstlane(F.tid >> 6);
    F.G = gridDim.x; { const int bx = blockIdx.x; F.vcu = (F.G % 8 == 0) ? (bx % 8) * (F.G / 8) + bx / 8 : bx; }
    F.ws = args.ws; F.ctl = (gu32*)(args.ws + WS_CTL); F.out = args.out;
    F.a = &args;
    for (int u = F.tid; u < (LDS_BYTES - LDSCTL_OFF) / 4; u += NWAVES * 64) ((LAS unsigned*)(F.lds + LDSCTL_OFF))[u] = 0u;
    __syncthreads();
    XcdBarrier bar; bar.bar = (unsigned*)(F.ctl + CW_BAR); bar.x = 0; bar.st = nullptr;
    if (!MK_PER_PHASE) bar = xcd_barrier_post((unsigned*)(F.ctl + CW_BAR), F.MISC + 8);
    const int lo = args.ph_lo, hi = args.ph_hi;
    int pc = 0;
    unsigned long long t_ph = PROBE_ECHO ? __builtin_amdgcn_s_memrealtime() : 0ull;
#define PH_ON (pc >= lo && pc < hi && ph_refresh(F))
#define PH_END_C(cls) do { if (!MK_PER_PHASE && pc >= lo && pc + 1 < hi) { const unsigned long long ta_ = (PROBE_IDLE && (PROBE_IDLE == 100 || PROBE_IDLE == (cls))) ? __builtin_amdgcn_s_memrealtime() : 0ull; xcd_barrier(bar); if (PROBE_MASK & 32) xcd_barrier(bar); \
        if (PROBE_IDLE && (PROBE_IDLE == 100 || PROBE_IDLE == (cls))) { const unsigned long long t1_ = __builtin_amdgcn_s_memrealtime(), d_ = t1_ - ta_; while (__builtin_amdgcn_s_memrealtime() - t1_ < d_) __builtin_amdgcn_s_sleep(8); xcd_barrier(bar); } \
        if (PROBE_ECHO == (cls)) { const unsigned long long t1_ = __builtin_amdgcn_s_memrealtime(), d_ = t1_ - t_ph; while (__builtin_amdgcn_s_memrealtime() - t1_ < d_) __builtin_amdgcn_s_sleep(8); xcd_barrier(bar); } \
        if (PROBE_ECHO) t_ph = __builtin_amdgcn_s_memrealtime(); } ++pc; } while (0)
#define PH_END PH_END_C(0)
    float* mod = (float*)(F.ws + WS_MOD);
    bf16* XN = (bf16*)(F.ws + WS_XN); bf16* BIG = (bf16*)(F.ws + WS_BIG); bf16* OB = (bf16*)(F.ws + WS_OB);
    float* RSS = (float*)(F.ws + WS_RSS); const float* CB = (const float*)(F.ws + WS_CB);
    if (PH_ON) { p0_mod(F); __syncthreads(); p0_convert(F); }
#if PROBE_MASK & 16
    if (PH_ON) { __syncthreads(); p0_mod(F); __syncthreads(); p0_convert(F); }
#endif
    PH_END_C(1);
    if (PH_ON) { tables_phase(F); bias_phase(F); xs0_phase(F, F.a->in[0], F.a->in[4], mod); }
#if PROBE_MASK & 16384
    if (PH_ON) { tables_phase(F); bias_phase(F); xs0_phase(F, F.a->in[0], F.a->in[4], mod); }
#endif
    PH_END_C(2);
#pragma unroll 1
    for (int L = 0; L < NLAYER; ++L) {
        const int kind = L % 3, slot = L / 3;
        const float* modL = mod + (size_t)L * NB * NMOD;
#pragma unroll 1
        for (int sub = 0; sub < 3; ++sub) {
            const int s = 3 * L + sub;
            const float* rss = RSS + (size_t)s * MT; const float* cb = CB + (size_t)s * NB * CB_LD;
            const bf16* outA; const bf16* outB; int outK;
            const int nhalf = (sub != 1) ? FFN_SPLIT : 1;
#pragma unroll 1
            for (int hf = 0; hf < nhalf; ++hf) {
            const int Mpart = MT / nhalf, pm_off = hf * (Mpart / 256);
            if (sub != 1) {
                const int ls = L * 2 + (sub >> 1);
                if (PH_ON) { pg8::Gemm g{XN, (const bf16*)(F.ws + WS_WGU) + (size_t)ls * 2 * FF * DM, Mpart, 2 * FF, DM, 1, 1}; pg8::StaticOrder S; S.init(Mpart, 2 * FF, F.G, (int)blockIdx.x, GU_WGM, pm_off);
                    pg8::EpiSwigluN E{BIG, FF, rss, cb, CB_LD, SEQ, F.lds + PRE_OFF};
#pragma unroll 1
                    for (int rep = 0; rep < ((PROBE_MASK & 1) ? 2 : 1); ++rep) { if (rep) __syncthreads(); pg8::gemm_phase<pg8::EpiSwigluN, pg8::StaticOrder, true, true>(F.lds + RING_OFF, g, S, E, F.tid); }
                    }
                PH_END_C(3);
                outA = BIG; outB = (const bf16*)(F.ws + WS_WD) + (size_t)ls * DM * FF; outK = FF;
            } else {
                const int nin = (kind == 2) ? 4 * DM : 3 * DM;
                const bf16* win = (kind == 0) ? (const bf16*)(F.ws + WS_WAI) + (size_t)slot * 3 * DM * DM : (kind == 1) ? (const bf16*)(F.ws + WS_WCI) : (const bf16*)(F.ws + WS_WHI);
                if (PH_ON) { pg8::Gemm g{XN, win, MT, nin, DM, 1, 1}; pg8::StaticOrder S; S.init(MT, nin, F.G, (int)blockIdx.x, GU_WGM);
                    pg8::EpiInN E{BIG, nin, rss, cb, CB_LD, SEQ, (kind == 0) ? 16 : 0, F.a->in[10] + (size_t)slot * 64, F.a->in[11] + (size_t)slot * 64, F.lds + PRE_OFF};
#pragma unroll 1
                    for (int rep = 0; rep < ((PROBE_MASK & 4) ? 2 : 1); ++rep) { if (rep) __syncthreads(); pg8::gemm_phase<pg8::EpiInN, pg8::StaticOrder, true, true>(F.lds + RING_OFF, g, S, E, F.tid); }
                    }
                PH_END_C(5);
                if (kind == 0) {
#if PROBE_MASK & 8192
                    if (PH_ON) { attn_phase(F, L, slot, 1); __syncthreads(); }
#endif
                    if (PH_ON) attn_phase(F, L, slot);
                    PH_END_C(7);
                } else if (kind == 1) {
                    if (PH_ON) conv_phase(F);
                    PH_END_C(8);
                } else {
#if PROBE_MASK & 64
                    if (PH_ON) { hgrn_prep_phase(F, L, XN, DM, XN); __syncthreads(); }
#endif
                    if (PH_ON) hgrn_prep_phase(F, L, BIG, 8192, OB);
                    PH_END_C(9);
#if PROBE_MASK & 128
                    if (PH_ON) { hgrn_scan_phase(F, XN); __syncthreads(); }
#endif
                    if (PH_ON) hgrn_scan_phase(F, OB);
                    PH_END_C(10);
                    if (PH_ON) hgrn_final_phase(F, OB);
                    PH_END_C(11);
                }
                outA = OB; outB = (kind == 0) ? (const bf16*)(F.ws + WS_WAO) + (size_t)slot * DM * DM : (kind == 1) ? (const bf16*)(F.ws + WS_WCO) : (const bf16*)(F.ws + WS_WHO); outK = DM;
            }
            if (PH_ON) { pg8::Gemm g{outA, outB, Mpart, DM, outK, (sub != 1) ? 1 : 0, 1};     pg8::StaticOrder S; S.init(Mpart, DM, F.G, (int)blockIdx.x, OUT_WGM, pm_off);
                const int sn = s + 1; const bool last = (s == 3 * NLAYER - 1);
                const float* TAB = (const float*)(F.ws + WS_TAB);
                pg8::EpiResN E{(s == 0) ? (const void*)F.a->in[0] : (const void*)(F.ws + WS_XH), last ? (void*)F.out : (void*)(F.ws + WS_XH), (s == 0) ? 1 : 0, last ? 1 : 0, DM, TAB + (size_t)(s * 2 + 0) * NB * DM, TAB + (size_t)(s * 2 + 1) * NB * DM, DM, SEQ, last ? (bf16*)nullptr : XN, RSS + (size_t)sn * MT, F.lds + PRE_OFF, 1.0f};
#pragma unroll 1
                for (int rep = (((PROBE_MASK & 2) || ((PROBE_MASK & 2048) && sub != 1) || ((PROBE_MASK & 4096) && sub == 1)) ? 0 : 1); rep < 2; ++rep) {
                    pg8::EpiResN E2 = E;
#if PROBE_MASK & (2 | 2048 | 4096)
                    { const bool dbl = (PROBE_MASK & 2) || ((PROBE_MASK & 2048) && sub != 1) || ((PROBE_MASK & 4096) && sub == 1);
                      if (dbl) { E2.gscale = 0.5f; if (rep == 0) { E2.rssn = RSS + (size_t)12 * MT; if (last) { E2.out = (void*)(F.ws + WS_XH); E2.out_f32 = 0; } } else if (s == 0) { E2.base = (const void*)(F.ws + WS_XH); E2.base_f32 = 0; } } }
#endif
                    if (rep == 0) __syncthreads();
                    pg8::gemm_phase<pg8::EpiResN, pg8::StaticOrder, true, true, OUT_A_AUX>(F.lds + RING_OFF, g, S, E2, F.tid); if (rep == 0) __syncthreads(); } }
            PH_END_C((sub != 1) ? 4 : 6);
            }
        }
    }
#undef PH_ON
#undef PH_END
#undef PH_END_C
}
extern "C" void kernel_launch(void* const* d_in, const int* in_sizes, int n_in, void* d_out, int out_size, void* d_ws, size_t ws_size, hipStream_t stream) {
    static int grid = 0;
    if (grid == 0) {
        if (n_in != 21 || in_sizes[0] != MT * DM || out_size != MT * DM || ws_size < WS_END) { fprintf(stderr, "kernel_launch: shape/workspace mismatch (n_in %d, in0 %d, out %d, ws %zu, need %zu); nothing launched\n", n_in, n_in > 0 ? in_sizes[0] : -1, out_size, ws_size, (size_t)WS_END); grid = -1; return; }
        int dev = 0, cus = 0, per_cu = 0;
        if (hipGetDevice(&dev) != hipSuccess || hipDeviceGetAttribute(&cus, hipDeviceAttributeMultiprocessorCount, dev) != hipSuccess) { fprintf(stderr, "kernel_launch: device query failed\n"); grid = -1; return; }
        if (hipFuncSetAttribute((const void*)trunk_fwd, hipFuncAttributeMaxDynamicSharedMemorySize, LDS_BYTES) != hipSuccess) { fprintf(stderr, "kernel_launch: hipFuncSetAttribute failed\n"); grid = -1; return; }
        if (hipOccupancyMaxActiveBlocksPerMultiprocessor(&per_cu, (const void*)trunk_fwd, NWAVES * 64, LDS_BYTES) != hipSuccess || per_cu < 1) fprintf(stderr, "kernel_launch: note: occupancy query reports %d workgroups per CU\n", per_cu);
        (void)hipGetLastError();
        grid = cus;
    }
    if (grid < 0) return;
    if (hipMemsetAsync((char*)d_ws + WS_CTL, 0, CTL_ZERO_BYTES, stream) != hipSuccess) { fprintf(stderr, "kernel_launch: memset failed\n"); return; }
    Args a{};
    for (int i = 0; i < 21; ++i) a.in[i] = (const float*)d_in[i];
    a.out = (float*)d_out; a.ws = (unsigned char*)d_ws;
#if MK_PER_PHASE
    for (int p = 0; p < N_PHASES; ++p) { a.ph_lo = p; a.ph_hi = p + 1; hipLaunchKernelGGL(trunk_fwd, dim3(grid), dim3(NWAVES * 64), LDS_BYTES, stream, a); }
#else
    a.ph_lo = 0; a.ph_hi = N_PHASES;
    hipLaunchKernelGGL(trunk_fwd, dim3(grid), dim3(NWAVES * 64), LDS_BYTES, stream, a);
#endif
    const hipError_t le = hipPeekAtLastError();
    if (le != hipSuccess) fprintf(stderr, "kernel_launch: launch failed: %s\n", hipGetErrorName(le));
}
```

```cpp
#include <hip/hip_runtime.h>
#include <cstdio>
#include <cstdint>
template <int X> __device__ __forceinline__ float sx(float v) { return __int_as_float(__builtin_amdgcn_ds_swizzle(__float_as_int(v), (X << 10) | 0x1f)); }
__device__ __forceinline__ float sum32(float v) { auto rr = __builtin_amdgcn_permlane32_swap(__float_as_uint(v), __float_as_uint(v), false, false); return __uint_as_float(rr[0]) + __uint_as_float(rr[1]); }
__device__ __forceinline__ float max32(float v) { auto rr = __builtin_amdgcn_permlane32_swap(__float_as_uint(v), __float_as_uint(v), false, false); return fmaxf(__uint_as_float(rr[0]), __uint_as_float(rr[1])); }
__device__ __forceinline__ float wave_sum(float v) { v += sx<1>(v); v += sx<2>(v); v += sx<4>(v); v += sx<8>(v); v += sx<16>(v); return sum32(v); }
__device__ __forceinline__ float wave_max(float v) { v = fmaxf(v, sx<1>(v)); v = fmaxf(v, sx<2>(v)); v = fmaxf(v, sx<4>(v)); v = fmaxf(v, sx<8>(v)); v = fmaxf(v, sx<16>(v)); return max32(v); }
typedef float f32x2_cv __attribute__((ext_vector_type(2))); typedef __bf16 bf16x2_cv __attribute__((ext_vector_type(2)));
__device__ __forceinline__ unsigned pk2(float lo, float hi) { const f32x2_cv v = {lo, hi}; const bf16x2_cv b = __builtin_convertvector(v, bf16x2_cv); return __builtin_bit_cast(unsigned, b); }
__device__ __forceinline__ unsigned f2bf(float f) { return pk2(f, 0.f) & 0xffffu; }
namespace pg8 {
#define PG8_LAS __attribute__((address_space(3)))
typedef unsigned short bf16_t;
typedef short bf16x8 __attribute__((ext_vector_type(8)));
typedef float f32x4 __attribute__((ext_vector_type(4)));
typedef unsigned u32x4 __attribute__((ext_vector_type(4)));
constexpr int BM = 256, BK = 64, HALF = 128, HTB = HALF * BK * 2  , STAGE_BYTES = 8 * HTB, NXCD = 8, WGM = 8;

__host__ __device__ __forceinline__ int lds_byte(int r, int c) { const int st = (r >> 4) * 2 + (c >> 5), rr = r & 15, cc = c & 31, ob = rr * 64 + cc * 2; return st * 1024 + (ob ^ (((ob >> 9) & 1) << 5)); }
__host__ __device__ __forceinline__ void stage_rc(int b, int& R, int& C) { const int st = b / 1024, sb = b % 1024, swz = sb ^ (((sb >> 9) & 1) << 5); R = (st >> 1) * 16 + swz / 64; C = (st & 1) * 32 + (swz % 64) / 2; }
__host__ __device__ __forceinline__ int perm32(int rho) { const int n = rho >> 4, i = rho & 15; return 8 * (i >> 2) + 4 * n + (i & 3); }

struct Unit { int pm, pn; };
struct Gemm { const bf16_t* A; const bf16_t* Bt; int M, N, K; int a_tiled = 0, b_tiled = 0; };

struct StaticOrder {
    int nM, nN, nwg, G, c, wgm, pm_off;
    __host__ __device__ void init(int M, int N, int G_, int c_, int wgm_ = WGM, int pm_off_ = 0) { nM = M / BM; nN = N / BM; nwg = nM * nN; G = G_; c = c_; wgm = wgm_; pm_off = pm_off_; }
    __host__ __device__ bool next(int i, Unit& u) const {
        const long L = (long)i * G + c; if (L >= nwg) return false;
        int wgid = (int)L; { const int q = nwg / NXCD, r = nwg % NXCD, xcd = wgid % NXCD, off = wgid / NXCD; wgid = (xcd < r ? xcd * (q + 1) : r * (q + 1) + (xcd - r) * q) + off; }
        const int nig = wgm * nN, gid = wgid / nig, fm = gid * wgm, gsz = (nM - fm) < wgm ? (nM - fm) : wgm;
        u.pm = pm_off + fm + ((wgid % nig) % gsz); u.pn = (wgid % nig) / gsz; return true;
    }
    __device__ __forceinline__ void a_ready(const Unit&) const {}
    __device__ __forceinline__ void done(const Unit&) const {}
};

__device__ __forceinline__ unsigned cvt_pk_bf16(float lo, float hi) { unsigned r; asm volatile("v_cvt_pk_bf16_f32 %0, %1, %2" : "=v"(r) : "v"(lo), "v"(hi)); return r; }
typedef float f32x2 __attribute__((ext_vector_type(2)));
typedef unsigned u32x2 __attribute__((ext_vector_type(2)));
struct EpiStore {
    static constexpr bool HAS_PRE = false;
    static constexpr bool PERM = true, AFTER_DRAIN = false;
    bf16_t* O; int ldc;
    __device__ __forceinline__ void operator()(const f32x4 (&acc)[2][2][4][2], const Unit& u, int wr, int wc, int fr, int fq) const {
        const int row0 = u.pm * BM + wr * 64 + fr, col0 = u.pn * BM + wc * 32 + 8 * fq;
#pragma unroll
        for (int ai = 0; ai < 2; ++ai)
#pragma unroll
            for (int m = 0; m < 4; ++m) { bf16_t* rowp = O + (size_t)(row0 + ai * HALF + m * 16) * ldc + col0;
#pragma unroll
                for (int bj = 0; bj < 2; ++bj) { const f32x4 v0 = acc[ai][bj][m][0], v1 = acc[ai][bj][m][1];
                    u32x4 w; w.x = cvt_pk_bf16(v0[0], v0[1]); w.y = cvt_pk_bf16(v0[2], v0[3]); w.z = cvt_pk_bf16(v1[0], v1[1]); w.w = cvt_pk_bf16(v1[2], v1[3]);
                    *(u32x4*)(rowp + bj * HALF) = w; } }
    }
};
__device__ __forceinline__ float swiglu1(float g, float u) { const float e = __builtin_amdgcn_exp2f(g * -1.4426950408889634f); return g * u * __builtin_amdgcn_rcpf(1.0f + e); }
struct EpiSwiglu {
    static constexpr bool HAS_PRE = false;
    static constexpr bool PERM = true, AFTER_DRAIN = false;
    bf16_t* O; int ldc;
    __device__ __forceinline__ void operator()(const f32x4 (&acc)[2][2][4][2], const Unit& u, int wr, int wc, int fr, int fq) const {
        const int row0 = u.pm * BM + wr * 64 + fr, col0 = u.pn * HALF + wc * 32 + 8 * fq;
#pragma unroll
        for (int ai = 0; ai < 2; ++ai)
#pragma unroll
            for (int m = 0; m < 4; ++m) { bf16_t* rowp = O + (size_t)(row0 + ai * HALF + m * 16) * ldc + col0;
                const f32x4 g0 = acc[ai][0][m][0], g1 = acc[ai][0][m][1], u0 = acc[ai][1][m][0], u1 = acc[ai][1][m][1];
                u32x4 w;
                w.x = cvt_pk_bf16(swiglu1(g0[0], u0[0]), swiglu1(g0[1], u0[1])); w.y = cvt_pk_bf16(swiglu1(g0[2], u0[2]), swiglu1(g0[3], u0[3]));
                w.z = cvt_pk_bf16(swiglu1(g1[0], u1[0]), swiglu1(g1[1], u1[1])); w.w = cvt_pk_bf16(swiglu1(g1[2], u1[2]), swiglu1(g1[3], u1[3]));
                *(u32x4*)rowp = w; }
    }
};
struct EpiRes {
    static constexpr bool HAS_PRE = false;
    static constexpr bool PERM = false, AFTER_DRAIN = false;
    const float* base; float* out; int ldc; const float* gate; int gstride; float coef; int rows_per_batch;
    __device__ __forceinline__ void operator()(const f32x4 (&acc)[2][2][4][2], const Unit& u, int wr, int wc, int fr, int fq) const {
        const int row0 = u.pm * BM + wr * 64 + fr, col0 = u.pn * BM + wc * 32 + 4 * fq;
        const float* gp = gate + (size_t)((u.pm * BM) / rows_per_batch) * gstride + col0;
        f32x4 gv[2][2];
#pragma unroll
        for (int bj = 0; bj < 2; ++bj)
#pragma unroll
            for (int n = 0; n < 2; ++n) gv[bj][n] = *(const f32x4*)(gp + bj * HALF + n * 16) * coef;
#pragma unroll
        for (int ai = 0; ai < 2; ++ai)
#pragma unroll
            for (int m = 0; m < 4; ++m) { const size_t off = (size_t)(row0 + ai * HALF + m * 16) * ldc + col0;
#pragma unroll
                for (int bj = 0; bj < 2; ++bj)
#pragma unroll
                    for (int n = 0; n < 2; ++n) { const f32x4 bs = *(const f32x4*)(base + off + bj * HALF + n * 16); *(f32x4*)(out + off + bj * HALF + n * 16) = bs + gv[bj][n] * acc[ai][bj][m][n]; }
                if (m & 1) asm volatile("" ::: "memory"); }
    }
};
__device__ __forceinline__ float rstd_of(const float* rss, int row) { return rsqrtf(rss[row] * (1.0f / 2048.0f) + 1e-6f); }
struct EpiSwigluN {
    static constexpr bool HAS_PRE = true;
    static constexpr bool PERM = true, AFTER_DRAIN = false;
    bf16_t* O; int ldc; const float* rss; const float* cb; int cbstride; int rows_per_batch; PG8_LAS unsigned char* pre_lds;
    __device__ __forceinline__ void pre(const Unit& u, int lane) const {
        __builtin_amdgcn_global_load_lds((const unsigned*)(cb + (size_t)((u.pm * BM) / rows_per_batch) * cbstride + u.pn * BM + 4 * lane), (PG8_LAS unsigned*)pre_lds, 16, 0, 0);
        __builtin_amdgcn_global_load_lds((const unsigned*)(rss + u.pm * BM + 4 * lane), (PG8_LAS unsigned*)(pre_lds + 1024), 16, 0, 0); }
    __device__ __forceinline__ void operator()(const f32x4 (&acc)[2][2][4][2], const Unit& u, int wr, int wc, int fr, int fq) const {
        const int col0 = u.pn * HALF + wc * 32 + 8 * fq;
        const PG8_LAS float* cbp = (const PG8_LAS float*)pre_lds + wc * 32 + 8 * fq; const PG8_LAS float* rp = (const PG8_LAS float*)(pre_lds + 1024) + wr * 64 + fr;
        const f32x4 cg0 = *(const PG8_LAS f32x4*)(cbp), cg1 = *(const PG8_LAS f32x4*)(cbp + 4), cu0 = *(const PG8_LAS f32x4*)(cbp + HALF), cu1 = *(const PG8_LAS f32x4*)(cbp + HALF + 4);
#pragma unroll
        for (int ai = 0; ai < 2; ++ai)
#pragma unroll
            for (int m = 0; m < 4; ++m) { const float rs = rsqrtf(rp[ai * HALF + m * 16] * (1.0f / 2048.0f) + 1e-6f);
                bf16_t* rowp = O + ((size_t)(u.pm * (ldc >> 6) + (col0 >> 6)) * BM + (wr * 64 + fr + ai * HALF + m * 16)) * 64 + (col0 & 63);
                const f32x4 g0 = acc[ai][0][m][0] * rs + cg0, g1 = acc[ai][0][m][1] * rs + cg1, u0 = acc[ai][1][m][0] * rs + cu0, u1 = acc[ai][1][m][1] * rs + cu1;
                u32x4 w;
                w.x = pk2(swiglu1(g0[0], u0[0]), swiglu1(g0[1], u0[1])); w.y = pk2(swiglu1(g0[2], u0[2]), swiglu1(g0[3], u0[3]));
                w.z = pk2(swiglu1(g1[0], u1[0]), swiglu1(g1[1], u1[1])); w.w = pk2(swiglu1(g1[2], u1[2]), swiglu1(g1[3], u1[3]));
                __builtin_nontemporal_store(w, (u32x4*)rowp); }
    }
};
struct EpiInN {
    static constexpr bool HAS_PRE = true;
    static constexpr bool PERM = true, AFTER_DRAIN = false;
    bf16_t* O; int ldc; const float* rss; const float* cb; int cbstride; int rows_per_batch; int nqk; const float* gq; const float* gk; PG8_LAS unsigned char* pre_lds;
    __device__ __forceinline__ void pre(const Unit& u, int lane) const {
        __builtin_amdgcn_global_load_lds((const unsigned*)(cb + (size_t)((u.pm * BM) / rows_per_batch) * cbstride + u.pn * BM + 4 * lane), (PG8_LAS unsigned*)pre_lds, 16, 0, 0);
        __builtin_amdgcn_global_load_lds((const unsigned*)(rss + u.pm * BM + 4 * lane), (PG8_LAS unsigned*)(pre_lds + 1024), 16, 0, 0); }
    __device__ __forceinline__ void operator()(const f32x4 (&acc)[2][2][4][2], const Unit& u, int wr, int wc, int fr, int fq) const {
        const int row0 = u.pm * BM + wr * 64 + fr, pc0 = u.pn * BM + wc * 32 + 8 * fq;
        const PG8_LAS float* cbp = (const PG8_LAS float*)pre_lds + wc * 32 + 8 * fq; const PG8_LAS float* rp = (const PG8_LAS float*)(pre_lds + 1024) + wr * 64 + fr;
        f32x4 cv[2][2];
#pragma unroll
        for (int bj = 0; bj < 2; ++bj)
#pragma unroll
            for (int n = 0; n < 2; ++n) cv[bj][n] = *(const PG8_LAS f32x4*)(cbp + bj * HALF + 4 * n);
        if (u.pn < nqk) {
            const bool isq = u.pn < (nqk >> 1); const float* gp = (isq ? gq : gk) + 8 * fq; const float gs = isq ? 0.125f * 1.4426950408889634f : 1.0f;
            f32x4 gv[2][2];
#pragma unroll
            for (int bj = 0; bj < 2; ++bj)
#pragma unroll
                for (int n = 0; n < 2; ++n) gv[bj][n] = *(const f32x4*)(gp + 32 * bj + 4 * n) * gs;
            const int lc0 = u.pn * BM + wc * 64 + 8 * fq;
#pragma unroll
            for (int ai = 0; ai < 2; ++ai)
#pragma unroll
                for (int m = 0; m < 4; ++m) { const int row = row0 + ai * HALF + m * 16; const float rs = rsqrtf(rp[ai * HALF + m * 16] * (1.0f / 2048.0f) + 1e-6f); bf16_t* rowp = O + (size_t)row * ldc + lc0;
                    f32x4 v[2][2]; float ss = 0.f;
#pragma unroll
                    for (int bj = 0; bj < 2; ++bj)
#pragma unroll
                        for (int n = 0; n < 2; ++n) { v[bj][n] = acc[ai][bj][m][n] * rs + cv[bj][n]; ss += (v[bj][n][0] * v[bj][n][0] + v[bj][n][1] * v[bj][n][1]) + (v[bj][n][2] * v[bj][n][2] + v[bj][n][3] * v[bj][n][3]); }
                    ss += sx<16>(ss); ss = sum32(ss);
                    const float rg = rsqrtf(ss * (1.0f / 64.0f) + 1e-6f);
#pragma unroll
                    for (int bj = 0; bj < 2; ++bj) { const f32x4 v0 = v[bj][0] * rg * gv[bj][0], v1 = v[bj][1] * rg * gv[bj][1];
                        u32x4 w; w.x = pk2(v0[0], v0[1]); w.y = pk2(v0[2], v0[3]); w.z = pk2(v1[0], v1[1]); w.w = pk2(v1[2], v1[3]);
                        if (isq) __builtin_nontemporal_store(w, (u32x4*)(rowp + 32 * bj)); else *(u32x4*)(rowp + 32 * bj) = w; } }
        } else {
#pragma unroll
            for (int ai = 0; ai < 2; ++ai)
#pragma unroll
                for (int m = 0; m < 4; ++m) { const int row = row0 + ai * HALF + m * 16; const float rs = rsqrtf(rp[ai * HALF + m * 16] * (1.0f / 2048.0f) + 1e-6f); bf16_t* rowp = O + (size_t)row * ldc + pc0;
#pragma unroll
                    for (int bj = 0; bj < 2; ++bj) { const f32x4 v0 = acc[ai][bj][m][0] * rs + cv[bj][0], v1 = acc[ai][bj][m][1] * rs + cv[bj][1];
                        u32x4 w; w.x = pk2(v0[0], v0[1]); w.y = pk2(v0[2], v0[3]); w.z = pk2(v1[0], v1[1]); w.w = pk2(v1[2], v1[3]);
                        *(u32x4*)(rowp + bj * HALF) = w; } }
        }
    }
};
typedef _Float16 f16x4 __attribute__((ext_vector_type(4)));
struct EpiResN {
    static constexpr bool HAS_PRE = true;
    static constexpr bool PERM = false, AFTER_DRAIN = false;
    const void* base; void* out; int base_f32, out_f32;
    int ldc; const float* gvt; const float* ant; int tstride; int rows_per_batch;
    bf16_t* xs; float* rssn; PG8_LAS unsigned char* pre_lds;
    float gscale;
    __device__ __forceinline__ void pre(const Unit& u, int lane) const {
        const size_t o = (size_t)((u.pm * BM) / rows_per_batch) * tstride + u.pn * BM + 4 * lane;
        __builtin_amdgcn_global_load_lds((const unsigned*)(gvt + o), (PG8_LAS unsigned*)pre_lds, 16, 0, 0);
        __builtin_amdgcn_global_load_lds((const unsigned*)(ant + o), (PG8_LAS unsigned*)(pre_lds + 1024), 16, 0, 0); }
    __device__ __forceinline__ void operator()(const f32x4 (&acc)[2][2][4][2], const Unit& u, int wr, int wc, int fr, int fq) const {
        const int col0 = u.pn * BM + wc * 32 + 4 * fq;
        const PG8_LAS float* gp = (const PG8_LAS float*)pre_lds + wc * 32 + 4 * fq;
        f32x4 gv[2][2], an[2][2];
#pragma unroll
        for (int bj = 0; bj < 2; ++bj)
#pragma unroll
            for (int n = 0; n < 2; ++n) { gv[bj][n] = *(const PG8_LAS f32x4*)(gp + bj * HALF + n * 16) * gscale; an[bj][n] = *(const PG8_LAS f32x4*)(gp + 256 + bj * HALF + n * 16); }
        if (base_f32) {
#pragma unroll
            for (int ai = 0; ai < 2; ++ai)
#pragma unroll
                for (int m = 0; m < 4; ++m) { const int rr = wr * 64 + fr + ai * HALF + m * 16; const unsigned off = (unsigned)((u.pm * BM + rr) * ldc + col0); float ss = 0.f;
                    const unsigned xso = ((unsigned)(u.pm * (ldc >> 6) + 4 * u.pn) * BM + rr) * 64u + 4u * fq;
#pragma unroll
                    for (int bj = 0; bj < 2; ++bj)
#pragma unroll
                        for (int n = 0; n < 2; ++n) { const unsigned o2 = off + bj * HALF + n * 16;
                            const f32x4 xn = *(const f32x4*)((const char*)base + 4u * o2) + gv[bj][n] * acc[ai][bj][m][n];
                            *(f16x4*)((char*)out + 2u * o2) = __builtin_convertvector(xn, f16x4);
                            ss += (xn[0] * xn[0] + xn[1] * xn[1]) + (xn[2] * xn[2] + xn[3] * xn[3]); const f32x4 h = xn * an[bj][n];
                            u32x2 w; w.x = pk2(h[0], h[1]); w.y = pk2(h[2], h[3]); *(u32x2*)((char*)xs + 2u * (xso + (unsigned)(2 * bj + (wc >> 1)) * (BM * 64) + (wc & 1) * 32 + n * 16)) = w; }
                    ss += sx<16>(ss); ss = sum32(ss); if (fq == 0) __hip_atomic_fetch_add(rssn + (u.pm * BM + rr), ss, __ATOMIC_RELAXED, __HIP_MEMORY_SCOPE_AGENT);
                    if (m & 1) asm volatile("" ::: "memory"); }
        } else {
            f16x4 bsv[2][4][2][2];
#pragma unroll
            for (int ai = 0; ai < 2; ++ai)
#pragma unroll
                for (int m = 0; m < 4; ++m)
#pragma unroll
                    for (int bj = 0; bj < 2; ++bj)
#pragma unroll
                        for (int n = 0; n < 2; ++n) bsv[ai][m][bj][n] = *(const f16x4*)((const char*)base + 2u * (unsigned)((u.pm * BM + wr * 64 + fr + ai * HALF + m * 16) * ldc + col0 + bj * HALF + n * 16));
            asm volatile("" ::: "memory");
#pragma unroll
            for (int ai = 0; ai < 2; ++ai) {
#pragma unroll
                for (int m = 0; m < 4; ++m) { const int rr = wr * 64 + fr + ai * HALF + m * 16; const unsigned off = (unsigned)((u.pm * BM + rr) * ldc + col0); float ss = 0.f;
                    const unsigned xso = ((unsigned)(u.pm * (ldc >> 6) + 4 * u.pn) * BM + rr) * 64u + 4u * fq;
#pragma unroll
                    for (int bj = 0; bj < 2; ++bj)
#pragma unroll
                        for (int n = 0; n < 2; ++n) { const unsigned o2 = off + bj * HALF + n * 16;
                            const f32x4 xn = __builtin_convertvector(bsv[ai][m][bj][n], f32x4) + gv[bj][n] * acc[ai][bj][m][n];
                            if (out_f32) *(f32x4*)((char*)out + 4u * o2) = xn; else *(f16x4*)((char*)out + 2u * o2) = __builtin_convertvector(xn, f16x4);
                            if (xs) { ss += (xn[0] * xn[0] + xn[1] * xn[1]) + (xn[2] * xn[2] + xn[3] * xn[3]); const f32x4 h = xn * *(const PG8_LAS f32x4*)(gp + 256 + bj * HALF + n * 16);
                                u32x2 w; w.x = pk2(h[0], h[1]); w.y = pk2(h[2], h[3]); *(u32x2*)((char*)xs + 2u * (xso + (unsigned)(2 * bj + (wc >> 1)) * (BM * 64) + (wc & 1) * 32 + n * 16)) = w; } }
                    if (xs) { ss += sx<16>(ss); ss = sum32(ss); if (fq == 0) __hip_atomic_fetch_add(rssn + (u.pm * BM + rr), ss, __ATOMIC_RELAXED, __HIP_MEMORY_SCOPE_AGENT); } }
                asm volatile("" ::: "memory"); }
        }
    }
};
template <class Epi, class Sched, bool ALIGN_EPI = false, bool SP2 = false, int A_AUX = 0>
__device__ __forceinline__ void gemm_phase(PG8_LAS unsigned char* lds, const Gemm g, const Sched& S, const Epi& E, int tid_in) {
    int tid_o = tid_in; asm volatile("" : "+v"(tid_o));
    const int tid = tid_o, wid = __builtin_amdgcn_readfirstlane(tid >> 6), lane = tid & 63, wr = wid >> 2, wc = wid & 3, fr = lane & 15, fq = lane >> 4;
    const int K = g.K, nt = K / BK;
    unsigned voffA[2], voffB[2];
#pragma unroll
    for (int i = 0; i < 2; ++i) { int R, C; stage_rc(tid * 16 + i * 8192, R, C); const int Rb = Epi::PERM ? ((R & ~31) + perm32(R & 31)) : R;
        voffA[i] = (unsigned)(R * (g.a_tiled ? BK : K) + C) * 2u; voffB[i] = (unsigned)(Rb * (g.b_tiled ? BK : K) + C) * 2u; }
    const size_t kstepA = g.a_tiled ? (size_t)(BM * BK * 2) : (size_t)(BK * 2), kstepB = g.b_tiled ? (size_t)(BM * BK * 2) : (size_t)(BK * 2);
    const size_t hstepA = g.a_tiled ? (size_t)(HALF * BK * 2) : (size_t)HALF * K * 2, hstepB = g.b_tiled ? (size_t)(HALF * BK * 2) : (size_t)HALF * K * 2;
    const size_t tstepA = (size_t)BM * K * 2, tstepB = tstepA;
    const unsigned ldsw = (unsigned)wid * 1024u;
    const int aoff = lds_byte(wr * 64 + fr, fq * 8), boff = lds_byte(wc * 32 + fr, fq * 8);
#define PG8_SA(b, h) (((b) * 2 + (h)) * HTB)
#define PG8_SB(b, h) ((4 + (b) * 2 + (h)) * HTB)
#define PG8_STAGE(bufoff, gbase, voff) do { _Pragma("unroll") for (int _i = 0; _i < 2; ++_i) \
        __builtin_amdgcn_global_load_lds((const unsigned*)((const char*)(gbase) + (voff)[_i]), (PG8_LAS unsigned*)(lds + (bufoff) + ldsw + _i * 8192), 16, 0, 0); } while (0)
#define PG8_STAGE_A(bufoff, gbase, voff) do { _Pragma("unroll") for (int _i = 0; _i < 2; ++_i) \
        __builtin_amdgcn_global_load_lds((const unsigned*)((const char*)(gbase) + (voff)[_i]), (PG8_LAS unsigned*)(lds + (bufoff) + ldsw + _i * 8192), 16, 0, A_AUX); } while (0)
#define PG8_LDA(dst, b, h) do { _Pragma("unroll") for (int m = 0; m < 4; ++m) _Pragma("unroll") for (int k = 0; k < 2; ++k) dst[m][k] = *(const PG8_LAS bf16x8*)(lds + PG8_SA(b, h) + aoff + m * 2048 + k * 1024); } while (0)
#define PG8_LDB(dst, b, h) do { _Pragma("unroll") for (int n = 0; n < 2; ++n) _Pragma("unroll") for (int k = 0; k < 2; ++k) dst[n][k] = *(const PG8_LAS bf16x8*)(lds + PG8_SB(b, h) + boff + n * 2048 + k * 1024); } while (0)
#define PG8_MMA(ai, bj, At, Bt) do { __builtin_amdgcn_s_setprio(1); _Pragma("unroll") for (int m = 0; m < 4; ++m) _Pragma("unroll") for (int n = 0; n < 2; ++n) _Pragma("unroll") for (int k = 0; k < 2; ++k) \
        acc[ai][bj][m][n] = __builtin_amdgcn_mfma_f32_16x16x32_bf16(Bt[n][k], At[m][k], acc[ai][bj][m][n], 0, 0, 0); __builtin_amdgcn_s_setprio(0); } while (0)
#define PG8_WAIT_V(n) asm volatile("s_waitcnt vmcnt(" #n ")" ::: "memory")
#define PG8_WAIT_L(n) asm volatile("s_waitcnt lgkmcnt(" #n ")" ::: "memory")
#define PG8_BAR __builtin_amdgcn_s_barrier()
#define PG8_SCHED __builtin_amdgcn_sched_barrier(0)
    Unit cur, nxt; int ui = 0;
    if (!S.next(0, cur)) return;
    f32x4 acc[2][2][4][2];
#pragma unroll
    for (int a = 0; a < 2; ++a)
#pragma unroll
        for (int b = 0; b < 2; ++b)
#pragma unroll
            for (int m = 0; m < 4; ++m)
#pragma unroll
                for (int n = 0; n < 2; ++n) acc[a][b][m][n] = (f32x4){0.f, 0.f, 0.f, 0.f};
    bf16x8 At[4][2], B0[2][2], B1[2][2];
    const char* cA = (const char*)g.A + (size_t)cur.pm * tstepA; const char* cB = (const char*)g.Bt + (size_t)cur.pn * tstepB;
    S.a_ready(cur);
    if constexpr (SP2) {
        PG8_STAGE(PG8_SB(0, 0), cB, voffB); PG8_STAGE(PG8_SB(0, 1), cB + hstepB, voffB); PG8_STAGE_A(PG8_SA(0, 0), cA, voffA); PG8_STAGE_A(PG8_SA(0, 1), cA + hstepA, voffA);
        if (wr == 1) PG8_BAR;
        PG8_WAIT_V(2); PG8_BAR;
        PG8_STAGE(PG8_SB(1, 0), cB + kstepB, voffB); PG8_STAGE_A(PG8_SA(1, 0), cA + kstepA, voffA); PG8_STAGE(PG8_SB(1, 1), cB + hstepB + kstepB, voffB);
        PG8_WAIT_V(6); PG8_BAR;
    } else {
        PG8_STAGE(PG8_SB(0, 0), cB, voffB); PG8_STAGE_A(PG8_SA(0, 0), cA, voffA); PG8_STAGE(PG8_SB(0, 1), cB + hstepB, voffB); PG8_STAGE_A(PG8_SA(0, 1), cA + hstepA, voffA);
        if (wr == 1) PG8_BAR;
        PG8_WAIT_V(4); PG8_BAR;
        PG8_STAGE(PG8_SB(1, 0), cB + kstepB, voffB); PG8_STAGE_A(PG8_SA(1, 0), cA + kstepA, voffA); PG8_STAGE(PG8_SB(1, 1), cB + hstepB + kstepB, voffB);
        PG8_WAIT_V(6); PG8_BAR;
    }
    for (;;) {
        const bool has_next = S.next(ui + 1, nxt);
        const char* nA = has_next ? (const char*)g.A + (size_t)nxt.pm * tstepA : cA; const char* nB = has_next ? (const char*)g.Bt + (size_t)nxt.pn * tstepB : cB;
        for (int t = 0; t < nt; t += 2) {
            const bool last = (t == nt - 2);
            const char* a1 = cA + (size_t)(t + 1) * kstepA;
            const char* a2 = last ? nA : cA + (size_t)(t + 2) * kstepA; const char* b2 = last ? nB : cB + (size_t)(t + 2) * kstepB;
            const char* a3 = a2 + kstepA; const char* b3 = b2 + kstepB;
            if (last && has_next) S.a_ready(nxt);
            if constexpr (SP2) {
            if constexpr (Epi::HAS_PRE) { if (last && wid == 0) { int ln = fr | (fq << 4); asm volatile("" : "+v"(ln)); E.pre(cur, ln); } }
            PG8_LDB(B0, 0, 0); PG8_LDB(B1, 0, 1); PG8_SCHED; PG8_LDA(At, 0, 0); PG8_STAGE_A(PG8_SA(1, 1), a1 + hstepA, voffA);
            PG8_WAIT_V(8); PG8_WAIT_L(0); PG8_BAR; PG8_MMA(0, 0, At, B0); PG8_MMA(0, 1, At, B1); PG8_BAR; PG8_SCHED;
            PG8_LDA(At, 0, 1); PG8_STAGE(PG8_SB(0, 0), b2, voffB); PG8_STAGE(PG8_SB(0, 1), b2 + hstepB, voffB); PG8_STAGE_A(PG8_SA(0, 0), a2, voffA);
            PG8_WAIT_V(8); PG8_WAIT_L(0); PG8_BAR; PG8_MMA(1, 0, At, B0); PG8_MMA(1, 1, At, B1); PG8_BAR; PG8_SCHED;
            PG8_LDB(B0, 1, 0); PG8_LDB(B1, 1, 1); PG8_SCHED; PG8_LDA(At, 1, 0); PG8_STAGE_A(PG8_SA(0, 1), a2 + hstepA, voffA);
            PG8_WAIT_V(8); PG8_WAIT_L(0); PG8_BAR; PG8_MMA(0, 0, At, B0); PG8_MMA(0, 1, At, B1); PG8_BAR; PG8_SCHED;
            PG8_LDA(At, 1, 1); PG8_STAGE(PG8_SB(1, 0), b3, voffB); PG8_STAGE(PG8_SB(1, 1), b3 + hstepB, voffB); PG8_STAGE_A(PG8_SA(1, 0), a3, voffA);
            PG8_WAIT_V(8); PG8_WAIT_L(0); PG8_BAR; PG8_MMA(1, 0, At, B0); PG8_MMA(1, 1, At, B1); PG8_BAR; PG8_SCHED;
            } else {
            PG8_LDB(B0, 0, 0); PG8_SCHED; PG8_LDA(At, 0, 0); PG8_STAGE_A(PG8_SA(1, 1), a1 + hstepA, voffA);
            PG8_WAIT_L(8); PG8_BAR; PG8_WAIT_L(0); PG8_MMA(0, 0, At, B0); PG8_BAR; PG8_SCHED;
            PG8_LDB(B1, 0, 1); PG8_STAGE(PG8_SB(0, 0), b2, voffB);
            PG8_BAR; PG8_WAIT_L(0); PG8_MMA(0, 1, At, B1); PG8_BAR;
            PG8_LDA(At, 0, 1); PG8_STAGE_A(PG8_SA(0, 0), a2, voffA);
            PG8_BAR; PG8_WAIT_L(0); PG8_MMA(1, 0, At, B0); PG8_BAR; PG8_SCHED;
            PG8_STAGE(PG8_SB(0, 1), b2 + hstepB, voffB);
            PG8_WAIT_V(6); PG8_BAR; PG8_MMA(1, 1, At, B1); PG8_BAR;
            PG8_LDB(B0, 1, 0); PG8_SCHED; PG8_LDA(At, 1, 0); PG8_STAGE_A(PG8_SA(0, 1), a2 + hstepA, voffA);
            PG8_WAIT_L(8); PG8_BAR; PG8_WAIT_L(0); PG8_MMA(0, 0, At, B0); PG8_BAR; PG8_SCHED;
            PG8_LDB(B1, 1, 1); PG8_STAGE(PG8_SB(1, 0), b3, voffB);
            PG8_BAR; PG8_WAIT_L(0); PG8_MMA(0, 1, At, B1); PG8_BAR;
            PG8_LDA(At, 1, 1); PG8_STAGE_A(PG8_SA(1, 0), a3, voffA);
            PG8_BAR; PG8_WAIT_L(0); PG8_MMA(1, 0, At, B0); PG8_BAR; PG8_SCHED;
            PG8_STAGE(PG8_SB(1, 1), b3 + hstepB, voffB);
            PG8_WAIT_V(6); PG8_BAR; PG8_MMA(1, 1, At, B1); PG8_BAR;
            }
        }
        if constexpr (ALIGN_EPI) { if (wr == 0) PG8_BAR; }
        if constexpr (!Epi::AFTER_DRAIN) { E(acc, cur, wr, wc, fr, fq); S.done(cur); }
        if (!has_next) break;
#pragma unroll
        for (int a = 0; a < 2; ++a)
#pragma unroll
            for (int b = 0; b < 2; ++b)
#pragma unroll
                for (int m = 0; m < 4; ++m)
#pragma unroll
                    for (int n = 0; n < 2; ++n) acc[a][b][m][n] = (f32x4){0.f, 0.f, 0.f, 0.f};
        cur = nxt; cA = nA; cB = nB; ++ui;
        if constexpr (ALIGN_EPI) { if (wr == 1) PG8_BAR; }
    }
    PG8_WAIT_V(0);
    if constexpr (!ALIGN_EPI) { if (wr == 0) PG8_BAR; }
    PG8_BAR;
    if constexpr (Epi::AFTER_DRAIN) { E.fused(acc, cur, wr, wc, fr, fq, lds, wid, lane); S.done(cur); }
#undef PG8_SA
#undef PG8_SB
#undef PG8_STAGE
#undef PG8_STAGE_A
#undef PG8_LDA
#undef PG8_LDB
#undef PG8_MMA
#undef PG8_WAIT_V
#undef PG8_WAIT_L
#undef PG8_BAR
#undef PG8_SCHED
}
}
#define GAS __attribute__((address_space(1)))
#define LAS __attribute__((address_space(3)))
typedef unsigned short bf16;
typedef unsigned v4u __attribute__((ext_vector_type(4)));
typedef float f32x4 __attribute__((ext_vector_type(4)));
typedef short bf16x8 __attribute__((ext_vector_type(8)));
typedef GAS unsigned gu32;
typedef GAS unsigned long long gu64;
#define RLX_AGENT __ATOMIC_RELAXED, __HIP_MEMORY_SCOPE_AGENT
#define LDS_WAIT() asm volatile("s_waitcnt lgkmcnt(0)" ::: "memory")
#define VM_WAIT() asm volatile("s_waitcnt vmcnt(0)" ::: "memory")
__device__ __forceinline__ unsigned long long rt() { return __builtin_amdgcn_s_memrealtime(); }
#define XB_TMO      128
#define XB_XCNT(j)  (256  + 64 * (j))
#define XB_XSUB(j)  (1280 + 64 * (j))
#define XB_XGEN(j)  (2304 + 64 * (j))
#define XB_TOP      3328
#define XB_TOPGEN   3392
#define XCD_BAR_WORDS 3456
#define XB_SPIN_CAP (1u << 18)

__device__ __forceinline__ unsigned xb_ld(unsigned* p)              { return __hip_atomic_load(p, __ATOMIC_RELAXED, __HIP_MEMORY_SCOPE_AGENT); }
__device__ __forceinline__ unsigned xb_add(unsigned* p, unsigned v) { return __hip_atomic_fetch_add(p, v, __ATOMIC_RELAXED, __HIP_MEMORY_SCOPE_AGENT); }
__device__ __forceinline__ unsigned xb_xcc_id() { return (unsigned)__builtin_amdgcn_s_getreg((3 << 11) | 20) & 0xFu; }
#define XB_SPIN(cond, bar) do { unsigned _sp = 0; while (cond) { __builtin_amdgcn_s_sleep(1); \
    if ((++_sp & 255u) == 0u) { if (xb_ld(&(bar)[XB_TMO])) break; if (_sp > XB_SPIN_CAP) { atomicAdd(&(bar)[XB_TMO], 1u); break; } } } } while (0)

struct XcdBarrier {
    unsigned* bar; unsigned x;
    volatile LAS unsigned* st;
};

__device__ __forceinline__ XcdBarrier xcd_barrier_post(unsigned* bar, volatile LAS unsigned* st) {
    XcdBarrier b; b.bar = bar; b.x = xb_xcc_id(); b.st = st;
    if (threadIdx.x == 0) (void)xb_add(&bar[XB_XCNT(b.x)], 1u);
    return b;
}
__device__ __forceinline__ void xcd_barrier_complete(unsigned* bar, unsigned x, unsigned& nloc, unsigned& nx) {
    const unsigned G = gridDim.x * gridDim.y * gridDim.z;
    unsigned sum, cnt, mine, sp = 0u;
    for (;;) {
        sum = 0u; cnt = 0u; mine = 0u;
#pragma unroll
        for (unsigned j = 0; j < 16; ++j) { const unsigned c = xb_ld(&bar[XB_XCNT(j)]); sum += c; cnt += (c > 0u) ? 1u : 0u; mine = (j == x) ? c : mine; }
        if (sum == G) break;
        __builtin_amdgcn_s_sleep(1);
        if ((++sp & 255u) == 0u) { if (xb_ld(&bar[XB_TMO])) break; if (sp > XB_SPIN_CAP) { atomicAdd(&bar[XB_TMO], 1u); break; } }
    }
    nloc = mine > 0u ? mine : 1u; nx = cnt > 0u ? cnt : 1u;
}

__device__ __forceinline__ void xcd_barrier(const XcdBarrier& b) {
    asm volatile("s_waitcnt vmcnt(0)" ::: "memory");
    __syncthreads();
    if (threadIdx.x == 0) {
        unsigned* bar = b.bar;
        __builtin_amdgcn_s_waitcnt(0);
        unsigned nloc = b.st[0], nx = b.st[1];
        if (nloc == 0u) { xcd_barrier_complete(bar, b.x, nloc, nx); b.st[0] = nloc; b.st[1] = nx; }
        const unsigned old = xb_add(&bar[XB_XSUB(b.x)], 1u);
        const unsigned gen = old / nloc;
        if (old + 1u == (gen + 1u) * nloc) {
            __builtin_amdgcn_fence(__ATOMIC_RELEASE, "agent");
            asm volatile("s_waitcnt vmcnt(0)" ::: "memory");
            const unsigned og = xb_add(&bar[XB_TOP], 1u);
            const unsigned tg = og / nx;
            if (og + 1u == (tg + 1u) * nx) xb_add(&bar[XB_TOPGEN], 1u);
            else XB_SPIN(xb_ld(&bar[XB_TOPGEN]) == tg, bar);
            __builtin_amdgcn_fence(__ATOMIC_ACQUIRE, "agent");
            xb_add(&bar[XB_XGEN(b.x)], 1u);
            asm volatile("s_waitcnt vmcnt(0)" ::: "memory");
        } else {
            XB_SPIN(xb_ld(&bar[XB_XGEN(b.x)]) == gen, bar);
            __builtin_amdgcn_fence(__ATOMIC_ACQUIRE, "agent");
            asm volatile("s_waitcnt vmcnt(0)" ::: "memory");
        }
    }
    __syncthreads();
}
namespace att {
using bf16x8 = __attribute__((ext_vector_type(8))) short;
using s16x4  = __attribute__((ext_vector_type(4))) short;
using f32x16 = __attribute__((ext_vector_type(16))) float;
using u32x4  = __attribute__((ext_vector_type(4))) unsigned;
constexpr int SEQ_ = 8192, LDQ = 6144; constexpr size_t SHM_V = 16384, SHM_K = 16384;
#define KSWZ(row, colB) ((row) * 256 + ((colB) ^ (((row) & 7) << 4)))
#define SBAR() __builtin_amdgcn_sched_barrier(0)
__device__ __forceinline__ int crow(int r, int hi) { return (r & 3) + 8 * (r >> 2) + 4 * hi; }
__device__ __forceinline__ unsigned cvtpk(float lo, float hi) {
  unsigned r; asm volatile("v_cvt_pk_bf16_f32 %0, %1, %2" : "=v"(r) : "v"(lo), "v"(hi)); return r;
}
__device__ __forceinline__ void qkt(f32x16& p0, f32x16& p1, const bf16* Ks, const bf16x8* qr, int r32, int hi, int jmap, float dbase, float slope2, float negm, bool diag) {
  asm volatile("" : "+v"(negm));
  if (diag) {
#pragma unroll
    for (int r = 0; r < 16; ++r) { const float d = (float)((r & 3) + 8 * (r >> 2)) + dbase;
      p0[r] = fmaf(-slope2, fabsf(d), negm); p1[r] = fmaf(-slope2, fabsf(d + 32.f), negm); }
  } else {
    const float u0 = fmaf(slope2, dbase, negm), u1 = fmaf(slope2, dbase + 32.f, negm);
#pragma unroll
    for (int r = 0; r < 16; ++r) { p0[r] = fmaf(slope2, (float)((r & 3) + 8 * (r >> 2)), u0); p1[r] = fmaf(slope2, (float)((r & 3) + 8 * (r >> 2)), u1); }
  }
#pragma unroll
  for (int d0 = 0; d0 < 4; ++d0) { const int cb = (jmap * 64 + d0 * 16 + hi * 8) * 2;
    bf16x8 b0 = *reinterpret_cast<const bf16x8*>((const char*)Ks + KSWZ(r32, cb));
    bf16x8 b1 = *reinterpret_cast<const bf16x8*>((const char*)Ks + KSWZ(32 + r32, cb));
    p0 = __builtin_amdgcn_mfma_f32_32x32x16_bf16(b0, qr[d0], p0, 0, 0, 0);
    p1 = __builtin_amdgcn_mfma_f32_32x32x16_bf16(b1, qr[d0], p1, 0, 0, 0); }
}
__device__ __forceinline__ void partialSM(f32x16& p0, f32x16& p1) {
#pragma unroll
  for (int r = 0; r < 16; ++r) p0[r] = __builtin_amdgcn_exp2f(p0[r]);
}
__device__ __forceinline__ void finishSM(f32x16& p0, f32x16& p1, float alpha, float& l_reg, bf16x8& pa0, bf16x8& pa1, bf16x8& pa2, bf16x8& pa3) {
  for (int r = 0; r < 16; ++r) p1[r] = __builtin_amdgcn_exp2f(p1[r]);
  float ps = 0; for (int r = 0; r < 16; ++r) ps += p0[r]; for (int r = 0; r < 16; ++r) ps += p1[r];
  { auto rr = __builtin_amdgcn_permlane32_swap(__float_as_uint(ps), __float_as_uint(ps), false, false);
    ps = __uint_as_float(rr[0]) + __uint_as_float(rr[1]); }
  l_reg = l_reg * alpha + ps;
#define PK4(P, BASE, OUT) do { unsigned a0 = cvtpk(P[BASE + 0], P[BASE + 1]), a1 = cvtpk(P[BASE + 2], P[BASE + 3]);   \
    unsigned b0 = cvtpk(P[BASE + 4], P[BASE + 5]), b1 = cvtpk(P[BASE + 6], P[BASE + 7]);                              \
    auto r0 = __builtin_amdgcn_permlane32_swap(a0, b0, false, false); auto r1 = __builtin_amdgcn_permlane32_swap(a1, b1, false, false); \
    u32x4 w = {r0[0], r1[0], r0[1], r1[1]}; OUT = *reinterpret_cast<bf16x8*>(&w); } while (0)
  PK4(p0, 0, pa0); PK4(p0, 8, pa1); PK4(p1, 0, pa2); PK4(p1, 8, pa3);
#undef PK4
}
__device__ __forceinline__ int v_st(int k, int c) { const int kk = (k & ~0xC) | ((k & 4) << 1) | ((k & 8) >> 1); return ((kk >> 3) * 4 + (c >> 5)) * 512 + ((kk & 7) * 32 + (c & 31)) * 2; }
__device__ __forceinline__ int v_rd_base(int lane) { return ((lane & 3) << 3) | (((lane >> 2) & 3) << 6) | (((lane >> 4) & 1) << 5) | (((lane >> 5) & 1) << 8); }
constexpr int v_rd_off(int d0, int ks, int half) { return d0 * 512 + ks * 4096 + half * 2048; }
template <int OFF> __device__ __forceinline__ s16x4 tr_read(int vb) {
  s16x4 r; asm volatile("ds_read_b64_tr_b16 %0, %1 offset:%2" : "=&v"(r) : "v"(vb), "i"(OFF) : "memory"); return r;
}
template <int D0> __device__ __forceinline__ void pv_one(f32x16& od, int vb, bf16x8 pa0, bf16x8 pa1, bf16x8 pa2, bf16x8 pa3) {
  const s16x4 l0 = tr_read<v_rd_off(D0, 0, 0)>(vb), h0 = tr_read<v_rd_off(D0, 0, 1)>(vb), l1 = tr_read<v_rd_off(D0, 1, 0)>(vb), h1 = tr_read<v_rd_off(D0, 1, 1)>(vb);
  const s16x4 l2 = tr_read<v_rd_off(D0, 2, 0)>(vb), h2 = tr_read<v_rd_off(D0, 2, 1)>(vb), l3 = tr_read<v_rd_off(D0, 3, 0)>(vb), h3 = tr_read<v_rd_off(D0, 3, 1)>(vb);
  asm volatile("s_waitcnt lgkmcnt(0)" ::: "memory"); SBAR();
#define PK(L, H) (bf16x8){L[0], L[1], L[2], L[3], H[0], H[1], H[2], H[3]}
  od = __builtin_amdgcn_mfma_f32_32x32x16_bf16(pa0, PK(l0, h0), od, 0, 0, 0);
  od = __builtin_amdgcn_mfma_f32_32x32x16_bf16(pa1, PK(l1, h1), od, 0, 0, 0);
  od = __builtin_amdgcn_mfma_f32_32x32x16_bf16(pa2, PK(l2, h2), od, 0, 0, 0);
  od = __builtin_amdgcn_mfma_f32_32x32x16_bf16(pa3, PK(l3, h3), od, 0, 0, 0);
#undef PK
}
#define PV_RD(S, D0) const s16x4 S##l0 = tr_read<v_rd_off(D0, 0, 0)>(vb), S##h0 = tr_read<v_rd_off(D0, 0, 1)>(vb), S##l1 = tr_read<v_rd_off(D0, 1, 0)>(vb), S##h1 = tr_read<v_rd_off(D0, 1, 1)>(vb), \
    S##l2 = tr_read<v_rd_off(D0, 2, 0)>(vb), S##h2 = tr_read<v_rd_off(D0, 2, 1)>(vb), S##l3 = tr_read<v_rd_off(D0, 3, 0)>(vb), S##h3 = tr_read<v_rd_off(D0, 3, 1)>(vb)
#define PV_PK(L, H) (bf16x8){L[0], L[1], L[2], L[3], H[0], H[1], H[2], H[3]}
#define PV_MM(S, OD) do { OD = __builtin_amdgcn_mfma_f32_32x32x16_bf16(pa0, PV_PK(S##l0, S##h0), OD, 0, 0, 0); OD = __builtin_amdgcn_mfma_f32_32x32x16_bf16(pa1, PV_PK(S##l1, S##h1), OD, 0, 0, 0); \
    OD = __builtin_amdgcn_mfma_f32_32x32x16_bf16(pa2, PV_PK(S##l2, S##h2), OD, 0, 0, 0); OD = __builtin_amdgcn_mfma_f32_32x32x16_bf16(pa3, PV_PK(S##l3, S##h3), OD, 0, 0, 0); } while (0)
__device__ __forceinline__ void pv_d0(f32x16* o, int vb, bf16x8 pa0, bf16x8 pa1, bf16x8 pa2, bf16x8 pa3) {
  PV_RD(a, 0); PV_RD(b, 1);
  asm volatile("s_waitcnt lgkmcnt(8)" ::: "memory"); SBAR();
  PV_MM(a, o[0]);
  PV_RD(c, 2);
  asm volatile("s_waitcnt lgkmcnt(8)" ::: "memory"); SBAR();
  PV_MM(b, o[1]);
  PV_RD(d, 3);
  asm volatile("s_waitcnt lgkmcnt(8)" ::: "memory"); SBAR();
  PV_MM(c, o[2]);
  asm volatile("s_waitcnt lgkmcnt(0)" ::: "memory"); SBAR();
  PV_MM(d, o[3]);
}
#undef PV_RD
#undef PV_PK
#undef PV_MM
__device__ __forceinline__ void attn_unit(int tid_in, int b, int h, int qb, int tb, const bf16* __restrict__ QKV, bf16* __restrict__ OB, float lam, float omli, float slope2, float m_ref, const float* __restrict__ subg, char* lds, gu32* qhead, volatile LAS unsigned* qslot) {
  int tid_o = tid_in; asm volatile("" : "+v"(tid_o));
  const int tid = tid_o, wid = __builtin_amdgcn_readfirstlane(tid >> 6), lane = tid & 63, r32 = lane & 31, hi = lane >> 5;
  const int jmap = wid >> 2, wq = wid & 3;
  constexpr int KR = 0, VR = 3 * 16384, WSO = 6 * 16384;
  float* ws = (float*)(lds + WSO) + wid * 64; float* li_l = ws;
  const long rowbase = (long)b * SEQ_; const int q0 = qb * 128 + wq * 32;
  float l_reg = 0.f; f32x16 o[4] = {}; bf16x8 qr[4];
  const bf16* Qw = QKV + (rowbase + q0 + r32) * LDQ + h * 128 + jmap * 64 + hi * 8;
#pragma unroll
  for (int d0 = 0; d0 < 4; ++d0) qr[d0] = *reinterpret_cast<const bf16x8*>(Qw + d0 * 16);
  const char* KVmid = (const char*)(QKV + (rowbase + 64 * tb) * LDQ + 2048 + h * 128 + 1024);
  unsigned koff[2], voff[2];
#pragma unroll
  for (int jb = 0; jb < 2; ++jb) { const int blk = 2 * wid + jb;
    { const int row = 4 * blk + (lane >> 4), chunk = (lane & 15) ^ (row & 7);
      koff[jb] = (unsigned)(row * LDQ * 2 + chunk * 16); }
    { const int sl = 64 * blk + lane, kk = 8 * (sl >> 7) + ((sl & 31) >> 2), c = 32 * ((sl >> 5) & 3) + 8 * (sl & 3);
      const int k = (kk & ~0xC) | ((kk & 4) << 1) | ((kk & 8) >> 1);
      voff[jb] = (unsigned)(k * LDQ * 2 + c * 2); } }
  const unsigned lds0 = (unsigned)(uintptr_t)lds;
  const int vb0 = (int)(lds0 + VR) + v_rd_base(lane);
  typedef __attribute__((address_space(3))) unsigned lds_u32;
#define DMA_K(t, slot) do { const char* t_ = KVmid + (size_t)(t) * (64 * LDQ * 2) - 2048; \
    __builtin_amdgcn_global_load_lds((const unsigned*)(t_ + koff[0]), (lds_u32*)(lds0 + KR + (slot) * 16384 + (2 * wid) * 1024), 16, 0, 0); \
    __builtin_amdgcn_global_load_lds((const unsigned*)(t_ + koff[1]), (lds_u32*)(lds0 + KR + (slot) * 16384 + (2 * wid + 1) * 1024), 16, 0, 0); } while (0)
#define DMA_V(t, slot) do { const char* t_ = KVmid + (size_t)(t) * (64 * LDQ * 2) + 2048; \
    __builtin_amdgcn_global_load_lds((const unsigned*)(t_ + voff[0]), (lds_u32*)(lds0 + VR + (slot) * 16384 + (2 * wid) * 1024), 16, 0, 0); \
    __builtin_amdgcn_global_load_lds((const unsigned*)(t_ + voff[1]), (lds_u32*)(lds0 + VR + (slot) * 16384 + (2 * wid + 1) * 1024), 16, 0, 0); } while (0)
#define WAIT_BAR(N) asm volatile("s_waitcnt vmcnt(" #N ") lgkmcnt(0)\n\ts_barrier" ::: "memory")
  f32x16 pA0, pA1, pB0, pB1; bf16x8 pa0, pa1, pa2, pa3;
  const int NT = 2 * qb + 2 - tb, cq = 2 * qb + (wq >> 1) - tb;
  const float dq = (float)(4 * hi - (q0 + r32) + 64 * tb);
#define QKT(P0, P1, kslot, t) qkt(P0, P1, (const bf16*)(lds + KR + (kslot) * 16384), qr, r32, hi, jmap, (float)(64 * (t)) + dq, slope2, ((t) > cq) ? -1e30f : -m_ref, (t) == cq)
  int sc = 0, sp = 2;
#define ROT() do { sp = sc; sc = (sc == 2) ? 0 : sc + 1; } while (0)
  asm volatile("s_waitcnt vmcnt(0)" : "+v"(qr[0]), "+v"(qr[1]), "+v"(qr[2]), "+v"(qr[3]) :: "memory");
  DMA_K(0, 0); DMA_V(0, 0); DMA_K(1, 1);
  WAIT_BAR(4);
  if (2 < NT) DMA_K(2, 2);
  DMA_V(1, 1);
  QKT(pA0, pA1, 0, 0); partialSM(pA0, pA1);
#define STEP(PX0, PX1, PY0, PY1, t) do { ROT(); \
    if ((t) + 1 < NT) { WAIT_BAR(4); } else { WAIT_BAR(2); } \
    { const int sn_ = (sp == 0) ? 2 : sp - 1;        \
      if ((t) + 2 < NT) DMA_K((t) + 2, sp); \
      if ((t) + 1 < NT) DMA_V((t) + 1, (3 - sc - sp)); (void)sn_; } \
    SBAR(); QKT(PX0, PX1, sc, t); \
    finishSM(PY0, PY1, 1.f, l_reg, pa0, pa1, pa2, pa3); SBAR(); \
    pv_d0(o, vb0 + sp * 16384, pa0, pa1, pa2, pa3); partialSM(PX0, PX1); } while (0)
  for (int t = 1; t + 1 < NT; t += 2) {
    STEP(pB0, pB1, pA0, pA1, t);
    STEP(pA0, pA1, pB0, pB1, t + 1);
  }
  if ((NT & 1) == 0) {
    STEP(pB0, pB1, pA0, pA1, NT - 1);
    WAIT_BAR(0);
    finishSM(pB0, pB1, 1.f, l_reg, pa0, pa1, pa2, pa3); SBAR();
  } else {
    WAIT_BAR(0);
    finishSM(pA0, pA1, 1.f, l_reg, pa0, pa1, pa2, pa3); SBAR();
  }
  pv_d0(o, vb0 + sc * 16384, pa0, pa1, pa2, pa3);
  unsigned nxt_unit = 0u; if (tid == 0) nxt_unit = __hip_atomic_fetch_add(qhead, 1u, __ATOMIC_RELAXED, __HIP_MEMORY_SCOPE_AGENT);
  if (hi == 0) li_l[r32] = l_reg; asm volatile("s_waitcnt lgkmcnt(0)" ::: "memory");
#pragma unroll
  for (int r = 0; r < 16; ++r) { const float rl = __builtin_amdgcn_rcpf(li_l[crow(r, hi)]);
#pragma unroll
    for (int d0 = 0; d0 < 4; ++d0) o[d0][r] *= rl; }
  float* xch = (float*)lds + (size_t)wq * 4096 + lane;
  __syncthreads();
  if (jmap == 1) {
#pragma unroll
    for (int d0 = 0; d0 < 4; ++d0)
#pragma unroll
      for (int r = 0; r < 16; ++r) xch[(d0 * 16 + r) * 64] = o[d0][r];
  }
  __syncthreads();
  if (jmap == 0) {
    float ss[16];
#pragma unroll
    for (int r = 0; r < 16; ++r) { float s = 0.f;
#pragma unroll
      for (int d0 = 0; d0 < 4; ++d0) { const float df = o[d0][r] - lam * xch[(d0 * 16 + r) * 64]; o[d0][r] = df; s += df * df; }
      ss[r] = s; }
#pragma unroll
    for (int r = 0; r < 16; ++r) { float s = ss[r]; s += sx<1>(s); s += sx<2>(s); s += sx<4>(s); s += sx<8>(s); s += sx<16>(s);
      ss[r] = rsqrtf(s * (1.0f / 128.0f) + 1e-6f) * omli; }
    float gs[4]; int r32o = r32; asm volatile("" : "+v"(r32o));
#pragma unroll
    for (int d0 = 0; d0 < 4; ++d0) gs[d0] = subg[d0 * 32 + r32o];
    bf16* stg = (bf16*)(lds + 65536) + wq * 4096;
    int sto = 4 * hi * 128 + r32; asm volatile("" : "+v"(sto));
#pragma unroll
    for (int r = 0; r < 16; ++r) { const int orow = (r & 3) + 8 * (r >> 2);
#pragma unroll
      for (int d0 = 0; d0 < 4; ++d0) stg[sto + orow * 128 + d0 * 32] = (bf16)f2bf(o[d0][r] * ss[r] * gs[d0]); }
    asm volatile("s_waitcnt lgkmcnt(0)" ::: "memory");
    unsigned ooff = (unsigned)((q0 + (lane >> 4)) * 2048 + (lane & 15) * 8); asm volatile("" : "+v"(ooff));
    bf16* Ow = OB + rowbase * 2048 + h * 128 + ooff;
#pragma unroll
    for (int i = 0; i < 8; ++i) { const u32x4 v = *(const u32x4*)(stg + (4 * i + (lane >> 4)) * 128 + (lane & 15) * 8); *(u32x4*)(Ow + (4 * i) * 2048) = v; }
  }
  if (tid == 0) *qslot = nxt_unit;
  __syncthreads();
#undef DMA_K
#undef DMA_V
#undef WAIT_BAR
#undef ROT
#undef STEP
#undef QKT
}
#undef KSWZ
#undef SBAR
}
constexpr int DM = 2048, NB = 4, SEQ = 8192, MT = NB * SEQ, FF = 5632, NLAYER = 4, NH = 16, NMOD = 9 * DM;
constexpr float RMS_EPS = 1e-6f;
constexpr int NWAVES = 8;
#ifndef PROBE_MASK
#define PROBE_MASK 0
#endif
#ifndef PROBE_IDLE
#define PROBE_IDLE 0
#endif
#ifndef PROBE_ECHO
#define PROBE_ECHO 0
#endif
#ifndef FFN_SPLIT
#define FFN_SPLIT 1
#endif
#ifndef GU_WGM
#define GU_WGM 8
#endif
#ifndef OUT_A_AUX
#define OUT_A_AUX 0
#endif
#ifndef OUT_WGM
#define OUT_WGM 4
#endif
#ifndef MK_PER_PHASE
#define MK_PER_PHASE 0
#endif
constexpr int N_PHASES = 32 + 8 * 2 * (FFN_SPLIT - 1);
constexpr size_t MiB = 1u << 20;
constexpr size_t WS_CTL = 0, CTL_ZERO_BYTES = 3 * MiB;
constexpr size_t WS_MOD = 1696 * MiB;
constexpr size_t WS_EBL = 3 * MiB;
constexpr size_t WS_WGU = 8 * MiB;
constexpr size_t WS_WD  = 360 * MiB;
constexpr size_t WS_WAI = 536 * MiB;
constexpr size_t WS_WAO = 584 * MiB;
constexpr size_t WS_WCI = 600 * MiB, WS_WCO = 624 * MiB;
constexpr size_t WS_WHI = 632 * MiB, WS_WHO = 664 * MiB;
constexpr size_t WS_XN  = 672 * MiB;
constexpr size_t WS_BIG = 800 * MiB;
constexpr size_t WS_OB  = 1312 * MiB;
constexpr size_t WS_KLT = 1440 * MiB;
constexpr size_t WS_IT  = 1568 * MiB;
constexpr size_t WS_RSS = 1 * MiB, RSS_BYTES = 2 * MiB;
constexpr size_t WS_CB  = 1698 * MiB;
constexpr int CB_LD = 2 * 5632;
constexpr size_t WS_TAB = 1701 * MiB;
constexpr size_t WS_XH  = 1702 * MiB;
constexpr size_t WS_END = 1830 * MiB;
constexpr int CW_BAR = 4096;
constexpr int RING_OFF = 0, RING_BYTES = 131072;
constexpr int LDSCTL_OFF = RING_BYTES, MISC_OFF = LDSCTL_OFF + 320;
constexpr int PRE_OFF = LDSCTL_OFF + 1024;
constexpr int LDS_BYTES = 147456;

struct Args { const float* in[21]; float* out; unsigned char* ws; int ph_lo, ph_hi; };
struct Frame {
    LAS unsigned char* lds;
    volatile LAS unsigned* MISC;
    gu32* ctl;
    int tid, lane, wave, vcu, G;
    const struct Args* a; float* out; unsigned char* ws;
};
__device__ __forceinline__ float bf_lo(unsigned w) { return __uint_as_float(w << 16); }
__device__ __forceinline__ float bf_hi(unsigned w) { return __uint_as_float(w & 0xffff0000u); }
__device__ __forceinline__ float bf_f(bf16 x) { return __uint_as_float((unsigned)x << 16); }

__device__ __forceinline__ void unpack8(const v4u w, float (&x)[8]) { x[0] = bf_lo(w.x); x[1] = bf_hi(w.x); x[2] = bf_lo(w.y); x[3] = bf_hi(w.y); x[4] = bf_lo(w.z); x[5] = bf_hi(w.z); x[6] = bf_lo(w.w); x[7] = bf_hi(w.w); }
__device__ __forceinline__ void p0_mod(Frame& F) {
    LAS float* cond = (LAS float*)(F.lds);
    LAS float* part = (LAS float*)(F.lds + 32768);
    const float* c = F.a->in[1]; const float* aw = F.a->in[2]; const float* ab = F.a->in[3]; float* mod = (float*)(F.ws + WS_MOD);
    for (int i = F.tid; i < NB * DM; i += NWAVES * 64) { const float v = c[i]; cond[i] = v / (1.0f + __expf(-v)); }
    __syncthreads();
    const int cg = F.tid & 15, ks = F.tid >> 4;
    for (int it = F.vcu; it < NLAYER * (NMOD / 64); it += F.G) {
        const int L = it / (NMOD / 64), n0 = (it % (NMOD / 64)) * 64;
        f32x4 a0 = {0.f, 0.f, 0.f, 0.f}, a1 = a0, a2 = a0, a3 = a0;
        const float* wp = aw + ((size_t)L * DM + ks * 64) * NMOD + n0 + 4 * cg;
#pragma unroll 8
        for (int k = 0; k < 64; ++k) { const f32x4 w = *(const f32x4*)(wp + (size_t)k * NMOD); const int kk = ks * 64 + k;
            a0 += w * cond[kk]; a1 += w * cond[DM + kk]; a2 += w * cond[2 * DM + kk]; a3 += w * cond[3 * DM + kk]; }
        *(LAS f32x4*)(part + (ks * 4 + 0) * 64 + 4 * cg) = a0; *(LAS f32x4*)(part + (ks * 4 + 1) * 64 + 4 * cg) = a1;
        *(LAS f32x4*)(part + (ks * 4 + 2) * 64 + 4 * cg) = a2; *(LAS f32x4*)(part + (ks * 4 + 3) * 64 + 4 * cg) = a3;
        __syncthreads();
        if (F.tid < 256) { const int b = F.tid >> 6, col = F.tid & 63; float s = 0.f;
#pragma unroll 8
            for (int k2 = 0; k2 < 32; ++k2) s += part[(k2 * 4 + b) * 64 + col];
            mod[((size_t)L * NB + b) * NMOD + n0 + col] = s + ab[(size_t)L * NMOD + n0 + col]; }
        __syncthreads();
    }
}
struct CvItem { const float* W; bf16* WT; int K, N, mode, item; };
__device__ __forceinline__ CvItem cv_decode(Frame& F, int it) {
    constexpr int I_FFN = (DM / 64) * (FF / 32);
    constexpr int I_IN3 = (DM / 64) * (3 * DM / 32), I_SQ = (DM / 64) * (DM / 32), I_IN4 = (DM / 64) * (4 * DM / 32);
    int r = it;
    if (r < 24 * I_FFN) { const int m = r / I_FFN, ls = m / 3, which = m % 3; r -= m * I_FFN;
        if (which == 0) return CvItem{F.a->in[5] + (size_t)ls * DM * FF, (bf16*)(F.ws + WS_WGU) + (size_t)ls * 2 * FF * DM, DM, FF, 1, r};
        if (which == 1) return CvItem{F.a->in[6] + (size_t)ls * DM * FF, (bf16*)(F.ws + WS_WGU) + (size_t)ls * 2 * FF * DM, DM, FF, 2, r};
        return CvItem{F.a->in[7] + (size_t)ls * FF * DM, (bf16*)(F.ws + WS_WD) + (size_t)ls * DM * FF, FF, DM, 0, r}; }
    r -= 24 * I_FFN;
    if (r < 2 * I_IN3) { const int s = r / I_IN3; return CvItem{F.a->in[8] + (size_t)s * DM * 3 * DM, (bf16*)(F.ws + WS_WAI) + (size_t)s * 3 * DM * DM, DM, 3 * DM, 3, r - s * I_IN3}; } r -= 2 * I_IN3;
    if (r < 2 * I_SQ) { const int s = r / I_SQ; return CvItem{F.a->in[9] + (size_t)s * DM * DM, (bf16*)(F.ws + WS_WAO) + (size_t)s * DM * DM, DM, DM, 0, r - s * I_SQ}; } r -= 2 * I_SQ;
    if (r < I_IN3) return CvItem{F.a->in[14], (bf16*)(F.ws + WS_WCI), DM, 3 * DM, 0, r}; r -= I_IN3;
    if (r < I_SQ) return CvItem{F.a->in[16], (bf16*)(F.ws + WS_WCO), DM, DM, 0, r}; r -= I_SQ;
    if (r < I_IN4) return CvItem{F.a->in[17], (bf16*)(F.ws + WS_WHI), DM, 4 * DM, 0, r}; r -= I_IN4;
    return CvItem{F.a->in[18], (bf16*)(F.ws + WS_WHO), DM, DM, 0, r};
}
__device__ __forceinline__ void cv_load(const CvItem& c, float (&wv)[32], int lane) {
    const int nblk = c.N / 32, kb = c.item / nblk, nb = c.item % nblk;
    const float* wp = c.W + (size_t)(64 * kb + (lane >> 5)) * c.N + 32 * nb + (lane & 31);
#pragma unroll
    for (int i = 0; i < 32; ++i) wv[i] = wp[(size_t)(2 * i) * c.N];
}
__device__ __forceinline__ void cv_finish(const CvItem& c, const float (&wv)[32], LAS float* scr, int lane) {
    const int K = c.K, mode = c.mode, nblk = c.N / 32, kb = c.item / nblk, nb = c.item % nblk, n0 = 32 * nb;
    const int drow0 = (mode == 0 || (mode == 3 && n0 >= 2 * DM)) ? n0 : (mode == 3) ? ((n0 & ~255) + 128 * ((n0 >> 5) & 1) + 32 * ((n0 >> 6) & 3)) : ((n0 >> 7) * 256 + (mode - 1) * 128 + (n0 & 127));
#pragma unroll
    for (int i = 0; i < 32; ++i) scr[(2 * i + (lane >> 5)) * 33 + (lane & 31)] = wv[i];
    LDS_WAIT(); asm volatile("" ::: "memory");
    const int cc = lane & 7;
#pragma unroll
    for (int j = 0; j < 4; ++j) { const int n = (lane >> 3) + 8 * j; const LAS float* s = scr + (8 * cc) * 33 + n;
        v4u o; o.x = pk2(s[0 * 33], s[1 * 33]); o.y = pk2(s[2 * 33], s[3 * 33]); o.z = pk2(s[4 * 33], s[5 * 33]); o.w = pk2(s[6 * 33], s[7 * 33]);
        const int dr = drow0 + n;
        *(GAS v4u*)(c.WT + ((size_t)((dr >> 8) * (K >> 6) + kb) * 256 + (dr & 255)) * 64 + 8 * cc) = o; }
    LDS_WAIT(); asm volatile("" ::: "memory");
}
__device__ __forceinline__ void p0_convert(Frame& F) {
    LAS float* scr = (LAS float*)(F.lds + RING_OFF + F.wave * 16384);
    const int gw = F.vcu * NWAVES + F.wave, NGW = F.G * NWAVES;
    constexpr int NITEMS = 24 * ((DM / 64) * (FF / 32)) + 3 * ((DM / 64) * (3 * DM / 32)) + 4 * ((DM / 64) * (DM / 32)) + (DM / 64) * (4 * DM / 32);
    CvItem A, B; float wa[32], wb[32];
    int it = gw;
    if (it < NITEMS) { A = cv_decode(F, it); cv_load(A, wa, F.lane); }
    while (it < NITEMS) {
        int nx = it + NGW;
        if (nx < NITEMS) { B = cv_decode(F, nx); cv_load(B, wb, F.lane); }
        cv_finish(A, wa, scr, F.lane);
        it = nx; if (it >= NITEMS) break;
        nx = it + NGW;
        if (nx < NITEMS) { A = cv_decode(F, nx); cv_load(A, wa, F.lane); }
        cv_finish(B, wb, scr, F.lane);
        it = nx;
    }
}
__device__ __forceinline__ void xs0_phase(Frame& F, const float* xsrc, const float* g, const float* modL) {
    bf16* XN = (bf16*)(F.ws + WS_XN); float* rss = (float*)(F.ws + WS_RSS);
    const int gw = F.vcu * NWAVES + F.wave, NGW = F.G * NWAVES;
    for (int r0 = gw * 16; r0 < MT; r0 += NGW * 16) {
        const int b = r0 / SEQ;
        const float* sc = modL + (size_t)b * NMOD + DM;
        f32x4 a[8];
#pragma unroll
        for (int j = 0; j < 8; ++j) { const int col = 4 * F.lane + 256 * j; a[j] = *(const f32x4*)(g + col) * (*(const f32x4*)(sc + col) + 1.0f); }
#pragma unroll 2
        for (int r = 0; r < 16; ++r) {
            const GAS f32x4* xr = (const GAS f32x4*)(xsrc + (size_t)(r0 + r) * DM) + F.lane;
            f32x4 v[8]; float s = 0.f;
#pragma unroll
            for (int j = 0; j < 8; ++j) { v[j] = xr[64 * j]; s += (v[j].x * v[j].x + v[j].y * v[j].y) + (v[j].z * v[j].z + v[j].w * v[j].w); }
            s = wave_sum(s);
            if (F.lane == 0) rss[r0 + r] = s;
            bf16* o8 = XN + ((size_t)((r0 + r) >> 8) * 32 * 256 + ((r0 + r) & 255)) * 64 + (size_t)(F.lane >> 4) * (256 * 64) + 4 * (F.lane & 15);
#pragma unroll
            for (int j = 0; j < 8; ++j) { const f32x4 h = v[j] * a[j];
                *(GAS unsigned long long*)(o8 + (size_t)(4 * j) * (256 * 64)) = (unsigned long long)pk2(h.x, h.y) | ((unsigned long long)pk2(h.z, h.w) << 32); }
        }
    }
}
__device__ __forceinline__ void tables_phase(Frame& F) {
    const float* mod = (const float*)(F.ws + WS_MOD); float* TAB = (float*)(F.ws + WS_TAB); const float* ng = F.a->in[4];
    const int gt = F.vcu * (NWAVES * 64) + F.tid, NT = F.G * NWAVES * 64;
    for (int i = gt; i < 3 * NLAYER * NB * DM; i += NT) {
        const int col = i % DM, b = (i / DM) % NB, s = i / (DM * NB), L = s / 3, sub = s % 3, sn = s + 1, Ln = sn / 3, subn = sn % 3;
        TAB[((size_t)(s * 2 + 0) * NB + b) * DM + col] = ((sub == 1) ? 1.0f : 0.5f) * mod[((size_t)L * NB + b) * NMOD + (3 * sub + 2) * DM + col];
        TAB[((size_t)(s * 2 + 1) * NB + b) * DM + col] = (sn < 3 * NLAYER) ? ng[((size_t)Ln * 3 + subn) * DM + col] * (1.0f + mod[((size_t)Ln * NB + b) * NMOD + (3 * subn + 1) * DM + col]) : 0.f;
    }
}
__device__ __forceinline__ void bias_phase(Frame& F) {
    const float* mod = (const float*)(F.ws + WS_MOD); float* CB = (float*)(F.ws + WS_CB);
    const int gw = F.vcu * NWAVES + F.wave, NGW = F.G * NWAVES;
#pragma unroll 1
    for (int s = 0; s < 3 * NLAYER; ++s) {
        const int L = s / 3, sub = s % 3, kind = L % 3, slot = L / 3;
        const bf16* W; int N;
        if (sub != 1) { W = (const bf16*)(F.ws + WS_WGU) + (size_t)(L * 2 + (sub >> 1)) * 2 * FF * DM; N = 2 * FF; }
        else if (kind == 0) { W = (const bf16*)(F.ws + WS_WAI) + (size_t)slot * 3 * DM * DM; N = 3 * DM; }
        else if (kind == 1) { W = (const bf16*)(F.ws + WS_WCI); N = 3 * DM; }
        else { W = (const bf16*)(F.ws + WS_WHI); N = 4 * DM; }
        float sh[4][4][8];
#pragma unroll
        for (int b = 0; b < NB; ++b)
#pragma unroll
            for (int it = 0; it < 4; ++it) { const float* sp = mod + ((size_t)L * NB + b) * NMOD + (3 * sub) * DM + 8 * (64 * it + F.lane);
                const f32x4 s0 = *(const f32x4*)sp, s1 = *(const f32x4*)(sp + 4);
                sh[b][it][0] = s0.x; sh[b][it][1] = s0.y; sh[b][it][2] = s0.z; sh[b][it][3] = s0.w; sh[b][it][4] = s1.x; sh[b][it][5] = s1.y; sh[b][it][6] = s1.z; sh[b][it][7] = s1.w; }
        for (int n = gw; n < N; n += NGW) {
            const bf16* wrow = W + ((size_t)(n >> 8) * (DM >> 6) * 256 + (n & 255)) * 64 + (F.lane & 7) * 8;
            float d0 = 0.f, d1 = 0.f, d2 = 0.f, d3 = 0.f;
#pragma unroll
            for (int it = 0; it < 4; ++it) { float w[8]; unpack8(*(const GAS v4u*)(wrow + (size_t)(8 * it + (F.lane >> 3)) * 256 * 64), w);
#pragma unroll
                for (int i = 0; i < 8; ++i) { d0 += w[i] * sh[0][it][i]; d1 += w[i] * sh[1][it][i]; d2 += w[i] * sh[2][it][i]; d3 += w[i] * sh[3][it][i]; } }
            d0 = wave_sum(d0); d1 = wave_sum(d1); d2 = wave_sum(d2); d3 = wave_sum(d3);
            if (F.lane == 0) { float* cp = CB + (size_t)s * NB * CB_LD + n; cp[0] = d0; cp[CB_LD] = d1; cp[2 * CB_LD] = d2; cp[3 * CB_LD] = d3; }
        }
    }
}
constexpr int CW_ATTNQ = 8192;
__device__ __forceinline__ void attn_phase(Frame& F, int L, int slot, int qword = 0) {
    const bf16* QKV = (const bf16*)(F.ws + WS_BIG); bf16* OB = (bf16*)(F.ws + WS_OB);
    const float* lv = F.a->in[12] + (size_t)slot * 4 * 64;
    int ln = F.lane; asm volatile("" : "+v"(ln));
    const float sa = wave_sum(lv[ln] * lv[64 + ln]), sb = wave_sum(lv[128 + ln] * lv[192 + ln]);
    asm volatile("" : "+s"(L));
    const float lambda_init = (L == 0) ? 0.2f : (L == 1) ? 0.35550906f : (L == 2) ? 0.47071302f : 0.55605822f;
    const float lam = expf(sa) - expf(sb) + lambda_init;
    const float* subg = F.a->in[13] + (size_t)slot * 128;
    float gm = fabsf(F.a->in[10][slot * 64 + ln] * F.a->in[11][slot * 64 + ln]);
    gm = wave_max(gm);
    const float twoB24 = 16.0f * gm + 24.0f;
    const float m_ref = (8.0f * gm) * 1.4426950408889634f * 1.02f + 0.5f;
    gu32* qhead = F.ctl + CW_ATTNQ + 64 * slot + 256 * qword;
    if (F.tid == 0) F.MISC[16] = __hip_atomic_fetch_add(qhead, 1u, RLX_AGENT);
    __syncthreads();
    int n = (int)F.MISC[16];
    while (n < NB * NH * (SEQ / 128)) {
        const int qb = 63 - (n >> 6), bhq = n & 63, h = 15 - (bhq >> 2), b = bhq & 3;
        const float slope = exp2f(-0.5f * (float)(h + 1));
        const float W = (twoB24 - __logf(1.0f - __expf(-slope))) / slope;
        int tb = (int)floorf(((float)(128 * qb) - W) * (1.0f / 64.0f)); tb = (tb < 0 ? 0 : tb);
        att::attn_unit(F.tid, b, h, qb, tb, QKV, OB, lam, 1.0f - lambda_init, slope * 1.4426950408889634f, m_ref, subg, (char*)(F.lds + RING_OFF), qhead, F.MISC + 16);
        n = (int)F.MISC[16];
    }
}
__device__ __forceinline__ void conv_phase(Frame& F) {
    const bf16* U = (const bf16*)(F.ws + WS_BIG); bf16* OB = (bf16*)(F.ws + WS_OB); const float* cw = F.a->in[15];
    const int gt = F.vcu * (NWAVES * 64) + F.tid, NT = F.G * NWAVES * 64;
    for (int item = gt; item < 256 * (MT / 16); item += NT) {
        int dg = item & 255; asm volatile("" : "+v"(dg));
        const int run = item >> 8, row0 = run * 16, d = dg * 8;
        float w0[8], w1[8], w2[8];
#pragma unroll
        for (int i = 0; i < 8; ++i) { w0[i] = cw[d + i]; w1[i] = cw[DM + d + i]; w2[i] = cw[2 * DM + d + i]; }
        float vm2[8], vm1[8];
        if ((row0 % SEQ) == 0) {
#pragma unroll
            for (int i = 0; i < 8; ++i) { vm2[i] = 0.f; vm1[i] = 0.f; }
        } else {
            float a[8], b[8];
            unpack8(*(const GAS v4u*)(U + (size_t)(row0 - 2) * 6144 + 2048 + d), a); unpack8(*(const GAS v4u*)(U + (size_t)(row0 - 2) * 6144 + 4096 + d), b);
#pragma unroll
            for (int i = 0; i < 8; ++i) vm2[i] = a[i] * b[i];
            unpack8(*(const GAS v4u*)(U + (size_t)(row0 - 1) * 6144 + 2048 + d), a); unpack8(*(const GAS v4u*)(U + (size_t)(row0 - 1) * 6144 + 4096 + d), b);
#pragma unroll
            for (int i = 0; i < 8; ++i) vm1[i] = a[i] * b[i];
        }
#pragma unroll 4
        for (int t = 0; t < 16; ++t) {
            const bf16* rp = U + (size_t)(row0 + t) * 6144 + d;
            float bg[8], cg[8], uu[8], y[8];
            unpack8(*(const GAS v4u*)(rp), bg); unpack8(*(const GAS v4u*)(rp + 2048), cg); unpack8(*(const GAS v4u*)(rp + 4096), uu);
#pragma unroll
            for (int i = 0; i < 8; ++i) { const float v = cg[i] * uu[i]; y[i] = bg[i] * (w0[i] * vm2[i] + w1[i] * vm1[i] + w2[i] * v); vm2[i] = vm1[i]; vm1[i] = v; }
            v4u o; o.x = pk2(y[0], y[1]); o.y = pk2(y[2], y[3]); o.z = pk2(y[4], y[5]); o.w = pk2(y[6], y[7]);
            *(GAS v4u*)(OB + (size_t)(row0 + t) * DM + d) = o;
        }
    }
}
#define LDS_BAR() asm volatile("s_waitcnt lgkmcnt(0)\n\ts_barrier" ::: "memory")
typedef short s16x4 __attribute__((ext_vector_type(4)));
typedef float f32x16 __attribute__((ext_vector_type(16)));
__device__ __forceinline__ int crow16(int r, int hi) { return (r & 3) + 8 * (r >> 2) + 4 * hi; }
constexpr int H_P256 = 272, H_P128 = 144;
__device__ __forceinline__ void hgrn_prep_phase(Frame& F, int layer, bf16* QBO, int qbld, bf16* OBO) {
    bf16* BIG = (bf16*)(F.ws + WS_BIG); bf16* KLT = (bf16*)(F.ws + WS_KLT); bf16* ITG = (bf16*)(F.ws + WS_IT); float* EBL = (float*)(F.ws + WS_EBL); bf16* OB = (bf16*)(F.ws + WS_OB);
    const float* lbl = F.a->in[20];
    LAS unsigned char* QS = F.lds; LAS unsigned char* KS = F.lds + 64 * H_P256; LAS unsigned char* ITL = F.lds + 2 * 64 * H_P256; LAS float* TOT = (LAS float*)(F.lds + 2 * 64 * H_P256 + 128 * H_P128);
    const int kp = F.lane, seg = F.wave, r32 = F.lane & 31, hi = F.lane >> 5;
    unsigned qw[8], fw[8], iw[8]; f32x2_cv lgt[4];
#define H1_LOAD(un) do { const int bh_ = (un) >> 7, c_ = (un) & 127; const size_t rb_ = (size_t)(bh_ >> 4) * SEQ + (size_t)c_ * 64; \
        _Pragma("unroll") for (int L_ = 0; L_ < 4; ++L_) lgt[L_] = *(const GAS f32x2_cv*)(lbl + L_ * DM + (bh_ & 15) * 128 + 2 * kp); \
        _Pragma("unroll") for (int tt = 0; tt < 8; ++tt) { const bf16* pq = BIG + (rb_ + 8 * seg + tt) * 8192 + (bh_ & 15) * 128 + 2 * kp; \
            qw[tt] = *(const GAS unsigned*)pq; fw[tt] = *(const GAS unsigned*)(pq + 2048); iw[tt] = *(const GAS unsigned*)(pq + 4096); } } while (0)
    for (int unit = F.vcu; unit < NB * NH * (SEQ / 64); unit += F.G) {
        const int bh = unit >> 7, c = unit & 127, b = bh >> 4, h = bh & 15; const size_t rowbase = (size_t)b * SEQ + (size_t)c * 64;
        if (unit == F.vcu) H1_LOAD(unit);
        float lb[2];
#pragma unroll
        for (int kk = 0; kk < 2; ++kk) { const float l0 = lgt[0][kk], l1 = lgt[1][kk], l2 = lgt[2][kk], l3 = lgt[3][kk];
            const float mx = fmaxf(fmaxf(l0, l1), fmaxf(l2, l3)); const float e0 = __expf(l0 - mx), e1 = __expf(l1 - mx), e2 = __expf(l2 - mx), e3 = __expf(l3 - mx);
            float cumv = 0.f; if (layer >= 1) cumv += e1; if (layer >= 2) cumv += e2; if (layer >= 3) cumv += e3;
            lb[kk] = cumv * __builtin_amdgcn_rcpf(e0 + e1 + e2 + e3); }
        float bcs[8][2], kv[8][2]; float cum[2] = {0.f, 0.f};
#pragma unroll
        for (int tt = 0; tt < 8; ++tt)
#pragma unroll
            for (int kk = 0; kk < 2; ++kk) { const float x = kk ? bf_hi(fw[tt]) : bf_lo(fw[tt]); const float sig = __builtin_amdgcn_rcpf(1.0f + __expf(-x));
                const float f = lb[kk] + (1.0f - lb[kk]) * sig; cum[kk] += __builtin_amdgcn_logf(f) * 0.6931471805599453f;     bcs[tt][kk] = cum[kk]; kv[tt][kk] = 1.0f - f; }
        TOT[seg * 128 + 2 * kp] = cum[0]; TOT[seg * 128 + 2 * kp + 1] = cum[1];
        LDS_BAR();
        float off[2] = {0.f, 0.f}, rb[2] = {0.f, 0.f}, bl[2] = {0.f, 0.f};
#pragma unroll
        for (int s = 0; s < 8; ++s)
#pragma unroll
            for (int kk = 0; kk < 2; ++kk) { const float tv = TOT[s * 128 + 2 * kp + kk]; if (s < seg) off[kk] += tv; if (s < 4) rb[kk] += tv; bl[kk] += tv; }
        float erb[2], enrb[2], ebl[2];
#pragma unroll
        for (int kk = 0; kk < 2; ++kk) { erb[kk] = __expf(rb[kk]); enrb[kk] = __expf(-rb[kk]); ebl[kk] = __expf(bl[kk]); }
        unsigned klw[2][4], itw[2][4];
#pragma unroll
        for (int tt = 0; tt < 8; ++tt) { float qb_[2], qs_[2], ks_[2], kl_[2];
#pragma unroll
            for (int kk = 0; kk < 2; ++kk) { const float bb = bcs[tt][kk] + off[kk]; const float q = kk ? bf_hi(qw[tt]) : bf_lo(qw[tt]);
                const float eb = __expf(bb), enb = __builtin_amdgcn_rcpf(eb);
                qb_[kk] = q * eb; qs_[kk] = qb_[kk] * enrb[kk]; ks_[kk] = kv[tt][kk] * (erb[kk] * enb); kl_[kk] = kv[tt][kk] * (ebl[kk] * enb); }
            *(GAS unsigned*)(QBO + (rowbase + 8 * seg + tt) * qbld + h * 128 + 2 * kp) = pk2(qb_[0], qb_[1]);
            *(LAS unsigned*)(QS + (8 * seg + tt) * H_P256 + 4 * kp) = pk2(qs_[0], qs_[1]);
            *(LAS unsigned*)(KS + (8 * seg + tt) * H_P256 + 4 * kp) = pk2(ks_[0], ks_[1]);
            if (tt & 1) { klw[0][tt >> 1] |= f2bf(kl_[0]) << 16; klw[1][tt >> 1] |= f2bf(kl_[1]) << 16; itw[0][tt >> 1] |= (iw[tt] & 0xffffu) << 16; itw[1][tt >> 1] |= (iw[tt] >> 16) << 16; }
            else { klw[0][tt >> 1] = f2bf(kl_[0]); klw[1][tt >> 1] = f2bf(kl_[1]); itw[0][tt >> 1] = iw[tt] & 0xffffu; itw[1][tt >> 1] = iw[tt] >> 16; }
        }
#pragma unroll
        for (int kk = 0; kk < 2; ++kk) { const v4u kw = {klw[kk][0], klw[kk][1], klw[kk][2], klw[kk][3]}, tw = {itw[kk][0], itw[kk][1], itw[kk][2], itw[kk][3]};
            *(GAS v4u*)(KLT + (size_t)unit * 8192 + (2 * kp + kk) * 64 + 8 * seg) = kw;
            *(GAS v4u*)(ITG + (size_t)unit * 8192 + (2 * kp + kk) * 64 + 8 * seg) = tw;
            *(LAS v4u*)(ITL + (2 * kp + kk) * H_P128 + 16 * seg) = tw; }
        if (seg == 0) { EBL[(size_t)unit * 128 + 2 * kp] = ebl[0]; EBL[(size_t)unit * 128 + 2 * kp + 1] = ebl[1]; }
        LDS_BAR();
        if (unit + F.G < NB * NH * (SEQ / 64)) H1_LOAD(unit + F.G);
        const int tt_ = F.wave & 1, vt = F.wave >> 1;
        f32x16 z = {};
        for (int st = 0; st <= tt_; ++st) {
            f32x16 x = {};
            bf16x8 af[8], bqf[8];
#pragma unroll
            for (int step = 0; step < 8; ++step) { af[step] = *(const LAS bf16x8*)(KS + (32 * st + r32) * H_P256 + (16 * step + 8 * hi) * 2);
                bqf[step] = *(const LAS bf16x8*)(QS + (32 * tt_ + r32) * H_P256 + (16 * step + 8 * hi) * 2); }
#pragma unroll
            for (int step = 0; step < 8; ++step) x = __builtin_amdgcn_mfma_f32_32x32x16_bf16(af[step], bqf[step], x, 0, 0, 0);
            if (st == tt_) {
#pragma unroll
                for (int r = 0; r < 16; ++r) if (crow16(r, hi) > r32) x[r] = 0.f;
            }
#pragma unroll
            for (int sp = 0; sp < 2; ++sp) {
                v4u pw; pw.x = pk2(x[8 * sp + 0], x[8 * sp + 1]); pw.y = pk2(x[8 * sp + 2], x[8 * sp + 3]); pw.z = pk2(x[8 * sp + 4], x[8 * sp + 5]); pw.w = pk2(x[8 * sp + 6], x[8 * sp + 7]);
                const bf16x8 xs = __builtin_bit_cast(bf16x8, pw);
                const LAS unsigned char* ip = ITL + (32 * vt + r32) * H_P128 + (32 * st + 16 * sp + 4 * hi) * 2;
                const s16x4 lo = *(const LAS s16x4*)ip, hh = *(const LAS s16x4*)(ip + 16);
                const bf16x8 pb = __builtin_shufflevector(lo, hh, 0, 1, 2, 3, 4, 5, 6, 7);
                z = __builtin_amdgcn_mfma_f32_32x32x16_bf16(xs, pb, z, 0, 0, 0);
            }
        }
        bf16* op = OBO + (rowbase + 32 * tt_) * DM + h * 128 + 32 * vt + r32;
#pragma unroll
        for (int r = 0; r < 16; ++r) op[(size_t)crow16(r, hi) * DM] = (bf16)f2bf(z[r]);
        LDS_BAR();
    }
}
#undef H1_LOAD
__device__ __forceinline__ void hgrn_scan_phase(Frame& F, bf16* OBO) {
    const bf16* BIG = (const bf16*)(F.ws + WS_BIG); const bf16* KLT = (const bf16*)(F.ws + WS_KLT); const bf16* ITG = (const bf16*)(F.ws + WS_IT); const float* EBL = (const float*)(F.ws + WS_EBL); const bf16* OB = (const bf16*)(F.ws + WS_OB);
    constexpr int TB = 64 * H_P256 + 128 * H_P128 + 32 * H_P128 + 512;
    constexpr int STB = 32 * H_P256;
    constexpr int IOB = 64 * 64;
    LAS unsigned char* TL = F.lds; LAS unsigned char* STL = F.lds + 2 * TB; LAS unsigned char* ISL = STL + 2 * STB; LAS unsigned char* OSL = ISL + 2 * IOB;
    const int tid = F.tid, r32 = F.lane & 31, hi = F.lane >> 5, w = F.wave;
    for (int unit = F.vcu; unit < NB * NH * 4; unit += F.G) {
        const int bh = unit >> 2, vq = unit & 3, b = bh >> 4, h = bh & 15;
        f32x16 acc = {};
        v4u q0[2], k0[2], i0, e0, q1[2], k1[2], i1, e1, ivr[2];
        i0 = i1 = e0 = e1 = ivr[0] = ivr[1] = (v4u){(unsigned)tid >> 31, 0u, 0u, 0u};
        const int ioq = (F.lane + 64 * (w & 1));
#define H2_LOAD(Q, K, I, E, c) do { const size_t rb_ = (size_t)b * SEQ + (size_t)(c) * 64; const size_t un_ = (size_t)bh * 128 + (c); \
        _Pragma("unroll") for (int i_ = 0; i_ < 2; ++i_) { const int p_ = tid + 512 * i_; \
            Q[i_] = *(const GAS v4u*)(BIG + (rb_ + (p_ >> 4)) * 8192 + h * 128 + (p_ & 15) * 8); K[i_] = *(const GAS v4u*)(KLT + un_ * 8192 + (size_t)p_ * 8); } \
        if (tid < 256) I = *(const GAS v4u*)(ITG + un_ * 8192 + (size_t)(32 * vq) * 64 + (size_t)tid * 8); \
        if (tid < 32) E = *(const GAS v4u*)(EBL + un_ * 128 + 4 * tid); } while (0)
#define H2_WRITE(Q, K, I, E, bufo) do { LAS unsigned char* tb_ = TL + (bufo); _Pragma("unroll") for (int i_ = 0; i_ < 2; ++i_) { const int p_ = tid + 512 * i_; \
            *(LAS v4u*)(tb_ + (p_ >> 4) * H_P256 + (p_ & 15) * 16) = Q[i_]; *(LAS v4u*)(tb_ + 64 * H_P256 + (p_ >> 3) * H_P128 + (p_ & 7) * 16) = K[i_]; } \
        if (tid < 256) *(LAS v4u*)(tb_ + 64 * H_P256 + 128 * H_P128 + (tid >> 3) * H_P128 + (tid & 7) * 16) = I; \
        if (tid < 32) *(LAS v4u*)(tb_ + 64 * H_P256 + 128 * H_P128 + 32 * H_P128 + 16 * tid) = E; } while (0)
#define H2_IVLD(c) do { _Pragma("unroll") for (int j_ = 0; j_ < 2; ++j_) { const int q_ = ioq + 128 * j_; \
            ivr[j_] = *(const GAS v4u*)(OB + ((size_t)b * SEQ + (size_t)(c) * 64 + (q_ >> 2)) * DM + h * 128 + 32 * vq + (q_ & 3) * 8); } } while (0)
#define H2_IVST(slot) do { _Pragma("unroll") for (int j_ = 0; j_ < 2; ++j_) { const int q_ = ioq + 128 * j_; *(LAS v4u*)(ISL + (slot) * IOB + (q_ >> 2) * 64 + (q_ & 3) * 16) = ivr[j_]; } } while (0)
#define H2_OST(c, slot) do { _Pragma("unroll") for (int j_ = 0; j_ < 2; ++j_) { const int q_ = ioq + 128 * j_; const v4u v_ = *(const LAS v4u*)(OSL + (slot) * IOB + (q_ >> 2) * 64 + (q_ & 3) * 16); \
            *(GAS v4u*)(OBO + ((size_t)b * SEQ + (size_t)(c) * 64 + (q_ >> 2)) * DM + h * 128 + 32 * vq + (q_ & 3) * 8) = v_; } } while (0)
#define H2_STEP(c, cur, Qn, Kn, In, En) do { LAS unsigned char* tb_ = TL + (cur) * TB; LAS unsigned char* st_ = STL + (cur) * STB; \
          \
          \
        if (w >= 6 && (c) + 1 < SEQ / 64) H2_IVST((cur) ^ 1);      \
        if ((c) + 1 < SEQ / 64) H2_WRITE(Qn, Kn, In, En, ((cur) ^ 1) * TB); \
        if (w >= 6) { if ((c) + 2 < SEQ / 64) H2_IVLD((c) + 2); \
            if ((c) >= 1) H2_OST((c) - 1, (cur) ^ 1); }             \
        if ((c) + 3 < SEQ / 64) H2_LOAD(Qn, Kn, In, En, (c) + 3); \
        if (w < 4) { const LAS float* eb_ = (const LAS float*)(tb_ + 64 * H_P256 + 128 * H_P128 + 32 * H_P128); \
            _Pragma("unroll") for (int r = 0; r < 16; ++r) acc[r] *= eb_[32 * w + crow16(r, hi)]; \
            _Pragma("unroll") for (int step = 0; step < 4; ++step) { const bf16x8 a_ = *(const LAS bf16x8*)(tb_ + 64 * H_P256 + (32 * w + r32) * H_P128 + (16 * step + 8 * hi) * 2); \
                const bf16x8 b_ = *(const LAS bf16x8*)(tb_ + 64 * H_P256 + 128 * H_P128 + r32 * H_P128 + (16 * step + 8 * hi) * 2); acc = __builtin_amdgcn_mfma_f32_32x32x16_bf16(a_, b_, acc, 0, 0, 0); } \
            LAS unsigned char* sn_ = STL + ((cur) ^ 1) * STB + r32 * H_P256 + (32 * w + 4 * hi) * 2; \
            _Pragma("unroll") for (int g = 0; g < 4; ++g) *(LAS unsigned long long*)(sn_ + 16 * g) = (unsigned long long)pk2(acc[4 * g], acc[4 * g + 1]) | ((unsigned long long)pk2(acc[4 * g + 2], acc[4 * g + 3]) << 32); \
        } else if (w < 6) { f32x16 o_ = {}; \
            _Pragma("unroll") for (int step = 0; step < 8; ++step) { const bf16x8 a_ = *(const LAS bf16x8*)(tb_ + (32 * (w - 4) + r32) * H_P256 + (16 * step + 8 * hi) * 2); \
                const bf16x8 b_ = *(const LAS bf16x8*)(st_ + r32 * H_P256 + (16 * step + 8 * hi) * 2); o_ = __builtin_amdgcn_mfma_f32_32x32x16_bf16(a_, b_, o_, 0, 0, 0); } \
            const int so_ = (32 * (w - 4) + 4 * hi) * 64 + r32 * 2; bf16 iv_[16]; \
            _Pragma("unroll") for (int r = 0; r < 16; ++r) iv_[r] = *(const LAS bf16*)(ISL + (cur) * IOB + so_ + ((r & 3) + 8 * (r >> 2)) * 64);     \
            _Pragma("unroll") for (int r = 0; r < 16; ++r) *(LAS bf16*)(OSL + (cur) * IOB + so_ + ((r & 3) + 8 * (r >> 2)) * 64) = (bf16)f2bf(o_[r] + bf_f(iv_[r])); } \
        LDS_BAR(); } while (0)
        { const unsigned zz = (unsigned)tid >> 31;
          for (int i = tid; i < STB / 16; i += NWAVES * 64) *(LAS v4u*)(STL + 16 * i) = (v4u){zz, zz, zz, zz}; }
        H2_LOAD(q0, k0, i0, e0, 0); H2_WRITE(q0, k0, i0, e0, 0);
        H2_LOAD(q1, k1, i1, e1, 1); H2_LOAD(q0, k0, i0, e0, 2);
        if (w >= 6) { H2_IVLD(0); H2_IVST(0); H2_IVLD(1); }
        LDS_BAR();
#pragma unroll 1
        for (int c = 0; c < SEQ / 64; c += 2) {
            H2_STEP(c, 0, q1, k1, i1, e1);
            H2_STEP(c + 1, 1, q0, k0, i0, e0);
        }
        if (w >= 6) H2_OST(SEQ / 64 - 1, 1);
        LDS_BAR();
#undef H2_LOAD
#undef H2_WRITE
#undef H2_IVLD
#undef H2_IVST
#undef H2_OST
#undef H2_STEP
    }
}
__device__ __forceinline__ void hgrn_final_phase(Frame& F, bf16* OBO) {
    const bf16* BIG = (const bf16*)(F.ws + WS_BIG); bf16* OB = (bf16*)(F.ws + WS_OB); const float* gn = F.a->in[19];
    const int gw = F.vcu * NWAVES + F.wave, NGW = F.G * NWAVES;
    const int dv = (F.lane & 15) * 8;
    const f32x4 g0 = *(const f32x4*)(gn + dv), g1 = *(const f32x4*)(gn + dv + 4);
    for (int row = gw; row < MT; row += NGW) {
        GAS v4u* po = (GAS v4u*)(OB + (size_t)row * DM) + F.lane; const GAS v4u* pg = (const GAS v4u*)(BIG + (size_t)row * 8192 + 6144) + F.lane;
        v4u wo[4], wg[4];
#pragma unroll
        for (int it = 0; it < 4; ++it) { wo[it] = po[64 * it]; wg[it] = pg[64 * it]; }
#pragma unroll
        for (int it = 0; it < 4; ++it) { float x[8], gg[8]; unpack8(wo[it], x); unpack8(wg[it], gg);
            float ss = 0.f;
#pragma unroll
            for (int i = 0; i < 8; ++i) ss += x[i] * x[i];
            ss += sx<1>(ss); ss += sx<2>(ss); ss += sx<4>(ss); ss += sx<8>(ss);
            const float rstd = rsqrtf(ss * (1.0f / 128.0f) + RMS_EPS);
            float y[8];
#pragma unroll
            for (int i = 0; i < 8; ++i) { const float gi = (i < 4) ? g0[i] : g1[i - 4]; y[i] = x[i] * rstd * gi * (gg[i] * __builtin_amdgcn_rcpf(1.0f + __expf(-gg[i]))); }
            v4u o; o.x = pk2(y[0], y[1]); o.y = pk2(y[2], y[3]); o.z = pk2(y[4], y[5]); o.w = pk2(y[6], y[7]);
            ((GAS v4u*)(OBO + (size_t)row * DM) + F.lane)[64 * it] = o; }
    }
}
__device__ __forceinline__ bool ph_refresh(Frame& F) { unsigned m = ~0u; asm volatile("" : "+s"(m));
    const int t = (F.wave << 6) | (int)__builtin_amdgcn_mbcnt_hi(m, __builtin_amdgcn_mbcnt_lo(m, 0u));
    F.tid = t; F.lane = t & 63; return true; }
__global__ void __launch_bounds__(NWAVES * 64, 2) trunk_fwd(Args args) {
    extern __shared__ __attribute__((aligned(16))) unsigned char lds[];
    Frame F;
    F.lds = (LAS unsigned char*)lds;
    F.MISC = (volatile LAS unsigned*)(F.lds + MISC_OFF);
    F.tid = threadIdx.x; F.lane = F.tid & 63; F.wave = __builtin_amdgcn_readfirstlane(F.tid >> 6);
    F.G = gridDim.x; { const int bx = blockIdx.x; F.vcu = (F.G % 8 == 0) ? (bx % 8) * (F.G / 8) + bx / 8 : bx; }
    F.ws = args.ws; F.ctl = (gu32*)(args.ws + WS_CTL); F.out = args.out;
    F.a = &args;
    for (int u = F.tid; u < (LDS_BYTES - LDSCTL_OFF) / 4; u += NWAVES * 64) ((LAS unsigned*)(F.lds + LDSCTL_OFF))[u] = 0u;
    __syncthreads();
    XcdBarrier bar; bar.bar = (unsigned*)(F.ctl + CW_BAR); bar.x = 0; bar.st = nullptr;
    if (!MK_PER_PHASE) bar = xcd_barrier_post((unsigned*)(F.ctl + CW_BAR), F.MISC + 8);
    const int lo = args.ph_lo, hi = args.ph_hi;
    int pc = 0;
    unsigned long long t_ph = PROBE_ECHO ? __builtin_amdgcn_s_memrealtime() : 0ull;
#define PH_ON (pc >= lo && pc < hi && ph_refresh(F))
#define PH_END_C(cls) do { if (!MK_PER_PHASE && pc >= lo && pc + 1 < hi) { const unsigned long long ta_ = (PROBE_IDLE && (PROBE_IDLE == 100 || PROBE_IDLE == (cls))) ? __builtin_amdgcn_s_memrealtime() : 0ull; xcd_barrier(bar); if (PROBE_MASK & 32) xcd_barrier(bar); \
        if (PROBE_IDLE && (PROBE_IDLE == 100 || PROBE_IDLE == (cls))) { const unsigned long long t1_ = __builtin_amdgcn_s_memrealtime(), d_ = t1_ - ta_; while (__builtin_amdgcn_s_memrealtime() - t1_ < d_) __builtin_amdgcn_s_sleep(8); xcd_barrier(bar); } \
        if (PROBE_ECHO == (cls)) { const unsigned long long t1_ = __builtin_amdgcn_s_memrealtime(), d_ = t1_ - t_ph; while (__builtin_amdgcn_s_memrealtime() - t1_ < d_) __builtin_amdgcn_s_sleep(8); xcd_barrier(bar); } \
        if (PROBE_ECHO) t_ph = __builtin_amdgcn_s_memrealtime(); } ++pc; } while (0)
#define PH_END PH_END_C(0)
    float* mod = (float*)(F.ws + WS_MOD);
    bf16* XN = (bf16*)(F.ws + WS_XN); bf16* BIG = (bf16*)(F.ws + WS_BIG); bf16* OB = (bf16*)(F.ws + WS_OB);
    float* RSS = (float*)(F.ws + WS_RSS); const float* CB = (const float*)(F.ws + WS_CB);
    if (PH_ON) { p0_mod(F); __syncthreads(); p0_convert(F); }
#if PROBE_MASK & 16
    if (PH_ON) { __syncthreads(); p0_mod(F); __syncthreads(); p0_convert(F); }
#endif
    PH_END_C(1);
    if (PH_ON) { tables_phase(F); bias_phase(F); xs0_phase(F, F.a->in[0], F.a->in[4], mod); }
#if PROBE_MASK & 16384
    if (PH_ON) { tables_phase(F); bias_phase(F); xs0_phase(F, F.a->in[0], F.a->in[4], mod); }
#endif
    PH_END_C(2);
#pragma unroll 1
    for (int L = 0; L < NLAYER; ++L) {
        const int kind = L % 3, slot = L / 3;
        const float* modL = mod + (size_t)L * NB * NMOD;
#pragma unroll 1
        for (int sub = 0; sub < 3; ++sub) {
            const int s = 3 * L + sub;
            const float* rss = RSS + (size_t)s * MT; const float* cb = CB + (size_t)s * NB * CB_LD;
            const bf16* outA; const bf16* outB; int outK;
            const int nhalf = (sub != 1) ? FFN_SPLIT : 1;
#pragma unroll 1
            for (int hf = 0; hf < nhalf; ++hf) {
            const int Mpart = MT / nhalf, pm_off = hf * (Mpart / 256);
            if (sub != 1) {
                const int ls = L * 2 + (sub >> 1);
                if (PH_ON) { pg8::Gemm g{XN, (const bf16*)(F.ws + WS_WGU) + (size_t)ls * 2 * FF * DM, Mpart, 2 * FF, DM, 1, 1}; pg8::StaticOrder S; S.init(Mpart, 2 * FF, F.G, (int)blockIdx.x, GU_WGM, pm_off);
                    pg8::EpiSwigluN E{BIG, FF, rss, cb, CB_LD, SEQ, F.lds + PRE_OFF};
#pragma unroll 1
                    for (int rep = 0; rep < ((PROBE_MASK & 1) ? 2 : 1); ++rep) { if (rep) __syncthreads(); pg8::gemm_phase<pg8::EpiSwigluN, pg8::StaticOrder, true, true>(F.lds + RING_OFF, g, S, E, F.tid); }
                    }
                PH_END_C(3);
                outA = BIG; outB = (const bf16*)(F.ws + WS_WD) + (size_t)ls * DM * FF; outK = FF;
            } else {
                const int nin = (kind == 2) ? 4 * DM : 3 * DM;
                const bf16* win = (kind == 0) ? (const bf16*)(F.ws + WS_WAI) + (size_t)slot * 3 * DM * DM : (kind == 1) ? (const bf16*)(F.ws + WS_WCI) : (const bf16*)(F.ws + WS_WHI);
                if (PH_ON) { pg8::Gemm g{XN, win, MT, nin, DM, 1, 1}; pg8::StaticOrder S; S.init(MT, nin, F.G, (int)blockIdx.x, GU_WGM);
                    pg8::EpiInN E{BIG, nin, rss, cb, CB_LD, SEQ, (kind == 0) ? 16 : 0, F.a->in[10] + (size_t)slot * 64, F.a->in[11] + (size_t)slot * 64, F.lds + PRE_OFF};
#pragma unroll 1
                    for (int rep = 0; rep < ((PROBE_MASK & 4) ? 2 : 1); ++rep) { if (rep) __syncthreads(); pg8::gemm_phase<pg8::EpiInN, pg8::StaticOrder, true, true>(F.lds + RING_OFF, g, S, E, F.tid); }
                    }
                PH_END_C(5);
                if (kind == 0) {
#if PROBE_MASK & 8192
                    if (PH_ON) { attn_phase(F, L, slot, 1); __syncthreads(); }
#endif
                    if (PH_ON) attn_phase(F, L, slot);
                    PH_END_C(7);
                } else if (kind == 1) {
                    if (PH_ON) conv_phase(F);
                    PH_END_C(8);
                } else {
#if PROBE_MASK & 64
                    if (PH_ON) { hgrn_prep_phase(F, L, XN, DM, XN); __syncthreads(); }
#endif
                    if (PH_ON) hgrn_prep_phase(F, L, BIG, 8192, OB);
                    PH_END_C(9);
#if PROBE_MASK & 128
                    if (PH_ON) { hgrn_scan_phase(F, XN); __syncthreads(); }
#endif
                    if (PH_ON) hgrn_scan_phase(F, OB);
                    PH_END_C(10);
                    if (PH_ON) hgrn_final_phase(F, OB);
                    PH_END_C(11);
                }
                outA = OB; outB = (kind == 0) ? (const bf16*)(F.ws + WS_WAO) + (size_t)slot * DM * DM : (kind == 1) ? (const bf16*)(F.ws + WS_WCO) : (const bf16*)(F.ws + WS_WHO); outK = DM;
            }
            if (PH_ON) { pg8::Gemm g{outA, outB, Mpart, DM, outK, (sub != 1) ? 1 : 0, 1};     pg8::StaticOrder S; S.init(Mpart, DM, F.G, (int)blockIdx.x, OUT_WGM, pm_off);
                const int sn = s + 1; const bool last = (s == 3 * NLAYER - 1);
                const float* TAB = (const float*)(F.ws + WS_TAB);
                pg8::EpiResN E{(s == 0) ? (const void*)F.a->in[0] : (const void*)(F.ws + WS_XH), last ? (void*)F.out : (void*)(F.ws + WS_XH), (s == 0) ? 1 : 0, last ? 1 : 0, DM, TAB + (size_t)(s * 2 + 0) * NB * DM, TAB + (size_t)(s * 2 + 1) * NB * DM, DM, SEQ, last ? (bf16*)nullptr : XN, RSS + (size_t)sn * MT, F.lds + PRE_OFF, 1.0f};
#pragma unroll 1
                for (int rep = (((PROBE_MASK & 2) || ((PROBE_MASK & 2048) && sub != 1) || ((PROBE_MASK & 4096) && sub == 1)) ? 0 : 1); rep < 2; ++rep) {
                    pg8::EpiResN E2 = E;
#if PROBE_MASK & (2 | 2048 | 4096)
                    { const bool dbl = (PROBE_MASK & 2) || ((PROBE_MASK & 2048) && sub != 1) || ((PROBE_MASK & 4096) && sub == 1);
                      if (dbl) { E2.gscale = 0.5f; if (rep == 0) { E2.rssn = RSS + (size_t)12 * MT; if (last) { E2.out = (void*)(F.ws + WS_XH); E2.out_f32 = 0; } } else if (s == 0) { E2.base = (const void*)(F.ws + WS_XH); E2.base_f32 = 0; } } }
#endif
                    if (rep == 0) __syncthreads();
                    pg8::gemm_phase<pg8::EpiResN, pg8::StaticOrder, true, true, OUT_A_AUX>(F.lds + RING_OFF, g, S, E2, F.tid); if (rep == 0) __syncthreads(); } }
            PH_END_C((sub != 1) ? 4 : 6);
            }
        }
    }
#undef PH_ON
#undef PH_END
#undef PH_END_C
}
extern "C" void kernel_launch(void* const* d_in, const int* in_sizes, int n_in, void* d_out, int out_size, void* d_ws, size_t ws_size, hipStream_t stream) {
    static int grid = 0;
    if (grid == 0) {
        if (n_in != 21 || in_sizes[0] != MT * DM || out_size != MT * DM || ws_size < WS_END) { fprintf(stderr, "kernel_launch: shape/workspace mismatch (n_in %d, in0 %d, out %d, ws %zu, need %zu); nothing launched\n", n_in, n_in > 0 ? in_sizes[0] : -1, out_size, ws_size, (size_t)WS_END); grid = -1; return; }
        int dev = 0, cus = 0, per_cu = 0;
        if (hipGetDevice(&dev) != hipSuccess || hipDeviceGetAttribute(&cus, hipDeviceAttributeMultiprocessorCount, dev) != hipSuccess) { fprintf(stderr, "kernel_launch: device query failed\n"); grid = -1; return; }
        if (hipFuncSetAttribute((const void*)trunk_fwd, hipFuncAttributeMaxDynamicSharedMemorySize, LDS_BYTES) != hipSuccess) { fprintf(stderr, "kernel_launch: hipFuncSetAttribute failed\n"); grid = -1; return; }
        if (hipOccupancyMaxActiveBlocksPerMultiprocessor(&per_cu, (const void*)trunk_fwd, NWAVES * 64, LDS_BYTES) != hipSuccess || per_cu < 1) fprintf(stderr, "kernel_launch: note: occupancy query reports %d workgroups per CU\n", per_cu);
        (void)hipGetLastError();
        grid = cus;
    }
    if (grid < 0) return;
    if (hipMemsetAsync((char*)d_ws + WS_CTL, 0, CTL_ZERO_BYTES, stream) != hipSuccess) { fprintf(stderr, "kernel_launch: memset failed\n"); return; }
    Args a{};
    for (int i = 0; i < 21; ++i) a.in[i] = (const float*)d_in[i];
    a.out = (float*)d_out; a.ws = (unsigned char*)d_ws;
#if MK_PER_PHASE
    for (int p = 0; p < N_PHASES; ++p) { a.ph_lo = p; a.ph_hi = p + 1; hipLaunchKernelGGL(trunk_fwd, dim3(grid), dim3(NWAVES * 64), LDS_BYTES, stream, a); }
#else
    a.ph_lo = 0; a.ph_hi = N_PHASES;
    hipLaunchKernelGGL(trunk_fwd, dim3(grid), dim3(NWAVES * 64), LDS_BYTES, stream, a);
#endif
    const hipError_t le = hipPeekAtLastError();
    if (le != hipSuccess) fprintf(stderr, "kernel_launch: launch failed: %s\n", hipGetErrorName(le));
}
```

```cpp
#include <hip/hip_runtime.h>
#include <cstdio>
#include <cstdint>
template <int X> __device__ __forceinline__ float sx(float v) { return __int_as_float(__builtin_amdgcn_ds_swizzle(__float_as_int(v), (X << 10) | 0x1f)); }
__device__ __forceinline__ float sum32(float v) { auto rr = __builtin_amdgcn_permlane32_swap(__float_as_uint(v), __float_as_uint(v), false, false); return __uint_as_float(rr[0]) + __uint_as_float(rr[1]); }
__device__ __forceinline__ float max32(float v) { auto rr = __builtin_amdgcn_permlane32_swap(__float_as_uint(v), __float_as_uint(v), false, false); return fmaxf(__uint_as_float(rr[0]), __uint_as_float(rr[1])); }
__device__ __forceinline__ float wave_sum(float v) { v += sx<1>(v); v += sx<2>(v); v += sx<4>(v); v += sx<8>(v); v += sx<16>(v); return sum32(v); }
__device__ __forceinline__ float wave_max(float v) { v = fmaxf(v, sx<1>(v)); v = fmaxf(v, sx<2>(v)); v = fmaxf(v, sx<4>(v)); v = fmaxf(v, sx<8>(v)); v = fmaxf(v, sx<16>(v)); return max32(v); }
typedef float f32x2_cv __attribute__((ext_vector_type(2))); typedef __bf16 bf16x2_cv __attribute__((ext_vector_type(2)));
__device__ __forceinline__ unsigned pk2(float lo, float hi) { const f32x2_cv v = {lo, hi}; const bf16x2_cv b = __builtin_convertvector(v, bf16x2_cv); return __builtin_bit_cast(unsigned, b); }
__device__ __forceinline__ unsigned f2bf(float f) { return pk2(f, 0.f) & 0xffffu; }
namespace pg8 {
#define PG8_LAS __attribute__((address_space(3)))
typedef unsigned short bf16_t;
typedef short bf16x8 __attribute__((ext_vector_type(8)));
typedef float f32x4 __attribute__((ext_vector_type(4)));
typedef unsigned u32x4 __attribute__((ext_vector_type(4)));
constexpr int BM = 256, BK = 64, HALF = 128, HTB = HALF * BK * 2  , STAGE_BYTES = 8 * HTB, NXCD = 8, WGM = 8;

__host__ __device__ __forceinline__ int lds_byte(int r, int c) { const int st = (r >> 4) * 2 + (c >> 5), rr = r & 15, cc = c & 31, ob = rr * 64 + cc * 2; return st * 1024 + (ob ^ (((ob >> 9) & 1) << 5)); }
__host__ __device__ __forceinline__ void stage_rc(int b, int& R, int& C) { const int st = b / 1024, sb = b % 1024, swz = sb ^ (((sb >> 9) & 1) << 5); R = (st >> 1) * 16 + swz / 64; C = (st & 1) * 32 + (swz % 64) / 2; }
__host__ __device__ __forceinline__ int perm32(int rho) { const int n = rho >> 4, i = rho & 15; return 8 * (i >> 2) + 4 * n + (i & 3); }

struct Unit { int pm, pn; };
struct Gemm { const bf16_t* A; const bf16_t* Bt; int M, N, K; int a_tiled = 0, b_tiled = 0; };

struct StaticOrder {
    int nM, nN, nwg, G, c, wgm, pm_off;
    __host__ __device__ void init(int M, int N, int G_, int c_, int wgm_ = WGM, int pm_off_ = 0) { nM = M / BM; nN = N / BM; nwg = nM * nN; G = G_; c = c_; wgm = wgm_; pm_off = pm_off_; }
    __host__ __device__ bool next(int i, Unit& u) const {
        const long L = (long)i * G + c; if (L >= nwg) return false;
        int wgid = (int)L; { const int q = nwg / NXCD, r = nwg % NXCD, xcd = wgid % NXCD, off = wgid / NXCD; wgid = (xcd < r ? xcd * (q + 1) : r * (q + 1) + (xcd - r) * q) + off; }
        const int nig = wgm * nN, gid = wgid / nig, fm = gid * wgm, gsz = (nM - fm) < wgm ? (nM - fm) : wgm;
        u.pm = pm_off + fm + ((wgid % nig) % gsz); u.pn = (wgid % nig) / gsz; return true;
    }
    __device__ __forceinline__ void a_ready(const Unit&) const {}
    __device__ __forceinline__ void done(const Unit&) const {}
};

__device__ __forceinline__ unsigned cvt_pk_bf16(float lo, float hi) { unsigned r; asm volatile("v_cvt_pk_bf16_f32 %0, %1, %2" : "=v"(r) : "v"(lo), "v"(hi)); return r; }
typedef float f32x2 __attribute__((ext_vector_type(2)));
typedef unsigned u32x2 __attribute__((ext_vector_type(2)));
struct EpiStore {
    static constexpr bool HAS_PRE = false;
    static constexpr bool PERM = true, AFTER_DRAIN = false;
    bf16_t* O; int ldc;
    __device__ __forceinline__ void operator()(const f32x4 (&acc)[2][2][4][2], const Unit& u, int wr, int wc, int fr, int fq) const {
        const int row0 = u.pm * BM + wr * 64 + fr, col0 = u.pn * BM + wc * 32 + 8 * fq;
#pragma unroll
        for (int ai = 0; ai < 2; ++ai)
#pragma unroll
            for (int m = 0; m < 4; ++m) { bf16_t* rowp = O + (size_t)(row0 + ai * HALF + m * 16) * ldc + col0;
#pragma unroll
                for (int bj = 0; bj < 2; ++bj) { const f32x4 v0 = acc[ai][bj][m][0], v1 = acc[ai][bj][m][1];
                    u32x4 w; w.x = cvt_pk_bf16(v0[0], v0[1]); w.y = cvt_pk_bf16(v0[2], v0[3]); w.z = cvt_pk_bf16(v1[0], v1[1]); w.w = cvt_pk_bf16(v1[2], v1[3]);
                    *(u32x4*)(rowp + bj * HALF) = w; } }
    }
};
__device__ __forceinline__ float swiglu1(float g, float u) { const float e = __builtin_amdgcn_exp2f(g * -1.4426950408889634f); return g * u * __builtin_amdgcn_rcpf(1.0f + e); }
struct EpiSwiglu {
    static constexpr bool HAS_PRE = false;
    static constexpr bool PERM = true, AFTER_DRAIN = false;
    bf16_t* O; int ldc;
    __device__ __forceinline__ void operator()(const f32x4 (&acc)[2][2][4][2], const Unit& u, int wr, int wc, int fr, int fq) const {
        const int row0 = u.pm * BM + wr * 64 + fr, col0 = u.pn * HALF + wc * 32 + 8 * fq;
#pragma unroll
        for (int ai = 0; ai < 2; ++ai)
#pragma unroll
            for (int m = 0; m < 4; ++m) { bf16_t* rowp = O + (size_t)(row0 + ai * HALF + m * 16) * ldc + col0;
                const f32x4 g0 = acc[ai][0][m][0], g1 = acc[ai][0][m][1], u0 = acc[ai][1][m][0], u1 = acc[ai][1][m][1];
                u32x4 w;
                w.x = cvt_pk_bf16(swiglu1(g0[0], u0[0]), swiglu1(g0[1], u0[1])); w.y = cvt_pk_bf16(swiglu1(g0[2], u0[2]), swiglu1(g0[3], u0[3]));
                w.z = cvt_pk_bf16(swiglu1(g1[0], u1[0]), swiglu1(g1[1], u1[1])); w.w = cvt_pk_bf16(swiglu1(g1[2], u1[2]), swiglu1(g1[3], u1[3]));
                *(u32x4*)rowp = w; }
    }
};
struct EpiRes {
    static constexpr bool HAS_PRE = false;
    static constexpr bool PERM = false, AFTER_DRAIN = false;
    const float* base; float* out; int ldc; const float* gate; int gstride; float coef; int rows_per_batch;
    __device__ __forceinline__ void operator()(const f32x4 (&acc)[2][2][4][2], const Unit& u, int wr, int wc, int fr, int fq) const {
        const int row0 = u.pm * BM + wr * 64 + fr, col0 = u.pn * BM + wc * 32 + 4 * fq;
        const float* gp = gate + (size_t)((u.pm * BM) / rows_per_batch) * gstride + col0;
        f32x4 gv[2][2];
#pragma unroll
        for (int bj = 0; bj < 2; ++bj)
#pragma unroll
            for (int n = 0; n < 2; ++n) gv[bj][n] = *(const f32x4*)(gp + bj * HALF + n * 16) * coef;
#pragma unroll
        for (int ai = 0; ai < 2; ++ai)
#pragma unroll
            for (int m = 0; m < 4; ++m) { const size_t off = (size_t)(row0 + ai * HALF + m * 16) * ldc + col0;
#pragma unroll
                for (int bj = 0; bj < 2; ++bj)
#pragma unroll
                    for (int n = 0; n < 2; ++n) { const f32x4 bs = *(const f32x4*)(base + off + bj * HALF + n * 16); *(f32x4*)(out + off + bj * HALF + n * 16) = bs + gv[bj][n] * acc[ai][bj][m][n]; }
                if (m & 1) asm volatile("" ::: "memory"); }
    }
};
__device__ __forceinline__ float rstd_of(const float* rss, int row) { return rsqrtf(rss[row] * (1.0f / 2048.0f) + 1e-6f); }
struct EpiSwigluN {
    static constexpr bool HAS_PRE = true;
    static constexpr bool PERM = true, AFTER_DRAIN = false;
    bf16_t* O; int ldc; const float* rss; const float* cb; int cbstride; int rows_per_batch; PG8_LAS unsigned char* pre_lds;
    __device__ __forceinline__ void pre(const Unit& u, int lane) const {
        __builtin_amdgcn_global_load_lds((const unsigned*)(cb + (size_t)((u.pm * BM) / rows_per_batch) * cbstride + u.pn * BM + 4 * lane), (PG8_LAS unsigned*)pre_lds, 16, 0, 0);
        __builtin_amdgcn_global_load_lds((const unsigned*)(rss + u.pm * BM + 4 * lane), (PG8_LAS unsigned*)(pre_lds + 1024), 16, 0, 0); }
    __device__ __forceinline__ void operator()(const f32x4 (&acc)[2][2][4][2], const Unit& u, int wr, int wc, int fr, int fq) const {
        const int col0 = u.pn * HALF + wc * 32 + 8 * fq;
        const PG8_LAS float* cbp = (const PG8_LAS float*)pre_lds + wc * 32 + 8 * fq; const PG8_LAS float* rp = (const PG8_LAS float*)(pre_lds + 1024) + wr * 64 + fr;
        constexpr float LC = 1.4426950408889634f, ILC = 0.6931471805599453f;
        const f32x4 cg0 = *(const PG8_LAS f32x4*)(cbp) * LC, cg1 = *(const PG8_LAS f32x4*)(cbp + 4) * LC, cu0 = *(const PG8_LAS f32x4*)(cbp + HALF) * ILC, cu1 = *(const PG8_LAS f32x4*)(cbp + HALF + 4) * ILC;
#pragma unroll
        for (int ai = 0; ai < 2; ++ai)
#pragma unroll
            for (int m = 0; m < 4; ++m) { const float rs = __builtin_amdgcn_rsqf(rp[ai * HALF + m * 16] * (1.0f / 2048.0f) + 1e-6f), rsg = rs * LC, rsu = rs * ILC;
                bf16_t* rowp = O + ((size_t)(u.pm * (ldc >> 6) + (col0 >> 6)) * BM + (wr * 64 + fr + ai * HALF + m * 16)) * 64 + (col0 & 63);
                const f32x4 h0 = acc[ai][0][m][0] * rsg + cg0, h1 = acc[ai][0][m][1] * rsg + cg1, u0 = acc[ai][1][m][0] * rsu + cu0, u1 = acc[ai][1][m][1] * rsu + cu1;
                f32x4 e0, e1;
#pragma unroll
                for (int i = 0; i < 4; ++i) { e0[i] = __builtin_amdgcn_exp2f(-h0[i]); e1[i] = __builtin_amdgcn_exp2f(-h1[i]); }
                e0 = e0 + 1.0f; e1 = e1 + 1.0f;
                f32x4 r0, r1;
#pragma unroll
                for (int i = 0; i < 4; ++i) { r0[i] = __builtin_amdgcn_rcpf(e0[i]); r1[i] = __builtin_amdgcn_rcpf(e1[i]); }
                const f32x4 o0 = (h0 * u0) * r0, o1 = (h1 * u1) * r1;
                u32x4 w;
                w.x = pk2(o0[0], o0[1]); w.y = pk2(o0[2], o0[3]); w.z = pk2(o1[0], o1[1]); w.w = pk2(o1[2], o1[3]);
                __builtin_nontemporal_store(w, (u32x4*)rowp); }
    }
};
struct EpiInN {
    static constexpr bool HAS_PRE = true;
    static constexpr bool PERM = true, AFTER_DRAIN = false;
    bf16_t* O; int ldc; const float* rss; const float* cb; int cbstride; int rows_per_batch; int nqk; const float* gq; const float* gk; PG8_LAS unsigned char* pre_lds;
    __device__ __forceinline__ void pre(const Unit& u, int lane) const {
        __builtin_amdgcn_global_load_lds((const unsigned*)(cb + (size_t)((u.pm * BM) / rows_per_batch) * cbstride + u.pn * BM + 4 * lane), (PG8_LAS unsigned*)pre_lds, 16, 0, 0);
        __builtin_amdgcn_global_load_lds((const unsigned*)(rss + u.pm * BM + 4 * lane), (PG8_LAS unsigned*)(pre_lds + 1024), 16, 0, 0); }
    __device__ __forceinline__ void operator()(const f32x4 (&acc)[2][2][4][2], const Unit& u, int wr, int wc, int fr, int fq) const {
        const int row0 = u.pm * BM + wr * 64 + fr, pc0 = u.pn * BM + wc * 32 + 8 * fq;
        const PG8_LAS float* cbp = (const PG8_LAS float*)pre_lds + wc * 32 + 8 * fq; const PG8_LAS float* rp = (const PG8_LAS float*)(pre_lds + 1024) + wr * 64 + fr;
        f32x4 cv[2][2];
#pragma unroll
        for (int bj = 0; bj < 2; ++bj)
#pragma unroll
            for (int n = 0; n < 2; ++n) cv[bj][n] = *(const PG8_LAS f32x4*)(cbp + bj * HALF + 4 * n);
        if (u.pn < nqk) {
            const bool isq = u.pn < (nqk >> 1); const float* gp = (isq ? gq : gk) + 8 * fq; const float gs = isq ? 0.125f * 1.4426950408889634f : 1.0f;
            f32x4 gv[2][2];
#pragma unroll
            for (int bj = 0; bj < 2; ++bj)
#pragma unroll
                for (int n = 0; n < 2; ++n) gv[bj][n] = *(const f32x4*)(gp + 32 * bj + 4 * n) * gs;
            const int lc0 = u.pn * BM + wc * 64 + 8 * fq;
#pragma unroll
            for (int ai = 0; ai < 2; ++ai)
#pragma unroll
                for (int m = 0; m < 4; ++m) { const int row = row0 + ai * HALF + m * 16; const float rs = rsqrtf(rp[ai * HALF + m * 16] * (1.0f / 2048.0f) + 1e-6f); bf16_t* rowp = O + (size_t)row * ldc + lc0;
                    f32x4 v[2][2]; float ss = 0.f;
#pragma unroll
                    for (int bj = 0; bj < 2; ++bj)
#pragma unroll
                        for (int n = 0; n < 2; ++n) { v[bj][n] = acc[ai][bj][m][n] * rs + cv[bj][n]; ss += (v[bj][n][0] * v[bj][n][0] + v[bj][n][1] * v[bj][n][1]) + (v[bj][n][2] * v[bj][n][2] + v[bj][n][3] * v[bj][n][3]); }
                    ss += sx<16>(ss); ss = sum32(ss);
                    const float rg = rsqrtf(ss * (1.0f / 64.0f) + 1e-6f);
#pragma unroll
                    for (int bj = 0; bj < 2; ++bj) { const f32x4 v0 = v[bj][0] * rg * gv[bj][0], v1 = v[bj][1] * rg * gv[bj][1];
                        u32x4 w; w.x = pk2(v0[0], v0[1]); w.y = pk2(v0[2], v0[3]); w.z = pk2(v1[0], v1[1]); w.w = pk2(v1[2], v1[3]);
                        if (isq) __builtin_nontemporal_store(w, (u32x4*)(rowp + 32 * bj)); else *(u32x4*)(rowp + 32 * bj) = w; } }
        } else {
#pragma unroll
            for (int ai = 0; ai < 2; ++ai)
#pragma unroll
                for (int m = 0; m < 4; ++m) { const int row = row0 + ai * HALF + m * 16; const float rs = rsqrtf(rp[ai * HALF + m * 16] * (1.0f / 2048.0f) + 1e-6f); bf16_t* rowp = O + (size_t)row * ldc + pc0;
#pragma unroll
                    for (int bj = 0; bj < 2; ++bj) { const f32x4 v0 = acc[ai][bj][m][0] * rs + cv[bj][0], v1 = acc[ai][bj][m][1] * rs + cv[bj][1];
                        u32x4 w; w.x = pk2(v0[0], v0[1]); w.y = pk2(v0[2], v0[3]); w.z = pk2(v1[0], v1[1]); w.w = pk2(v1[2], v1[3]);
                        *(u32x4*)(rowp + bj * HALF) = w; } }
        }
    }
};
typedef _Float16 f16x4 __attribute__((ext_vector_type(4)));
struct EpiResN {
    static constexpr bool HAS_PRE = true;
    static constexpr bool PERM = false, AFTER_DRAIN = false;
    const void* base; void* out; int base_f32, out_f32;
    int ldc; const float* gvt; const float* ant; int tstride; int rows_per_batch;
    bf16_t* xs; float* rssn; PG8_LAS unsigned char* pre_lds;
    float gscale;
    __device__ __forceinline__ void pre(const Unit& u, int lane) const {
        const size_t o = (size_t)((u.pm * BM) / rows_per_batch) * tstride + u.pn * BM + 4 * lane;
        __builtin_amdgcn_global_load_lds((const unsigned*)(gvt + o), (PG8_LAS unsigned*)pre_lds, 16, 0, 0);
        __builtin_amdgcn_global_load_lds((const unsigned*)(ant + o), (PG8_LAS unsigned*)(pre_lds + 1024), 16, 0, 0); }
    __device__ __forceinline__ void operator()(const f32x4 (&acc)[2][2][4][2], const Unit& u, int wr, int wc, int fr, int fq) const {
        const int col0 = u.pn * BM + wc * 32 + 4 * fq;
        const PG8_LAS float* gp = (const PG8_LAS float*)pre_lds + wc * 32 + 4 * fq;
        f32x4 gv[2][2], an[2][2];
#pragma unroll
        for (int bj = 0; bj < 2; ++bj)
#pragma unroll
            for (int n = 0; n < 2; ++n) { gv[bj][n] = *(const PG8_LAS f32x4*)(gp + bj * HALF + n * 16) * gscale; an[bj][n] = *(const PG8_LAS f32x4*)(gp + 256 + bj * HALF + n * 16); }
        if (base_f32) {
#pragma unroll
            for (int ai = 0; ai < 2; ++ai)
#pragma unroll
                for (int m = 0; m < 4; ++m) { const int rr = wr * 64 + fr + ai * HALF + m * 16; const unsigned off = (unsigned)((u.pm * BM + rr) * ldc + col0); float ss = 0.f;
                    const unsigned xso = ((unsigned)(u.pm * (ldc >> 6) + 4 * u.pn) * BM + rr) * 64u + 4u * fq;
#pragma unroll
                    for (int bj = 0; bj < 2; ++bj)
#pragma unroll
                        for (int n = 0; n < 2; ++n) { const unsigned o2 = off + bj * HALF + n * 16;
                            const f32x4 xn = *(const f32x4*)((const char*)base + 4u * o2) + gv[bj][n] * acc[ai][bj][m][n];
                            *(f16x4*)((char*)out + 2u * o2) = __builtin_convertvector(xn, f16x4);
                            ss += (xn[0] * xn[0] + xn[1] * xn[1]) + (xn[2] * xn[2] + xn[3] * xn[3]); const f32x4 h = xn * an[bj][n];
                            u32x2 w; w.x = pk2(h[0], h[1]); w.y = pk2(h[2], h[3]); *(u32x2*)((char*)xs + 2u * (xso + (unsigned)(2 * bj + (wc >> 1)) * (BM * 64) + (wc & 1) * 32 + n * 16)) = w; }
                    ss += sx<16>(ss); ss = sum32(ss); if (fq == 0) __hip_atomic_fetch_add(rssn + (u.pm * BM + rr), ss, __ATOMIC_RELAXED, __HIP_MEMORY_SCOPE_AGENT);
                    if (m & 1) asm volatile("" ::: "memory"); }
        } else {
            f16x4 bsv[2][4][2][2];
#pragma unroll
            for (int ai = 0; ai < 2; ++ai)
#pragma unroll
                for (int m = 0; m < 4; ++m)
#pragma unroll
                    for (int bj = 0; bj < 2; ++bj)
#pragma unroll
                        for (int n = 0; n < 2; ++n) bsv[ai][m][bj][n] = *(const f16x4*)((const char*)base + 2u * (unsigned)((u.pm * BM + wr * 64 + fr + ai * HALF + m * 16) * ldc + col0 + bj * HALF + n * 16));
            asm volatile("" ::: "memory");
#pragma unroll
            for (int ai = 0; ai < 2; ++ai) {
#pragma unroll
                for (int m = 0; m < 4; ++m) { const int rr = wr * 64 + fr + ai * HALF + m * 16; const unsigned off = (unsigned)((u.pm * BM + rr) * ldc + col0); float ss = 0.f;
                    const unsigned xso = ((unsigned)(u.pm * (ldc >> 6) + 4 * u.pn) * BM + rr) * 64u + 4u * fq;
#pragma unroll
                    for (int bj = 0; bj < 2; ++bj)
#pragma unroll
                        for (int n = 0; n < 2; ++n) { const unsigned o2 = off + bj * HALF + n * 16;
                            const f32x4 xn = __builtin_convertvector(bsv[ai][m][bj][n], f32x4) + gv[bj][n] * acc[ai][bj][m][n];
                            if (out_f32) *(f32x4*)((char*)out + 4u * o2) = xn; else *(f16x4*)((char*)out + 2u * o2) = __builtin_convertvector(xn, f16x4);
                            if (xs) { ss += (xn[0] * xn[0] + xn[1] * xn[1]) + (xn[2] * xn[2] + xn[3] * xn[3]); const f32x4 h = xn * *(const PG8_LAS f32x4*)(gp + 256 + bj * HALF + n * 16);
                                u32x2 w; w.x = pk2(h[0], h[1]); w.y = pk2(h[2], h[3]); *(u32x2*)((char*)xs + 2u * (xso + (unsigned)(2 * bj + (wc >> 1)) * (BM * 64) + (wc & 1) * 32 + n * 16)) = w; } }
                    if (xs) { ss += sx<16>(ss); ss = sum32(ss); if (fq == 0) __hip_atomic_fetch_add(rssn + (u.pm * BM + rr), ss, __ATOMIC_RELAXED, __HIP_MEMORY_SCOPE_AGENT); } }
                asm volatile("" ::: "memory"); }
        }
    }
};
template <class Epi, class Sched, bool ALIGN_EPI = false, bool SP2 = false, int A_AUX = 0>
__device__ __forceinline__ void gemm_phase(PG8_LAS unsigned char* lds, const Gemm g, const Sched& S, const Epi& E, int tid_in) {
    int tid_o = tid_in; asm volatile("" : "+v"(tid_o));
    const int tid = tid_o, wid = __builtin_amdgcn_readfirstlane(tid >> 6), lane = tid & 63, wr = wid >> 2, wc = wid & 3, fr = lane & 15, fq = lane >> 4;
    const int K = g.K, nt = K / BK;
    unsigned voffA[2], voffB[2];
#pragma unroll
    for (int i = 0; i < 2; ++i) { int R, C; stage_rc(tid * 16 + i * 8192, R, C); const int Rb = Epi::PERM ? ((R & ~31) + perm32(R & 31)) : R;
        voffA[i] = (unsigned)(R * (g.a_tiled ? BK : K) + C) * 2u; voffB[i] = (unsigned)(Rb * (g.b_tiled ? BK : K) + C) * 2u; }
    const size_t kstepA = g.a_tiled ? (size_t)(BM * BK * 2) : (size_t)(BK * 2), kstepB = g.b_tiled ? (size_t)(BM * BK * 2) : (size_t)(BK * 2);
    const size_t hstepA = g.a_tiled ? (size_t)(HALF * BK * 2) : (size_t)HALF * K * 2, hstepB = g.b_tiled ? (size_t)(HALF * BK * 2) : (size_t)HALF * K * 2;
    const size_t tstepA = (size_t)BM * K * 2, tstepB = tstepA;
    const unsigned ldsw = (unsigned)wid * 1024u;
    const int aoff = lds_byte(wr * 64 + fr, fq * 8), boff = lds_byte(wc * 32 + fr, fq * 8);
#define PG8_SA(b, h) (((b) * 2 + (h)) * HTB)
#define PG8_SB(b, h) ((4 + (b) * 2 + (h)) * HTB)
#define PG8_STAGE(bufoff, gbase, voff) do { _Pragma("unroll") for (int _i = 0; _i < 2; ++_i) \
        __builtin_amdgcn_global_load_lds((const unsigned*)((const char*)(gbase) + (voff)[_i]), (PG8_LAS unsigned*)(lds + (bufoff) + ldsw + _i * 8192), 16, 0, 0); } while (0)
#define PG8_STAGE_A(bufoff, gbase, voff) do { _Pragma("unroll") for (int _i = 0; _i < 2; ++_i) \
        __builtin_amdgcn_global_load_lds((const unsigned*)((const char*)(gbase) + (voff)[_i]), (PG8_LAS unsigned*)(lds + (bufoff) + ldsw + _i * 8192), 16, 0, A_AUX); } while (0)
#define PG8_LDA(dst, b, h) do { _Pragma("unroll") for (int m = 0; m < 4; ++m) _Pragma("unroll") for (int k = 0; k < 2; ++k) dst[m][k] = *(const PG8_LAS bf16x8*)(lds + PG8_SA(b, h) + aoff + m * 2048 + k * 1024); } while (0)
#define PG8_LDB(dst, b, h) do { _Pragma("unroll") for (int n = 0; n < 2; ++n) _Pragma("unroll") for (int k = 0; k < 2; ++k) dst[n][k] = *(const PG8_LAS bf16x8*)(lds + PG8_SB(b, h) + boff + n * 2048 + k * 1024); } while (0)
#define PG8_MMA(ai, bj, At, Bt) do { __builtin_amdgcn_s_setprio(1); _Pragma("unroll") for (int m = 0; m < 4; ++m) _Pragma("unroll") for (int n = 0; n < 2; ++n) _Pragma("unroll") for (int k = 0; k < 2; ++k) \
        acc[ai][bj][m][n] = __builtin_amdgcn_mfma_f32_16x16x32_bf16(Bt[n][k], At[m][k], acc[ai][bj][m][n], 0, 0, 0); __builtin_amdgcn_s_setprio(0); } while (0)
#define PG8_WAIT_V(n) asm volatile("s_waitcnt vmcnt(" #n ")" ::: "memory")
#define PG8_WAIT_L(n) asm volatile("s_waitcnt lgkmcnt(" #n ")" ::: "memory")
#define PG8_BAR __builtin_amdgcn_s_barrier()
#define PG8_SCHED __builtin_amdgcn_sched_barrier(0)
    Unit cur, nxt; int ui = 0;
    if (!S.next(0, cur)) return;
    f32x4 acc[2][2][4][2];
#pragma unroll
    for (int a = 0; a < 2; ++a)
#pragma unroll
        for (int b = 0; b < 2; ++b)
#pragma unroll
            for (int m = 0; m < 4; ++m)
#pragma unroll
                for (int n = 0; n < 2; ++n) acc[a][b][m][n] = (f32x4){0.f, 0.f, 0.f, 0.f};
    bf16x8 At[4][2], B0[2][2], B1[2][2];
    const char* cA = (const char*)g.A + (size_t)cur.pm * tstepA; const char* cB = (const char*)g.Bt + (size_t)cur.pn * tstepB;
    S.a_ready(cur);
    if constexpr (SP2) {
        PG8_STAGE(PG8_SB(0, 0), cB, voffB); PG8_STAGE(PG8_SB(0, 1), cB + hstepB, voffB); PG8_STAGE_A(PG8_SA(0, 0), cA, voffA); PG8_STAGE_A(PG8_SA(0, 1), cA + hstepA, voffA);
        if (wr == 1) PG8_BAR;
        PG8_WAIT_V(2); PG8_BAR;
        PG8_STAGE(PG8_SB(1, 0), cB + kstepB, voffB); PG8_STAGE_A(PG8_SA(1, 0), cA + kstepA, voffA); PG8_STAGE(PG8_SB(1, 1), cB + hstepB + kstepB, voffB);
        PG8_WAIT_V(6); PG8_BAR;
    } else {
        PG8_STAGE(PG8_SB(0, 0), cB, voffB); PG8_STAGE_A(PG8_SA(0, 0), cA, voffA); PG8_STAGE(PG8_SB(0, 1), cB + hstepB, voffB); PG8_STAGE_A(PG8_SA(0, 1), cA + hstepA, voffA);
        if (wr == 1) PG8_BAR;
        PG8_WAIT_V(4); PG8_BAR;
        PG8_STAGE(PG8_SB(1, 0), cB + kstepB, voffB); PG8_STAGE_A(PG8_SA(1, 0), cA + kstepA, voffA); PG8_STAGE(PG8_SB(1, 1), cB + hstepB + kstepB, voffB);
        PG8_WAIT_V(6); PG8_BAR;
    }
    for (;;) {
        const bool has_next = S.next(ui + 1, nxt);
        const char* nA = has_next ? (const char*)g.A + (size_t)nxt.pm * tstepA : cA; const char* nB = has_next ? (const char*)g.Bt + (size_t)nxt.pn * tstepB : cB;
        for (int t = 0; t < nt; t += 2) {
            const bool last = (t == nt - 2);
            const char* a1 = cA + (size_t)(t + 1) * kstepA;
            const char* a2 = last ? nA : cA + (size_t)(t + 2) * kstepA; const char* b2 = last ? nB : cB + (size_t)(t + 2) * kstepB;
            const char* a3 = a2 + kstepA; const char* b3 = b2 + kstepB;
            if (last && has_next) S.a_ready(nxt);
            if constexpr (SP2) {
            if constexpr (Epi::HAS_PRE) { if (last && wid == 0) { int ln = fr | (fq << 4); asm volatile("" : "+v"(ln)); E.pre(cur, ln); } }
            PG8_LDB(B0, 0, 0); PG8_LDB(B1, 0, 1); PG8_SCHED; PG8_LDA(At, 0, 0); PG8_STAGE_A(PG8_SA(1, 1), a1 + hstepA, voffA);
            PG8_WAIT_V(8); PG8_WAIT_L(0); PG8_BAR; PG8_MMA(0, 0, At, B0); PG8_MMA(0, 1, At, B1); PG8_BAR; PG8_SCHED;
            PG8_LDA(At, 0, 1); PG8_STAGE(PG8_SB(0, 0), b2, voffB); PG8_STAGE(PG8_SB(0, 1), b2 + hstepB, voffB); PG8_STAGE_A(PG8_SA(0, 0), a2, voffA);
            PG8_WAIT_V(8); PG8_WAIT_L(0); PG8_BAR; PG8_MMA(1, 0, At, B0); PG8_MMA(1, 1, At, B1); PG8_BAR; PG8_SCHED;
            PG8_LDB(B0, 1, 0); PG8_LDB(B1, 1, 1); PG8_SCHED; PG8_LDA(At, 1, 0); PG8_STAGE_A(PG8_SA(0, 1), a2 + hstepA, voffA);
            PG8_WAIT_V(8); PG8_WAIT_L(0); PG8_BAR; PG8_MMA(0, 0, At, B0); PG8_MMA(0, 1, At, B1); PG8_BAR; PG8_SCHED;
            PG8_LDA(At, 1, 1); PG8_STAGE(PG8_SB(1, 0), b3, voffB); PG8_STAGE(PG8_SB(1, 1), b3 + hstepB, voffB); PG8_STAGE_A(PG8_SA(1, 0), a3, voffA);
            PG8_WAIT_V(8); PG8_WAIT_L(0); PG8_BAR; PG8_MMA(1, 0, At, B0); PG8_MMA(1, 1, At, B1); PG8_BAR; PG8_SCHED;
            } else {
            PG8_LDB(B0, 0, 0); PG8_SCHED; PG8_LDA(At, 0, 0); PG8_STAGE_A(PG8_SA(1, 1), a1 + hstepA, voffA);
            PG8_WAIT_L(8); PG8_BAR; PG8_WAIT_L(0); PG8_MMA(0, 0, At, B0); PG8_BAR; PG8_SCHED;
            PG8_LDB(B1, 0, 1); PG8_STAGE(PG8_SB(0, 0), b2, voffB);
            PG8_BAR; PG8_WAIT_L(0); PG8_MMA(0, 1, At, B1); PG8_BAR;
            PG8_LDA(At, 0, 1); PG8_STAGE_A(PG8_SA(0, 0), a2, voffA);
            PG8_BAR; PG8_WAIT_L(0); PG8_MMA(1, 0, At, B0); PG8_BAR; PG8_SCHED;
            PG8_STAGE(PG8_SB(0, 1), b2 + hstepB, voffB);
            PG8_WAIT_V(6); PG8_BAR; PG8_MMA(1, 1, At, B1); PG8_BAR;
            PG8_LDB(B0, 1, 0); PG8_SCHED; PG8_LDA(At, 1, 0); PG8_STAGE_A(PG8_SA(0, 1), a2 + hstepA, voffA);
            PG8_WAIT_L(8); PG8_BAR; PG8_WAIT_L(0); PG8_MMA(0, 0, At, B0); PG8_BAR; PG8_SCHED;
            PG8_LDB(B1, 1, 1); PG8_STAGE(PG8_SB(1, 0), b3, voffB);
            PG8_BAR; PG8_WAIT_L(0); PG8_MMA(0, 1, At, B1); PG8_BAR;
            PG8_LDA(At, 1, 1); PG8_STAGE_A(PG8_SA(1, 0), a3, voffA);
            PG8_BAR; PG8_WAIT_L(0); PG8_MMA(1, 0, At, B0); PG8_BAR; PG8_SCHED;
            PG8_STAGE(PG8_SB(1, 1), b3 + hstepB, voffB);
            PG8_WAIT_V(6); PG8_BAR; PG8_MMA(1, 1, At, B1); PG8_BAR;
            }
        }
        if constexpr (ALIGN_EPI) { if (wr == 0) PG8_BAR; }
        if constexpr (!Epi::AFTER_DRAIN) { E(acc, cur, wr, wc, fr, fq); S.done(cur); }
        if (!has_next) break;
#pragma unroll
        for (int a = 0; a < 2; ++a)
#pragma unroll
            for (int b = 0; b < 2; ++b)
#pragma unroll
                for (int m = 0; m < 4; ++m)
#pragma unroll
                    for (int n = 0; n < 2; ++n) acc[a][b][m][n] = (f32x4){0.f, 0.f, 0.f, 0.f};
        cur = nxt; cA = nA; cB = nB; ++ui;
        if constexpr (ALIGN_EPI) { if (wr == 1) PG8_BAR; }
    }
    PG8_WAIT_V(0);
    if constexpr (!ALIGN_EPI) { if (wr == 0) PG8_BAR; }
    PG8_BAR;
    if constexpr (Epi::AFTER_DRAIN) { E.fused(acc, cur, wr, wc, fr, fq, lds, wid, lane); S.done(cur); }
#undef PG8_SA
#undef PG8_SB
#undef PG8_STAGE
#undef PG8_STAGE_A
#undef PG8_LDA
#undef PG8_LDB
#undef PG8_MMA
#undef PG8_WAIT_V
#undef PG8_WAIT_L
#undef PG8_BAR
#undef PG8_SCHED
}
}
#define GAS __attribute__((address_space(1)))
#define LAS __attribute__((address_space(3)))
typedef unsigned short bf16;
typedef unsigned v4u __attribute__((ext_vector_type(4)));
typedef float f32x4 __attribute__((ext_vector_type(4)));
typedef short bf16x8 __attribute__((ext_vector_type(8)));
typedef GAS unsigned gu32;
typedef GAS unsigned long long gu64;
#define RLX_AGENT __ATOMIC_RELAXED, __HIP_MEMORY_SCOPE_AGENT
#define LDS_WAIT() asm volatile("s_waitcnt lgkmcnt(0)" ::: "memory")
#define VM_WAIT() asm volatile("s_waitcnt vmcnt(0)" ::: "memory")
__device__ __forceinline__ unsigned long long rt() { return __builtin_amdgcn_s_memrealtime(); }
#define XB_TMO      128
#define XB_XCNT(j)  (256  + 64 * (j))
#define XB_XSUB(j)  (1280 + 64 * (j))
#define XB_XGEN(j)  (2304 + 64 * (j))
#define XB_TOP      3328
#define XB_TOPGEN   3392
#define XCD_BAR_WORDS 3456
#define XB_SPIN_CAP (1u << 18)

__device__ __forceinline__ unsigned xb_ld(unsigned* p)              { return __hip_atomic_load(p, __ATOMIC_RELAXED, __HIP_MEMORY_SCOPE_AGENT); }
__device__ __forceinline__ unsigned xb_add(unsigned* p, unsigned v) { return __hip_atomic_fetch_add(p, v, __ATOMIC_RELAXED, __HIP_MEMORY_SCOPE_AGENT); }
__device__ __forceinline__ unsigned xb_xcc_id() { return (unsigned)__builtin_amdgcn_s_getreg((3 << 11) | 20) & 0xFu; }
#define XB_SPIN(cond, bar) do { unsigned _sp = 0; while (cond) { __builtin_amdgcn_s_sleep(1); \
    if ((++_sp & 255u) == 0u) { if (xb_ld(&(bar)[XB_TMO])) break; if (_sp > XB_SPIN_CAP) { atomicAdd(&(bar)[XB_TMO], 1u); break; } } } } while (0)

struct XcdBarrier {
    unsigned* bar; unsigned x;
    volatile LAS unsigned* st;
};

__device__ __forceinline__ XcdBarrier xcd_barrier_post(unsigned* bar, volatile LAS unsigned* st) {
    XcdBarrier b; b.bar = bar; b.x = xb_xcc_id(); b.st = st;
    if (threadIdx.x == 0) (void)xb_add(&bar[XB_XCNT(b.x)], 1u);
    return b;
}
__device__ __forceinline__ void xcd_barrier_complete(unsigned* bar, unsigned x, unsigned& nloc, unsigned& nx) {
    const unsigned G = gridDim.x * gridDim.y * gridDim.z;
    unsigned sum, cnt, mine, sp = 0u;
    for (;;) {
        sum = 0u; cnt = 0u; mine = 0u;
#pragma unroll
        for (unsigned j = 0; j < 16; ++j) { const unsigned c = xb_ld(&bar[XB_XCNT(j)]); sum += c; cnt += (c > 0u) ? 1u : 0u; mine = (j == x) ? c : mine; }
        if (sum == G) break;
        __builtin_amdgcn_s_sleep(1);
        if ((++sp & 255u) == 0u) { if (xb_ld(&bar[XB_TMO])) break; if (sp > XB_SPIN_CAP) { atomicAdd(&bar[XB_TMO], 1u); break; } }
    }
    nloc = mine > 0u ? mine : 1u; nx = cnt > 0u ? cnt : 1u;
}

__device__ __forceinline__ void xcd_barrier(const XcdBarrier& b) {
    asm volatile("s_waitcnt vmcnt(0)" ::: "memory");
    __syncthreads();
    if (threadIdx.x == 0) {
        unsigned* bar = b.bar;
        __builtin_amdgcn_s_waitcnt(0);
        unsigned nloc = b.st[0], nx = b.st[1];
        if (nloc == 0u) { xcd_barrier_complete(bar, b.x, nloc, nx); b.st[0] = nloc; b.st[1] = nx; }
        const unsigned old = xb_add(&bar[XB_XSUB(b.x)], 1u);
        const unsigned gen = old / nloc;
        if (old + 1u == (gen + 1u) * nloc) {
            __builtin_amdgcn_fence(__ATOMIC_RELEASE, "agent");
            asm volatile("s_waitcnt vmcnt(0)" ::: "memory");
            const unsigned og = xb_add(&bar[XB_TOP], 1u);
            const unsigned tg = og / nx;
            if (og + 1u == (tg + 1u) * nx) xb_add(&bar[XB_TOPGEN], 1u);
            else XB_SPIN(xb_ld(&bar[XB_TOPGEN]) == tg, bar);
            __builtin_amdgcn_fence(__ATOMIC_ACQUIRE, "agent");
            xb_add(&bar[XB_XGEN(b.x)], 1u);
            asm volatile("s_waitcnt vmcnt(0)" ::: "memory");
        } else {
            XB_SPIN(xb_ld(&bar[XB_XGEN(b.x)]) == gen, bar);
            __builtin_amdgcn_fence(__ATOMIC_ACQUIRE, "agent");
            asm volatile("s_waitcnt vmcnt(0)" ::: "memory");
        }
    }
    __syncthreads();
}
namespace att {
using bf16x8 = __attribute__((ext_vector_type(8))) short;
using s16x4  = __attribute__((ext_vector_type(4))) short;
using f32x16 = __attribute__((ext_vector_type(16))) float;
using u32x4  = __attribute__((ext_vector_type(4))) unsigned;
constexpr int SEQ_ = 8192, LDQ = 6144; constexpr size_t SHM_V = 16384, SHM_K = 16384;
#define KSWZ(row, colB) ((row) * 256 + ((colB) ^ (((row) & 7) << 4)))
#define SBAR() __builtin_amdgcn_sched_barrier(0)
__device__ __forceinline__ int crow(int r, int hi) { return (r & 3) + 8 * (r >> 2) + 4 * hi; }
__device__ __forceinline__ unsigned cvtpk(float lo, float hi) {
  unsigned r; asm volatile("v_cvt_pk_bf16_f32 %0, %1, %2" : "=v"(r) : "v"(lo), "v"(hi)); return r;
}
__device__ __forceinline__ void qkt(f32x16& p0, f32x16& p1, const bf16* Ks, const bf16x8* qr, int r32, int hi, int jmap, float dbase, float slope2, float negm, bool diag) {
  asm volatile("" : "+v"(negm));
  if (diag) {
#pragma unroll
    for (int r = 0; r < 16; ++r) { const float d = (float)((r & 3) + 8 * (r >> 2)) + dbase;
      p0[r] = fmaf(-slope2, fabsf(d), negm); p1[r] = fmaf(-slope2, fabsf(d + 32.f), negm); }
  } else {
    const float u0 = fmaf(slope2, dbase, negm), u1 = fmaf(slope2, dbase + 32.f, negm);
#pragma unroll
    for (int r = 0; r < 16; ++r) { p0[r] = fmaf(slope2, (float)((r & 3) + 8 * (r >> 2)), u0); p1[r] = fmaf(slope2, (float)((r & 3) + 8 * (r >> 2)), u1); }
  }
#pragma unroll
  for (int d0 = 0; d0 < 4; ++d0) { const int cb = (jmap * 64 + d0 * 16 + hi * 8) * 2;
    bf16x8 b0 = *reinterpret_cast<const bf16x8*>((const char*)Ks + KSWZ(r32, cb));
    bf16x8 b1 = *reinterpret_cast<const bf16x8*>((const char*)Ks + KSWZ(32 + r32, cb));
    p0 = __builtin_amdgcn_mfma_f32_32x32x16_bf16(b0, qr[d0], p0, 0, 0, 0);
    p1 = __builtin_amdgcn_mfma_f32_32x32x16_bf16(b1, qr[d0], p1, 0, 0, 0); }
}
__device__ __forceinline__ void partialSM(f32x16& p0, f32x16& p1) {
#pragma unroll
  for (int r = 0; r < 16; ++r) p0[r] = __builtin_amdgcn_exp2f(p0[r]);
}
__device__ __forceinline__ void finishSM(f32x16& p0, f32x16& p1, float alpha, float& l_reg, bf16x8& pa0, bf16x8& pa1, bf16x8& pa2, bf16x8& pa3) {
  for (int r = 0; r < 16; ++r) p1[r] = __builtin_amdgcn_exp2f(p1[r]);
  float ps = 0; for (int r = 0; r < 16; ++r) ps += p0[r]; for (int r = 0; r < 16; ++r) ps += p1[r];
  { auto rr = __builtin_amdgcn_permlane32_swap(__float_as_uint(ps), __float_as_uint(ps), false, false);
    ps = __uint_as_float(rr[0]) + __uint_as_float(rr[1]); }
  l_reg = l_reg * alpha + ps;
#define PK4(P, BASE, OUT) do { unsigned a0 = cvtpk(P[BASE + 0], P[BASE + 1]), a1 = cvtpk(P[BASE + 2], P[BASE + 3]);   \
    unsigned b0 = cvtpk(P[BASE + 4], P[BASE + 5]), b1 = cvtpk(P[BASE + 6], P[BASE + 7]);                              \
    auto r0 = __builtin_amdgcn_permlane32_swap(a0, b0, false, false); auto r1 = __builtin_amdgcn_permlane32_swap(a1, b1, false, false); \
    u32x4 w = {r0[0], r1[0], r0[1], r1[1]}; OUT = *reinterpret_cast<bf16x8*>(&w); } while (0)
  PK4(p0, 0, pa0); PK4(p0, 8, pa1); PK4(p1, 0, pa2); PK4(p1, 8, pa3);
#undef PK4
}
__device__ __forceinline__ int v_st(int k, int c) { const int kk = (k & ~0xC) | ((k & 4) << 1) | ((k & 8) >> 1); return ((kk >> 3) * 4 + (c >> 5)) * 512 + ((kk & 7) * 32 + (c & 31)) * 2; }
__device__ __forceinline__ int v_rd_base(int lane) { return ((lane & 3) << 3) | (((lane >> 2) & 3) << 6) | (((lane >> 4) & 1) << 5) | (((lane >> 5) & 1) << 8); }
constexpr int v_rd_off(int d0, int ks, int half) { return d0 * 512 + ks * 4096 + half * 2048; }
template <int OFF> __device__ __forceinline__ s16x4 tr_read(int vb) {
  s16x4 r; asm volatile("ds_read_b64_tr_b16 %0, %1 offset:%2" : "=&v"(r) : "v"(vb), "i"(OFF) : "memory"); return r;
}
template <int D0> __device__ __forceinline__ void pv_one(f32x16& od, int vb, bf16x8 pa0, bf16x8 pa1, bf16x8 pa2, bf16x8 pa3) {
  const s16x4 l0 = tr_read<v_rd_off(D0, 0, 0)>(vb), h0 = tr_read<v_rd_off(D0, 0, 1)>(vb), l1 = tr_read<v_rd_off(D0, 1, 0)>(vb), h1 = tr_read<v_rd_off(D0, 1, 1)>(vb);
  const s16x4 l2 = tr_read<v_rd_off(D0, 2, 0)>(vb), h2 = tr_read<v_rd_off(D0, 2, 1)>(vb), l3 = tr_read<v_rd_off(D0, 3, 0)>(vb), h3 = tr_read<v_rd_off(D0, 3, 1)>(vb);
  asm volatile("s_waitcnt lgkmcnt(0)" ::: "memory"); SBAR();
#define PK(L, H) (bf16x8){L[0], L[1], L[2], L[3], H[0], H[1], H[2], H[3]}
  od = __builtin_amdgcn_mfma_f32_32x32x16_bf16(pa0, PK(l0, h0), od, 0, 0, 0);
  od = __builtin_amdgcn_mfma_f32_32x32x16_bf16(pa1, PK(l1, h1), od, 0, 0, 0);
  od = __builtin_amdgcn_mfma_f32_32x32x16_bf16(pa2, PK(l2, h2), od, 0, 0, 0);
  od = __builtin_amdgcn_mfma_f32_32x32x16_bf16(pa3, PK(l3, h3), od, 0, 0, 0);
#undef PK
}
#define PV_RD(S, D0) const s16x4 S##l0 = tr_read<v_rd_off(D0, 0, 0)>(vb), S##h0 = tr_read<v_rd_off(D0, 0, 1)>(vb), S##l1 = tr_read<v_rd_off(D0, 1, 0)>(vb), S##h1 = tr_read<v_rd_off(D0, 1, 1)>(vb), \
    S##l2 = tr_read<v_rd_off(D0, 2, 0)>(vb), S##h2 = tr_read<v_rd_off(D0, 2, 1)>(vb), S##l3 = tr_read<v_rd_off(D0, 3, 0)>(vb), S##h3 = tr_read<v_rd_off(D0, 3, 1)>(vb)
#define PV_PK(L, H) (bf16x8){L[0], L[1], L[2], L[3], H[0], H[1], H[2], H[3]}
#define PV_MM(S, OD) do { OD = __builtin_amdgcn_mfma_f32_32x32x16_bf16(pa0, PV_PK(S##l0, S##h0), OD, 0, 0, 0); OD = __builtin_amdgcn_mfma_f32_32x32x16_bf16(pa1, PV_PK(S##l1, S##h1), OD, 0, 0, 0); \
    OD = __builtin_amdgcn_mfma_f32_32x32x16_bf16(pa2, PV_PK(S##l2, S##h2), OD, 0, 0, 0); OD = __builtin_amdgcn_mfma_f32_32x32x16_bf16(pa3, PV_PK(S##l3, S##h3), OD, 0, 0, 0); } while (0)
__device__ __forceinline__ void pv_d0(f32x16* o, int vb, bf16x8 pa0, bf16x8 pa1, bf16x8 pa2, bf16x8 pa3) {
  PV_RD(a, 0); PV_RD(b, 1);
  asm volatile("s_waitcnt lgkmcnt(8)" ::: "memory"); SBAR();
  PV_MM(a, o[0]);
  PV_RD(c, 2);
  asm volatile("s_waitcnt lgkmcnt(8)" ::: "memory"); SBAR();
  PV_MM(b, o[1]);
  PV_RD(d, 3);
  asm volatile("s_waitcnt lgkmcnt(8)" ::: "memory"); SBAR();
  PV_MM(c, o[2]);
  asm volatile("s_waitcnt lgkmcnt(0)" ::: "memory"); SBAR();
  PV_MM(d, o[3]);
}
#undef PV_RD
#undef PV_PK
#undef PV_MM
__device__ __forceinline__ void attn_unit(int tid_in, int b, int h, int qb, int tb, const bf16* __restrict__ QKV, bf16* __restrict__ OB, float lam, float omli, float slope2, float m_ref, const float* __restrict__ subg, char* lds, gu32* qhead, volatile LAS unsigned* qslot) {
  int tid_o = tid_in; asm volatile("" : "+v"(tid_o));
  const int tid = tid_o, wid = __builtin_amdgcn_readfirstlane(tid >> 6), lane = tid & 63, r32 = lane & 31, hi = lane >> 5;
  const int jmap = wid >> 2, wq = wid & 3;
  constexpr int KR = 0, VR = 3 * 16384, WSO = 6 * 16384;
  float* ws = (float*)(lds + WSO) + wid * 64; float* li_l = ws;
  const long rowbase = (long)b * SEQ_; const int q0 = qb * 128 + wq * 32;
  float l_reg = 0.f; f32x16 o[4] = {}; bf16x8 qr[4];
  const bf16* Qw = QKV + (rowbase + q0 + r32) * LDQ + h * 128 + jmap * 64 + hi * 8;
#pragma unroll
  for (int d0 = 0; d0 < 4; ++d0) qr[d0] = *reinterpret_cast<const bf16x8*>(Qw + d0 * 16);
  const char* KVmid = (const char*)(QKV + (rowbase + 64 * tb) * LDQ + 2048 + h * 128 + 1024);
  unsigned koff[2], voff[2];
#pragma unroll
  for (int jb = 0; jb < 2; ++jb) { const int blk = 2 * wid + jb;
    { const int row = 4 * blk + (lane >> 4), chunk = (lane & 15) ^ (row & 7);
      koff[jb] = (unsigned)(row * LDQ * 2 + chunk * 16); }
    { const int sl = 64 * blk + lane, kk = 8 * (sl >> 7) + ((sl & 31) >> 2), c = 32 * ((sl >> 5) & 3) + 8 * (sl & 3);
      const int k = (kk & ~0xC) | ((kk & 4) << 1) | ((kk & 8) >> 1);
      voff[jb] = (unsigned)(k * LDQ * 2 + c * 2); } }
  const unsigned lds0 = (unsigned)(uintptr_t)lds;
  const int vb0 = (int)(lds0 + VR) + v_rd_base(lane);
  typedef __attribute__((address_space(3))) unsigned lds_u32;
#define DMA_K(t, slot) do { const char* t_ = KVmid + (size_t)(t) * (64 * LDQ * 2) - 2048; \
    __builtin_amdgcn_global_load_lds((const unsigned*)(t_ + koff[0]), (lds_u32*)(lds0 + KR + (slot) * 16384 + (2 * wid) * 1024), 16, 0, 0); \
    __builtin_amdgcn_global_load_lds((const unsigned*)(t_ + koff[1]), (lds_u32*)(lds0 + KR + (slot) * 16384 + (2 * wid + 1) * 1024), 16, 0, 0); } while (0)
#define DMA_V(t, slot) do { const char* t_ = KVmid + (size_t)(t) * (64 * LDQ * 2) + 2048; \
    __builtin_amdgcn_global_load_lds((const unsigned*)(t_ + voff[0]), (lds_u32*)(lds0 + VR + (slot) * 16384 + (2 * wid) * 1024), 16, 0, 0); \
    __builtin_amdgcn_global_load_lds((const unsigned*)(t_ + voff[1]), (lds_u32*)(lds0 + VR + (slot) * 16384 + (2 * wid + 1) * 1024), 16, 0, 0); } while (0)
#define WAIT_BAR(N) asm volatile("s_waitcnt vmcnt(" #N ") lgkmcnt(0)\n\ts_barrier" ::: "memory")
  f32x16 pA0, pA1, pB0, pB1; bf16x8 pa0, pa1, pa2, pa3;
  const int NT = 2 * qb + 2 - tb, cq = 2 * qb + (wq >> 1) - tb;
  const float dq = (float)(4 * hi - (q0 + r32) + 64 * tb);
#define QKT(P0, P1, kslot, t) qkt(P0, P1, (const bf16*)(lds + KR + (kslot) * 16384), qr, r32, hi, jmap, (float)(64 * (t)) + dq, slope2, ((t) > cq) ? -1e30f : -m_ref, (t) == cq)
  int sc = 0, sp = 2;
#define ROT() do { sp = sc; sc = (sc == 2) ? 0 : sc + 1; } while (0)
  asm volatile("s_waitcnt vmcnt(0)" : "+v"(qr[0]), "+v"(qr[1]), "+v"(qr[2]), "+v"(qr[3]) :: "memory");
  DMA_K(0, 0); DMA_V(0, 0); DMA_K(1, 1);
  WAIT_BAR(4);
  if (2 < NT) DMA_K(2, 2);
  DMA_V(1, 1);
  QKT(pA0, pA1, 0, 0); partialSM(pA0, pA1);
#define STEP(PX0, PX1, PY0, PY1, t) do { ROT(); \
    if ((t) + 1 < NT) { WAIT_BAR(4); } else { WAIT_BAR(2); } \
    { const int sn_ = (sp == 0) ? 2 : sp - 1;        \
      if ((t) + 2 < NT) DMA_K((t) + 2, sp); \
      if ((t) + 1 < NT) DMA_V((t) + 1, (3 - sc - sp)); (void)sn_; } \
    SBAR(); QKT(PX0, PX1, sc, t); \
    finishSM(PY0, PY1, 1.f, l_reg, pa0, pa1, pa2, pa3); SBAR(); \
    pv_d0(o, vb0 + sp * 16384, pa0, pa1, pa2, pa3); partialSM(PX0, PX1); } while (0)
  for (int t = 1; t + 1 < NT; t += 2) {
    STEP(pB0, pB1, pA0, pA1, t);
    STEP(pA0, pA1, pB0, pB1, t + 1);
  }
  if ((NT & 1) == 0) {
    STEP(pB0, pB1, pA0, pA1, NT - 1);
    WAIT_BAR(0);
    finishSM(pB0, pB1, 1.f, l_reg, pa0, pa1, pa2, pa3); SBAR();
  } else {
    WAIT_BAR(0);
    finishSM(pA0, pA1, 1.f, l_reg, pa0, pa1, pa2, pa3); SBAR();
  }
  pv_d0(o, vb0 + sc * 16384, pa0, pa1, pa2, pa3);
  unsigned nxt_unit = 0u; if (tid == 0) nxt_unit = __hip_atomic_fetch_add(qhead, 1u, __ATOMIC_RELAXED, __HIP_MEMORY_SCOPE_AGENT);
  if (hi == 0) li_l[r32] = l_reg; asm volatile("s_waitcnt lgkmcnt(0)" ::: "memory");
#pragma unroll
  for (int r = 0; r < 16; ++r) { const float rl = __builtin_amdgcn_rcpf(li_l[crow(r, hi)]);
#pragma unroll
    for (int d0 = 0; d0 < 4; ++d0) o[d0][r] *= rl; }
  float* xch = (float*)lds + (size_t)wq * 4096 + lane;
  __syncthreads();
  if (jmap == 1) {
#pragma unroll
    for (int d0 = 0; d0 < 4; ++d0)
#pragma unroll
      for (int r = 0; r < 16; ++r) xch[(d0 * 16 + r) * 64] = o[d0][r];
  }
  __syncthreads();
  if (jmap == 0) {
    float ss[16];
#pragma unroll
    for (int r = 0; r < 16; ++r) { float s = 0.f;
#pragma unroll
      for (int d0 = 0; d0 < 4; ++d0) { const float df = o[d0][r] - lam * xch[(d0 * 16 + r) * 64]; o[d0][r] = df; s += df * df; }
      ss[r] = s; }
#pragma unroll
    for (int r = 0; r < 16; ++r) { float s = ss[r]; s += sx<1>(s); s += sx<2>(s); s += sx<4>(s); s += sx<8>(s); s += sx<16>(s);
      ss[r] = rsqrtf(s * (1.0f / 128.0f) + 1e-6f) * omli; }
    float gs[4]; int r32o = r32; asm volatile("" : "+v"(r32o));
#pragma unroll
    for (int d0 = 0; d0 < 4; ++d0) gs[d0] = subg[d0 * 32 + r32o];
    bf16* stg = (bf16*)(lds + 65536) + wq * 4096;
    int sto = 4 * hi * 128 + r32; asm volatile("" : "+v"(sto));
#pragma unroll
    for (int r = 0; r < 16; ++r) { const int orow = (r & 3) + 8 * (r >> 2);
#pragma unroll
      for (int d0 = 0; d0 < 4; ++d0) stg[sto + orow * 128 + d0 * 32] = (bf16)f2bf(o[d0][r] * ss[r] * gs[d0]); }
    asm volatile("s_waitcnt lgkmcnt(0)" ::: "memory");
    unsigned ooff = (unsigned)((q0 + (lane >> 4)) * 2048 + (lane & 15) * 8); asm volatile("" : "+v"(ooff));
    bf16* Ow = OB + rowbase * 2048 + h * 128 + ooff;
#pragma unroll
    for (int i = 0; i < 8; ++i) { const u32x4 v = *(const u32x4*)(stg + (4 * i + (lane >> 4)) * 128 + (lane & 15) * 8); *(u32x4*)(Ow + (4 * i) * 2048) = v; }
  }
  if (tid == 0) *qslot = nxt_unit;
  __syncthreads();
#undef DMA_K
#undef DMA_V
#undef WAIT_BAR
#undef ROT
#undef STEP
#undef QKT
}
#undef KSWZ
#undef SBAR
}
constexpr int DM = 2048, NB = 4, SEQ = 8192, MT = NB * SEQ, FF = 5632, NLAYER = 4, NH = 16, NMOD = 9 * DM;
constexpr float RMS_EPS = 1e-6f;
constexpr int NWAVES = 8;
#ifndef PROBE_MASK
#define PROBE_MASK 0
#endif
#ifndef PROBE_IDLE
#define PROBE_IDLE 0
#endif
#ifndef PROBE_ECHO
#define PROBE_ECHO 0
#endif
#ifndef FFN_SPLIT
#define FFN_SPLIT 1
#endif
#ifndef GU_WGM
#define GU_WGM 8
#endif
#ifndef OUT_A_AUX
#define OUT_A_AUX 0
#endif
#ifndef OUT_WGM
#define OUT_WGM 4
#endif
#ifndef MK_PER_PHASE
#define MK_PER_PHASE 0
#endif
constexpr int N_PHASES = 32 + 8 * 2 * (FFN_SPLIT - 1);
constexpr size_t MiB = 1u << 20;
constexpr size_t WS_CTL = 0, CTL_ZERO_BYTES = 3 * MiB;
constexpr size_t WS_MOD = 1696 * MiB;
constexpr size_t WS_EBL = 3 * MiB;
constexpr size_t WS_WGU = 8 * MiB;
constexpr size_t WS_WD  = 360 * MiB;
constexpr size_t WS_WAI = 536 * MiB;
constexpr size_t WS_WAO = 584 * MiB;
constexpr size_t WS_WCI = 600 * MiB, WS_WCO = 624 * MiB;
constexpr size_t WS_WHI = 632 * MiB, WS_WHO = 664 * MiB;
constexpr size_t WS_XN  = 672 * MiB;
constexpr size_t WS_BIG = 800 * MiB;
constexpr size_t WS_OB  = 1312 * MiB;
constexpr size_t WS_KLT = 1440 * MiB;
constexpr size_t WS_IT  = 1568 * MiB;
constexpr size_t WS_RSS = 1 * MiB, RSS_BYTES = 2 * MiB;
constexpr size_t WS_CB  = 1698 * MiB;
constexpr int CB_LD = 2 * 5632;
constexpr size_t WS_TAB = 1701 * MiB;
constexpr size_t WS_XH  = 1702 * MiB;
constexpr size_t WS_END = 1830 * MiB;
constexpr int CW_BAR = 4096;
constexpr int RING_OFF = 0, RING_BYTES = 131072;
constexpr int LDSCTL_OFF = RING_BYTES, MISC_OFF = LDSCTL_OFF + 320;
constexpr int PRE_OFF = LDSCTL_OFF + 1024;
constexpr int LDS_BYTES = 147456;

struct Args { const float* in[21]; float* out; unsigned char* ws; int ph_lo, ph_hi; };
struct Frame {
    LAS unsigned char* lds;
    volatile LAS unsigned* MISC;
    gu32* ctl;
    int tid, lane, wave, vcu, G;
    const struct Args* a; float* out; unsigned char* ws;
};
__device__ __forceinline__ float bf_lo(unsigned w) { return __uint_as_float(w << 16); }
__device__ __forceinline__ float bf_hi(unsigned w) { return __uint_as_float(w & 0xffff0000u); }
__device__ __forceinline__ float bf_f(bf16 x) { return __uint_as_float((unsigned)x << 16); }

__device__ __forceinline__ void unpack8(const v4u w, float (&x)[8]) { x[0] = bf_lo(w.x); x[1] = bf_hi(w.x); x[2] = bf_lo(w.y); x[3] = bf_hi(w.y); x[4] = bf_lo(w.z); x[5] = bf_hi(w.z); x[6] = bf_lo(w.w); x[7] = bf_hi(w.w); }
__device__ __forceinline__ void p0_mod(Frame& F) {
    LAS float* cond = (LAS float*)(F.lds);
    LAS float* part = (LAS float*)(F.lds + 32768);
    const float* c = F.a->in[1]; const float* aw = F.a->in[2]; const float* ab = F.a->in[3]; float* mod = (float*)(F.ws + WS_MOD);
    for (int i = F.tid; i < NB * DM; i += NWAVES * 64) { const float v = c[i]; cond[i] = v / (1.0f + __expf(-v)); }
    __syncthreads();
    const int cg = F.tid & 15, ks = F.tid >> 4;
    for (int it = F.vcu; it < NLAYER * (NMOD / 64); it += F.G) {
        const int L = it / (NMOD / 64), n0 = (it % (NMOD / 64)) * 64;
        f32x4 a0 = {0.f, 0.f, 0.f, 0.f}, a1 = a0, a2 = a0, a3 = a0;
        const float* wp = aw + ((size_t)L * DM + ks * 64) * NMOD + n0 + 4 * cg;
#pragma unroll 8
        for (int k = 0; k < 64; ++k) { const f32x4 w = *(const f32x4*)(wp + (size_t)k * NMOD); const int kk = ks * 64 + k;
            a0 += w * cond[kk]; a1 += w * cond[DM + kk]; a2 += w * cond[2 * DM + kk]; a3 += w * cond[3 * DM + kk]; }
        *(LAS f32x4*)(part + (ks * 4 + 0) * 64 + 4 * cg) = a0; *(LAS f32x4*)(part + (ks * 4 + 1) * 64 + 4 * cg) = a1;
        *(LAS f32x4*)(part + (ks * 4 + 2) * 64 + 4 * cg) = a2; *(LAS f32x4*)(part + (ks * 4 + 3) * 64 + 4 * cg) = a3;
        __syncthreads();
        if (F.tid < 256) { const int b = F.tid >> 6, col = F.tid & 63; float s = 0.f;
#pragma unroll 8
            for (int k2 = 0; k2 < 32; ++k2) s += part[(k2 * 4 + b) * 64 + col];
            mod[((size_t)L * NB + b) * NMOD + n0 + col] = s + ab[(size_t)L * NMOD + n0 + col]; }
        __syncthreads();
    }
}
struct CvItem { const float* W; bf16* WT; int K, N, mode, item; };
__device__ __forceinline__ CvItem cv_decode(Frame& F, int it) {
    constexpr int I_FFN = (DM / 64) * (FF / 32);
    constexpr int I_IN3 = (DM / 64) * (3 * DM / 32), I_SQ = (DM / 64) * (DM / 32), I_IN4 = (DM / 64) * (4 * DM / 32);
    int r = it;
    if (r < 24 * I_FFN) { const int m = r / I_FFN, ls = m / 3, which = m % 3; r -= m * I_FFN;
        if (which == 0) return CvItem{F.a->in[5] + (size_t)ls * DM * FF, (bf16*)(F.ws + WS_WGU) + (size_t)ls * 2 * FF * DM, DM, FF, 1, r};
        if (which == 1) return CvItem{F.a->in[6] + (size_t)ls * DM * FF, (bf16*)(F.ws + WS_WGU) + (size_t)ls * 2 * FF * DM, DM, FF, 2, r};
        return CvItem{F.a->in[7] + (size_t)ls * FF * DM, (bf16*)(F.ws + WS_WD) + (size_t)ls * DM * FF, FF, DM, 0, r}; }
    r -= 24 * I_FFN;
    if (r < 2 * I_IN3) { const int s = r / I_IN3; return CvItem{F.a->in[8] + (size_t)s * DM * 3 * DM, (bf16*)(F.ws + WS_WAI) + (size_t)s * 3 * DM * DM, DM, 3 * DM, 3, r - s * I_IN3}; } r -= 2 * I_IN3;
    if (r < 2 * I_SQ) { const int s = r / I_SQ; return CvItem{F.a->in[9] + (size_t)s * DM * DM, (bf16*)(F.ws + WS_WAO) + (size_t)s * DM * DM, DM, DM, 0, r - s * I_SQ}; } r -= 2 * I_SQ;
    if (r < I_IN3) return CvItem{F.a->in[14], (bf16*)(F.ws + WS_WCI), DM, 3 * DM, 0, r}; r -= I_IN3;
    if (r < I_SQ) return CvItem{F.a->in[16], (bf16*)(F.ws + WS_WCO), DM, DM, 0, r}; r -= I_SQ;
    if (r < I_IN4) return CvItem{F.a->in[17], (bf16*)(F.ws + WS_WHI), DM, 4 * DM, 0, r}; r -= I_IN4;
    return CvItem{F.a->in[18], (bf16*)(F.ws + WS_WHO), DM, DM, 0, r};
}
__device__ __forceinline__ void cv_load(const CvItem& c, float (&wv)[32], int lane) {
    const int nblk = c.N / 32, kb = c.item / nblk, nb = c.item % nblk;
    const float* wp = c.W + (size_t)(64 * kb + (lane >> 5)) * c.N + 32 * nb + (lane & 31);
#pragma unroll
    for (int i = 0; i < 32; ++i) wv[i] = wp[(size_t)(2 * i) * c.N];
}
__device__ __forceinline__ void cv_finish(const CvItem& c, const float (&wv)[32], LAS float* scr, int lane) {
    const int K = c.K, mode = c.mode, nblk = c.N / 32, kb = c.item / nblk, nb = c.item % nblk, n0 = 32 * nb;
    const int drow0 = (mode == 0 || (mode == 3 && n0 >= 2 * DM)) ? n0 : (mode == 3) ? ((n0 & ~255) + 128 * ((n0 >> 5) & 1) + 32 * ((n0 >> 6) & 3)) : ((n0 >> 7) * 256 + (mode - 1) * 128 + (n0 & 127));
#pragma unroll
    for (int i = 0; i < 32; ++i) scr[(2 * i + (lane >> 5)) * 33 + (lane & 31)] = wv[i];
    LDS_WAIT(); asm volatile("" ::: "memory");
    const int cc = lane & 7;
#pragma unroll
    for (int j = 0; j < 4; ++j) { const int n = (lane >> 3) + 8 * j; const LAS float* s = scr + (8 * cc) * 33 + n;
        v4u o; o.x = pk2(s[0 * 33], s[1 * 33]); o.y = pk2(s[2 * 33], s[3 * 33]); o.z = pk2(s[4 * 33], s[5 * 33]); o.w = pk2(s[6 * 33], s[7 * 33]);
        const int dr = drow0 + n;
        *(GAS v4u*)(c.WT + ((size_t)((dr >> 8) * (K >> 6) + kb) * 256 + (dr & 255)) * 64 + 8 * cc) = o; }
    LDS_WAIT(); asm volatile("" ::: "memory");
}
__device__ __forceinline__ void p0_convert(Frame& F) {
    LAS float* scr = (LAS float*)(F.lds + RING_OFF + F.wave * 16384);
    const int gw = F.vcu * NWAVES + F.wave, NGW = F.G * NWAVES;
    constexpr int NITEMS = 24 * ((DM / 64) * (FF / 32)) + 3 * ((DM / 64) * (3 * DM / 32)) + 4 * ((DM / 64) * (DM / 32)) + (DM / 64) * (4 * DM / 32);
    CvItem A, B; float wa[32], wb[32];
    int it = gw;
    if (it < NITEMS) { A = cv_decode(F, it); cv_load(A, wa, F.lane); }
    while (it < NITEMS) {
        int nx = it + NGW;
        if (nx < NITEMS) { B = cv_decode(F, nx); cv_load(B, wb, F.lane); }
        cv_finish(A, wa, scr, F.lane);
        it = nx; if (it >= NITEMS) break;
        nx = it + NGW;
        if (nx < NITEMS) { A = cv_decode(F, nx); cv_load(A, wa, F.lane); }
        cv_finish(B, wb, scr, F.lane);
        it = nx;
    }
}
__device__ __forceinline__ void xs0_phase(Frame& F, const float* xsrc, const float* g, const float* modL) {
    bf16* XN = (bf16*)(F.ws + WS_XN); float* rss = (float*)(F.ws + WS_RSS);
    const int gw = F.vcu * NWAVES + F.wave, NGW = F.G * NWAVES;
    for (int r0 = gw * 16; r0 < MT; r0 += NGW * 16) {
        const int b = r0 / SEQ;
        const float* sc = modL + (size_t)b * NMOD + DM;
        f32x4 a[8];
#pragma unroll
        for (int j = 0; j < 8; ++j) { const int col = 4 * F.lane + 256 * j; a[j] = *(const f32x4*)(g + col) * (*(const f32x4*)(sc + col) + 1.0f); }
#pragma unroll 2
        for (int r = 0; r < 16; ++r) {
            const GAS f32x4* xr = (const GAS f32x4*)(xsrc + (size_t)(r0 + r) * DM) + F.lane;
            f32x4 v[8]; float s = 0.f;
#pragma unroll
            for (int j = 0; j < 8; ++j) { v[j] = xr[64 * j]; s += (v[j].x * v[j].x + v[j].y * v[j].y) + (v[j].z * v[j].z + v[j].w * v[j].w); }
            s = wave_sum(s);
            if (F.lane == 0) rss[r0 + r] = s;
            bf16* o8 = XN + ((size_t)((r0 + r) >> 8) * 32 * 256 + ((r0 + r) & 255)) * 64 + (size_t)(F.lane >> 4) * (256 * 64) + 4 * (F.lane & 15);
#pragma unroll
            for (int j = 0; j < 8; ++j) { const f32x4 h = v[j] * a[j];
                *(GAS unsigned long long*)(o8 + (size_t)(4 * j) * (256 * 64)) = (unsigned long long)pk2(h.x, h.y) | ((unsigned long long)pk2(h.z, h.w) << 32); }
        }
    }
}
__device__ __forceinline__ void tables_phase(Frame& F) {
    const float* mod = (const float*)(F.ws + WS_MOD); float* TAB = (float*)(F.ws + WS_TAB); const float* ng = F.a->in[4];
    const int gt = F.vcu * (NWAVES * 64) + F.tid, NT = F.G * NWAVES * 64;
    for (int i = gt; i < 3 * NLAYER * NB * DM; i += NT) {
        const int col = i % DM, b = (i / DM) % NB, s = i / (DM * NB), L = s / 3, sub = s % 3, sn = s + 1, Ln = sn / 3, subn = sn % 3;
        TAB[((size_t)(s * 2 + 0) * NB + b) * DM + col] = ((sub == 1) ? 1.0f : 0.5f) * mod[((size_t)L * NB + b) * NMOD + (3 * sub + 2) * DM + col];
        TAB[((size_t)(s * 2 + 1) * NB + b) * DM + col] = (sn < 3 * NLAYER) ? ng[((size_t)Ln * 3 + subn) * DM + col] * (1.0f + mod[((size_t)Ln * NB + b) * NMOD + (3 * subn + 1) * DM + col]) : 0.f;
    }
}
__device__ __forceinline__ void bias_phase(Frame& F) {
    const float* mod = (const float*)(F.ws + WS_MOD); float* CB = (float*)(F.ws + WS_CB);
    const int gw = F.vcu * NWAVES + F.wave, NGW = F.G * NWAVES;
#pragma unroll 1
    for (int s = 0; s < 3 * NLAYER; ++s) {
        const int L = s / 3, sub = s % 3, kind = L % 3, slot = L / 3;
        const bf16* W; int N;
        if (sub != 1) { W = (const bf16*)(F.ws + WS_WGU) + (size_t)(L * 2 + (sub >> 1)) * 2 * FF * DM; N = 2 * FF; }
        else if (kind == 0) { W = (const bf16*)(F.ws + WS_WAI) + (size_t)slot * 3 * DM * DM; N = 3 * DM; }
        else if (kind == 1) { W = (const bf16*)(F.ws + WS_WCI); N = 3 * DM; }
        else { W = (const bf16*)(F.ws + WS_WHI); N = 4 * DM; }
        float sh[4][4][8];
#pragma unroll
        for (int b = 0; b < NB; ++b)
#pragma unroll
            for (int it = 0; it < 4; ++it) { const float* sp = mod + ((size_t)L * NB + b) * NMOD + (3 * sub) * DM + 8 * (64 * it + F.lane);
                const f32x4 s0 = *(const f32x4*)sp, s1 = *(const f32x4*)(sp + 4);
                sh[b][it][0] = s0.x; sh[b][it][1] = s0.y; sh[b][it][2] = s0.z; sh[b][it][3] = s0.w; sh[b][it][4] = s1.x; sh[b][it][5] = s1.y; sh[b][it][6] = s1.z; sh[b][it][7] = s1.w; }
        for (int n = gw; n < N; n += NGW) {
            const bf16* wrow = W + ((size_t)(n >> 8) * (DM >> 6) * 256 + (n & 255)) * 64 + (F.lane & 7) * 8;
            float d0 = 0.f, d1 = 0.f, d2 = 0.f, d3 = 0.f;
#pragma unroll
            for (int it = 0; it < 4; ++it) { float w[8]; unpack8(*(const GAS v4u*)(wrow + (size_t)(8 * it + (F.lane >> 3)) * 256 * 64), w);
#pragma unroll
                for (int i = 0; i < 8; ++i) { d0 += w[i] * sh[0][it][i]; d1 += w[i] * sh[1][it][i]; d2 += w[i] * sh[2][it][i]; d3 += w[i] * sh[3][it][i]; } }
            d0 = wave_sum(d0); d1 = wave_sum(d1); d2 = wave_sum(d2); d3 = wave_sum(d3);
            if (F.lane == 0) { float* cp = CB + (size_t)s * NB * CB_LD + n; cp[0] = d0; cp[CB_LD] = d1; cp[2 * CB_LD] = d2; cp[3 * CB_LD] = d3; }
        }
    }
}
constexpr int CW_ATTNQ = 8192;
__device__ __forceinline__ void attn_phase(Frame& F, int L, int slot, int qword = 0) {
    const bf16* QKV = (const bf16*)(F.ws + WS_BIG); bf16* OB = (bf16*)(F.ws + WS_OB);
    const float* lv = F.a->in[12] + (size_t)slot * 4 * 64;
    int ln = F.lane; asm volatile("" : "+v"(ln));
    const float sa = wave_sum(lv[ln] * lv[64 + ln]), sb = wave_sum(lv[128 + ln] * lv[192 + ln]);
    asm volatile("" : "+s"(L));
    const float lambda_init = (L == 0) ? 0.2f : (L == 1) ? 0.35550906f : (L == 2) ? 0.47071302f : 0.55605822f;
    const float lam = expf(sa) - expf(sb) + lambda_init;
    const float* subg = F.a->in[13] + (size_t)slot * 128;
    float gm = fabsf(F.a->in[10][slot * 64 + ln] * F.a->in[11][slot * 64 + ln]);
    gm = wave_max(gm);
    const float twoB24 = 16.0f * gm + 24.0f;
    const float m_ref = (8.0f * gm) * 1.4426950408889634f * 1.02f + 0.5f;
    gu32* qhead = F.ctl + CW_ATTNQ + 64 * slot + 256 * qword;
    if (F.tid == 0) F.MISC[16] = __hip_atomic_fetch_add(qhead, 1u, RLX_AGENT);
    __syncthreads();
    int n = (int)F.MISC[16];
    while (n < NB * NH * (SEQ / 128)) {
        const int qb = 63 - (n >> 6), bhq = n & 63, h = 15 - (bhq >> 2), b = bhq & 3;
        const float slope = exp2f(-0.5f * (float)(h + 1));
        const float W = (twoB24 - __logf(1.0f - __expf(-slope))) / slope;
        int tb = (int)floorf(((float)(128 * qb) - W) * (1.0f / 64.0f)); tb = (tb < 0 ? 0 : tb);
        att::attn_unit(F.tid, b, h, qb, tb, QKV, OB, lam, 1.0f - lambda_init, slope * 1.4426950408889634f, m_ref, subg, (char*)(F.lds + RING_OFF), qhead, F.MISC + 16);
        n = (int)F.MISC[16];
    }
}
__device__ __forceinline__ void conv_phase(Frame& F) {
    const bf16* U = (const bf16*)(F.ws + WS_BIG); bf16* OB = (bf16*)(F.ws + WS_OB); const float* cw = F.a->in[15];
    const int gt = F.vcu * (NWAVES * 64) + F.tid, NT = F.G * NWAVES * 64;
    for (int item = gt; item < 256 * (MT / 16); item += NT) {
        int dg = item & 255; asm volatile("" : "+v"(dg));
        const int run = item >> 8, row0 = run * 16, d = dg * 8;
        float w0[8], w1[8], w2[8];
#pragma unroll
        for (int i = 0; i < 8; ++i) { w0[i] = cw[d + i]; w1[i] = cw[DM + d + i]; w2[i] = cw[2 * DM + d + i]; }
        float vm2[8], vm1[8];
        if ((row0 % SEQ) == 0) {
#pragma unroll
            for (int i = 0; i < 8; ++i) { vm2[i] = 0.f; vm1[i] = 0.f; }
        } else {
            float a[8], b[8];
            unpack8(*(const GAS v4u*)(U + (size_t)(row0 - 2) * 6144 + 2048 + d), a); unpack8(*(const GAS v4u*)(U + (size_t)(row0 - 2) * 6144 + 4096 + d), b);
#pragma unroll
            for (int i = 0; i < 8; ++i) vm2[i] = a[i] * b[i];
            unpack8(*(const GAS v4u*)(U + (size_t)(row0 - 1) * 6144 + 2048 + d), a); unpack8(*(const GAS v4u*)(U + (size_t)(row0 - 1) * 6144 + 4096 + d), b);
#pragma unroll
            for (int i = 0; i < 8; ++i) vm1[i] = a[i] * b[i];
        }
#pragma unroll 4
        for (int t = 0; t < 16; ++t) {
            const bf16* rp = U + (size_t)(row0 + t) * 6144 + d;
            float bg[8], cg[8], uu[8], y[8];
            unpack8(*(const GAS v4u*)(rp), bg); unpack8(*(const GAS v4u*)(rp + 2048), cg); unpack8(*(const GAS v4u*)(rp + 4096), uu);
#pragma unroll
            for (int i = 0; i < 8; ++i) { const float v = cg[i] * uu[i]; y[i] = bg[i] * (w0[i] * vm2[i] + w1[i] * vm1[i] + w2[i] * v); vm2[i] = vm1[i]; vm1[i] = v; }
            v4u o; o.x = pk2(y[0], y[1]); o.y = pk2(y[2], y[3]); o.z = pk2(y[4], y[5]); o.w = pk2(y[6], y[7]);
            *(GAS v4u*)(OB + (size_t)(row0 + t) * DM + d) = o;
        }
    }
}
#define LDS_BAR() asm volatile("s_waitcnt lgkmcnt(0)\n\ts_barrier" ::: "memory")
typedef short s16x4 __attribute__((ext_vector_type(4)));
typedef float f32x16 __attribute__((ext_vector_type(16)));
__device__ __forceinline__ int crow16(int r, int hi) { return (r & 3) + 8 * (r >> 2) + 4 * hi; }
constexpr int H_P256 = 272, H_P128 = 144;
__device__ __forceinline__ void hgrn_prep_phase(Frame& F, int layer, bf16* QBO, int qbld, bf16* OBO) {
    bf16* BIG = (bf16*)(F.ws + WS_BIG); bf16* KLT = (bf16*)(F.ws + WS_KLT); bf16* ITG = (bf16*)(F.ws + WS_IT); float* EBL = (float*)(F.ws + WS_EBL); bf16* OB = (bf16*)(F.ws + WS_OB);
    const float* lbl = F.a->in[20];
    LAS unsigned char* QS = F.lds; LAS unsigned char* KS = F.lds + 64 * H_P256; LAS unsigned char* ITL = F.lds + 2 * 64 * H_P256; LAS float* TOT = (LAS float*)(F.lds + 2 * 64 * H_P256 + 128 * H_P128);
    const int kp = F.lane, seg = F.wave, r32 = F.lane & 31, hi = F.lane >> 5;
    unsigned qw[8], fw[8], iw[8]; f32x2_cv lgt[4];
#define H1_LOAD(un) do { const int bh_ = (un) >> 7, c_ = (un) & 127; const size_t rb_ = (size_t)(bh_ >> 4) * SEQ + (size_t)c_ * 64; \
        _Pragma("unroll") for (int L_ = 0; L_ < 4; ++L_) lgt[L_] = *(const GAS f32x2_cv*)(lbl + L_ * DM + (bh_ & 15) * 128 + 2 * kp); \
        _Pragma("unroll") for (int tt = 0; tt < 8; ++tt) { const bf16* pq = BIG + (rb_ + 8 * seg + tt) * 8192 + (bh_ & 15) * 128 + 2 * kp; \
            qw[tt] = *(const GAS unsigned*)pq; fw[tt] = *(const GAS unsigned*)(pq + 2048); iw[tt] = *(const GAS unsigned*)(pq + 4096); } } while (0)
    for (int unit = F.vcu; unit < NB * NH * (SEQ / 64); unit += F.G) {
        const int bh = unit >> 7, c = unit & 127, b = bh >> 4, h = bh & 15; const size_t rowbase = (size_t)b * SEQ + (size_t)c * 64;
        if (unit == F.vcu) H1_LOAD(unit);
        float lb[2];
#pragma unroll
        for (int kk = 0; kk < 2; ++kk) { const float l0 = lgt[0][kk], l1 = lgt[1][kk], l2 = lgt[2][kk], l3 = lgt[3][kk];
            const float mx = fmaxf(fmaxf(l0, l1), fmaxf(l2, l3)); const float e0 = __expf(l0 - mx), e1 = __expf(l1 - mx), e2 = __expf(l2 - mx), e3 = __expf(l3 - mx);
            float cumv = 0.f; if (layer >= 1) cumv += e1; if (layer >= 2) cumv += e2; if (layer >= 3) cumv += e3;
            lb[kk] = cumv * __builtin_amdgcn_rcpf(e0 + e1 + e2 + e3); }
        float bcs[8][2], kv[8][2]; float cum[2] = {0.f, 0.f};
#pragma unroll
        for (int tt = 0; tt < 8; ++tt)
#pragma unroll
            for (int kk = 0; kk < 2; ++kk) { const float x = kk ? bf_hi(fw[tt]) : bf_lo(fw[tt]); const float sig = __builtin_amdgcn_rcpf(1.0f + __expf(-x));
                const float f = lb[kk] + (1.0f - lb[kk]) * sig; cum[kk] += __builtin_amdgcn_logf(f) * 0.6931471805599453f;     bcs[tt][kk] = cum[kk]; kv[tt][kk] = 1.0f - f; }
        TOT[seg * 128 + 2 * kp] = cum[0]; TOT[seg * 128 + 2 * kp + 1] = cum[1];
        LDS_BAR();
        float off[2] = {0.f, 0.f}, rb[2] = {0.f, 0.f}, bl[2] = {0.f, 0.f};
#pragma unroll
        for (int s = 0; s < 8; ++s)
#pragma unroll
            for (int kk = 0; kk < 2; ++kk) { const float tv = TOT[s * 128 + 2 * kp + kk]; if (s < seg) off[kk] += tv; if (s < 4) rb[kk] += tv; bl[kk] += tv; }
        float erb[2], enrb[2], ebl[2];
#pragma unroll
        for (int kk = 0; kk < 2; ++kk) { erb[kk] = __expf(rb[kk]); enrb[kk] = __expf(-rb[kk]); ebl[kk] = __expf(bl[kk]); }
        unsigned klw[2][4], itw[2][4];
#pragma unroll
        for (int tt = 0; tt < 8; ++tt) { float qb_[2], qs_[2], ks_[2], kl_[2];
#pragma unroll
            for (int kk = 0; kk < 2; ++kk) { const float bb = bcs[tt][kk] + off[kk]; const float q = kk ? bf_hi(qw[tt]) : bf_lo(qw[tt]);
                const float eb = __expf(bb), enb = __builtin_amdgcn_rcpf(eb);
                qb_[kk] = q * eb; qs_[kk] = qb_[kk] * enrb[kk]; ks_[kk] = kv[tt][kk] * (erb[kk] * enb); kl_[kk] = kv[tt][kk] * (ebl[kk] * enb); }
            *(GAS unsigned*)(QBO + (rowbase + 8 * seg + tt) * qbld + h * 128 + 2 * kp) = pk2(qb_[0], qb_[1]);
            *(LAS unsigned*)(QS + (8 * seg + tt) * H_P256 + 4 * kp) = pk2(qs_[0], qs_[1]);
            *(LAS unsigned*)(KS + (8 * seg + tt) * H_P256 + 4 * kp) = pk2(ks_[0], ks_[1]);
            if (tt & 1) { klw[0][tt >> 1] |= f2bf(kl_[0]) << 16; klw[1][tt >> 1] |= f2bf(kl_[1]) << 16; itw[0][tt >> 1] |= (iw[tt] & 0xffffu) << 16; itw[1][tt >> 1] |= (iw[tt] >> 16) << 16; }
            else { klw[0][tt >> 1] = f2bf(kl_[0]); klw[1][tt >> 1] = f2bf(kl_[1]); itw[0][tt >> 1] = iw[tt] & 0xffffu; itw[1][tt >> 1] = iw[tt] >> 16; }
        }
#pragma unroll
        for (int kk = 0; kk < 2; ++kk) { const v4u kw = {klw[kk][0], klw[kk][1], klw[kk][2], klw[kk][3]}, tw = {itw[kk][0], itw[kk][1], itw[kk][2], itw[kk][3]};
            *(GAS v4u*)(KLT + (size_t)unit * 8192 + (2 * kp + kk) * 64 + 8 * seg) = kw;
            *(GAS v4u*)(ITG + (size_t)unit * 8192 + (2 * kp + kk) * 64 + 8 * seg) = tw;
            *(LAS v4u*)(ITL + (2 * kp + kk) * H_P128 + 16 * seg) = tw; }
        if (seg == 0) { EBL[(size_t)unit * 128 + 2 * kp] = ebl[0]; EBL[(size_t)unit * 128 + 2 * kp + 1] = ebl[1]; }
        LDS_BAR();
        if (unit + F.G < NB * NH * (SEQ / 64)) H1_LOAD(unit + F.G);
        const int tt_ = F.wave & 1, vt = F.wave >> 1;
        f32x16 z = {};
        for (int st = 0; st <= tt_; ++st) {
            f32x16 x = {};
            bf16x8 af[8], bqf[8];
#pragma unroll
            for (int step = 0; step < 8; ++step) { af[step] = *(const LAS bf16x8*)(KS + (32 * st + r32) * H_P256 + (16 * step + 8 * hi) * 2);
                bqf[step] = *(const LAS bf16x8*)(QS + (32 * tt_ + r32) * H_P256 + (16 * step + 8 * hi) * 2); }
#pragma unroll
            for (int step = 0; step < 8; ++step) x = __builtin_amdgcn_mfma_f32_32x32x16_bf16(af[step], bqf[step], x, 0, 0, 0);
            if (st == tt_) {
#pragma unroll
                for (int r = 0; r < 16; ++r) if (crow16(r, hi) > r32) x[r] = 0.f;
            }
#pragma unroll
            for (int sp = 0; sp < 2; ++sp) {
                v4u pw; pw.x = pk2(x[8 * sp + 0], x[8 * sp + 1]); pw.y = pk2(x[8 * sp + 2], x[8 * sp + 3]); pw.z = pk2(x[8 * sp + 4], x[8 * sp + 5]); pw.w = pk2(x[8 * sp + 6], x[8 * sp + 7]);
                const bf16x8 xs = __builtin_bit_cast(bf16x8, pw);
                const LAS unsigned char* ip = ITL + (32 * vt + r32) * H_P128 + (32 * st + 16 * sp + 4 * hi) * 2;
                const s16x4 lo = *(const LAS s16x4*)ip, hh = *(const LAS s16x4*)(ip + 16);
                const bf16x8 pb = __builtin_shufflevector(lo, hh, 0, 1, 2, 3, 4, 5, 6, 7);
                z = __builtin_amdgcn_mfma_f32_32x32x16_bf16(xs, pb, z, 0, 0, 0);
            }
        }
        bf16* op = OBO + (rowbase + 32 * tt_) * DM + h * 128 + 32 * vt + r32;
#pragma unroll
        for (int r = 0; r < 16; ++r) op[(size_t)crow16(r, hi) * DM] = (bf16)f2bf(z[r]);
        LDS_BAR();
    }
}
#undef H1_LOAD
__device__ __forceinline__ void hgrn_scan_phase(Frame& F, bf16* OBO) {
    const bf16* BIG = (const bf16*)(F.ws + WS_BIG); const bf16* KLT = (const bf16*)(F.ws + WS_KLT); const bf16* ITG = (const bf16*)(F.ws + WS_IT); const float* EBL = (const float*)(F.ws + WS_EBL); const bf16* OB = (const bf16*)(F.ws + WS_OB);
    constexpr int TB = 64 * H_P256 + 128 * H_P128 + 32 * H_P128 + 512;
    constexpr int STB = 32 * H_P256;
    constexpr int IOB = 64 * 64;
    LAS unsigned char* TL = F.lds; LAS unsigned char* STL = F.lds + 2 * TB; LAS unsigned char* ISL = STL + 2 * STB; LAS unsigned char* OSL = ISL + 2 * IOB;
    const int tid = F.tid, r32 = F.lane & 31, hi = F.lane >> 5, w = F.wave;
    for (int unit = F.vcu; unit < NB * NH * 4; unit += F.G) {
        const int bh = unit >> 2, vq = unit & 3, b = bh >> 4, h = bh & 15;
        f32x16 acc = {};
        v4u q0[2], k0[2], i0, e0, q1[2], k1[2], i1, e1, ivr[2];
        i0 = i1 = e0 = e1 = ivr[0] = ivr[1] = (v4u){(unsigned)tid >> 31, 0u, 0u, 0u};
        const int ioq = (F.lane + 64 * (w & 1));
#define H2_LOAD(Q, K, I, E, c) do { const size_t rb_ = (size_t)b * SEQ + (size_t)(c) * 64; const size_t un_ = (size_t)bh * 128 + (c); \
        _Pragma("unroll") for (int i_ = 0; i_ < 2; ++i_) { const int p_ = tid + 512 * i_; \
            Q[i_] = *(const GAS v4u*)(BIG + (rb_ + (p_ >> 4)) * 8192 + h * 128 + (p_ & 15) * 8); K[i_] = *(const GAS v4u*)(KLT + un_ * 8192 + (size_t)p_ * 8); } \
        if (tid < 256) I = *(const GAS v4u*)(ITG + un_ * 8192 + (size_t)(32 * vq) * 64 + (size_t)tid * 8); \
        if (tid < 32) E = *(const GAS v4u*)(EBL + un_ * 128 + 4 * tid); } while (0)
#define H2_WRITE(Q, K, I, E, bufo) do { LAS unsigned char* tb_ = TL + (bufo); _Pragma("unroll") for (int i_ = 0; i_ < 2; ++i_) { const int p_ = tid + 512 * i_; \
            *(LAS v4u*)(tb_ + (p_ >> 4) * H_P256 + (p_ & 15) * 16) = Q[i_]; *(LAS v4u*)(tb_ + 64 * H_P256 + (p_ >> 3) * H_P128 + (p_ & 7) * 16) = K[i_]; } \
        if (tid < 256) *(LAS v4u*)(tb_ + 64 * H_P256 + 128 * H_P128 + (tid >> 3) * H_P128 + (tid & 7) * 16) = I; \
        if (tid < 32) *(LAS v4u*)(tb_ + 64 * H_P256 + 128 * H_P128 + 32 * H_P128 + 16 * tid) = E; } while (0)
#define H2_IVLD(c) do { _Pragma("unroll") for (int j_ = 0; j_ < 2; ++j_) { const int q_ = ioq + 128 * j_; \
            ivr[j_] = *(const GAS v4u*)(OB + ((size_t)b * SEQ + (size_t)(c) * 64 + (q_ >> 2)) * DM + h * 128 + 32 * vq + (q_ & 3) * 8); } } while (0)
#define H2_IVST(slot) do { _Pragma("unroll") for (int j_ = 0; j_ < 2; ++j_) { const int q_ = ioq + 128 * j_; *(LAS v4u*)(ISL + (slot) * IOB + (q_ >> 2) * 64 + (q_ & 3) * 16) = ivr[j_]; } } while (0)
#define H2_OST(c, slot) do { _Pragma("unroll") for (int j_ = 0; j_ < 2; ++j_) { const int q_ = ioq + 128 * j_; const v4u v_ = *(const LAS v4u*)(OSL + (slot) * IOB + (q_ >> 2) * 64 + (q_ & 3) * 16); \
            *(GAS v4u*)(OBO + ((size_t)b * SEQ + (size_t)(c) * 64 + (q_ >> 2)) * DM + h * 128 + 32 * vq + (q_ & 3) * 8) = v_; } } while (0)
#define H2_STEP(c, cur, Qn, Kn, In, En) do { LAS unsigned char* tb_ = TL + (cur) * TB; LAS unsigned char* st_ = STL + (cur) * STB; \
          \
          \
        if (w >= 6 && (c) + 1 < SEQ / 64) H2_IVST((cur) ^ 1);      \
        if ((c) + 1 < SEQ / 64) H2_WRITE(Qn, Kn, In, En, ((cur) ^ 1) * TB); \
        if (w >= 6) { if ((c) + 2 < SEQ / 64) H2_IVLD((c) + 2); \
            if ((c) >= 1) H2_OST((c) - 1, (cur) ^ 1); }             \
        if ((c) + 3 < SEQ / 64) H2_LOAD(Qn, Kn, In, En, (c) + 3); \
        if (w < 4) { const LAS float* eb_ = (const LAS float*)(tb_ + 64 * H_P256 + 128 * H_P128 + 32 * H_P128); \
            _Pragma("unroll") for (int r = 0; r < 16; ++r) acc[r] *= eb_[32 * w + crow16(r, hi)]; \
            _Pragma("unroll") for (int step = 0; step < 4; ++step) { const bf16x8 a_ = *(const LAS bf16x8*)(tb_ + 64 * H_P256 + (32 * w + r32) * H_P128 + (16 * step + 8 * hi) * 2); \
                const bf16x8 b_ = *(const LAS bf16x8*)(tb_ + 64 * H_P256 + 128 * H_P128 + r32 * H_P128 + (16 * step + 8 * hi) * 2); acc = __builtin_amdgcn_mfma_f32_32x32x16_bf16(a_, b_, acc, 0, 0, 0); } \
            LAS unsigned char* sn_ = STL + ((cur) ^ 1) * STB + r32 * H_P256 + (32 * w + 4 * hi) * 2; \
            _Pragma("unroll") for (int g = 0; g < 4; ++g) *(LAS unsigned long long*)(sn_ + 16 * g) = (unsigned long long)pk2(acc[4 * g], acc[4 * g + 1]) | ((unsigned long long)pk2(acc[4 * g + 2], acc[4 * g + 3]) << 32); \
        } else if (w < 6) { f32x16 o_ = {}; \
            _Pragma("unroll") for (int step = 0; step < 8; ++step) { const bf16x8 a_ = *(const LAS bf16x8*)(tb_ + (32 * (w - 4) + r32) * H_P256 + (16 * step + 8 * hi) * 2); \
                const bf16x8 b_ = *(const LAS bf16x8*)(st_ + r32 * H_P256 + (16 * step + 8 * hi) * 2); o_ = __builtin_amdgcn_mfma_f32_32x32x16_bf16(a_, b_, o_, 0, 0, 0); } \
            const int so_ = (32 * (w - 4) + 4 * hi) * 64 + r32 * 2; bf16 iv_[16]; \
            _Pragma("unroll") for (int r = 0; r < 16; ++r) iv_[r] = *(const LAS bf16*)(ISL + (cur) * IOB + so_ + ((r & 3) + 8 * (r >> 2)) * 64);     \
            _Pragma("unroll") for (int r = 0; r < 16; ++r) *(LAS bf16*)(OSL + (cur) * IOB + so_ + ((r & 3) + 8 * (r >> 2)) * 64) = (bf16)f2bf(o_[r] + bf_f(iv_[r])); } \
        LDS_BAR(); } while (0)
        { const unsigned zz = (unsigned)tid >> 31;
          for (int i = tid; i < STB / 16; i += NWAVES * 64) *(LAS v4u*)(STL + 16 * i) = (v4u){zz, zz, zz, zz}; }
        H2_LOAD(q0, k0, i0, e0, 0); H2_WRITE(q0, k0, i0, e0, 0);
        H2_LOAD(q1, k1, i1, e1, 1); H2_LOAD(q0, k0, i0, e0, 2);
        if (w >= 6) { H2_IVLD(0); H2_IVST(0); H2_IVLD(1); }
        LDS_BAR();
#pragma unroll 1
        for (int c = 0; c < SEQ / 64; c += 2) {
            H2_STEP(c, 0, q1, k1, i1, e1);
            H2_STEP(c + 1, 1, q0, k0, i0, e0);
        }
        if (w >= 6) H2_OST(SEQ / 64 - 1, 1);
        LDS_BAR();
#undef H2_LOAD
#undef H2_WRITE
#undef H2_IVLD
#undef H2_IVST
#undef H2_OST
#undef H2_STEP
    }
}
__device__ __forceinline__ void hgrn_final_phase(Frame& F, bf16* OBO) {
    const bf16* BIG = (const bf16*)(F.ws + WS_BIG); bf16* OB = (bf16*)(F.ws + WS_OB); const float* gn = F.a->in[19];
    const int gw = F.vcu * NWAVES + F.wave, NGW = F.G * NWAVES;
    const int dv = (F.lane & 15) * 8;
    const f32x4 g0 = *(const f32x4*)(gn + dv), g1 = *(const f32x4*)(gn + dv + 4);
    for (int row = gw; row < MT; row += NGW) {
        GAS v4u* po = (GAS v4u*)(OB + (size_t)row * DM) + F.lane; const GAS v4u* pg = (const GAS v4u*)(BIG + (size_t)row * 8192 + 6144) + F.lane;
        v4u wo[4], wg[4];
#pragma unroll
        for (int it = 0; it < 4; ++it) { wo[it] = po[64 * it]; wg[it] = pg[64 * it]; }
#pragma unroll
        for (int it = 0; it < 4; ++it) { float x[8], gg[8]; unpack8(wo[it], x); unpack8(wg[it], gg);
            float ss = 0.f;
#pragma unroll
            for (int i = 0; i < 8; ++i) ss += x[i] * x[i];
            ss += sx<1>(ss); ss += sx<2>(ss); ss += sx<4>(ss); ss += sx<8>(ss);
            const float rstd = rsqrtf(ss * (1.0f / 128.0f) + RMS_EPS);
            float y[8];
#pragma unroll
            for (int i = 0; i < 8; ++i) { const float gi = (i < 4) ? g0[i] : g1[i - 4]; y[i] = x[i] * rstd * gi * (gg[i] * __builtin_amdgcn_rcpf(1.0f + __expf(-gg[i]))); }
            v4u o; o.x = pk2(y[0], y[1]); o.y = pk2(y[2], y[3]); o.z = pk2(y[4], y[5]); o.w = pk2(y[6], y[7]);
            ((GAS v4u*)(OBO + (size_t)row * DM) + F.lane)[64 * it] = o; }
    }
}
__device__ __forceinline__ bool ph_refresh(Frame& F) { unsigned m = ~0u; asm volatile("" : "+s"(m));
    const int t = (F.wave << 6) | (int)__builtin_amdgcn_mbcnt_hi(m, __builtin_amdgcn_mbcnt_lo(m, 0u));
    F.tid = t; F.lane = t & 63; return true; }
__global__ void __launch_bounds__(NWAVES * 64, 2) trunk_fwd(Args args) {
    extern __shared__ __attribute__((aligned(16))) unsigned char lds[];
    Frame F;
    F.lds = (LAS unsigned char*)lds;
    F.MISC = (volatile LAS unsigned*)(F.lds + MISC_OFF);
    F.tid = threadIdx.x; F.lane = F.tid & 63; F.wave = __builtin_amdgcn_readfirstlane(F.tid >> 6);
    F.G = gridDim.x; { const int bx = blockIdx.x; F.vcu = (F.G % 8 == 0) ? (bx % 8) * (F.G / 8) + bx / 8 : bx; }
    F.ws = args.ws; F.ctl = (gu32*)(args.ws + WS_CTL); F.out = args.out;
    F.a = &args;
    for (int u = F.tid; u < (LDS_BYTES - LDSCTL_OFF) / 4; u += NWAVES * 64) ((LAS unsigned*)(F.lds + LDSCTL_OFF))[u] = 0u;
    __syncthreads();
    XcdBarrier bar; bar.bar = (unsigned*)(F.ctl + CW_BAR); bar.x = 0; bar.st = nullptr;
    if (!MK_PER_PHASE) bar = xcd_barrier_post((unsigned*)(F.ctl + CW_BAR), F.MISC + 8);
    const int lo = args.ph_lo, hi = args.ph_hi;
    int pc = 0;
    unsigned long long t_ph = PROBE_ECHO ? __builtin_amdgcn_s_memrealtime() : 0ull;
#define PH_ON (pc >= lo && pc < hi && ph_refresh(F))
#define PH_END_C(cls) do { if (!MK_PER_PHASE && pc >= lo && pc + 1 < hi) { const unsigned long long ta_ = (PROBE_IDLE && (PROBE_IDLE == 100 || PROBE_IDLE == (cls))) ? __builtin_amdgcn_s_memrealtime() : 0ull; xcd_barrier(bar); if (PROBE_MASK & 32) xcd_barrier(bar); \
        if (PROBE_IDLE && (PROBE_IDLE == 100 || PROBE_IDLE == (cls))) { const unsigned long long t1_ = __builtin_amdgcn_s_memrealtime(), d_ = t1_ - ta_; while (__builtin_amdgcn_s_memrealtime() - t1_ < d_) __builtin_amdgcn_s_sleep(8); xcd_barrier(bar); } \
        if (PROBE_ECHO == (cls)) { const unsigned long long t1_ = __builtin_amdgcn_s_memrealtime(), d_ = t1_ - t_ph; while (__builtin_amdgcn_s_memrealtime() - t1_ < d_) __builtin_amdgcn_s_sleep(8); xcd_barrier(bar); } \
        if (PROBE_ECHO) t_ph = __builtin_amdgcn_s_memrealtime(); } ++pc; } while (0)
#define PH_END PH_END_C(0)
    float* mod = (float*)(F.ws + WS_MOD);
    bf16* XN = (bf16*)(F.ws + WS_XN); bf16* BIG = (bf16*)(F.ws + WS_BIG); bf16* OB = (bf16*)(F.ws + WS_OB);
    float* RSS = (float*)(F.ws + WS_RSS); const float* CB = (const float*)(F.ws + WS_CB);
    if (PH_ON) { p0_mod(F); __syncthreads(); p0_convert(F); }
#if PROBE_MASK & 16
    if (PH_ON) { __syncthreads(); p0_mod(F); __syncthreads(); p0_convert(F); }
#endif
    PH_END_C(1);
    if (PH_ON) { tables_phase(F); bias_phase(F); xs0_phase(F, F.a->in[0], F.a->in[4], mod); }
#if PROBE_MASK & 16384
    if (PH_ON) { tables_phase(F); bias_phase(F); xs0_phase(F, F.a->in[0], F.a->in[4], mod); }
#endif
    PH_END_C(2);
#pragma unroll 1
    for (int L = 0; L < NLAYER; ++L) {
        const int kind = L % 3, slot = L / 3;
        const float* modL = mod + (size_t)L * NB * NMOD;
#pragma unroll 1
        for (int sub = 0; sub < 3; ++sub) {
            const int s = 3 * L + sub;
            const float* rss = RSS + (size_t)s * MT; const float* cb = CB + (size_t)s * NB * CB_LD;
            const bf16* outA; const bf16* outB; int outK;
            const int nhalf = (sub != 1) ? FFN_SPLIT : 1;
#pragma unroll 1
            for (int hf = 0; hf < nhalf; ++hf) {
            const int Mpart = MT / nhalf, pm_off = hf * (Mpart / 256);
            if (sub != 1) {
                const int ls = L * 2 + (sub >> 1);
                if (PH_ON) { pg8::Gemm g{XN, (const bf16*)(F.ws + WS_WGU) + (size_t)ls * 2 * FF * DM, Mpart, 2 * FF, DM, 1, 1}; pg8::StaticOrder S; S.init(Mpart, 2 * FF, F.G, (int)blockIdx.x, GU_WGM, pm_off);
                    pg8::EpiSwigluN E{BIG, FF, rss, cb, CB_LD, SEQ, F.lds + PRE_OFF};
#pragma unroll 1
                    for (int rep = 0; rep < ((PROBE_MASK & 1) ? 2 : 1); ++rep) { if (rep) __syncthreads(); pg8::gemm_phase<pg8::EpiSwigluN, pg8::StaticOrder, true, true>(F.lds + RING_OFF, g, S, E, F.tid); }
                    }
                PH_END_C(3);
                outA = BIG; outB = (const bf16*)(F.ws + WS_WD) + (size_t)ls * DM * FF; outK = FF;
            } else {
                const int nin = (kind == 2) ? 4 * DM : 3 * DM;
                const bf16* win = (kind == 0) ? (const bf16*)(F.ws + WS_WAI) + (size_t)slot * 3 * DM * DM : (kind == 1) ? (const bf16*)(F.ws + WS_WCI) : (const bf16*)(F.ws + WS_WHI);
                if (PH_ON) { pg8::Gemm g{XN, win, MT, nin, DM, 1, 1}; pg8::StaticOrder S; S.init(MT, nin, F.G, (int)blockIdx.x, GU_WGM);
                    pg8::EpiInN E{BIG, nin, rss, cb, CB_LD, SEQ, (kind == 0) ? 16 : 0, F.a->in[10] + (size_t)slot * 64, F.a->in[11] + (size_t)slot * 64, F.lds + PRE_OFF};
#pragma unroll 1
                    for (int rep = 0; rep < ((PROBE_MASK & 4) ? 2 : 1); ++rep) { if (rep) __syncthreads(); pg8::gemm_phase<pg8::EpiInN, pg8::StaticOrder, true, true>(F.lds + RING_OFF, g, S, E, F.tid); }
                    }
                PH_END_C(5);
                if (kind == 0) {
#if PROBE_MASK & 8192
                    if (PH_ON) { attn_phase(F, L, slot, 1); __syncthreads(); }
#endif
                    if (PH_ON) attn_phase(F, L, slot);
                    PH_END_C(7);
                } else if (kind == 1) {
                    if (PH_ON) conv_phase(F);
                    PH_END_C(8);
                } else {
#if PROBE_MASK & 64
                    if (PH_ON) { hgrn_prep_phase(F, L, XN, DM, XN); __syncthreads(); }
#endif
                    if (PH_ON) hgrn_prep_phase(F, L, BIG, 8192, OB);
                    PH_END_C(9);
#if PROBE_MASK & 128
                    if (PH_ON) { hgrn_scan_phase(F, XN); __syncthreads(); }
#endif
                    if (PH_ON) hgrn_scan_phase(F, OB);
                    PH_END_C(10);
                    if (PH_ON) hgrn_final_phase(F, OB);
                    PH_END_C(11);
                }
                outA = OB; outB = (kind == 0) ? (const bf16*)(F.ws + WS_WAO) + (size_t)slot * DM * DM : (kind == 1) ? (const bf16*)(F.ws + WS_WCO) : (const bf16*)(F.ws + WS_WHO); outK = DM;
            }
            if (PH_ON) { pg8::Gemm g{outA, outB, Mpart, DM, outK, (sub != 1) ? 1 : 0, 1};     pg8::StaticOrder S; S.init(Mpart, DM, F.G, (int)blockIdx.x, OUT_WGM, pm_off);
                const int sn = s + 1; const bool last = (s == 3 * NLAYER - 1);
                const float* TAB = (const float*)(F.ws + WS_TAB);
                pg8::EpiResN E{(s == 0) ? (const void*)F.a->in[0] : (const void*)(F.ws + WS_XH), last ? (void*)F.out : (void*)(F.ws + WS_XH), (s == 0) ? 1 : 0, last ? 1 : 0, DM, TAB + (size_t)(s * 2 + 0) * NB * DM, TAB + (size_t)(s * 2 + 1) * NB * DM, DM, SEQ, last ? (bf16*)nullptr : XN, RSS + (size_t)sn * MT, F.lds + PRE_OFF, 1.0f};
#pragma unroll 1
                for (int rep = (((PROBE_MASK & 2) || ((PROBE_MASK & 2048) && sub != 1) || ((PROBE_MASK & 4096) && sub == 1)) ? 0 : 1); rep < 2; ++rep) {
                    pg8::EpiResN E2 = E;
#if PROBE_MASK & (2 | 2048 | 4096)
                    { const bool dbl = (PROBE_MASK & 2) || ((PROBE_MASK & 2048) && sub != 1) || ((PROBE_MASK & 4096) && sub == 1);
                      if (dbl) { E2.gscale = 0.5f; if (rep == 0) { E2.rssn = RSS + (size_t)12 * MT; if (last) { E2.out = (void*)(F.ws + WS_XH); E2.out_f32 = 0; } } else if (s == 0) { E2.base = (const void*)(F.ws + WS_XH); E2.base_f32 = 0; } } }
#endif
                    if (rep == 0) __syncthreads();
                    pg8::gemm_phase<pg8::EpiResN, pg8::StaticOrder, true, true, OUT_A_AUX>(F.lds + RING_OFF, g, S, E2, F.tid); if (rep == 0) __syncthreads(); } }
            PH_END_C((sub != 1) ? 4 : 6);
            }
        }
    }
#undef PH_ON
#undef PH_END
#undef PH_END_C
}
extern "C" void kernel_launch(void* const* d_in, const int* in_sizes, int n_in, void* d_out, int out_size, void* d_ws, size_t ws_size, hipStream_t stream) {
    static int grid = 0;
    if (grid == 0) {
        if (n_in != 21 || in_sizes[0] != MT * DM || out_size != MT * DM || ws_size < WS_END) { fprintf(stderr, "kernel_launch: shape/workspace mismatch (n_in %d, in0 %d, out %d, ws %zu, need %zu); nothing launched\n", n_in, n_in > 0 ? in_sizes[0] : -1, out_size, ws_size, (size_t)WS_END); grid = -1; return; }
        int dev = 0, cus = 0, per_cu = 0;
        if (hipGetDevice(&dev) != hipSuccess || hipDeviceGetAttribute(&cus, hipDeviceAttributeMultiprocessorCount, dev) != hipSuccess) { fprintf(stderr, "kernel_launch: device query failed\n"); grid = -1; return; }
        if (hipFuncSetAttribute((const void*)trunk_fwd, hipFuncAttributeMaxDynamicSharedMemorySize, LDS_BYTES) != hipSuccess) { fprintf(stderr, "kernel_launch: hipFuncSetAttribute failed\n"); grid = -1; return; }
        if (hipOccupancyMaxActiveBlocksPerMultiprocessor(&per_cu, (const void*)trunk_fwd, NWAVES * 64, LDS_BYTES) != hipSuccess || per_cu < 1) fprintf(stderr, "kernel_launch: note: occupancy query reports %d workgroups per CU\n", per_cu);
        (void)hipGetLastError();
        grid = cus;
    }
    if (grid < 0) return;
    if (hipMemsetAsync((char*)d_ws + WS_CTL, 0, CTL_ZERO_BYTES, stream) != hipSuccess) { fprintf(stderr, "kernel_launch: memset failed\n"); return; }
    Args a{};
    for (int i = 0; i < 21; ++i) a.in[i] = (const float*)d_in[i];
    a.out = (float*)d_out; a.ws = (unsigned char*)d_ws;
#if MK_PER_PHASE
    for (int p = 0; p < N_PHASES; ++p) { a.ph_lo = p; a.ph_hi = p + 1; hipLaunchKernelGGL(trunk_fwd, dim3(grid), dim3(NWAVES * 64), LDS_BYTES, stream, a); }
#else
    a.ph_lo = 0; a.ph_hi = N_PHASES;
    hipLaunchKernelGGL(trunk_fwd, dim3(grid), dim3(NWAVES * 64), LDS_BYTES, stream, a);
#endif
    const hipError_t le = hipPeekAtLastError();
    if (le != hipSuccess) fprintf(stderr, "kernel_launch: launch failed: %s\n", hipGetErrorName(le));
}
```

```cpp
#include <hip/hip_runtime.h>
#include <cstdio>
#include <cstdint>
template <int X> __device__ __forceinline__ float sx(float v) { return __int_as_float(__builtin_amdgcn_ds_swizzle(__float_as_int(v), (X << 10) | 0x1f)); }
__device__ __forceinline__ float sum32(float v) { auto rr = __builtin_amdgcn_permlane32_swap(__float_as_uint(v), __float_as_uint(v), false, false); return __uint_as_float(rr[0]) + __uint_as_float(rr[1]); }
__device__ __forceinline__ float max32(float v) { auto rr = __builtin_amdgcn_permlane32_swap(__float_as_uint(v), __float_as_uint(v), false, false); return fmaxf(__uint_as_float(rr[0]), __uint_as_float(rr[1])); }
__device__ __forceinline__ float wave_sum(float v) { v += sx<1>(v); v += sx<2>(v); v += sx<4>(v); v += sx<8>(v); v += sx<16>(v); return sum32(v); }
__device__ __forceinline__ float wave_max(float v) { v = fmaxf(v, sx<1>(v)); v = fmaxf(v, sx<2>(v)); v = fmaxf(v, sx<4>(v)); v = fmaxf(v, sx<8>(v)); v = fmaxf(v, sx<16>(v)); return max32(v); }
typedef float f32x2_cv __attribute__((ext_vector_type(2))); typedef __bf16 bf16x2_cv __attribute__((ext_vector_type(2)));
__device__ __forceinline__ unsigned pk2(float lo, float hi) { const f32x2_cv v = {lo, hi}; const bf16x2_cv b = __builtin_convertvector(v, bf16x2_cv); return __builtin_bit_cast(unsigned, b); }
__device__ __forceinline__ unsigned f2bf(float f) { return pk2(f, 0.f) & 0xffffu; }
namespace pg8 {
#define PG8_LAS __attribute__((address_space(3)))
typedef unsigned short bf16_t;
typedef short bf16x8 __attribute__((ext_vector_type(8)));
typedef float f32x4 __attribute__((ext_vector_type(4)));
typedef unsigned u32x4 __attribute__((ext_vector_type(4)));
constexpr int BM = 256, BK = 64, HALF = 128, HTB = HALF * BK * 2  , STAGE_BYTES = 8 * HTB, NXCD = 8, WGM = 8;

__host__ __device__ __forceinline__ int lds_byte(int r, int c) { const int st = (r >> 4) * 2 + (c >> 5), rr = r & 15, cc = c & 31, ob = rr * 64 + cc * 2; return st * 1024 + (ob ^ (((ob >> 9) & 1) << 5)); }
__host__ __device__ __forceinline__ void stage_rc(int b, int& R, int& C) { const int st = b / 1024, sb = b % 1024, swz = sb ^ (((sb >> 9) & 1) << 5); R = (st >> 1) * 16 + swz / 64; C = (st & 1) * 32 + (swz % 64) / 2; }
__host__ __device__ __forceinline__ int perm32(int rho) { const int n = rho >> 4, i = rho & 15; return 8 * (i >> 2) + 4 * n + (i & 3); }

struct Unit { int pm, pn; };
struct Gemm { const bf16_t* A; const bf16_t* Bt; int M, N, K; int a_tiled = 0, b_tiled = 0; };

struct StaticOrder {
    int nM, nN, nwg, G, c, wgm, pm_off;
    __host__ __device__ void init(int M, int N, int G_, int c_, int wgm_ = WGM, int pm_off_ = 0) { nM = M / BM; nN = N / BM; nwg = nM * nN; G = G_; c = c_; wgm = wgm_; pm_off = pm_off_; }
    __host__ __device__ bool next(int i, Unit& u) const {
        const long L = (long)i * G + c; if (L >= nwg) return false;
        int wgid = (int)L; { const int q = nwg / NXCD, r = nwg % NXCD, xcd = wgid % NXCD, off = wgid / NXCD; wgid = (xcd < r ? xcd * (q + 1) : r * (q + 1) + (xcd - r) * q) + off; }
        const int nig = wgm * nN, gid = wgid / nig, fm = gid * wgm, gsz = (nM - fm) < wgm ? (nM - fm) : wgm;
        u.pm = pm_off + fm + ((wgid % nig) % gsz); u.pn = (wgid % nig) / gsz; return true;
    }
    __device__ __forceinline__ void a_ready(const Unit&) const {}
    __device__ __forceinline__ void done(const Unit&) const {}
};

__device__ __forceinline__ unsigned cvt_pk_bf16(float lo, float hi) { unsigned r; asm volatile("v_cvt_pk_bf16_f32 %0, %1, %2" : "=v"(r) : "v"(lo), "v"(hi)); return r; }
typedef float f32x2 __attribute__((ext_vector_type(2)));
typedef unsigned u32x2 __attribute__((ext_vector_type(2)));
struct EpiStore {
    static constexpr bool HAS_PRE = false;
    static constexpr bool PERM = true, AFTER_DRAIN = false;
    bf16_t* O; int ldc;
    __device__ __forceinline__ void operator()(const f32x4 (&acc)[2][2][4][2], const Unit& u, int wr, int wc, int fr, int fq) const {
        const int row0 = u.pm * BM + wr * 64 + fr, col0 = u.pn * BM + wc * 32 + 8 * fq;
#pragma unroll
        for (int ai = 0; ai < 2; ++ai)
#pragma unroll
            for (int m = 0; m < 4; ++m) { bf16_t* rowp = O + (size_t)(row0 + ai * HALF + m * 16) * ldc + col0;
#pragma unroll
                for (int bj = 0; bj < 2; ++bj) { const f32x4 v0 = acc[ai][bj][m][0], v1 = acc[ai][bj][m][1];
                    u32x4 w; w.x = cvt_pk_bf16(v0[0], v0[1]); w.y = cvt_pk_bf16(v0[2], v0[3]); w.z = cvt_pk_bf16(v1[0], v1[1]); w.w = cvt_pk_bf16(v1[2], v1[3]);
                    *(u32x4*)(rowp + bj * HALF) = w; } }
    }
};
__device__ __forceinline__ float swiglu1(float g, float u) { const float e = __builtin_amdgcn_exp2f(g * -1.4426950408889634f); return g * u * __builtin_amdgcn_rcpf(1.0f + e); }
struct EpiSwiglu {
    static constexpr bool HAS_PRE = false;
    static constexpr bool PERM = true, AFTER_DRAIN = false;
    bf16_t* O; int ldc;
    __device__ __forceinline__ void operator()(const f32x4 (&acc)[2][2][4][2], const Unit& u, int wr, int wc, int fr, int fq) const {
        const int row0 = u.pm * BM + wr * 64 + fr, col0 = u.pn * HALF + wc * 32 + 8 * fq;
#pragma unroll
        for (int ai = 0; ai < 2; ++ai)
#pragma unroll
            for (int m = 0; m < 4; ++m) { bf16_t* rowp = O + (size_t)(row0 + ai * HALF + m * 16) * ldc + col0;
                const f32x4 g0 = acc[ai][0][m][0], g1 = acc[ai][0][m][1], u0 = acc[ai][1][m][0], u1 = acc[ai][1][m][1];
                u32x4 w;
                w.x = cvt_pk_bf16(swiglu1(g0[0], u0[0]), swiglu1(g0[1], u0[1])); w.y = cvt_pk_bf16(swiglu1(g0[2], u0[2]), swiglu1(g0[3], u0[3]));
                w.z = cvt_pk_bf16(swiglu1(g1[0], u1[0]), swiglu1(g1[1], u1[1])); w.w = cvt_pk_bf16(swiglu1(g1[2], u1[2]), swiglu1(g1[3], u1[3]));
                *(u32x4*)rowp = w; }
    }
};
struct EpiRes {
    static constexpr bool HAS_PRE = false;
    static constexpr bool PERM = false, AFTER_DRAIN = false;
    const float* base; float* out; int ldc; const float* gate; int gstride; float coef; int rows_per_batch;
    __device__ __forceinline__ void operator()(const f32x4 (&acc)[2][2][4][2], const Unit& u, int wr, int wc, int fr, int fq) const {
        const int row0 = u.pm * BM + wr * 64 + fr, col0 = u.pn * BM + wc * 32 + 4 * fq;
        const float* gp = gate + (size_t)((u.pm * BM) / rows_per_batch) * gstride + col0;
        f32x4 gv[2][2];
#pragma unroll
        for (int bj = 0; bj < 2; ++bj)
#pragma unroll
            for (int n = 0; n < 2; ++n) gv[bj][n] = *(const f32x4*)(gp + bj * HALF + n * 16) * coef;
#pragma unroll
        for (int ai = 0; ai < 2; ++ai)
#pragma unroll
            for (int m = 0; m < 4; ++m) { const size_t off = (size_t)(row0 + ai * HALF + m * 16) * ldc + col0;
#pragma unroll
                for (int bj = 0; bj < 2; ++bj)
#pragma unroll
                    for (int n = 0; n < 2; ++n) { const f32x4 bs = *(const f32x4*)(base + off + bj * HALF + n * 16); *(f32x4*)(out + off + bj * HALF + n * 16) = bs + gv[bj][n] * acc[ai][bj][m][n]; }
                if (m & 1) asm volatile("" ::: "memory"); }
    }
};
__device__ __forceinline__ float rstd_of(const float* rss, int row) { return rsqrtf(rss[row] * (1.0f / 2048.0f) + 1e-6f); }
struct EpiSwigluN {
    static constexpr bool HAS_PRE = true;
    static constexpr bool PERM = true, AFTER_DRAIN = false;
    bf16_t* O; int ldc; const float* rss; const float* cb; int cbstride; int rows_per_batch; PG8_LAS unsigned char* pre_lds;
    __device__ __forceinline__ void pre(const Unit& u, int lane) const {
        __builtin_amdgcn_global_load_lds((const unsigned*)(cb + (size_t)((u.pm * BM) / rows_per_batch) * cbstride + u.pn * BM + 4 * lane), (PG8_LAS unsigned*)pre_lds, 16, 0, 0);
        __builtin_amdgcn_global_load_lds((const unsigned*)(rss + u.pm * BM + 4 * lane), (PG8_LAS unsigned*)(pre_lds + 1024), 16, 0, 0); }
    __device__ __forceinline__ void operator()(const f32x4 (&acc)[2][2][4][2], const Unit& u, int wr, int wc, int fr, int fq) const {
        const int col0 = u.pn * HALF + wc * 32 + 8 * fq;
        const PG8_LAS float* cbp = (const PG8_LAS float*)pre_lds + wc * 32 + 8 * fq; const PG8_LAS float* rp = (const PG8_LAS float*)(pre_lds + 1024) + wr * 64 + fr;
        constexpr float LC = 1.4426950408889634f, ILC = 0.6931471805599453f;
        const f32x4 cg0 = *(const PG8_LAS f32x4*)(cbp) * LC, cg1 = *(const PG8_LAS f32x4*)(cbp + 4) * LC, cu0 = *(const PG8_LAS f32x4*)(cbp + HALF) * ILC, cu1 = *(const PG8_LAS f32x4*)(cbp + HALF + 4) * ILC;
#pragma unroll
        for (int ai = 0; ai < 2; ++ai)
#pragma unroll
            for (int m = 0; m < 4; ++m) { const float rs = __builtin_amdgcn_rsqf(rp[ai * HALF + m * 16] * (1.0f / 2048.0f) + 1e-6f), rsg = rs * LC, rsu = rs * ILC;
                bf16_t* rowp = O + ((size_t)(u.pm * (ldc >> 6) + (col0 >> 6)) * BM + (wr * 64 + fr + ai * HALF + m * 16)) * 64 + (col0 & 63);
                const f32x4 h0 = acc[ai][0][m][0] * rsg + cg0, h1 = acc[ai][0][m][1] * rsg + cg1, u0 = acc[ai][1][m][0] * rsu + cu0, u1 = acc[ai][1][m][1] * rsu + cu1;
                f32x4 e0, e1;
#pragma unroll
                for (int i = 0; i < 4; ++i) { e0[i] = __builtin_amdgcn_exp2f(-h0[i]); e1[i] = __builtin_amdgcn_exp2f(-h1[i]); }
                e0 = e0 + 1.0f; e1 = e1 + 1.0f;
                f32x4 r0, r1;
#pragma unroll
                for (int i = 0; i < 4; ++i) { r0[i] = __builtin_amdgcn_rcpf(e0[i]); r1[i] = __builtin_amdgcn_rcpf(e1[i]); }
                const f32x4 o0 = (h0 * u0) * r0, o1 = (h1 * u1) * r1;
                u32x4 w;
                w.x = pk2(o0[0], o0[1]); w.y = pk2(o0[2], o0[3]); w.z = pk2(o1[0], o1[1]); w.w = pk2(o1[2], o1[3]);
                __builtin_nontemporal_store(w, (u32x4*)rowp); }
    }
};
struct EpiInN {
    static constexpr bool HAS_PRE = true;
    static constexpr bool PERM = true, AFTER_DRAIN = false;
    bf16_t* O; int ldc; const float* rss; const float* cb; int cbstride; int rows_per_batch; int nqk; const float* gq; const float* gk; PG8_LAS unsigned char* pre_lds;
    __device__ __forceinline__ void pre(const Unit& u, int lane) const {
        __builtin_amdgcn_global_load_lds((const unsigned*)(cb + (size_t)((u.pm * BM) / rows_per_batch) * cbstride + u.pn * BM + 4 * lane), (PG8_LAS unsigned*)pre_lds, 16, 0, 0);
        __builtin_amdgcn_global_load_lds((const unsigned*)(rss + u.pm * BM + 4 * lane), (PG8_LAS unsigned*)(pre_lds + 1024), 16, 0, 0); }
    __device__ __forceinline__ void operator()(const f32x4 (&acc)[2][2][4][2], const Unit& u, int wr, int wc, int fr, int fq) const {
        const int row0 = u.pm * BM + wr * 64 + fr, pc0 = u.pn * BM + wc * 32 + 8 * fq;
        const PG8_LAS float* cbp = (const PG8_LAS float*)pre_lds + wc * 32 + 8 * fq; const PG8_LAS float* rp = (const PG8_LAS float*)(pre_lds + 1024) + wr * 64 + fr;
        f32x4 cv[2][2];
#pragma unroll
        for (int bj = 0; bj < 2; ++bj)
#pragma unroll
            for (int n = 0; n < 2; ++n) cv[bj][n] = *(const PG8_LAS f32x4*)(cbp + bj * HALF + 4 * n);
        if (u.pn < nqk) {
            const bool isq = u.pn < (nqk >> 1); const float* gp = (isq ? gq : gk) + 8 * fq; const float gs = isq ? 0.125f * 1.4426950408889634f : 1.0f;
            f32x4 gv[2][2];
#pragma unroll
            for (int bj = 0; bj < 2; ++bj)
#pragma unroll
                for (int n = 0; n < 2; ++n) gv[bj][n] = *(const f32x4*)(gp + 32 * bj + 4 * n) * gs;
            const int lc0 = u.pn * BM + wc * 64 + 8 * fq;
#pragma unroll
            for (int ai = 0; ai < 2; ++ai)
#pragma unroll
                for (int m = 0; m < 4; ++m) { const int row = row0 + ai * HALF + m * 16; const float rs = rsqrtf(rp[ai * HALF + m * 16] * (1.0f / 2048.0f) + 1e-6f); bf16_t* rowp = O + (size_t)row * ldc + lc0;
                    f32x4 v[2][2]; float ss = 0.f;
#pragma unroll
                    for (int bj = 0; bj < 2; ++bj)
#pragma unroll
                        for (int n = 0; n < 2; ++n) { v[bj][n] = acc[ai][bj][m][n] * rs + cv[bj][n]; ss += (v[bj][n][0] * v[bj][n][0] + v[bj][n][1] * v[bj][n][1]) + (v[bj][n][2] * v[bj][n][2] + v[bj][n][3] * v[bj][n][3]); }
                    ss += sx<16>(ss); ss = sum32(ss);
                    const float rg = rsqrtf(ss * (1.0f / 64.0f) + 1e-6f);
#pragma unroll
                    for (int bj = 0; bj < 2; ++bj) { const f32x4 v0 = v[bj][0] * rg * gv[bj][0], v1 = v[bj][1] * rg * gv[bj][1];
                        u32x4 w; w.x = pk2(v0[0], v0[1]); w.y = pk2(v0[2], v0[3]); w.z = pk2(v1[0], v1[1]); w.w = pk2(v1[2], v1[3]);
                        if (isq) __builtin_nontemporal_store(w, (u32x4*)(rowp + 32 * bj)); else *(u32x4*)(rowp + 32 * bj) = w; } }
        } else {
#pragma unroll
            for (int ai = 0; ai < 2; ++ai)
#pragma unroll
                for (int m = 0; m < 4; ++m) { const int row = row0 + ai * HALF + m * 16; const float rs = rsqrtf(rp[ai * HALF + m * 16] * (1.0f / 2048.0f) + 1e-6f); bf16_t* rowp = O + (size_t)row * ldc + pc0;
#pragma unroll
                    for (int bj = 0; bj < 2; ++bj) { const f32x4 v0 = acc[ai][bj][m][0] * rs + cv[bj][0], v1 = acc[ai][bj][m][1] * rs + cv[bj][1];
                        u32x4 w; w.x = pk2(v0[0], v0[1]); w.y = pk2(v0[2], v0[3]); w.z = pk2(v1[0], v1[1]); w.w = pk2(v1[2], v1[3]);
                        *(u32x4*)(rowp + bj * HALF) = w; } }
        }
    }
};
typedef _Float16 f16x4 __attribute__((ext_vector_type(4)));
struct EpiResN {
    static constexpr bool HAS_PRE = true;
    static constexpr bool PERM = false, AFTER_DRAIN = false;
    const void* base; void* out; int base_f32, out_f32;
    int ldc; const float* gvt; const float* ant; int tstride; int rows_per_batch;
    bf16_t* xs; float* rssn; PG8_LAS unsigned char* pre_lds;
    float gscale;
    __device__ __forceinline__ void pre(const Unit& u, int lane) const {
        const size_t o = (size_t)((u.pm * BM) / rows_per_batch) * tstride + u.pn * BM + 4 * lane;
        __builtin_amdgcn_global_load_lds((const unsigned*)(gvt + o), (PG8_LAS unsigned*)pre_lds, 16, 0, 0);
        __builtin_amdgcn_global_load_lds((const unsigned*)(ant + o), (PG8_LAS unsigned*)(pre_lds + 1024), 16, 0, 0); }
    __device__ __forceinline__ void operator()(const f32x4 (&acc)[2][2][4][2], const Unit& u, int wr, int wc, int fr, int fq) const {
        const int col0 = u.pn * BM + wc * 32 + 4 * fq;
        const PG8_LAS float* gp = (const PG8_LAS float*)pre_lds + wc * 32 + 4 * fq;
        f32x4 gv[2][2], an[2][2];
#pragma unroll
        for (int bj = 0; bj < 2; ++bj)
#pragma unroll
            for (int n = 0; n < 2; ++n) { gv[bj][n] = *(const PG8_LAS f32x4*)(gp + bj * HALF + n * 16) * gscale; an[bj][n] = *(const PG8_LAS f32x4*)(gp + 256 + bj * HALF + n * 16); }
        if (base_f32) {
#pragma unroll
            for (int ai = 0; ai < 2; ++ai)
#pragma unroll
                for (int m = 0; m < 4; ++m) { const int rr = wr * 64 + fr + ai * HALF + m * 16; const unsigned off = (unsigned)((u.pm * BM + rr) * ldc + col0); float ss = 0.f;
                    const unsigned xso = ((unsigned)(u.pm * (ldc >> 6) + 4 * u.pn) * BM + rr) * 64u + 4u * fq;
#pragma unroll
                    for (int bj = 0; bj < 2; ++bj)
#pragma unroll
                        for (int n = 0; n < 2; ++n) { const unsigned o2 = off + bj * HALF + n * 16;
                            const f32x4 xn = *(const f32x4*)((const char*)base + 4u * o2) + gv[bj][n] * acc[ai][bj][m][n];
                            *(f16x4*)((char*)out + 2u * o2) = __builtin_convertvector(xn, f16x4);
                            ss += (xn[0] * xn[0] + xn[1] * xn[1]) + (xn[2] * xn[2] + xn[3] * xn[3]); const f32x4 h = xn * an[bj][n];
                            u32x2 w; w.x = pk2(h[0], h[1]); w.y = pk2(h[2], h[3]); *(u32x2*)((char*)xs + 2u * (xso + (unsigned)(2 * bj + (wc >> 1)) * (BM * 64) + (wc & 1) * 32 + n * 16)) = w; }
                    ss += sx<16>(ss); ss = sum32(ss); if (fq == 0) __hip_atomic_fetch_add(rssn + (u.pm * BM + rr), ss, __ATOMIC_RELAXED, __HIP_MEMORY_SCOPE_AGENT);
                    if (m & 1) asm volatile("" ::: "memory"); }
        } else {
            f16x4 bsv[2][4][2][2];
#pragma unroll
            for (int ai = 0; ai < 2; ++ai)
#pragma unroll
                for (int m = 0; m < 4; ++m)
#pragma unroll
                    for (int bj = 0; bj < 2; ++bj)
#pragma unroll
                        for (int n = 0; n < 2; ++n) bsv[ai][m][bj][n] = *(const f16x4*)((const char*)base + 2u * (unsigned)((u.pm * BM + wr * 64 + fr + ai * HALF + m * 16) * ldc + col0 + bj * HALF + n * 16));
            asm volatile("" ::: "memory");
#pragma unroll
            for (int ai = 0; ai < 2; ++ai) {
#pragma unroll
                for (int m = 0; m < 4; ++m) { const int rr = wr * 64 + fr + ai * HALF + m * 16; const unsigned off = (unsigned)((u.pm * BM + rr) * ldc + col0); float ss = 0.f;
                    const unsigned xso = ((unsigned)(u.pm * (ldc >> 6) + 4 * u.pn) * BM + rr) * 64u + 4u * fq;
#pragma unroll
                    for (int bj = 0; bj < 2; ++bj)
#pragma unroll
                        for (int n = 0; n < 2; ++n) { const unsigned o2 = off + bj * HALF + n * 16;
                            const f32x4 xn = __builtin_convertvector(bsv[ai][m][bj][n], f32x4) + gv[bj][n] * acc[ai][bj][m][n];
                            if (out_f32) *(f32x4*)((char*)out + 4u * o2) = xn; else *(f16x4*)((char*)out + 2u * o2) = __builtin_convertvector(xn, f16x4);
                            if (xs) { ss += (xn[0] * xn[0] + xn[1] * xn[1]) + (xn[2] * xn[2] + xn[3] * xn[3]); const f32x4 h = xn * *(const PG8_LAS f32x4*)(gp + 256 + bj * HALF + n * 16);
                                u32x2 w; w.x = pk2(h[0], h[1]); w.y = pk2(h[2], h[3]); *(u32x2*)((char*)xs + 2u * (xso + (unsigned)(2 * bj + (wc >> 1)) * (BM * 64) + (wc & 1) * 32 + n * 16)) = w; } }
                    if (xs) { ss += sx<16>(ss); ss = sum32(ss); if (fq == 0) __hip_atomic_fetch_add(rssn + (u.pm * BM + rr), ss, __ATOMIC_RELAXED, __HIP_MEMORY_SCOPE_AGENT); } }
                asm volatile("" ::: "memory"); }
        }
    }
};
template <class Epi, class Sched, bool ALIGN_EPI = false, bool SP2 = false, int A_AUX = 0>
__device__ __forceinline__ void gemm_phase(PG8_LAS unsigned char* lds, const Gemm g, const Sched& S, const Epi& E, int tid_in) {
    int tid_o = tid_in; asm volatile("" : "+v"(tid_o));
    const int tid = tid_o, wid = __builtin_amdgcn_readfirstlane(tid >> 6), lane = tid & 63, wr = wid >> 2, wc = wid & 3, fr = lane & 15, fq = lane >> 4;
    const int K = g.K, nt = K / BK;
    unsigned voffA[2], voffB[2];
#pragma unroll
    for (int i = 0; i < 2; ++i) { int R, C; stage_rc(tid * 16 + i * 8192, R, C); const int Rb = Epi::PERM ? ((R & ~31) + perm32(R & 31)) : R;
        voffA[i] = (unsigned)(R * (g.a_tiled ? BK : K) + C) * 2u; voffB[i] = (unsigned)(Rb * (g.b_tiled ? BK : K) + C) * 2u; }
    const size_t kstepA = g.a_tiled ? (size_t)(BM * BK * 2) : (size_t)(BK * 2), kstepB = g.b_tiled ? (size_t)(BM * BK * 2) : (size_t)(BK * 2);
    const size_t hstepA = g.a_tiled ? (size_t)(HALF * BK * 2) : (size_t)HALF * K * 2, hstepB = g.b_tiled ? (size_t)(HALF * BK * 2) : (size_t)HALF * K * 2;
    const size_t tstepA = (size_t)BM * K * 2, tstepB = tstepA;
    const unsigned ldsw = (unsigned)wid * 1024u;
    const int aoff = lds_byte(wr * 64 + fr, fq * 8), boff = lds_byte(wc * 32 + fr, fq * 8);
#define PG8_SA(b, h) (((b) * 2 + (h)) * HTB)
#define PG8_SB(b, h) ((4 + (b) * 2 + (h)) * HTB)
#define PG8_STAGE(bufoff, gbase, voff) do { _Pragma("unroll") for (int _i = 0; _i < 2; ++_i) \
        __builtin_amdgcn_global_load_lds((const unsigned*)((const char*)(gbase) + (voff)[_i]), (PG8_LAS unsigned*)(lds + (bufoff) + ldsw + _i * 8192), 16, 0, 0); } while (0)
#define PG8_STAGE_A(bufoff, gbase, voff) do { _Pragma("unroll") for (int _i = 0; _i < 2; ++_i) \
        __builtin_amdgcn_global_load_lds((const unsigned*)((const char*)(gbase) + (voff)[_i]), (PG8_LAS unsigned*)(lds + (bufoff) + ldsw + _i * 8192), 16, 0, A_AUX); } while (0)
#define PG8_LDA(dst, b, h) do { _Pragma("unroll") for (int m = 0; m < 4; ++m) _Pragma("unroll") for (int k = 0; k < 2; ++k) dst[m][k] = *(const PG8_LAS bf16x8*)(lds + PG8_SA(b, h) + aoff + m * 2048 + k * 1024); } while (0)
#define PG8_LDB(dst, b, h) do { _Pragma("unroll") for (int n = 0; n < 2; ++n) _Pragma("unroll") for (int k = 0; k < 2; ++k) dst[n][k] = *(const PG8_LAS bf16x8*)(lds + PG8_SB(b, h) + boff + n * 2048 + k * 1024); } while (0)
#define PG8_MMA(ai, bj, At, Bt) do { __builtin_amdgcn_s_setprio(1); _Pragma("unroll") for (int m = 0; m < 4; ++m) _Pragma("unroll") for (int n = 0; n < 2; ++n) _Pragma("unroll") for (int k = 0; k < 2; ++k) \
        acc[ai][bj][m][n] = __builtin_amdgcn_mfma_f32_16x16x32_bf16(Bt[n][k], At[m][k], acc[ai][bj][m][n], 0, 0, 0); __builtin_amdgcn_s_setprio(0); } while (0)
#define PG8_WAIT_V(n) asm volatile("s_waitcnt vmcnt(" #n ")" ::: "memory")
#define PG8_WAIT_L(n) asm volatile("s_waitcnt lgkmcnt(" #n ")" ::: "memory")
#define PG8_BAR __builtin_amdgcn_s_barrier()
#define PG8_SCHED __builtin_amdgcn_sched_barrier(0)
    Unit cur, nxt; int ui = 0;
    if (!S.next(0, cur)) return;
    f32x4 acc[2][2][4][2];
#pragma unroll
    for (int a = 0; a < 2; ++a)
#pragma unroll
        for (int b = 0; b < 2; ++b)
#pragma unroll
            for (int m = 0; m < 4; ++m)
#pragma unroll
                for (int n = 0; n < 2; ++n) acc[a][b][m][n] = (f32x4){0.f, 0.f, 0.f, 0.f};
    bf16x8 At[4][2], B0[2][2], B1[2][2];
    const char* cA = (const char*)g.A + (size_t)cur.pm * tstepA; const char* cB = (const char*)g.Bt + (size_t)cur.pn * tstepB;
    S.a_ready(cur);
    if constexpr (SP2) {
        PG8_STAGE(PG8_SB(0, 0), cB, voffB); PG8_STAGE(PG8_SB(0, 1), cB + hstepB, voffB); PG8_STAGE_A(PG8_SA(0, 0), cA, voffA); PG8_STAGE_A(PG8_SA(0, 1), cA + hstepA, voffA);
        if (wr == 1) PG8_BAR;
        PG8_WAIT_V(2); PG8_BAR;
        PG8_STAGE(PG8_SB(1, 0), cB + kstepB, voffB); PG8_STAGE_A(PG8_SA(1, 0), cA + kstepA, voffA); PG8_STAGE(PG8_SB(1, 1), cB + hstepB + kstepB, voffB);
        PG8_WAIT_V(6); PG8_BAR;
    } else {
        PG8_STAGE(PG8_SB(0, 0), cB, voffB); PG8_STAGE_A(PG8_SA(0, 0), cA, voffA); PG8_STAGE(PG8_SB(0, 1), cB + hstepB, voffB); PG8_STAGE_A(PG8_SA(0, 1), cA + hstepA, voffA);
        if (wr == 1) PG8_BAR;
        PG8_WAIT_V(4); PG8_BAR;
        PG8_STAGE(PG8_SB(1, 0), cB + kstepB, voffB); PG8_STAGE_A(PG8_SA(1, 0), cA + kstepA, voffA); PG8_STAGE(PG8_SB(1, 1), cB + hstepB + kstepB, voffB);
        PG8_WAIT_V(6); PG8_BAR;
    }
    for (;;) {
        const bool has_next = S.next(ui + 1, nxt);
        const char* nA = has_next ? (const char*)g.A + (size_t)nxt.pm * tstepA : cA; const char* nB = has_next ? (const char*)g.Bt + (size_t)nxt.pn * tstepB : cB;
        for (int t = 0; t < nt; t += 2) {
            const bool last = (t == nt - 2);
            const char* a1 = cA + (size_t)(t + 1) * kstepA;
            const char* a2 = last ? nA : cA + (size_t)(t + 2) * kstepA; const char* b2 = last ? nB : cB + (size_t)(t + 2) * kstepB;
            const char* a3 = a2 + kstepA; const char* b3 = b2 + kstepB;
            if (last && has_next) S.a_ready(nxt);
            if constexpr (SP2) {
            if constexpr (Epi::HAS_PRE) { if (last && wid == 0) { int ln = fr | (fq << 4); asm volatile("" : "+v"(ln)); E.pre(cur, ln); } }
            PG8_LDB(B0, 0, 0); PG8_LDB(B1, 0, 1); PG8_SCHED; PG8_LDA(At, 0, 0); PG8_STAGE_A(PG8_SA(1, 1), a1 + hstepA, voffA);
            PG8_WAIT_V(8); PG8_WAIT_L(0); PG8_BAR; PG8_MMA(0, 0, At, B0); PG8_MMA(0, 1, At, B1); PG8_BAR; PG8_SCHED;
            PG8_LDA(At, 0, 1); PG8_STAGE(PG8_SB(0, 0), b2, voffB); PG8_STAGE(PG8_SB(0, 1), b2 + hstepB, voffB); PG8_STAGE_A(PG8_SA(0, 0), a2, voffA);
            PG8_WAIT_V(8); PG8_WAIT_L(0); PG8_BAR; PG8_MMA(1, 0, At, B0); PG8_MMA(1, 1, At, B1); PG8_BAR; PG8_SCHED;
            PG8_LDB(B0, 1, 0); PG8_LDB(B1, 1, 1); PG8_SCHED; PG8_LDA(At, 1, 0); PG8_STAGE_A(PG8_SA(0, 1), a2 + hstepA, voffA);
            PG8_WAIT_V(8); PG8_WAIT_L(0); PG8_BAR; PG8_MMA(0, 0, At, B0); PG8_MMA(0, 1, At, B1); PG8_BAR; PG8_SCHED;
            PG8_LDA(At, 1, 1); PG8_STAGE(PG8_SB(1, 0), b3, voffB); PG8_STAGE(PG8_SB(1, 1), b3 + hstepB, voffB); PG8_STAGE_A(PG8_SA(1, 0), a3, voffA);
            PG8_WAIT_V(8); PG8_WAIT_L(0); PG8_BAR; PG8_MMA(1, 0, At, B0); PG8_MMA(1, 1, At, B1); PG8_BAR; PG8_SCHED;
            } else {
            PG8_LDB(B0, 0, 0); PG8_SCHED; PG8_LDA(At, 0, 0); PG8_STAGE_A(PG8_SA(1, 1), a1 + hstepA, voffA);
            PG8_WAIT_L(8); PG8_BAR; PG8_WAIT_L(0); PG8_MMA(0, 0, At, B0); PG8_BAR; PG8_SCHED;
            PG8_LDB(B1, 0, 1); PG8_STAGE(PG8_SB(0, 0), b2, voffB);
            PG8_BAR; PG8_WAIT_L(0); PG8_MMA(0, 1, At, B1); PG8_BAR;
            PG8_LDA(At, 0, 1); PG8_STAGE_A(PG8_SA(0, 0), a2, voffA);
            PG8_BAR; PG8_WAIT_L(0); PG8_MMA(1, 0, At, B0); PG8_BAR; PG8_SCHED;
            PG8_STAGE(PG8_SB(0, 1), b2 + hstepB, voffB);
            PG8_WAIT_V(6); PG8_BAR; PG8_MMA(1, 1, At, B1); PG8_BAR;
            PG8_LDB(B0, 1, 0); PG8_SCHED; PG8_LDA(At, 1, 0); PG8_STAGE_A(PG8_SA(0, 1), a2 + hstepA, voffA);
            PG8_WAIT_L(8); PG8_BAR; PG8_WAIT_L(0); PG8_MMA(0, 0, At, B0); PG8_BAR; PG8_SCHED;
            PG8_LDB(B1, 1, 1); PG8_STAGE(PG8_SB(1, 0), b3, voffB);
            PG8_BAR; PG8_WAIT_L(0); PG8_MMA(0, 1, At, B1); PG8_BAR;
            PG8_LDA(At, 1, 1); PG8_STAGE_A(PG8_SA(1, 0), a3, voffA);
            PG8_BAR; PG8_WAIT_L(0); PG8_MMA(1, 0, At, B0); PG8_BAR; PG8_SCHED;
            PG8_STAGE(PG8_SB(1, 1), b3 + hstepB, voffB);
            PG8_WAIT_V(6); PG8_BAR; PG8_MMA(1, 1, At, B1); PG8_BAR;
            }
        }
        if constexpr (ALIGN_EPI) { if (wr == 0) PG8_BAR; }
        if constexpr (!Epi::AFTER_DRAIN) { E(acc, cur, wr, wc, fr, fq); S.done(cur); }
        if (!has_next) break;
#pragma unroll
        for (int a = 0; a < 2; ++a)
#pragma unroll
            for (int b = 0; b < 2; ++b)
#pragma unroll
                for (int m = 0; m < 4; ++m)
#pragma unroll
                    for (int n = 0; n < 2; ++n) acc[a][b][m][n] = (f32x4){0.f, 0.f, 0.f, 0.f};
        cur = nxt; cA = nA; cB = nB; ++ui;
        if constexpr (ALIGN_EPI) { if (wr == 1) PG8_BAR; }
    }
    PG8_WAIT_V(0);
    if constexpr (!ALIGN_EPI) { if (wr == 0) PG8_BAR; }
    PG8_BAR;
    if constexpr (Epi::AFTER_DRAIN) { E.fused(acc, cur, wr, wc, fr, fq, lds, wid, lane); S.done(cur); }
#undef PG8_SA
#undef PG8_SB
#undef PG8_STAGE
#undef PG8_STAGE_A
#undef PG8_LDA
#undef PG8_LDB
#undef PG8_MMA
#undef PG8_WAIT_V
#undef PG8_WAIT_L
#undef PG8_BAR
#undef PG8_SCHED
}
}
#define GAS __attribute__((address_space(1)))
#define LAS __attribute__((address_space(3)))
typedef unsigned short bf16;
typedef unsigned v4u __attribute__((ext_vector_type(4)));
typedef float f32x4 __attribute__((ext_vector_type(4)));
typedef short bf16x8 __attribute__((ext_vector_type(8)));
typedef GAS unsigned gu32;
typedef GAS unsigned long long gu64;
#define RLX_AGENT __ATOMIC_RELAXED, __HIP_MEMORY_SCOPE_AGENT
#define LDS_WAIT() asm volatile("s_waitcnt lgkmcnt(0)" ::: "memory")
#define VM_WAIT() asm volatile("s_waitcnt vmcnt(0)" ::: "memory")
__device__ __forceinline__ unsigned long long rt() { return __builtin_amdgcn_s_memrealtime(); }
#define XB_TMO      128
#define XB_XCNT(j)  (256  + 64 * (j))
#define XB_XSUB(j)  (1280 + 64 * (j))
#define XB_XGEN(j)  (2304 + 64 * (j))
#define XB_TOP      3328
#define XB_TOPGEN   3392
#define XCD_BAR_WORDS 3456
#define XB_SPIN_CAP (1u << 18)

__device__ __forceinline__ unsigned xb_ld(unsigned* p)              { return __hip_atomic_load(p, __ATOMIC_RELAXED, __HIP_MEMORY_SCOPE_AGENT); }
__device__ __forceinline__ unsigned xb_add(unsigned* p, unsigned v) { return __hip_atomic_fetch_add(p, v, __ATOMIC_RELAXED, __HIP_MEMORY_SCOPE_AGENT); }
__device__ __forceinline__ unsigned xb_xcc_id() { return (unsigned)__builtin_amdgcn_s_getreg((3 << 11) | 20) & 0xFu; }
#define XB_SPIN(cond, bar) do { unsigned _sp = 0; while (cond) { __builtin_amdgcn_s_sleep(1); \
    if ((++_sp & 255u) == 0u) { if (xb_ld(&(bar)[XB_TMO])) break; if (_sp > XB_SPIN_CAP) { atomicAdd(&(bar)[XB_TMO], 1u); break; } } } } while (0)

struct XcdBarrier {
    unsigned* bar; unsigned x;
    volatile LAS unsigned* st;
};

__device__ __forceinline__ XcdBarrier xcd_barrier_post(unsigned* bar, volatile LAS unsigned* st) {
    XcdBarrier b; b.bar = bar; b.x = xb_xcc_id(); b.st = st;
    if (threadIdx.x == 0) (void)xb_add(&bar[XB_XCNT(b.x)], 1u);
    return b;
}
__device__ __forceinline__ void xcd_barrier_complete(unsigned* bar, unsigned x, unsigned& nloc, unsigned& nx) {
    const unsigned G = gridDim.x * gridDim.y * gridDim.z;
    unsigned sum, cnt, mine, sp = 0u;
    for (;;) {
        sum = 0u; cnt = 0u; mine = 0u;
#pragma unroll
        for (unsigned j = 0; j < 16; ++j) { const unsigned c = xb_ld(&bar[XB_XCNT(j)]); sum += c; cnt += (c > 0u) ? 1u : 0u; mine = (j == x) ? c : mine; }
        if (sum == G) break;
        __builtin_amdgcn_s_sleep(1);
        if ((++sp & 255u) == 0u) { if (xb_ld(&bar[XB_TMO])) break; if (sp > XB_SPIN_CAP) { atomicAdd(&bar[XB_TMO], 1u); break; } }
    }
    nloc = mine > 0u ? mine : 1u; nx = cnt > 0u ? cnt : 1u;
}

__device__ __forceinline__ void xcd_barrier(const XcdBarrier& b) {
    asm volatile("s_waitcnt vmcnt(0)" ::: "memory");
    __syncthreads();
    if (threadIdx.x == 0) {
        unsigned* bar = b.bar;
        __builtin_amdgcn_s_waitcnt(0);
        unsigned nloc = b.st[0], nx = b.st[1];
        if (nloc == 0u) { xcd_barrier_complete(bar, b.x, nloc, nx); b.st[0] = nloc; b.st[1] = nx; }
        const unsigned old = xb_add(&bar[XB_XSUB(b.x)], 1u);
        const unsigned gen = old / nloc;
        if (old + 1u == (gen + 1u) * nloc) {
            __builtin_amdgcn_fence(__ATOMIC_RELEASE, "agent");
            asm volatile("s_waitcnt vmcnt(0)" ::: "memory");
            const unsigned og = xb_add(&bar[XB_TOP], 1u);
            const unsigned tg = og / nx;
            if (og + 1u == (tg + 1u) * nx) xb_add(&bar[XB_TOPGEN], 1u);
            else XB_SPIN(xb_ld(&bar[XB_TOPGEN]) == tg, bar);
            __builtin_amdgcn_fence(__ATOMIC_ACQUIRE, "agent");
            xb_add(&bar[XB_XGEN(b.x)], 1u);
            asm volatile("s_waitcnt vmcnt(0)" ::: "memory");
        } else {
            XB_SPIN(xb_ld(&bar[XB_XGEN(b.x)]) == gen, bar);
            __builtin_amdgcn_fence(__ATOMIC_ACQUIRE, "agent");
            asm volatile("s_waitcnt vmcnt(0)" ::: "memory");
        }
    }
    __syncthreads();
}
namespace att {
using bf16x8 = __attribute__((ext_vector_type(8))) short;
using s16x4  = __attribute__((ext_vector_type(4))) short;
using f32x16 = __attribute__((ext_vector_type(16))) float;
using u32x4  = __attribute__((ext_vector_type(4))) unsigned;
constexpr int SEQ_ = 8192, LDQ = 6144; constexpr size_t SHM_V = 16384, SHM_K = 16384;
#define KSWZ(row, colB) ((row) * 256 + ((colB) ^ (((row) & 7) << 4)))
#define SBAR() __builtin_amdgcn_sched_barrier(0)
__device__ __forceinline__ int crow(int r, int hi) { return (r & 3) + 8 * (r >> 2) + 4 * hi; }
__device__ __forceinline__ unsigned cvtpk(float lo, float hi) {
  unsigned r; asm volatile("v_cvt_pk_bf16_f32 %0, %1, %2" : "=v"(r) : "v"(lo), "v"(hi)); return r;
}
__device__ __forceinline__ void qkt(f32x16& p0, f32x16& p1, const bf16* Ks, const bf16x8* qr, int r32, int hi, int jmap, float dbase, float slope2, float negm, bool diag) {
  asm volatile("" : "+v"(negm));
  if (diag) {
#pragma unroll
    for (int r = 0; r < 16; ++r) { const float d = (float)((r & 3) + 8 * (r >> 2)) + dbase;
      p0[r] = fmaf(-slope2, fabsf(d), negm); p1[r] = fmaf(-slope2, fabsf(d + 32.f), negm); }
  } else {
    const float u0 = fmaf(slope2, dbase, negm), u1 = fmaf(slope2, dbase + 32.f, negm);
#pragma unroll
    for (int r = 0; r < 16; ++r) { p0[r] = fmaf(slope2, (float)((r & 3) + 8 * (r >> 2)), u0); p1[r] = fmaf(slope2, (float)((r & 3) + 8 * (r >> 2)), u1); }
  }
#pragma unroll
  for (int d0 = 0; d0 < 4; ++d0) { const int cb = (jmap * 64 + d0 * 16 + hi * 8) * 2;
    bf16x8 b0 = *reinterpret_cast<const bf16x8*>((const char*)Ks + KSWZ(r32, cb));
    bf16x8 b1 = *reinterpret_cast<const bf16x8*>((const char*)Ks + KSWZ(32 + r32, cb));
    p0 = __builtin_amdgcn_mfma_f32_32x32x16_bf16(b0, qr[d0], p0, 0, 0, 0);
    p1 = __builtin_amdgcn_mfma_f32_32x32x16_bf16(b1, qr[d0], p1, 0, 0, 0); }
}
__device__ __forceinline__ void partialSM(f32x16& p0, f32x16& p1) {
#pragma unroll
  for (int r = 0; r < 16; ++r) p0[r] = __builtin_amdgcn_exp2f(p0[r]);
}
__device__ __forceinline__ void finishSM(f32x16& p0, f32x16& p1, float alpha, float& l_reg, bf16x8& pa0, bf16x8& pa1, bf16x8& pa2, bf16x8& pa3) {
  for (int r = 0; r < 16; ++r) p1[r] = __builtin_amdgcn_exp2f(p1[r]);
  float ps = 0; for (int r = 0; r < 16; ++r) ps += p0[r]; for (int r = 0; r < 16; ++r) ps += p1[r];
  { auto rr = __builtin_amdgcn_permlane32_swap(__float_as_uint(ps), __float_as_uint(ps), false, false);
    ps = __uint_as_float(rr[0]) + __uint_as_float(rr[1]); }
  l_reg = l_reg * alpha + ps;
#define PK4(P, BASE, OUT) do { unsigned a0 = cvtpk(P[BASE + 0], P[BASE + 1]), a1 = cvtpk(P[BASE + 2], P[BASE + 3]);   \
    unsigned b0 = cvtpk(P[BASE + 4], P[BASE + 5]), b1 = cvtpk(P[BASE + 6], P[BASE + 7]);                              \
    auto r0 = __builtin_amdgcn_permlane32_swap(a0, b0, false, false); auto r1 = __builtin_amdgcn_permlane32_swap(a1, b1, false, false); \
    u32x4 w = {r0[0], r1[0], r0[1], r1[1]}; OUT = *reinterpret_cast<bf16x8*>(&w); } while (0)
  PK4(p0, 0, pa0); PK4(p0, 8, pa1); PK4(p1, 0, pa2); PK4(p1, 8, pa3);
#undef PK4
}
__device__ __forceinline__ int v_st(int k, int c) { const int kk = (k & ~0xC) | ((k & 4) << 1) | ((k & 8) >> 1); return ((kk >> 3) * 4 + (c >> 5)) * 512 + ((kk & 7) * 32 + (c & 31)) * 2; }
__device__ __forceinline__ int v_rd_base(int lane) { return ((lane & 3) << 3) | (((lane >> 2) & 3) << 6) | (((lane >> 4) & 1) << 5) | (((lane >> 5) & 1) << 8); }
constexpr int v_rd_off(int d0, int ks, int half) { return d0 * 512 + ks * 4096 + half * 2048; }
template <int OFF> __device__ __forceinline__ s16x4 tr_read(int vb) {
  s16x4 r; asm volatile("ds_read_b64_tr_b16 %0, %1 offset:%2" : "=&v"(r) : "v"(vb), "i"(OFF) : "memory"); return r;
}
template <int D0> __device__ __forceinline__ void pv_one(f32x16& od, int vb, bf16x8 pa0, bf16x8 pa1, bf16x8 pa2, bf16x8 pa3) {
  const s16x4 l0 = tr_read<v_rd_off(D0, 0, 0)>(vb), h0 = tr_read<v_rd_off(D0, 0, 1)>(vb), l1 = tr_read<v_rd_off(D0, 1, 0)>(vb), h1 = tr_read<v_rd_off(D0, 1, 1)>(vb);
  const s16x4 l2 = tr_read<v_rd_off(D0, 2, 0)>(vb), h2 = tr_read<v_rd_off(D0, 2, 1)>(vb), l3 = tr_read<v_rd_off(D0, 3, 0)>(vb), h3 = tr_read<v_rd_off(D0, 3, 1)>(vb);
  asm volatile("s_waitcnt lgkmcnt(0)" ::: "memory"); SBAR();
#define PK(L, H) (bf16x8){L[0], L[1], L[2], L[3], H[0], H[1], H[2], H[3]}
  od = __builtin_amdgcn_mfma_f32_32x32x16_bf16(pa0, PK(l0, h0), od, 0, 0, 0);
  od = __builtin_amdgcn_mfma_f32_32x32x16_bf16(pa1, PK(l1, h1), od, 0, 0, 0);
  od = __builtin_amdgcn_mfma_f32_32x32x16_bf16(pa2, PK(l2, h2), od, 0, 0, 0);
  od = __builtin_amdgcn_mfma_f32_32x32x16_bf16(pa3, PK(l3, h3), od, 0, 0, 0);
#undef PK
}
#define PV_RD(S, D0) const s16x4 S##l0 = tr_read<v_rd_off(D0, 0, 0)>(vb), S##h0 = tr_read<v_rd_off(D0, 0, 1)>(vb), S##l1 = tr_read<v_rd_off(D0, 1, 0)>(vb), S##h1 = tr_read<v_rd_off(D0, 1, 1)>(vb), \
    S##l2 = tr_read<v_rd_off(D0, 2, 0)>(vb), S##h2 = tr_read<v_rd_off(D0, 2, 1)>(vb), S##l3 = tr_read<v_rd_off(D0, 3, 0)>(vb), S##h3 = tr_read<v_rd_off(D0, 3, 1)>(vb)
#define PV_PK(L, H) (bf16x8){L[0], L[1], L[2], L[3], H[0], H[1], H[2], H[3]}
#define PV_MM(S, OD) do { OD = __builtin_amdgcn_mfma_f32_32x32x16_bf16(pa0, PV_PK(S##l0, S##h0), OD, 0, 0, 0); OD = __builtin_amdgcn_mfma_f32_32x32x16_bf16(pa1, PV_PK(S##l1, S##h1), OD, 0, 0, 0); \
    OD = __builtin_amdgcn_mfma_f32_32x32x16_bf16(pa2, PV_PK(S##l2, S##h2), OD, 0, 0, 0); OD = __builtin_amdgcn_mfma_f32_32x32x16_bf16(pa3, PV_PK(S##l3, S##h3), OD, 0, 0, 0); } while (0)
__device__ __forceinline__ void pv_d0(f32x16* o, int vb, bf16x8 pa0, bf16x8 pa1, bf16x8 pa2, bf16x8 pa3) {
  PV_RD(a, 0); PV_RD(b, 1);
  asm volatile("s_waitcnt lgkmcnt(8)" ::: "memory"); SBAR();
  PV_MM(a, o[0]);
  PV_RD(c, 2);
  asm volatile("s_waitcnt lgkmcnt(8)" ::: "memory"); SBAR();
  PV_MM(b, o[1]);
  PV_RD(d, 3);
  asm volatile("s_waitcnt lgkmcnt(8)" ::: "memory"); SBAR();
  PV_MM(c, o[2]);
  asm volatile("s_waitcnt lgkmcnt(0)" ::: "memory"); SBAR();
  PV_MM(d, o[3]);
}
#undef PV_RD
#undef PV_PK
#undef PV_MM
__device__ __forceinline__ void attn_unit(int tid_in, int b, int h, int qb, int tb, const bf16* __restrict__ QKV, bf16* __restrict__ OB, float lam, float omli, float slope2, float m_ref, const float* __restrict__ subg, char* lds, gu32* qhead, volatile LAS unsigned* qslot) {
  int tid_o = tid_in; asm volatile("" : "+v"(tid_o));
  const int tid = tid_o, wid = __builtin_amdgcn_readfirstlane(tid >> 6), lane = tid & 63, r32 = lane & 31, hi = lane >> 5;
  const int jmap = wid >> 2, wq = wid & 3;
  constexpr int KR = 0, VR = 3 * 16384, WSO = 6 * 16384;
  float* ws = (float*)(lds + WSO) + wid * 64; float* li_l = ws;
  const long rowbase = (long)b * SEQ_; const int q0 = qb * 128 + wq * 32;
  float l_reg = 0.f; f32x16 o[4] = {}; bf16x8 qr[4];
  const bf16* Qw = QKV + (rowbase + q0 + r32) * LDQ + h * 128 + jmap * 64 + hi * 8;
#pragma unroll
  for (int d0 = 0; d0 < 4; ++d0) qr[d0] = *reinterpret_cast<const bf16x8*>(Qw + d0 * 16);
  const char* KVmid = (const char*)(QKV + (rowbase + 64 * tb) * LDQ + 2048 + h * 128 + 1024);
  unsigned koff[2], voff[2];
#pragma unroll
  for (int jb = 0; jb < 2; ++jb) { const int blk = 2 * wid + jb;
    { const int row = 4 * blk + (lane >> 4), chunk = (lane & 15) ^ (row & 7);
      koff[jb] = (unsigned)(row * LDQ * 2 + chunk * 16); }
    { const int sl = 64 * blk + lane, kk = 8 * (sl >> 7) + ((sl & 31) >> 2), c = 32 * ((sl >> 5) & 3) + 8 * (sl & 3);
      const int k = (kk & ~0xC) | ((kk & 4) << 1) | ((kk & 8) >> 1);
      voff[jb] = (unsigned)(k * LDQ * 2 + c * 2); } }
  const unsigned lds0 = (unsigned)(uintptr_t)lds;
  const int vb0 = (int)(lds0 + VR) + v_rd_base(lane);
  typedef __attribute__((address_space(3))) unsigned lds_u32;
#define DMA_K(t, slot) do { const char* t_ = KVmid + (size_t)(t) * (64 * LDQ * 2) - 2048; \
    __builtin_amdgcn_global_load_lds((const unsigned*)(t_ + koff[0]), (lds_u32*)(lds0 + KR + (slot) * 16384 + (2 * wid) * 1024), 16, 0, 0); \
    __builtin_amdgcn_global_load_lds((const unsigned*)(t_ + koff[1]), (lds_u32*)(lds0 + KR + (slot) * 16384 + (2 * wid + 1) * 1024), 16, 0, 0); } while (0)
#define DMA_V(t, slot) do { const char* t_ = KVmid + (size_t)(t) * (64 * LDQ * 2) + 2048; \
    __builtin_amdgcn_global_load_lds((const unsigned*)(t_ + voff[0]), (lds_u32*)(lds0 + VR + (slot) * 16384 + (2 * wid) * 1024), 16, 0, 0); \
    __builtin_amdgcn_global_load_lds((const unsigned*)(t_ + voff[1]), (lds_u32*)(lds0 + VR + (slot) * 16384 + (2 * wid + 1) * 1024), 16, 0, 0); } while (0)
#define WAIT_BAR(N) asm volatile("s_waitcnt vmcnt(" #N ") lgkmcnt(0)\n\ts_barrier" ::: "memory")
  f32x16 pA0, pA1, pB0, pB1; bf16x8 pa0, pa1, pa2, pa3;
  const int NT = 2 * qb + 2 - tb, cq = 2 * qb + (wq >> 1) - tb;
  const float dq = (float)(4 * hi - (q0 + r32) + 64 * tb);
#define QKT(P0, P1, kslot, t) qkt(P0, P1, (const bf16*)(lds + KR + (kslot) * 16384), qr, r32, hi, jmap, (float)(64 * (t)) + dq, slope2, ((t) > cq) ? -1e30f : -m_ref, (t) == cq)
  int sc = 0, sp = 2;
#define ROT() do { sp = sc; sc = (sc == 2) ? 0 : sc + 1; } while (0)
  asm volatile("s_waitcnt vmcnt(0)" : "+v"(qr[0]), "+v"(qr[1]), "+v"(qr[2]), "+v"(qr[3]) :: "memory");
  DMA_K(0, 0); DMA_V(0, 0); DMA_K(1, 1);
  WAIT_BAR(4);
  if (2 < NT) DMA_K(2, 2);
  DMA_V(1, 1);
  QKT(pA0, pA1, 0, 0); partialSM(pA0, pA1);
#define STEP(ORD, PX0, PX1, PY0, PY1, t) do { ROT(); \
    if ((t) + 1 < NT) { WAIT_BAR(4); } else { WAIT_BAR(2); } \
    {   \
      if ((t) + 2 < NT) DMA_K((t) + 2, sp); \
      if ((t) + 1 < NT) DMA_V((t) + 1, (3 - sc - sp)); } \
    SBAR(); \
    if ((ORD) == 0) { QKT(PX0, PX1, sc, t); \
      finishSM(PY0, PY1, 1.f, l_reg, pa0, pa1, pa2, pa3); SBAR(); \
      pv_d0(o, vb0 + sp * 16384, pa0, pa1, pa2, pa3); partialSM(PX0, PX1); } \
    else { finishSM(PY0, PY1, 1.f, l_reg, pa0, pa1, pa2, pa3); SBAR(); \
      pv_d0(o, vb0 + sp * 16384, pa0, pa1, pa2, pa3); SBAR(); \
      QKT(PX0, PX1, sc, t); partialSM(PX0, PX1); } } while (0)
#define TILE_LOOP(ORD) do { \
    for (int t = 1; t + 1 < NT; t += 2) { STEP(ORD, pB0, pB1, pA0, pA1, t); STEP(ORD, pA0, pA1, pB0, pB1, t + 1); } \
    if ((NT & 1) == 0) { STEP(ORD, pB0, pB1, pA0, pA1, NT - 1); \
      WAIT_BAR(0);                                               \
      finishSM(pB0, pB1, 1.f, l_reg, pa0, pa1, pa2, pa3); SBAR(); \
    } else { WAIT_BAR(0); \
      finishSM(pA0, pA1, 1.f, l_reg, pa0, pa1, pa2, pa3); SBAR(); } } while (0)
  if (jmap == 0) TILE_LOOP(0); else TILE_LOOP(1);
  pv_d0(o, vb0 + sc * 16384, pa0, pa1, pa2, pa3);
  unsigned nxt_unit = 0u; if (tid == 0) nxt_unit = __hip_atomic_fetch_add(qhead, 1u, __ATOMIC_RELAXED, __HIP_MEMORY_SCOPE_AGENT);
  if (hi == 0) li_l[r32] = l_reg; asm volatile("s_waitcnt lgkmcnt(0)" ::: "memory");
#pragma unroll
  for (int r = 0; r < 16; ++r) { const float rl = __builtin_amdgcn_rcpf(li_l[crow(r, hi)]);
#pragma unroll
    for (int d0 = 0; d0 < 4; ++d0) o[d0][r] *= rl; }
  float* xch = (float*)lds + (size_t)wq * 4096 + lane;
  __syncthreads();
  if (jmap == 1) {
#pragma unroll
    for (int d0 = 0; d0 < 4; ++d0)
#pragma unroll
      for (int r = 0; r < 16; ++r) xch[(d0 * 16 + r) * 64] = o[d0][r];
  }
  __syncthreads();
  if (jmap == 0) {
    float ss[16];
#pragma unroll
    for (int r = 0; r < 16; ++r) { float s = 0.f;
#pragma unroll
      for (int d0 = 0; d0 < 4; ++d0) { const float df = o[d0][r] - lam * xch[(d0 * 16 + r) * 64]; o[d0][r] = df; s += df * df; }
      ss[r] = s; }
#pragma unroll
    for (int r = 0; r < 16; ++r) { float s = ss[r]; s += sx<1>(s); s += sx<2>(s); s += sx<4>(s); s += sx<8>(s); s += sx<16>(s);
      ss[r] = rsqrtf(s * (1.0f / 128.0f) + 1e-6f) * omli; }
    float gs[4]; int r32o = r32; asm volatile("" : "+v"(r32o));
#pragma unroll
    for (int d0 = 0; d0 < 4; ++d0) gs[d0] = subg[d0 * 32 + r32o];
    bf16* stg = (bf16*)(lds + 65536) + wq * 4096;
    int sto = 4 * hi * 128 + r32; asm volatile("" : "+v"(sto));
#pragma unroll
    for (int r = 0; r < 16; ++r) { const int orow = (r & 3) + 8 * (r >> 2);
#pragma unroll
      for (int d0 = 0; d0 < 4; ++d0) stg[sto + orow * 128 + d0 * 32] = (bf16)f2bf(o[d0][r] * ss[r] * gs[d0]); }
    asm volatile("s_waitcnt lgkmcnt(0)" ::: "memory");
    unsigned ooff = (unsigned)((q0 + (lane >> 4)) * 2048 + (lane & 15) * 8); asm volatile("" : "+v"(ooff));
    bf16* Ow = OB + rowbase * 2048 + h * 128 + ooff;
#pragma unroll
    for (int i = 0; i < 8; ++i) { const u32x4 v = *(const u32x4*)(stg + (4 * i + (lane >> 4)) * 128 + (lane & 15) * 8); *(u32x4*)(Ow + (4 * i) * 2048) = v; }
  }
  if (tid == 0) *qslot = nxt_unit;
  __syncthreads();
#undef DMA_K
#undef DMA_V
#undef WAIT_BAR
#undef ROT
#undef STEP
#undef TILE_LOOP
#undef QKT
}
#undef KSWZ
#undef SBAR
}
constexpr int DM = 2048, NB = 4, SEQ = 8192, MT = NB * SEQ, FF = 5632, NLAYER = 4, NH = 16, NMOD = 9 * DM;
constexpr float RMS_EPS = 1e-6f;
constexpr int NWAVES = 8;
#ifndef PROBE_MASK
#define PROBE_MASK 0
#endif
#ifndef PROBE_IDLE
#define PROBE_IDLE 0
#endif
#ifndef PROBE_ECHO
#define PROBE_ECHO 0
#endif
#ifndef FFN_SPLIT
#define FFN_SPLIT 1
#endif
#ifndef GU_WGM
#define GU_WGM 8
#endif
#ifndef OUT_A_AUX
#define OUT_A_AUX 0
#endif
#ifndef OUT_WGM
#define OUT_WGM 4
#endif
#ifndef MK_PER_PHASE
#define MK_PER_PHASE 0
#endif
constexpr int N_PHASES = 32 + 8 * 2 * (FFN_SPLIT - 1);
constexpr size_t MiB = 1u << 20;
constexpr size_t WS_CTL = 0, CTL_ZERO_BYTES = 3 * MiB;
constexpr size_t WS_MOD = 1696 * MiB;
constexpr size_t WS_EBL = 3 * MiB;
constexpr size_t WS_WGU = 8 * MiB;
constexpr size_t WS_WD  = 360 * MiB;
constexpr size_t WS_WAI = 536 * MiB;
constexpr size_t WS_WAO = 584 * MiB;
constexpr size_t WS_WCI = 600 * MiB, WS_WCO = 624 * MiB;
constexpr size_t WS_WHI = 632 * MiB, WS_WHO = 664 * MiB;
constexpr size_t WS_XN  = 672 * MiB;
constexpr size_t WS_BIG = 800 * MiB;
constexpr size_t WS_OB  = 1312 * MiB;
constexpr size_t WS_KLT = 1440 * MiB;
constexpr size_t WS_IT  = 1568 * MiB;
constexpr size_t WS_RSS = 1 * MiB, RSS_BYTES = 2 * MiB;
constexpr size_t WS_CB  = 1698 * MiB;
constexpr int CB_LD = 2 * 5632;
constexpr size_t WS_TAB = 1701 * MiB;
constexpr size_t WS_XH  = 1702 * MiB;
constexpr size_t WS_END = 1830 * MiB;
constexpr int CW_BAR = 4096;
constexpr int RING_OFF = 0, RING_BYTES = 131072;
constexpr int LDSCTL_OFF = RING_BYTES, MISC_OFF = LDSCTL_OFF + 320;
constexpr int PRE_OFF = LDSCTL_OFF + 1024;
constexpr int LDS_BYTES = 147456;

struct Args { const float* in[21]; float* out; unsigned char* ws; int ph_lo, ph_hi; };
struct Frame {
    LAS unsigned char* lds;
    volatile LAS unsigned* MISC;
    gu32* ctl;
    int tid, lane, wave, vcu, G;
    const struct Args* a; float* out; unsigned char* ws;
};
__device__ __forceinline__ float bf_lo(unsigned w) { return __uint_as_float(w << 16); }
__device__ __forceinline__ float bf_hi(unsigned w) { return __uint_as_float(w & 0xffff0000u); }
__device__ __forceinline__ float bf_f(bf16 x) { return __uint_as_float((unsigned)x << 16); }

__device__ __forceinline__ void unpack8(const v4u w, float (&x)[8]) { x[0] = bf_lo(w.x); x[1] = bf_hi(w.x); x[2] = bf_lo(w.y); x[3] = bf_hi(w.y); x[4] = bf_lo(w.z); x[5] = bf_hi(w.z); x[6] = bf_lo(w.w); x[7] = bf_hi(w.w); }
__device__ __forceinline__ void p0_mod(Frame& F) {
    LAS float* cond = (LAS float*)(F.lds);
    LAS float* part = (LAS float*)(F.lds + 32768);
    const float* c = F.a->in[1]; const float* aw = F.a->in[2]; const float* ab = F.a->in[3]; float* mod = (float*)(F.ws + WS_MOD);
    for (int i = F.tid; i < NB * DM; i += NWAVES * 64) { const float v = c[i]; cond[i] = v / (1.0f + __expf(-v)); }
    __syncthreads();
    const int cg = F.tid & 15, ks = F.tid >> 4;
    for (int it = F.vcu; it < NLAYER * (NMOD / 64); it += F.G) {
        const int L = it / (NMOD / 64), n0 = (it % (NMOD / 64)) * 64;
        f32x4 a0 = {0.f, 0.f, 0.f, 0.f}, a1 = a0, a2 = a0, a3 = a0;
        const float* wp = aw + ((size_t)L * DM + ks * 64) * NMOD + n0 + 4 * cg;
#pragma unroll 8
        for (int k = 0; k < 64; ++k) { const f32x4 w = *(const f32x4*)(wp + (size_t)k * NMOD); const int kk = ks * 64 + k;
            a0 += w * cond[kk]; a1 += w * cond[DM + kk]; a2 += w * cond[2 * DM + kk]; a3 += w * cond[3 * DM + kk]; }
        *(LAS f32x4*)(part + (ks * 4 + 0) * 64 + 4 * cg) = a0; *(LAS f32x4*)(part + (ks * 4 + 1) * 64 + 4 * cg) = a1;
        *(LAS f32x4*)(part + (ks * 4 + 2) * 64 + 4 * cg) = a2; *(LAS f32x4*)(part + (ks * 4 + 3) * 64 + 4 * cg) = a3;
        __syncthreads();
        if (F.tid < 256) { const int b = F.tid >> 6, col = F.tid & 63; float s = 0.f;
#pragma unroll 8
            for (int k2 = 0; k2 < 32; ++k2) s += part[(k2 * 4 + b) * 64 + col];
            mod[((size_t)L * NB + b) * NMOD + n0 + col] = s + ab[(size_t)L * NMOD + n0 + col]; }
        __syncthreads();
    }
}
struct CvItem { const float* W; bf16* WT; int K, N, mode, item; };
__device__ __forceinline__ CvItem cv_decode(Frame& F, int it) {
    constexpr int I_FFN = (DM / 64) * (FF / 32);
    constexpr int I_IN3 = (DM / 64) * (3 * DM / 32), I_SQ = (DM / 64) * (DM / 32), I_IN4 = (DM / 64) * (4 * DM / 32);
    int r = it;
    if (r < 24 * I_FFN) { const int m = r / I_FFN, ls = m / 3, which = m % 3; r -= m * I_FFN;
        if (which == 0) return CvItem{F.a->in[5] + (size_t)ls * DM * FF, (bf16*)(F.ws + WS_WGU) + (size_t)ls * 2 * FF * DM, DM, FF, 1, r};
        if (which == 1) return CvItem{F.a->in[6] + (size_t)ls * DM * FF, (bf16*)(F.ws + WS_WGU) + (size_t)ls * 2 * FF * DM, DM, FF, 2, r};
        return CvItem{F.a->in[7] + (size_t)ls * FF * DM, (bf16*)(F.ws + WS_WD) + (size_t)ls * DM * FF, FF, DM, 0, r}; }
    r -= 24 * I_FFN;
    if (r < 2 * I_IN3) { const int s = r / I_IN3; return CvItem{F.a->in[8] + (size_t)s * DM * 3 * DM, (bf16*)(F.ws + WS_WAI) + (size_t)s * 3 * DM * DM, DM, 3 * DM, 3, r - s * I_IN3}; } r -= 2 * I_IN3;
    if (r < 2 * I_SQ) { const int s = r / I_SQ; return CvItem{F.a->in[9] + (size_t)s * DM * DM, (bf16*)(F.ws + WS_WAO) + (size_t)s * DM * DM, DM, DM, 0, r - s * I_SQ}; } r -= 2 * I_SQ;
    if (r < I_IN3) return CvItem{F.a->in[14], (bf16*)(F.ws + WS_WCI), DM, 3 * DM, 0, r}; r -= I_IN3;
    if (r < I_SQ) return CvItem{F.a->in[16], (bf16*)(F.ws + WS_WCO), DM, DM, 0, r}; r -= I_SQ;
    if (r < I_IN4) return CvItem{F.a->in[17], (bf16*)(F.ws + WS_WHI), DM, 4 * DM, 0, r}; r -= I_IN4;
    return CvItem{F.a->in[18], (bf16*)(F.ws + WS_WHO), DM, DM, 0, r};
}
__device__ __forceinline__ void cv_load(const CvItem& c, float (&wv)[32], int lane) {
    const int nblk = c.N / 32, kb = c.item / nblk, nb = c.item % nblk;
    const float* wp = c.W + (size_t)(64 * kb + (lane >> 5)) * c.N + 32 * nb + (lane & 31);
#pragma unroll
    for (int i = 0; i < 32; ++i) wv[i] = wp[(size_t)(2 * i) * c.N];
}
__device__ __forceinline__ void cv_finish(const CvItem& c, const float (&wv)[32], LAS float* scr, int lane) {
    const int K = c.K, mode = c.mode, nblk = c.N / 32, kb = c.item / nblk, nb = c.item % nblk, n0 = 32 * nb;
    const int drow0 = (mode == 0 || (mode == 3 && n0 >= 2 * DM)) ? n0 : (mode == 3) ? ((n0 & ~255) + 128 * ((n0 >> 5) & 1) + 32 * ((n0 >> 6) & 3)) : ((n0 >> 7) * 256 + (mode - 1) * 128 + (n0 & 127));
#pragma unroll
    for (int i = 0; i < 32; ++i) scr[(2 * i + (lane >> 5)) * 33 + (lane & 31)] = wv[i];
    LDS_WAIT(); asm volatile("" ::: "memory");
    const int cc = lane & 7;
#pragma unroll
    for (int j = 0; j < 4; ++j) { const int n = (lane >> 3) + 8 * j; const LAS float* s = scr + (8 * cc) * 33 + n;
        v4u o; o.x = pk2(s[0 * 33], s[1 * 33]); o.y = pk2(s[2 * 33], s[3 * 33]); o.z = pk2(s[4 * 33], s[5 * 33]); o.w = pk2(s[6 * 33], s[7 * 33]);
        const int dr = drow0 + n;
        *(GAS v4u*)(c.WT + ((size_t)((dr >> 8) * (K >> 6) + kb) * 256 + (dr & 255)) * 64 + 8 * cc) = o; }
    LDS_WAIT(); asm volatile("" ::: "memory");
}
__device__ __forceinline__ void p0_convert(Frame& F) {
    LAS float* scr = (LAS float*)(F.lds + RING_OFF + F.wave * 16384);
    const int gw = F.vcu * NWAVES + F.wave, NGW = F.G * NWAVES;
    constexpr int NITEMS = 24 * ((DM / 64) * (FF / 32)) + 3 * ((DM / 64) * (3 * DM / 32)) + 4 * ((DM / 64) * (DM / 32)) + (DM / 64) * (4 * DM / 32);
    CvItem A, B; float wa[32], wb[32];
    int it = gw;
    if (it < NITEMS) { A = cv_decode(F, it); cv_load(A, wa, F.lane); }
    while (it < NITEMS) {
        int nx = it + NGW;
        if (nx < NITEMS) { B = cv_decode(F, nx); cv_load(B, wb, F.lane); }
        cv_finish(A, wa, scr, F.lane);
        it = nx; if (it >= NITEMS) break;
        nx = it + NGW;
        if (nx < NITEMS) { A = cv_decode(F, nx); cv_load(A, wa, F.lane); }
        cv_finish(B, wb, scr, F.lane);
        it = nx;
    }
}
__device__ __forceinline__ void xs0_phase(Frame& F, const float* xsrc, const float* g, const float* modL) {
    bf16* XN = (bf16*)(F.ws + WS_XN); float* rss = (float*)(F.ws + WS_RSS);
    const int gw = F.vcu * NWAVES + F.wave, NGW = F.G * NWAVES;
    for (int r0 = gw * 16; r0 < MT; r0 += NGW * 16) {
        const int b = r0 / SEQ;
        const float* sc = modL + (size_t)b * NMOD + DM;
        f32x4 a[8];
#pragma unroll
        for (int j = 0; j < 8; ++j) { const int col = 4 * F.lane + 256 * j; a[j] = *(const f32x4*)(g + col) * (*(const f32x4*)(sc + col) + 1.0f); }
#pragma unroll 2
        for (int r = 0; r < 16; ++r) {
            const GAS f32x4* xr = (const GAS f32x4*)(xsrc + (size_t)(r0 + r) * DM) + F.lane;
            f32x4 v[8]; float s = 0.f;
#pragma unroll
            for (int j = 0; j < 8; ++j) { v[j] = xr[64 * j]; s += (v[j].x * v[j].x + v[j].y * v[j].y) + (v[j].z * v[j].z + v[j].w * v[j].w); }
            s = wave_sum(s);
            if (F.lane == 0) rss[r0 + r] = s;
            bf16* o8 = XN + ((size_t)((r0 + r) >> 8) * 32 * 256 + ((r0 + r) & 255)) * 64 + (size_t)(F.lane >> 4) * (256 * 64) + 4 * (F.lane & 15);
#pragma unroll
            for (int j = 0; j < 8; ++j) { const f32x4 h = v[j] * a[j];
                *(GAS unsigned long long*)(o8 + (size_t)(4 * j) * (256 * 64)) = (unsigned long long)pk2(h.x, h.y) | ((unsigned long long)pk2(h.z, h.w) << 32); }
        }
    }
}
__device__ __forceinline__ void tables_phase(Frame& F) {
    const float* mod = (const float*)(F.ws + WS_MOD); float* TAB = (float*)(F.ws + WS_TAB); const float* ng = F.a->in[4];
    const int gt = F.vcu * (NWAVES * 64) + F.tid, NT = F.G * NWAVES * 64;
    for (int i = gt; i < 3 * NLAYER * NB * DM; i += NT) {
        const int col = i % DM, b = (i / DM) % NB, s = i / (DM * NB), L = s / 3, sub = s % 3, sn = s + 1, Ln = sn / 3, subn = sn % 3;
        TAB[((size_t)(s * 2 + 0) * NB + b) * DM + col] = ((sub == 1) ? 1.0f : 0.5f) * mod[((size_t)L * NB + b) * NMOD + (3 * sub + 2) * DM + col];
        TAB[((size_t)(s * 2 + 1) * NB + b) * DM + col] = (sn < 3 * NLAYER) ? ng[((size_t)Ln * 3 + subn) * DM + col] * (1.0f + mod[((size_t)Ln * NB + b) * NMOD + (3 * subn + 1) * DM + col]) : 0.f;
    }
}
__device__ __forceinline__ void bias_phase(Frame& F) {
    const float* mod = (const float*)(F.ws + WS_MOD); float* CB = (float*)(F.ws + WS_CB);
    const int gw = F.vcu * NWAVES + F.wave, NGW = F.G * NWAVES;
#pragma unroll 1
    for (int s = 0; s < 3 * NLAYER; ++s) {
        const int L = s / 3, sub = s % 3, kind = L % 3, slot = L / 3;
        const bf16* W; int N;
        if (sub != 1) { W = (const bf16*)(F.ws + WS_WGU) + (size_t)(L * 2 + (sub >> 1)) * 2 * FF * DM; N = 2 * FF; }
        else if (kind == 0) { W = (const bf16*)(F.ws + WS_WAI) + (size_t)slot * 3 * DM * DM; N = 3 * DM; }
        else if (kind == 1) { W = (const bf16*)(F.ws + WS_WCI); N = 3 * DM; }
        else { W = (const bf16*)(F.ws + WS_WHI); N = 4 * DM; }
        float sh[4][4][8];
#pragma unroll
        for (int b = 0; b < NB; ++b)
#pragma unroll
            for (int it = 0; it < 4; ++it) { const float* sp = mod + ((size_t)L * NB + b) * NMOD + (3 * sub) * DM + 8 * (64 * it + F.lane);
                const f32x4 s0 = *(const f32x4*)sp, s1 = *(const f32x4*)(sp + 4);
                sh[b][it][0] = s0.x; sh[b][it][1] = s0.y; sh[b][it][2] = s0.z; sh[b][it][3] = s0.w; sh[b][it][4] = s1.x; sh[b][it][5] = s1.y; sh[b][it][6] = s1.z; sh[b][it][7] = s1.w; }
        for (int n = gw; n < N; n += NGW) {
            const bf16* wrow = W + ((size_t)(n >> 8) * (DM >> 6) * 256 + (n & 255)) * 64 + (F.lane & 7) * 8;
            float d0 = 0.f, d1 = 0.f, d2 = 0.f, d3 = 0.f;
#pragma unroll
            for (int it = 0; it < 4; ++it) { float w[8]; unpack8(*(const GAS v4u*)(wrow + (size_t)(8 * it + (F.lane >> 3)) * 256 * 64), w);
#pragma unroll
                for (int i = 0; i < 8; ++i) { d0 += w[i] * sh[0][it][i]; d1 += w[i] * sh[1][it][i]; d2 += w[i] * sh[2][it][i]; d3 += w[i] * sh[3][it][i]; } }
            d0 = wave_sum(d0); d1 = wave_sum(d1); d2 = wave_sum(d2); d3 = wave_sum(d3);
            if (F.lane == 0) { float* cp = CB + (size_t)s * NB * CB_LD + n; cp[0] = d0; cp[CB_LD] = d1; cp[2 * CB_LD] = d2; cp[3 * CB_LD] = d3; }
        }
    }
}
constexpr int CW_ATTNQ = 8192;
__device__ __forceinline__ void attn_phase(Frame& F, int L, int slot, int qword = 0) {
    const bf16* QKV = (const bf16*)(F.ws + WS_BIG); bf16* OB = (bf16*)(F.ws + WS_OB);
    const float* lv = F.a->in[12] + (size_t)slot * 4 * 64;
    int ln = F.lane; asm volatile("" : "+v"(ln));
    const float sa = wave_sum(lv[ln] * lv[64 + ln]), sb = wave_sum(lv[128 + ln] * lv[192 + ln]);
    asm volatile("" : "+s"(L));
    const float lambda_init = (L == 0) ? 0.2f : (L == 1) ? 0.35550906f : (L == 2) ? 0.47071302f : 0.55605822f;
    const float lam = expf(sa) - expf(sb) + lambda_init;
    const float* subg = F.a->in[13] + (size_t)slot * 128;
    float gm = fabsf(F.a->in[10][slot * 64 + ln] * F.a->in[11][slot * 64 + ln]);
    gm = wave_max(gm);
    const float twoB24 = 16.0f * gm + 24.0f;
    const float m_ref = (8.0f * gm) * 1.4426950408889634f * 1.02f + 0.5f;
    gu32* qbase = F.ctl + CW_ATTNQ + 64 * slot + 256 * qword;
    int cur = (int)blockIdx.x & 7, tried = 0;
    if (F.tid == 0) F.MISC[16] = __hip_atomic_fetch_add(qbase + cur, 1u, RLX_AGENT);
    __syncthreads();
    int n = (int)F.MISC[16];
    for (;;) {
        const int grp = cur >> 2, cnt = grp ? 11 * 64 : 5 * 64;
        if (n >= cnt) {
            if (++tried == 8) break;
            cur = (cur + 1) & 7;
            __syncthreads();
            if (F.tid == 0) F.MISC[16] = __hip_atomic_fetch_add(qbase + cur, 1u, RLX_AGENT);
            __syncthreads();
            n = (int)F.MISC[16];
            continue;
        }
        const unsigned long long hl = grp ? 0x012456789CEull : 0x3ABDFull;
        const int qb = 63 - (n & 63), h = (int)((hl >> (4 * (n >> 6))) & 15ull), b = cur & 3;
        const float slope = exp2f(-0.5f * (float)(h + 1));
        const float W = (twoB24 - __logf(1.0f - __expf(-slope))) / slope;
        int tb = (int)floorf(((float)(128 * qb) - W) * (1.0f / 64.0f)); tb = (tb < 0 ? 0 : tb);
        att::attn_unit(F.tid, b, h, qb, tb, QKV, OB, lam, 1.0f - lambda_init, slope * 1.4426950408889634f, m_ref, subg, (char*)(F.lds + RING_OFF), qbase + cur, F.MISC + 16);
        n = (int)F.MISC[16];
    }
}
__device__ __forceinline__ void conv_phase(Frame& F) {
    const bf16* U = (const bf16*)(F.ws + WS_BIG); bf16* OB = (bf16*)(F.ws + WS_OB); const float* cw = F.a->in[15];
    const int gt = F.vcu * (NWAVES * 64) + F.tid, NT = F.G * NWAVES * 64;
    for (int item = gt; item < 256 * (MT / 16); item += NT) {
        int dg = item & 255; asm volatile("" : "+v"(dg));
        const int run = item >> 8, row0 = run * 16, d = dg * 8;
        float w0[8], w1[8], w2[8];
#pragma unroll
        for (int i = 0; i < 8; ++i) { w0[i] = cw[d + i]; w1[i] = cw[DM + d + i]; w2[i] = cw[2 * DM + d + i]; }
        float vm2[8], vm1[8];
        if ((row0 % SEQ) == 0) {
#pragma unroll
            for (int i = 0; i < 8; ++i) { vm2[i] = 0.f; vm1[i] = 0.f; }
        } else {
            float a[8], b[8];
            unpack8(*(const GAS v4u*)(U + (size_t)(row0 - 2) * 6144 + 2048 + d), a); unpack8(*(const GAS v4u*)(U + (size_t)(row0 - 2) * 6144 + 4096 + d), b);
#pragma unroll
            for (int i = 0; i < 8; ++i) vm2[i] = a[i] * b[i];
            unpack8(*(const GAS v4u*)(U + (size_t)(row0 - 1) * 6144 + 2048 + d), a); unpack8(*(const GAS v4u*)(U + (size_t)(row0 - 1) * 6144 + 4096 + d), b);
#pragma unroll
            for (int i = 0; i < 8; ++i) vm1[i] = a[i] * b[i];
        }
#pragma unroll 4
        for (int t = 0; t < 16; ++t) {
            const bf16* rp = U + (size_t)(row0 + t) * 6144 + d;
            float bg[8], cg[8], uu[8], y[8];
            unpack8(*(const GAS v4u*)(rp), bg); unpack8(*(const GAS v4u*)(rp + 2048), cg); unpack8(*(const GAS v4u*)(rp + 4096), uu);
#pragma unroll
            for (int i = 0; i < 8; ++i) { const float v = cg[i] * uu[i]; y[i] = bg[i] * (w0[i] * vm2[i] + w1[i] * vm1[i] + w2[i] * v); vm2[i] = vm1[i]; vm1[i] = v; }
            v4u o; o.x = pk2(y[0], y[1]); o.y = pk2(y[2], y[3]); o.z = pk2(y[4], y[5]); o.w = pk2(y[6], y[7]);
            *(GAS v4u*)(OB + (size_t)(row0 + t) * DM + d) = o;
        }
    }
}
#define LDS_BAR() asm volatile("s_waitcnt lgkmcnt(0)\n\ts_barrier" ::: "memory")
typedef short s16x4 __attribute__((ext_vector_type(4)));
typedef float f32x16 __attribute__((ext_vector_type(16)));
__device__ __forceinline__ int crow16(int r, int hi) { return (r & 3) + 8 * (r >> 2) + 4 * hi; }
constexpr int H_P256 = 272, H_P128 = 144;
__device__ __forceinline__ void hgrn_prep_phase(Frame& F, int layer, bf16* QBO, int qbld, bf16* OBO) {
    bf16* BIG = (bf16*)(F.ws + WS_BIG); bf16* KLT = (bf16*)(F.ws + WS_KLT); bf16* ITG = (bf16*)(F.ws + WS_IT); float* EBL = (float*)(F.ws + WS_EBL); bf16* OB = (bf16*)(F.ws + WS_OB);
    const float* lbl = F.a->in[20];
    LAS unsigned char* QS = F.lds; LAS unsigned char* KS = F.lds + 64 * H_P256; LAS unsigned char* ITL = F.lds + 2 * 64 * H_P256; LAS float* TOT = (LAS float*)(F.lds + 2 * 64 * H_P256 + 128 * H_P128);
    const int kp = F.lane, seg = F.wave, r32 = F.lane & 31, hi = F.lane >> 5;
    unsigned qw[8], fw[8], iw[8]; f32x2_cv lgt[4];
#define H1_LOAD(un) do { const int bh_ = (un) >> 7, c_ = (un) & 127; const size_t rb_ = (size_t)(bh_ >> 4) * SEQ + (size_t)c_ * 64; \
        _Pragma("unroll") for (int L_ = 0; L_ < 4; ++L_) lgt[L_] = *(const GAS f32x2_cv*)(lbl + L_ * DM + (bh_ & 15) * 128 + 2 * kp); \
        _Pragma("unroll") for (int tt = 0; tt < 8; ++tt) { const bf16* pq = BIG + (rb_ + 8 * seg + tt) * 8192 + (bh_ & 15) * 128 + 2 * kp; \
            qw[tt] = *(const GAS unsigned*)pq; fw[tt] = *(const GAS unsigned*)(pq + 2048); iw[tt] = *(const GAS unsigned*)(pq + 4096); } } while (0)
    for (int unit = F.vcu; unit < NB * NH * (SEQ / 64); unit += F.G) {
        const int bh = unit >> 7, c = unit & 127, b = bh >> 4, h = bh & 15; const size_t rowbase = (size_t)b * SEQ + (size_t)c * 64;
        if (unit == F.vcu) H1_LOAD(unit);
        float lb[2];
#pragma unroll
        for (int kk = 0; kk < 2; ++kk) { const float l0 = lgt[0][kk], l1 = lgt[1][kk], l2 = lgt[2][kk], l3 = lgt[3][kk];
            const float mx = fmaxf(fmaxf(l0, l1), fmaxf(l2, l3)); const float e0 = __expf(l0 - mx), e1 = __expf(l1 - mx), e2 = __expf(l2 - mx), e3 = __expf(l3 - mx);
            float cumv = 0.f; if (layer >= 1) cumv += e1; if (layer >= 2) cumv += e2; if (layer >= 3) cumv += e3;
            lb[kk] = cumv * __builtin_amdgcn_rcpf(e0 + e1 + e2 + e3); }
        float bcs[8][2], kv[8][2]; float cum[2] = {0.f, 0.f};
#pragma unroll
        for (int tt = 0; tt < 8; ++tt)
#pragma unroll
            for (int kk = 0; kk < 2; ++kk) { const float x = kk ? bf_hi(fw[tt]) : bf_lo(fw[tt]); const float sig = __builtin_amdgcn_rcpf(1.0f + __expf(-x));
                const float f = lb[kk] + (1.0f - lb[kk]) * sig; cum[kk] += __builtin_amdgcn_logf(f) * 0.6931471805599453f;     bcs[tt][kk] = cum[kk]; kv[tt][kk] = 1.0f - f; }
        TOT[seg * 128 + 2 * kp] = cum[0]; TOT[seg * 128 + 2 * kp + 1] = cum[1];
        LDS_BAR();
        float off[2] = {0.f, 0.f}, rb[2] = {0.f, 0.f}, bl[2] = {0.f, 0.f};
#pragma unroll
        for (int s = 0; s < 8; ++s)
#pragma unroll
            for (int kk = 0; kk < 2; ++kk) { const float tv = TOT[s * 128 + 2 * kp + kk]; if (s < seg) off[kk] += tv; if (s < 4) rb[kk] += tv; bl[kk] += tv; }
        float erb[2], enrb[2], ebl[2];
#pragma unroll
        for (int kk = 0; kk < 2; ++kk) { erb[kk] = __expf(rb[kk]); enrb[kk] = __expf(-rb[kk]); ebl[kk] = __expf(bl[kk]); }
        unsigned klw[2][4], itw[2][4];
#pragma unroll
        for (int tt = 0; tt < 8; ++tt) { float qb_[2], qs_[2], ks_[2], kl_[2];
#pragma unroll
            for (int kk = 0; kk < 2; ++kk) { const float bb = bcs[tt][kk] + off[kk]; const float q = kk ? bf_hi(qw[tt]) : bf_lo(qw[tt]);
                const float eb = __expf(bb), enb = __builtin_amdgcn_rcpf(eb);
                qb_[kk] = q * eb; qs_[kk] = qb_[kk] * enrb[kk]; ks_[kk] = kv[tt][kk] * (erb[kk] * enb); kl_[kk] = kv[tt][kk] * (ebl[kk] * enb); }
            *(GAS unsigned*)(QBO + (rowbase + 8 * seg + tt) * qbld + h * 128 + 2 * kp) = pk2(qb_[0], qb_[1]);
            *(LAS unsigned*)(QS + (8 * seg + tt) * H_P256 + 4 * kp) = pk2(qs_[0], qs_[1]);
            *(LAS unsigned*)(KS + (8 * seg + tt) * H_P256 + 4 * kp) = pk2(ks_[0], ks_[1]);
            if (tt & 1) { klw[0][tt >> 1] |= f2bf(kl_[0]) << 16; klw[1][tt >> 1] |= f2bf(kl_[1]) << 16; itw[0][tt >> 1] |= (iw[tt] & 0xffffu) << 16; itw[1][tt >> 1] |= (iw[tt] >> 16) << 16; }
            else { klw[0][tt >> 1] = f2bf(kl_[0]); klw[1][tt >> 1] = f2bf(kl_[1]); itw[0][tt >> 1] = iw[tt] & 0xffffu; itw[1][tt >> 1] = iw[tt] >> 16; }
        }
#pragma unroll
        for (int kk = 0; kk < 2; ++kk) { const v4u kw = {klw[kk][0], klw[kk][1], klw[kk][2], klw[kk][3]}, tw = {itw[kk][0], itw[kk][1], itw[kk][2], itw[kk][3]};
            *(GAS v4u*)(KLT + (size_t)unit * 8192 + (2 * kp + kk) * 64 + 8 * seg) = kw;
            *(GAS v4u*)(ITG + (size_t)unit * 8192 + (2 * kp + kk) * 64 + 8 * seg) = tw;
            *(LAS v4u*)(ITL + (2 * kp + kk) * H_P128 + 16 * seg) = tw; }
        if (seg == 0) { EBL[(size_t)unit * 128 + 2 * kp] = ebl[0]; EBL[(size_t)unit * 128 + 2 * kp + 1] = ebl[1]; }
        LDS_BAR();
        if (unit + F.G < NB * NH * (SEQ / 64)) H1_LOAD(unit + F.G);
        const int tt_ = F.wave & 1, vt = F.wave >> 1;
        f32x16 z = {};
        for (int st = 0; st <= tt_; ++st) {
            f32x16 x = {};
            bf16x8 af[8], bqf[8];
#pragma unroll
            for (int step = 0; step < 8; ++step) { af[step] = *(const LAS bf16x8*)(KS + (32 * st + r32) * H_P256 + (16 * step + 8 * hi) * 2);
                bqf[step] = *(const LAS bf16x8*)(QS + (32 * tt_ + r32) * H_P256 + (16 * step + 8 * hi) * 2); }
#pragma unroll
            for (int step = 0; step < 8; ++step) x = __builtin_amdgcn_mfma_f32_32x32x16_bf16(af[step], bqf[step], x, 0, 0, 0);
            if (st == tt_) {
#pragma unroll
                for (int r = 0; r < 16; ++r) if (crow16(r, hi) > r32) x[r] = 0.f;
            }
#pragma unroll
            for (int sp = 0; sp < 2; ++sp) {
                v4u pw; pw.x = pk2(x[8 * sp + 0], x[8 * sp + 1]); pw.y = pk2(x[8 * sp + 2], x[8 * sp + 3]); pw.z = pk2(x[8 * sp + 4], x[8 * sp + 5]); pw.w = pk2(x[8 * sp + 6], x[8 * sp + 7]);
                const bf16x8 xs = __builtin_bit_cast(bf16x8, pw);
                const LAS unsigned char* ip = ITL + (32 * vt + r32) * H_P128 + (32 * st + 16 * sp + 4 * hi) * 2;
                const s16x4 lo = *(const LAS s16x4*)ip, hh = *(const LAS s16x4*)(ip + 16);
                const bf16x8 pb = __builtin_shufflevector(lo, hh, 0, 1, 2, 3, 4, 5, 6, 7);
                z = __builtin_amdgcn_mfma_f32_32x32x16_bf16(xs, pb, z, 0, 0, 0);
            }
        }
        bf16* op = OBO + (rowbase + 32 * tt_) * DM + h * 128 + 32 * vt + r32;
#pragma unroll
        for (int r = 0; r < 16; ++r) op[(size_t)crow16(r, hi) * DM] = (bf16)f2bf(z[r]);
        LDS_BAR();
    }
}
#undef H1_LOAD
__device__ __forceinline__ void hgrn_scan_phase(Frame& F, bf16* OBO) {
    const bf16* BIG = (const bf16*)(F.ws + WS_BIG); const bf16* KLT = (const bf16*)(F.ws + WS_KLT); const bf16* ITG = (const bf16*)(F.ws + WS_IT); const float* EBL = (const float*)(F.ws + WS_EBL); const bf16* OB = (const bf16*)(F.ws + WS_OB);
    constexpr int TB = 64 * H_P256 + 128 * H_P128 + 32 * H_P128 + 512;
    constexpr int STB = 32 * H_P256;
    constexpr int IOB = 64 * 64;
    LAS unsigned char* TL = F.lds; LAS unsigned char* STL = F.lds + 2 * TB; LAS unsigned char* ISL = STL + 2 * STB; LAS unsigned char* OSL = ISL + 2 * IOB;
    const int tid = F.tid, r32 = F.lane & 31, hi = F.lane >> 5, w = F.wave;
    for (int unit = F.vcu; unit < NB * NH * 4; unit += F.G) {
        const int bh = unit >> 2, vq = unit & 3, b = bh >> 4, h = bh & 15;
        f32x16 acc = {};
        v4u q0[2], k0[2], i0, e0, q1[2], k1[2], i1, e1, ivr[2];
        i0 = i1 = e0 = e1 = ivr[0] = ivr[1] = (v4u){(unsigned)tid >> 31, 0u, 0u, 0u};
        const int ioq = (F.lane + 64 * (w & 1));
#define H2_LOAD(Q, K, I, E, c) do { const size_t rb_ = (size_t)b * SEQ + (size_t)(c) * 64; const size_t un_ = (size_t)bh * 128 + (c); \
        _Pragma("unroll") for (int i_ = 0; i_ < 2; ++i_) { const int p_ = tid + 512 * i_; \
            Q[i_] = *(const GAS v4u*)(BIG + (rb_ + (p_ >> 4)) * 8192 + h * 128 + (p_ & 15) * 8); K[i_] = *(const GAS v4u*)(KLT + un_ * 8192 + (size_t)p_ * 8); } \
        if (tid < 256) I = *(const GAS v4u*)(ITG + un_ * 8192 + (size_t)(32 * vq) * 64 + (size_t)tid * 8); \
        if (tid < 32) E = *(const GAS v4u*)(EBL + un_ * 128 + 4 * tid); } while (0)
#define H2_WRITE(Q, K, I, E, bufo) do { LAS unsigned char* tb_ = TL + (bufo); _Pragma("unroll") for (int i_ = 0; i_ < 2; ++i_) { const int p_ = tid + 512 * i_; \
            *(LAS v4u*)(tb_ + (p_ >> 4) * H_P256 + (p_ & 15) * 16) = Q[i_]; *(LAS v4u*)(tb_ + 64 * H_P256 + (p_ >> 3) * H_P128 + (p_ & 7) * 16) = K[i_]; } \
        if (tid < 256) *(LAS v4u*)(tb_ + 64 * H_P256 + 128 * H_P128 + (tid >> 3) * H_P128 + (tid & 7) * 16) = I; \
        if (tid < 32) *(LAS v4u*)(tb_ + 64 * H_P256 + 128 * H_P128 + 32 * H_P128 + 16 * tid) = E; } while (0)
#define H2_IVLD(c) do { _Pragma("unroll") for (int j_ = 0; j_ < 2; ++j_) { const int q_ = ioq + 128 * j_; \
            ivr[j_] = *(const GAS v4u*)(OB + ((size_t)b * SEQ + (size_t)(c) * 64 + (q_ >> 2)) * DM + h * 128 + 32 * vq + (q_ & 3) * 8); } } while (0)
#define H2_IVST(slot) do { _Pragma("unroll") for (int j_ = 0; j_ < 2; ++j_) { const int q_ = ioq + 128 * j_; *(LAS v4u*)(ISL + (slot) * IOB + (q_ >> 2) * 64 + (q_ & 3) * 16) = ivr[j_]; } } while (0)
#define H2_OST(c, slot) do { _Pragma("unroll") for (int j_ = 0; j_ < 2; ++j_) { const int q_ = ioq + 128 * j_; const v4u v_ = *(const LAS v4u*)(OSL + (slot) * IOB + (q_ >> 2) * 64 + (q_ & 3) * 16); \
            *(GAS v4u*)(OBO + ((size_t)b * SEQ + (size_t)(c) * 64 + (q_ >> 2)) * DM + h * 128 + 32 * vq + (q_ & 3) * 8) = v_; } } while (0)
#define H2_STEP(c, cur, Qn, Kn, In, En) do { LAS unsigned char* tb_ = TL + (cur) * TB; LAS unsigned char* st_ = STL + (cur) * STB; \
          \
          \
        if (w >= 6 && (c) + 1 < SEQ / 64) H2_IVST((cur) ^ 1);      \
        if ((c) + 1 < SEQ / 64) H2_WRITE(Qn, Kn, In, En, ((cur) ^ 1) * TB); \
        if (w >= 6) { if ((c) + 2 < SEQ / 64) H2_IVLD((c) + 2); \
            if ((c) >= 1) H2_OST((c) - 1, (cur) ^ 1); }             \
        if ((c) + 3 < SEQ / 64) H2_LOAD(Qn, Kn, In, En, (c) + 3); \
        if (w < 4) { const LAS float* eb_ = (const LAS float*)(tb_ + 64 * H_P256 + 128 * H_P128 + 32 * H_P128); \
            _Pragma("unroll") for (int r = 0; r < 16; ++r) acc[r] *= eb_[32 * w + crow16(r, hi)]; \
            _Pragma("unroll") for (int step = 0; step < 4; ++step) { const bf16x8 a_ = *(const LAS bf16x8*)(tb_ + 64 * H_P256 + (32 * w + r32) * H_P128 + (16 * step + 8 * hi) * 2); \
                const bf16x8 b_ = *(const LAS bf16x8*)(tb_ + 64 * H_P256 + 128 * H_P128 + r32 * H_P128 + (16 * step + 8 * hi) * 2); acc = __builtin_amdgcn_mfma_f32_32x32x16_bf16(a_, b_, acc, 0, 0, 0); } \
            LAS unsigned char* sn_ = STL + ((cur) ^ 1) * STB + r32 * H_P256 + (32 * w + 4 * hi) * 2; \
            _Pragma("unroll") for (int g = 0; g < 4; ++g) *(LAS unsigned long long*)(sn_ + 16 * g) = (unsigned long long)pk2(acc[4 * g], acc[4 * g + 1]) | ((unsigned long long)pk2(acc[4 * g + 2], acc[4 * g + 3]) << 32); \
        } else if (w < 6) { f32x16 o_ = {}; \
            _Pragma("unroll") for (int step = 0; step < 8; ++step) { const bf16x8 a_ = *(const LAS bf16x8*)(tb_ + (32 * (w - 4) + r32) * H_P256 + (16 * step + 8 * hi) * 2); \
                const bf16x8 b_ = *(const LAS bf16x8*)(st_ + r32 * H_P256 + (16 * step + 8 * hi) * 2); o_ = __builtin_amdgcn_mfma_f32_32x32x16_bf16(a_, b_, o_, 0, 0, 0); } \
            const int so_ = (32 * (w - 4) + 4 * hi) * 64 + r32 * 2; bf16 iv_[16]; \
            _Pragma("unroll") for (int r = 0; r < 16; ++r) iv_[r] = *(const LAS bf16*)(ISL + (cur) * IOB + so_ + ((r & 3) + 8 * (r >> 2)) * 64);     \
            _Pragma("unroll") for (int r = 0; r < 16; ++r) *(LAS bf16*)(OSL + (cur) * IOB + so_ + ((r & 3) + 8 * (r >> 2)) * 64) = (bf16)f2bf(o_[r] + bf_f(iv_[r])); } \
        LDS_BAR(); } while (0)
        { const unsigned zz = (unsigned)tid >> 31;
          for (int i = tid; i < STB / 16; i += NWAVES * 64) *(LAS v4u*)(STL + 16 * i) = (v4u){zz, zz, zz, zz}; }
        H2_LOAD(q0, k0, i0, e0, 0); H2_WRITE(q0, k0, i0, e0, 0);
        H2_LOAD(q1, k1, i1, e1, 1); H2_LOAD(q0, k0, i0, e0, 2);
        if (w >= 6) { H2_IVLD(0); H2_IVST(0); H2_IVLD(1); }
        LDS_BAR();
#pragma unroll 1
        for (int c = 0; c < SEQ / 64; c += 2) {
            H2_STEP(c, 0, q1, k1, i1, e1);
            H2_STEP(c + 1, 1, q0, k0, i0, e0);
        }
        if (w >= 6) H2_OST(SEQ / 64 - 1, 1);
        LDS_BAR();
#undef H2_LOAD
#undef H2_WRITE
#undef H2_IVLD
#undef H2_IVST
#undef H2_OST
#undef H2_STEP
    }
}
__device__ __forceinline__ void hgrn_final_phase(Frame& F, bf16* OBO) {
    const bf16* BIG = (const bf16*)(F.ws + WS_BIG); bf16* OB = (bf16*)(F.ws + WS_OB); const float* gn = F.a->in[19];
    const int gw = F.vcu * NWAVES + F.wave, NGW = F.G * NWAVES;
    const int dv = (F.lane & 15) * 8;
    const f32x4 g0 = *(const f32x4*)(gn + dv), g1 = *(const f32x4*)(gn + dv + 4);
    for (int row = gw; row < MT; row += NGW) {
        GAS v4u* po = (GAS v4u*)(OB + (size_t)row * DM) + F.lane; const GAS v4u* pg = (const GAS v4u*)(BIG + (size_t)row * 8192 + 6144) + F.lane;
        v4u wo[4], wg[4];
#pragma unroll
        for (int it = 0; it < 4; ++it) { wo[it] = po[64 * it]; wg[it] = pg[64 * it]; }
#pragma unroll
        for (int it = 0; it < 4; ++it) { float x[8], gg[8]; unpack8(wo[it], x); unpack8(wg[it], gg);
            float ss = 0.f;
#pragma unroll
            for (int i = 0; i < 8; ++i) ss += x[i] * x[i];
            ss += sx<1>(ss); ss += sx<2>(ss); ss += sx<4>(ss); ss += sx<8>(ss);
            const float rstd = rsqrtf(ss * (1.0f / 128.0f) + RMS_EPS);
            float y[8];
#pragma unroll
            for (int i = 0; i < 8; ++i) { const float gi = (i < 4) ? g0[i] : g1[i - 4]; y[i] = x[i] * rstd * gi * (gg[i] * __builtin_amdgcn_rcpf(1.0f + __expf(-gg[i]))); }
            v4u o; o.x = pk2(y[0], y[1]); o.y = pk2(y[2], y[3]); o.z = pk2(y[4], y[5]); o.w = pk2(y[6], y[7]);
            ((GAS v4u*)(OBO + (size_t)row * DM) + F.lane)[64 * it] = o; }
    }
}
__device__ __forceinline__ bool ph_refresh(Frame& F) { unsigned m = ~0u; asm volatile("" : "+s"(m));
    const int t = (F.wave << 6) | (int)__builtin_amdgcn_mbcnt_hi(m, __builtin_amdgcn_mbcnt_lo(m, 0u));
    F.tid = t; F.lane = t & 63; return true; }
__global__ void __launch_bounds__(NWAVES * 64, 2) trunk_fwd(Args args) {
    extern __shared__ __attribute__((aligned(16))) unsigned char lds[];
    Frame F;
    F.lds = (LAS unsigned char*)lds;
    F.MISC = (volatile LAS unsigned*)(F.lds + MISC_OFF);
    F.tid = threadIdx.x; F.lane = F.tid & 63; F.wave = __builtin_amdgcn_readfirstlane(F.tid >> 6);
    F.G = gridDim.x; { const int bx = blockIdx.x; F.vcu = (F.G % 8 == 0) ? (bx % 8) * (F.G / 8) + bx / 8 : bx; }
    F.ws = args.ws; F.ctl = (gu32*)(args.ws + WS_CTL); F.out = args.out;
    F.a = &args;
    for (int u = F.tid; u < (LDS_BYTES - LDSCTL_OFF) / 4; u += NWAVES * 64) ((LAS unsigned*)(F.lds + LDSCTL_OFF))[u] = 0u;
    __syncthreads();
    XcdBarrier bar; bar.bar = (unsigned*)(F.ctl + CW_BAR); bar.x = 0; bar.st = nullptr;
    if (!MK_PER_PHASE) bar = xcd_barrier_post((unsigned*)(F.ctl + CW_BAR), F.MISC + 8);
    const int lo = args.ph_lo, hi = args.ph_hi;
    int pc = 0;
    unsigned long long t_ph = PROBE_ECHO ? __builtin_amdgcn_s_memrealtime() : 0ull;
#define PH_ON (pc >= lo && pc < hi && ph_refresh(F))
#define PH_END_C(cls) do { if (!MK_PER_PHASE && pc >= lo && pc + 1 < hi) { const unsigned long long ta_ = (PROBE_IDLE && (PROBE_IDLE == 100 || PROBE_IDLE == (cls))) ? __builtin_amdgcn_s_memrealtime() : 0ull; xcd_barrier(bar); if (PROBE_MASK & 32) xcd_barrier(bar); \
        if (PROBE_IDLE && (PROBE_IDLE == 100 || PROBE_IDLE == (cls))) { const unsigned long long t1_ = __builtin_amdgcn_s_memrealtime(), d_ = t1_ - ta_; while (__builtin_amdgcn_s_memrealtime() - t1_ < d_) __builtin_amdgcn_s_sleep(8); xcd_barrier(bar); } \
        if (PROBE_ECHO == (cls)) { const unsigned long long t1_ = __builtin_amdgcn_s_memrealtime(), d_ = t1_ - t_ph; while (__builtin_amdgcn_s_memrealtime() - t1_ < d_) __builtin_amdgcn_s_sleep(8); xcd_barrier(bar); } \
        if (PROBE_ECHO) t_ph = __builtin_amdgcn_s_memrealtime(); } ++pc; } while (0)
#define PH_END PH_END_C(0)
    float* mod = (float*)(F.ws + WS_MOD);
    bf16* XN = (bf16*)(F.ws + WS_XN); bf16* BIG = (bf16*)(F.ws + WS_BIG); bf16* OB = (bf16*)(F.ws + WS_OB);
    float* RSS = (float*)(F.ws + WS_RSS); const float* CB = (const float*)(F.ws + WS_CB);
    if (PH_ON) { p0_mod(F); __syncthreads(); p0_convert(F); }
#if PROBE_MASK & 16
    if (PH_ON) { __syncthreads(); p0_mod(F); __syncthreads(); p0_convert(F); }
#endif
    PH_END_C(1);
    if (PH_ON) { tables_phase(F); bias_phase(F); xs0_phase(F, F.a->in[0], F.a->in[4], mod); }
#if PROBE_MASK & 16384
    if (PH_ON) { tables_phase(F); bias_phase(F); xs0_phase(F, F.a->in[0], F.a->in[4], mod); }
#endif
    PH_END_C(2);
#pragma unroll 1
    for (int L = 0; L < NLAYER; ++L) {
        const int kind = L % 3, slot = L / 3;
        const float* modL = mod + (size_t)L * NB * NMOD;
#pragma unroll 1
        for (int sub = 0; sub < 3; ++sub) {
            const int s = 3 * L + sub;
            const float* rss = RSS + (size_t)s * MT; const float* cb = CB + (size_t)s * NB * CB_LD;
            const bf16* outA; const bf16* outB; int outK;
            const int nhalf = (sub != 1) ? FFN_SPLIT : 1;
#pragma unroll 1
            for (int hf = 0; hf < nhalf; ++hf) {
            const int Mpart = MT / nhalf, pm_off = hf * (Mpart / 256);
            if (sub != 1) {
                const int ls = L * 2 + (sub >> 1);
                if (PH_ON) { pg8::Gemm g{XN, (const bf16*)(F.ws + WS_WGU) + (size_t)ls * 2 * FF * DM, Mpart, 2 * FF, DM, 1, 1}; pg8::StaticOrder S; S.init(Mpart, 2 * FF, F.G, (int)blockIdx.x, GU_WGM, pm_off);
                    pg8::EpiSwigluN E{BIG, FF, rss, cb, CB_LD, SEQ, F.lds + PRE_OFF};
#pragma unroll 1
                    for (int rep = 0; rep < ((PROBE_MASK & 1) ? 2 : 1); ++rep) { if (rep) __syncthreads(); pg8::gemm_phase<pg8::EpiSwigluN, pg8::StaticOrder, true, true>(F.lds + RING_OFF, g, S, E, F.tid); }
                    }
                PH_END_C(3);
                outA = BIG; outB = (const bf16*)(F.ws + WS_WD) + (size_t)ls * DM * FF; outK = FF;
            } else {
                const int nin = (kind == 2) ? 4 * DM : 3 * DM;
                const bf16* win = (kind == 0) ? (const bf16*)(F.ws + WS_WAI) + (size_t)slot * 3 * DM * DM : (kind == 1) ? (const bf16*)(F.ws + WS_WCI) : (const bf16*)(F.ws + WS_WHI);
                if (PH_ON) { pg8::Gemm g{XN, win, MT, nin, DM, 1, 1}; pg8::StaticOrder S; S.init(MT, nin, F.G, (int)blockIdx.x, GU_WGM);
                    pg8::EpiInN E{BIG, nin, rss, cb, CB_LD, SEQ, (kind == 0) ? 16 : 0, F.a->in[10] + (size_t)slot * 64, F.a->in[11] + (size_t)slot * 64, F.lds + PRE_OFF};
#pragma unroll 1
                    for (int rep = 0; rep < ((PROBE_MASK & 4) ? 2 : 1); ++rep) { if (rep) __syncthreads(); pg8::gemm_phase<pg8::EpiInN, pg8::StaticOrder, true, true>(F.lds + RING_OFF, g, S, E, F.tid); }
                    }
                PH_END_C(5);
                if (kind == 0) {
#if PROBE_MASK & 8192
                    if (PH_ON) { attn_phase(F, L, slot, 1); __syncthreads(); }
#endif
                    if (PH_ON) attn_phase(F, L, slot);
                    PH_END_C(7);
                } else if (kind == 1) {
                    if (PH_ON) conv_phase(F);
                    PH_END_C(8);
                } else {
#if PROBE_MASK & 64
                    if (PH_ON) { hgrn_prep_phase(F, L, XN, DM, XN); __syncthreads(); }
#endif
                    if (PH_ON) hgrn_prep_phase(F, L, BIG, 8192, OB);
                    PH_END_C(9);
#if PROBE_MASK & 128
                    if (PH_ON) { hgrn_scan_phase(F, XN); __syncthreads(); }
#endif
                    if (PH_ON) hgrn_scan_phase(F, OB);
                    PH_END_C(10);
                    if (PH_ON) hgrn_final_phase(F, OB);
                    PH_END_C(11);
                }
                outA = OB; outB = (kind == 0) ? (const bf16*)(F.ws + WS_WAO) + (size_t)slot * DM * DM : (kind == 1) ? (const bf16*)(F.ws + WS_WCO) : (const bf16*)(F.ws + WS_WHO); outK = DM;
            }
            if (PH_ON) { pg8::Gemm g{outA, outB, Mpart, DM, outK, (sub != 1) ? 1 : 0, 1};     pg8::StaticOrder S; S.init(Mpart, DM, F.G, (int)blockIdx.x, OUT_WGM, pm_off);
                const int sn = s + 1; const bool last = (s == 3 * NLAYER - 1);
                const float* TAB = (const float*)(F.ws + WS_TAB);
                pg8::EpiResN E{(s == 0) ? (const void*)F.a->in[0] : (const void*)(F.ws + WS_XH), last ? (void*)F.out : (void*)(F.ws + WS_XH), (s == 0) ? 1 : 0, last ? 1 : 0, DM, TAB + (size_t)(s * 2 + 0) * NB * DM, TAB + (size_t)(s * 2 + 1) * NB * DM, DM, SEQ, last ? (bf16*)nullptr : XN, RSS + (size_t)sn * MT, F.lds + PRE_OFF, 1.0f};
#pragma unroll 1
                for (int rep = (((PROBE_MASK & 2) || ((PROBE_MASK & 2048) && sub != 1) || ((PROBE_MASK & 4096) && sub == 1)) ? 0 : 1); rep < 2; ++rep) {
                    pg8::EpiResN E2 = E;
#if PROBE_MASK & (2 | 2048 | 4096)
                    { const bool dbl = (PROBE_MASK & 2) || ((PROBE_MASK & 2048) && sub != 1) || ((PROBE_MASK & 4096) && sub == 1);
                      if (dbl) { E2.gscale = 0.5f; if (rep == 0) { E2.rssn = RSS + (size_t)12 * MT; if (last) { E2.out = (void*)(F.ws + WS_XH); E2.out_f32 = 0; } } else if (s == 0) { E2.base = (const void*)(F.ws + WS_XH); E2.base_f32 = 0; } } }
#endif
                    if (rep == 0) __syncthreads();
                    pg8::gemm_phase<pg8::EpiResN, pg8::StaticOrder, true, true, OUT_A_AUX>(F.lds + RING_OFF, g, S, E2, F.tid); if (rep == 0) __syncthreads(); } }
            PH_END_C((sub != 1) ? 4 : 6);
            }
        }
    }
#undef PH_ON
#undef PH_END
#undef PH_END_C
}
extern "C" void kernel_launch(void* const* d_in, const int* in_sizes, int n_in, void* d_out, int out_size, void* d_ws, size_t ws_size, hipStream_t stream) {
    static int grid = 0;
    if (grid == 0) {
        if (n_in != 21 || in_sizes[0] != MT * DM || out_size != MT * DM || ws_size < WS_END) { fprintf(stderr, "kernel_launch: shape/workspace mismatch (n_in %d, in0 %d, out %d, ws %zu, need %zu); nothing launched\n", n_in, n_in > 0 ? in_sizes[0] : -1, out_size, ws_size, (size_t)WS_END); grid = -1; return; }
        int dev = 0, cus = 0, per_cu = 0;
        if (hipGetDevice(&dev) != hipSuccess || hipDeviceGetAttribute(&cus, hipDeviceAttributeMultiprocessorCount, dev) != hipSuccess) { fprintf(stderr, "kernel_launch: device query failed\n"); grid = -1; return; }
        if (hipFuncSetAttribute((const void*)trunk_fwd, hipFuncAttributeMaxDynamicSharedMemorySize, LDS_BYTES) != hipSuccess) { fprintf(stderr, "kernel_launch: hipFuncSetAttribute failed\n"); grid = -1; return; }
        if (hipOccupancyMaxActiveBlocksPerMultiprocessor(&per_cu, (const void*)trunk_fwd, NWAVES * 64, LDS_BYTES) != hipSuccess || per_cu < 1) fprintf(stderr, "kernel_launch: note: occupancy query reports %d workgroups per CU\n", per_cu);
        (void)hipGetLastError();
        grid = cus;
    }
    if (grid < 0) return;
    if (hipMemsetAsync((char*)d_ws + WS_CTL, 0, CTL_ZERO_BYTES, stream) != hipSuccess) { fprintf(stderr, "kernel_launch: memset failed\n"); return; }
    Args a{};
    for (int i = 0; i < 21; ++i) a.in[i] = (const float*)d_in[i];
    a.out = (float*)d_out; a.ws = (unsigned char*)d_ws;
#if MK_PER_PHASE
    for (int p = 0; p < N_PHASES; ++p) { a.ph_lo = p; a.ph_hi = p + 1; hipLaunchKernelGGL(trunk_fwd, dim3(grid), dim3(NWAVES * 64), LDS_BYTES, stream, a); }
#else
    a.ph_lo = 0; a.ph_hi = N_PHASES;
    hipLaunchKernelGGL(trunk_fwd, dim3(grid), dim3(NWAVES * 64), LDS_BYTES, stream, a);
#endif
    const hipError_t le = hipPeekAtLastError();
    if (le != hipSuccess) fprintf(stderr, "kernel_launch: launch failed: %s\n", hipGetErrorName(le));
}
```

```cpp
#include <hip/hip_runtime.h>
#include <cstdio>
#include <cstdint>
template <int X> __device__ __forceinline__ float sx(float v) { return __int_as_float(__builtin_amdgcn_ds_swizzle(__float_as_int(v), (X << 10) | 0x1f)); }
__device__ __forceinline__ float sum32(float v) { auto rr = __builtin_amdgcn_permlane32_swap(__float_as_uint(v), __float_as_uint(v), false, false); return __uint_as_float(rr[0]) + __uint_as_float(rr[1]); }
__device__ __forceinline__ float max32(float v) { auto rr = __builtin_amdgcn_permlane32_swap(__float_as_uint(v), __float_as_uint(v), false, false); return fmaxf(__uint_as_float(rr[0]), __uint_as_float(rr[1])); }
__device__ __forceinline__ float wave_sum(float v) { v += sx<1>(v); v += sx<2>(v); v += sx<4>(v); v += sx<8>(v); v += sx<16>(v); return sum32(v); }
__device__ __forceinline__ float wave_max(float v) { v = fmaxf(v, sx<1>(v)); v = fmaxf(v, sx<2>(v)); v = fmaxf(v, sx<4>(v)); v = fmaxf(v, sx<8>(v)); v = fmaxf(v, sx<16>(v)); return max32(v); }
typedef float f32x2_cv __attribute__((ext_vector_type(2))); typedef __bf16 bf16x2_cv __attribute__((ext_vector_type(2)));
__device__ __forceinline__ unsigned pk2(float lo, float hi) { const f32x2_cv v = {lo, hi}; const bf16x2_cv b = __builtin_convertvector(v, bf16x2_cv); return __builtin_bit_cast(unsigned, b); }
__device__ __forceinline__ unsigned f2bf(float f) { return pk2(f, 0.f) & 0xffffu; }
namespace pg8 {
#define PG8_LAS __attribute__((address_space(3)))
typedef unsigned short bf16_t;
typedef short bf16x8 __attribute__((ext_vector_type(8)));
typedef float f32x4 __attribute__((ext_vector_type(4)));
typedef unsigned u32x4 __attribute__((ext_vector_type(4)));
constexpr int BM = 256, BK = 64, HALF = 128, HTB = HALF * BK * 2  , STAGE_BYTES = 8 * HTB, NXCD = 8, WGM = 8;

__host__ __device__ __forceinline__ int lds_byte(int r, int c) { const int st = (r >> 4) * 2 + (c >> 5), rr = r & 15, cc = c & 31, ob = rr * 64 + cc * 2; return st * 1024 + (ob ^ (((ob >> 9) & 1) << 5)); }
__host__ __device__ __forceinline__ void stage_rc(int b, int& R, int& C) { const int st = b / 1024, sb = b % 1024, swz = sb ^ (((sb >> 9) & 1) << 5); R = (st >> 1) * 16 + swz / 64; C = (st & 1) * 32 + (swz % 64) / 2; }
__host__ __device__ __forceinline__ int perm32(int rho) { const int n = rho >> 4, i = rho & 15; return 8 * (i >> 2) + 4 * n + (i & 3); }

struct Unit { int pm, pn; };
struct Gemm { const bf16_t* A; const bf16_t* Bt; int M, N, K; int a_tiled = 0, b_tiled = 0; };

struct StaticOrder {
    int nM, nN, nwg, G, c, wgm, pm_off;
    __host__ __device__ void init(int M, int N, int G_, int c_, int wgm_ = WGM, int pm_off_ = 0) { nM = M / BM; nN = N / BM; nwg = nM * nN; G = G_; c = c_; wgm = wgm_; pm_off = pm_off_; }
    __host__ __device__ bool next(int i, Unit& u) const {
        const long L = (long)i * G + c; if (L >= nwg) return false;
        int wgid = (int)L; { const int q = nwg / NXCD, r = nwg % NXCD, xcd = wgid % NXCD, off = wgid / NXCD; wgid = (xcd < r ? xcd * (q + 1) : r * (q + 1) + (xcd - r) * q) + off; }
        const int nig = wgm * nN, gid = wgid / nig, fm = gid * wgm, gsz = (nM - fm) < wgm ? (nM - fm) : wgm;
        u.pm = pm_off + fm + ((wgid % nig) % gsz); u.pn = (wgid % nig) / gsz; return true;
    }
    __device__ __forceinline__ void a_ready(const Unit&) const {}
    __device__ __forceinline__ void done(const Unit&) const {}
};

__device__ __forceinline__ unsigned cvt_pk_bf16(float lo, float hi) { unsigned r; asm volatile("v_cvt_pk_bf16_f32 %0, %1, %2" : "=v"(r) : "v"(lo), "v"(hi)); return r; }
typedef float f32x2 __attribute__((ext_vector_type(2)));
typedef unsigned u32x2 __attribute__((ext_vector_type(2)));
struct EpiStore {
    static constexpr bool HAS_PRE = false;
    static constexpr bool PERM = true, AFTER_DRAIN = false;
    bf16_t* O; int ldc;
    __device__ __forceinline__ void operator()(const f32x4 (&acc)[2][2][4][2], const Unit& u, int wr, int wc, int fr, int fq) const {
        const int row0 = u.pm * BM + wr * 64 + fr, col0 = u.pn * BM + wc * 32 + 8 * fq;
#pragma unroll
        for (int ai = 0; ai < 2; ++ai)
#pragma unroll
            for (int m = 0; m < 4; ++m) { bf16_t* rowp = O + (size_t)(row0 + ai * HALF + m * 16) * ldc + col0;
#pragma unroll
                for (int bj = 0; bj < 2; ++bj) { const f32x4 v0 = acc[ai][bj][m][0], v1 = acc[ai][bj][m][1];
                    u32x4 w; w.x = cvt_pk_bf16(v0[0], v0[1]); w.y = cvt_pk_bf16(v0[2], v0[3]); w.z = cvt_pk_bf16(v1[0], v1[1]); w.w = cvt_pk_bf16(v1[2], v1[3]);
                    *(u32x4*)(rowp + bj * HALF) = w; } }
    }
};
__device__ __forceinline__ float swiglu1(float g, float u) { const float e = __builtin_amdgcn_exp2f(g * -1.4426950408889634f); return g * u * __builtin_amdgcn_rcpf(1.0f + e); }
struct EpiSwiglu {
    static constexpr bool HAS_PRE = false;
    static constexpr bool PERM = true, AFTER_DRAIN = false;
    bf16_t* O; int ldc;
    __device__ __forceinline__ void operator()(const f32x4 (&acc)[2][2][4][2], const Unit& u, int wr, int wc, int fr, int fq) const {
        const int row0 = u.pm * BM + wr * 64 + fr, col0 = u.pn * HALF + wc * 32 + 8 * fq;
#pragma unroll
        for (int ai = 0; ai < 2; ++ai)
#pragma unroll
            for (int m = 0; m < 4; ++m) { bf16_t* rowp = O + (size_t)(row0 + ai * HALF + m * 16) * ldc + col0;
                const f32x4 g0 = acc[ai][0][m][0], g1 = acc[ai][0][m][1], u0 = acc[ai][1][m][0], u1 = acc[ai][1][m][1];
                u32x4 w;
                w.x = cvt_pk_bf16(swiglu1(g0[0], u0[0]), swiglu1(g0[1], u0[1])); w.y = cvt_pk_bf16(swiglu1(g0[2], u0[2]), swiglu1(g0[3], u0[3]));
                w.z = cvt_pk_bf16(swiglu1(g1[0], u1[0]), swiglu1(g1[1], u1[1])); w.w = cvt_pk_bf16(swiglu1(g1[2], u1[2]), swiglu1(g1[3], u1[3]));
                *(u32x4*)rowp = w; }
    }
};
struct EpiRes {
    static constexpr bool HAS_PRE = false;
    static constexpr bool PERM = false, AFTER_DRAIN = false;
    const float* base; float* out; int ldc; const float* gate; int gstride; float coef; int rows_per_batch;
    __device__ __forceinline__ void operator()(const f32x4 (&acc)[2][2][4][2], const Unit& u, int wr, int wc, int fr, int fq) const {
        const int row0 = u.pm * BM + wr * 64 + fr, col0 = u.pn * BM + wc * 32 + 4 * fq;
        const float* gp = gate + (size_t)((u.pm * BM) / rows_per_batch) * gstride + col0;
        f32x4 gv[2][2];
#pragma unroll
        for (int bj = 0; bj < 2; ++bj)
#pragma unroll
            for (int n = 0; n < 2; ++n) gv[bj][n] = *(const f32x4*)(gp + bj * HALF + n * 16) * coef;
#pragma unroll
        for (int ai = 0; ai < 2; ++ai)
#pragma unroll
            for (int m = 0; m < 4; ++m) { const size_t off = (size_t)(row0 + ai * HALF + m * 16) * ldc + col0;
#pragma unroll
                for (int bj = 0; bj < 2; ++bj)
#pragma unroll
                    for (int n = 0; n < 2; ++n) { const f32x4 bs = *(const f32x4*)(base + off + bj * HALF + n * 16); *(f32x4*)(out + off + bj * HALF + n * 16) = bs + gv[bj][n] * acc[ai][bj][m][n]; }
                if (m & 1) asm volatile("" ::: "memory"); }
    }
};
__device__ __forceinline__ float rstd_of(const float* rss, int row) { return rsqrtf(rss[row] * (1.0f / 2048.0f) + 1e-6f); }
struct EpiSwigluN {
    static constexpr bool HAS_PRE = true;
    static constexpr bool PERM = true, AFTER_DRAIN = false;
    bf16_t* O; int ldc; const float* rss; const float* cb; int cbstride; int rows_per_batch; PG8_LAS unsigned char* pre_lds;
    __device__ __forceinline__ void pre(const Unit& u, int lane) const {
        __builtin_amdgcn_global_load_lds((const unsigned*)(cb + (size_t)((u.pm * BM) / rows_per_batch) * cbstride + u.pn * BM + 4 * lane), (PG8_LAS unsigned*)pre_lds, 16, 0, 0);
        __builtin_amdgcn_global_load_lds((const unsigned*)(rss + u.pm * BM + 4 * lane), (PG8_LAS unsigned*)(pre_lds + 1024), 16, 0, 0); }
    __device__ __forceinline__ void operator()(const f32x4 (&acc)[2][2][4][2], const Unit& u, int wr, int wc, int fr, int fq) const {
        const int col0 = u.pn * HALF + wc * 32 + 8 * fq;
        const PG8_LAS float* cbp = (const PG8_LAS float*)pre_lds + wc * 32 + 8 * fq; const PG8_LAS float* rp = (const PG8_LAS float*)(pre_lds + 1024) + wr * 64 + fr;
        constexpr float LC = 1.4426950408889634f, ILC = 0.6931471805599453f;
        const f32x4 cg0 = *(const PG8_LAS f32x4*)(cbp) * LC, cg1 = *(const PG8_LAS f32x4*)(cbp + 4) * LC, cu0 = *(const PG8_LAS f32x4*)(cbp + HALF) * ILC, cu1 = *(const PG8_LAS f32x4*)(cbp + HALF + 4) * ILC;
#pragma unroll
        for (int ai = 0; ai < 2; ++ai)
#pragma unroll
            for (int m = 0; m < 4; ++m) { const float rs = __builtin_amdgcn_rsqf(rp[ai * HALF + m * 16] * (1.0f / 2048.0f) + 1e-6f), rsg = rs * LC, rsu = rs * ILC;
                bf16_t* rowp = O + ((size_t)(u.pm * (ldc >> 6) + (col0 >> 6)) * BM + (wr * 64 + fr + ai * HALF + m * 16)) * 64 + (col0 & 63);
                const f32x4 h0 = acc[ai][0][m][0] * rsg + cg0, h1 = acc[ai][0][m][1] * rsg + cg1, u0 = acc[ai][1][m][0] * rsu + cu0, u1 = acc[ai][1][m][1] * rsu + cu1;
                f32x4 e0, e1;
#pragma unroll
                for (int i = 0; i < 4; ++i) { e0[i] = __builtin_amdgcn_exp2f(-h0[i]); e1[i] = __builtin_amdgcn_exp2f(-h1[i]); }
                e0 = e0 + 1.0f; e1 = e1 + 1.0f;
                f32x4 r0, r1;
#pragma unroll
                for (int i = 0; i < 4; ++i) { r0[i] = __builtin_amdgcn_rcpf(e0[i]); r1[i] = __builtin_amdgcn_rcpf(e1[i]); }
                const f32x4 o0 = (h0 * u0) * r0, o1 = (h1 * u1) * r1;
                u32x4 w;
                w.x = pk2(o0[0], o0[1]); w.y = pk2(o0[2], o0[3]); w.z = pk2(o1[0], o1[1]); w.w = pk2(o1[2], o1[3]);
                __builtin_nontemporal_store(w, (u32x4*)rowp); }
    }
};
struct EpiInN {
    static constexpr bool HAS_PRE = true;
    static constexpr bool PERM = true, AFTER_DRAIN = false;
    bf16_t* O; int ldc; const float* rss; const float* cb; int cbstride; int rows_per_batch; int nqk; const float* gq; const float* gk; PG8_LAS unsigned char* pre_lds;
    __device__ __forceinline__ void pre(const Unit& u, int lane) const {
        __builtin_amdgcn_global_load_lds((const unsigned*)(cb + (size_t)((u.pm * BM) / rows_per_batch) * cbstride + u.pn * BM + 4 * lane), (PG8_LAS unsigned*)pre_lds, 16, 0, 0);
        __builtin_amdgcn_global_load_lds((const unsigned*)(rss + u.pm * BM + 4 * lane), (PG8_LAS unsigned*)(pre_lds + 1024), 16, 0, 0); }
    __device__ __forceinline__ void operator()(const f32x4 (&acc)[2][2][4][2], const Unit& u, int wr, int wc, int fr, int fq) const {
        const int row0 = u.pm * BM + wr * 64 + fr, pc0 = u.pn * BM + wc * 32 + 8 * fq;
        const PG8_LAS float* cbp = (const PG8_LAS float*)pre_lds + wc * 32 + 8 * fq; const PG8_LAS float* rp = (const PG8_LAS float*)(pre_lds + 1024) + wr * 64 + fr;
        f32x4 cv[2][2];
#pragma unroll
        for (int bj = 0; bj < 2; ++bj)
#pragma unroll
            for (int n = 0; n < 2; ++n) cv[bj][n] = *(const PG8_LAS f32x4*)(cbp + bj * HALF + 4 * n);
        if (u.pn < nqk) {
            const bool isq = u.pn < (nqk >> 1); const float* gp = (isq ? gq : gk) + 8 * fq; const float gs = isq ? 0.125f * 1.4426950408889634f : 1.0f;
            f32x4 gv[2][2];
#pragma unroll
            for (int bj = 0; bj < 2; ++bj)
#pragma unroll
                for (int n = 0; n < 2; ++n) gv[bj][n] = *(const f32x4*)(gp + 32 * bj + 4 * n) * gs;
            const int lc0 = u.pn * BM + wc * 64 + 8 * fq;
#pragma unroll
            for (int ai = 0; ai < 2; ++ai)
#pragma unroll
                for (int m = 0; m < 4; ++m) { const int row = row0 + ai * HALF + m * 16; const float rs = rsqrtf(rp[ai * HALF + m * 16] * (1.0f / 2048.0f) + 1e-6f); bf16_t* rowp = O + (size_t)row * ldc + lc0;
                    f32x4 v[2][2]; float ss = 0.f;
#pragma unroll
                    for (int bj = 0; bj < 2; ++bj)
#pragma unroll
                        for (int n = 0; n < 2; ++n) { v[bj][n] = acc[ai][bj][m][n] * rs + cv[bj][n]; ss += (v[bj][n][0] * v[bj][n][0] + v[bj][n][1] * v[bj][n][1]) + (v[bj][n][2] * v[bj][n][2] + v[bj][n][3] * v[bj][n][3]); }
                    ss += sx<16>(ss); ss = sum32(ss);
                    const float rg = rsqrtf(ss * (1.0f / 64.0f) + 1e-6f);
#pragma unroll
                    for (int bj = 0; bj < 2; ++bj) { const f32x4 v0 = v[bj][0] * rg * gv[bj][0], v1 = v[bj][1] * rg * gv[bj][1];
                        u32x4 w; w.x = pk2(v0[0], v0[1]); w.y = pk2(v0[2], v0[3]); w.z = pk2(v1[0], v1[1]); w.w = pk2(v1[2], v1[3]);
                        if (isq) __builtin_nontemporal_store(w, (u32x4*)(rowp + 32 * bj)); else *(u32x4*)(rowp + 32 * bj) = w; } }
        } else {
#pragma unroll
            for (int ai = 0; ai < 2; ++ai)
#pragma unroll
                for (int m = 0; m < 4; ++m) { const int row = row0 + ai * HALF + m * 16; const float rs = rsqrtf(rp[ai * HALF + m * 16] * (1.0f / 2048.0f) + 1e-6f); bf16_t* rowp = O + (size_t)row * ldc + pc0;
#pragma unroll
                    for (int bj = 0; bj < 2; ++bj) { const f32x4 v0 = acc[ai][bj][m][0] * rs + cv[bj][0], v1 = acc[ai][bj][m][1] * rs + cv[bj][1];
                        u32x4 w; w.x = pk2(v0[0], v0[1]); w.y = pk2(v0[2], v0[3]); w.z = pk2(v1[0], v1[1]); w.w = pk2(v1[2], v1[3]);
                        *(u32x4*)(rowp + bj * HALF) = w; } }
        }
    }
};
typedef _Float16 f16x4 __attribute__((ext_vector_type(4)));
struct EpiResN {
    static constexpr bool HAS_PRE = true;
    static constexpr bool PERM = false, AFTER_DRAIN = false;
    const void* base; void* out; int base_f32, out_f32;
    int ldc; const float* gvt; const float* ant; int tstride; int rows_per_batch;
    bf16_t* xs; float* rssn; PG8_LAS unsigned char* pre_lds;
    float gscale;
    __device__ __forceinline__ void pre(const Unit& u, int lane) const {
        const size_t o = (size_t)((u.pm * BM) / rows_per_batch) * tstride + u.pn * BM + 4 * lane;
        __builtin_amdgcn_global_load_lds((const unsigned*)(gvt + o), (PG8_LAS unsigned*)pre_lds, 16, 0, 0);
        __builtin_amdgcn_global_load_lds((const unsigned*)(ant + o), (PG8_LAS unsigned*)(pre_lds + 1024), 16, 0, 0); }
    __device__ __forceinline__ void operator()(const f32x4 (&acc)[2][2][4][2], const Unit& u, int wr, int wc, int fr, int fq) const {
        const int col0 = u.pn * BM + wc * 32 + 4 * fq;
        const PG8_LAS float* gp = (const PG8_LAS float*)pre_lds + wc * 32 + 4 * fq;
        f32x4 gv[2][2], an[2][2];
#pragma unroll
        for (int bj = 0; bj < 2; ++bj)
#pragma unroll
            for (int n = 0; n < 2; ++n) { gv[bj][n] = *(const PG8_LAS f32x4*)(gp + bj * HALF + n * 16) * gscale; an[bj][n] = *(const PG8_LAS f32x4*)(gp + 256 + bj * HALF + n * 16); }
        if (base_f32) {
#pragma unroll
            for (int ai = 0; ai < 2; ++ai)
#pragma unroll
                for (int m = 0; m < 4; ++m) { const int rr = wr * 64 + fr + ai * HALF + m * 16; const unsigned off = (unsigned)((u.pm * BM + rr) * ldc + col0); float ss = 0.f;
                    const unsigned xso = ((unsigned)(u.pm * (ldc >> 6) + 4 * u.pn) * BM + rr) * 64u + 4u * fq;
#pragma unroll
                    for (int bj = 0; bj < 2; ++bj)
#pragma unroll
                        for (int n = 0; n < 2; ++n) { const unsigned o2 = off + bj * HALF + n * 16;
                            const f32x4 xn = *(const f32x4*)((const char*)base + 4u * o2) + gv[bj][n] * acc[ai][bj][m][n];
                            *(f16x4*)((char*)out + 2u * o2) = __builtin_convertvector(xn, f16x4);
                            ss += (xn[0] * xn[0] + xn[1] * xn[1]) + (xn[2] * xn[2] + xn[3] * xn[3]); const f32x4 h = xn * an[bj][n];
                            u32x2 w; w.x = pk2(h[0], h[1]); w.y = pk2(h[2], h[3]); *(u32x2*)((char*)xs + 2u * (xso + (unsigned)(2 * bj + (wc >> 1)) * (BM * 64) + (wc & 1) * 32 + n * 16)) = w; }
                    ss += sx<16>(ss); ss = sum32(ss); if (fq == 0) __hip_atomic_fetch_add(rssn + (u.pm * BM + rr), ss, __ATOMIC_RELAXED, __HIP_MEMORY_SCOPE_AGENT);
                    if (m & 1) asm volatile("" ::: "memory"); }
        } else {
            f16x4 bsv[2][4][2][2];
#pragma unroll
            for (int ai = 0; ai < 2; ++ai)
#pragma unroll
                for (int m = 0; m < 4; ++m)
#pragma unroll
                    for (int bj = 0; bj < 2; ++bj)
#pragma unroll
                        for (int n = 0; n < 2; ++n) bsv[ai][m][bj][n] = *(const f16x4*)((const char*)base + 2u * (unsigned)((u.pm * BM + wr * 64 + fr + ai * HALF + m * 16) * ldc + col0 + bj * HALF + n * 16));
            asm volatile("" ::: "memory");
#pragma unroll
            for (int ai = 0; ai < 2; ++ai) {
#pragma unroll
                for (int m = 0; m < 4; ++m) { const int rr = wr * 64 + fr + ai * HALF + m * 16; const unsigned off = (unsigned)((u.pm * BM + rr) * ldc + col0); float ss = 0.f;
                    const unsigned xso = ((unsigned)(u.pm * (ldc >> 6) + 4 * u.pn) * BM + rr) * 64u + 4u * fq;
#pragma unroll
                    for (int bj = 0; bj < 2; ++bj)
#pragma unroll
                        for (int n = 0; n < 2; ++n) { const unsigned o2 = off + bj * HALF + n * 16;
                            const f32x4 xn = __builtin_convertvector(bsv[ai][m][bj][n], f32x4) + gv[bj][n] * acc[ai][bj][m][n];
                            if (out_f32) *(f32x4*)((char*)out + 4u * o2) = xn; else *(f16x4*)((char*)out + 2u * o2) = __builtin_convertvector(xn, f16x4);
                            if (xs) { ss += (xn[0] * xn[0] + xn[1] * xn[1]) + (xn[2] * xn[2] + xn[3] * xn[3]); const f32x4 h = xn * *(const PG8_LAS f32x4*)(gp + 256 + bj * HALF + n * 16);
                                u32x2 w; w.x = pk2(h[0], h[1]); w.y = pk2(h[2], h[3]); *(u32x2*)((char*)xs + 2u * (xso + (unsigned)(2 * bj + (wc >> 1)) * (BM * 64) + (wc & 1) * 32 + n * 16)) = w; } }
                    if (xs) { ss += sx<16>(ss); ss = sum32(ss); if (fq == 0) __hip_atomic_fetch_add(rssn + (u.pm * BM + rr), ss, __ATOMIC_RELAXED, __HIP_MEMORY_SCOPE_AGENT); } }
                asm volatile("" ::: "memory"); }
        }
    }
};
template <class Epi, class Sched, bool ALIGN_EPI = false, bool SP2 = false, int A_AUX = 0>
__device__ __forceinline__ void gemm_phase(PG8_LAS unsigned char* lds, const Gemm g, const Sched& S, const Epi& E, int tid_in) {
    int tid_o = tid_in; asm volatile("" : "+v"(tid_o));
    const int tid = tid_o, wid = __builtin_amdgcn_readfirstlane(tid >> 6), lane = tid & 63, wr = wid >> 2, wc = wid & 3, fr = lane & 15, fq = lane >> 4;
    const int K = g.K, nt = K / BK;
    unsigned voffA[2], voffB[2];
#pragma unroll
    for (int i = 0; i < 2; ++i) { int R, C; stage_rc(tid * 16 + i * 8192, R, C); const int Rb = Epi::PERM ? ((R & ~31) + perm32(R & 31)) : R;
        voffA[i] = (unsigned)(R * (g.a_tiled ? BK : K) + C) * 2u; voffB[i] = (unsigned)(Rb * (g.b_tiled ? BK : K) + C) * 2u; }
    const size_t kstepA = g.a_tiled ? (size_t)(BM * BK * 2) : (size_t)(BK * 2), kstepB = g.b_tiled ? (size_t)(BM * BK * 2) : (size_t)(BK * 2);
    const size_t hstepA = g.a_tiled ? (size_t)(HALF * BK * 2) : (size_t)HALF * K * 2, hstepB = g.b_tiled ? (size_t)(HALF * BK * 2) : (size_t)HALF * K * 2;
    const size_t tstepA = (size_t)BM * K * 2, tstepB = tstepA;
    const unsigned ldsw = (unsigned)wid * 1024u;
    const int aoff = lds_byte(wr * 64 + fr, fq * 8), boff = lds_byte(wc * 32 + fr, fq * 8);
#define PG8_SA(b, h) (((b) * 2 + (h)) * HTB)
#define PG8_SB(b, h) ((4 + (b) * 2 + (h)) * HTB)
#define PG8_STAGE(bufoff, gbase, voff) do { _Pragma("unroll") for (int _i = 0; _i < 2; ++_i) \
        __builtin_amdgcn_global_load_lds((const unsigned*)((const char*)(gbase) + (voff)[_i]), (PG8_LAS unsigned*)(lds + (bufoff) + ldsw + _i * 8192), 16, 0, 0); } while (0)
#define PG8_STAGE_A(bufoff, gbase, voff) do { _Pragma("unroll") for (int _i = 0; _i < 2; ++_i) \
        __builtin_amdgcn_global_load_lds((const unsigned*)((const char*)(gbase) + (voff)[_i]), (PG8_LAS unsigned*)(lds + (bufoff) + ldsw + _i * 8192), 16, 0, A_AUX); } while (0)
#define PG8_LDA(dst, b, h) do { _Pragma("unroll") for (int m = 0; m < 4; ++m) _Pragma("unroll") for (int k = 0; k < 2; ++k) dst[m][k] = *(const PG8_LAS bf16x8*)(lds + PG8_SA(b, h) + aoff + m * 2048 + k * 1024); } while (0)
#define PG8_LDB(dst, b, h) do { _Pragma("unroll") for (int n = 0; n < 2; ++n) _Pragma("unroll") for (int k = 0; k < 2; ++k) dst[n][k] = *(const PG8_LAS bf16x8*)(lds + PG8_SB(b, h) + boff + n * 2048 + k * 1024); } while (0)
#define PG8_MMA(ai, bj, At, Bt) do { __builtin_amdgcn_s_setprio(1); _Pragma("unroll") for (int m = 0; m < 4; ++m) _Pragma("unroll") for (int n = 0; n < 2; ++n) _Pragma("unroll") for (int k = 0; k < 2; ++k) \
        acc[ai][bj][m][n] = __builtin_amdgcn_mfma_f32_16x16x32_bf16(Bt[n][k], At[m][k], acc[ai][bj][m][n], 0, 0, 0); __builtin_amdgcn_s_setprio(0); } while (0)
#define PG8_WAIT_V(n) asm volatile("s_waitcnt vmcnt(" #n ")" ::: "memory")
#define PG8_WAIT_L(n) asm volatile("s_waitcnt lgkmcnt(" #n ")" ::: "memory")
#define PG8_BAR __builtin_amdgcn_s_barrier()
#define PG8_SCHED __builtin_amdgcn_sched_barrier(0)
    Unit cur, nxt; int ui = 0;
    if (!S.next(0, cur)) return;
    f32x4 acc[2][2][4][2];
#pragma unroll
    for (int a = 0; a < 2; ++a)
#pragma unroll
        for (int b = 0; b < 2; ++b)
#pragma unroll
            for (int m = 0; m < 4; ++m)
#pragma unroll
                for (int n = 0; n < 2; ++n) acc[a][b][m][n] = (f32x4){0.f, 0.f, 0.f, 0.f};
    bf16x8 At[4][2], B0[2][2], B1[2][2];
    const char* cA = (const char*)g.A + (size_t)cur.pm * tstepA; const char* cB = (const char*)g.Bt + (size_t)cur.pn * tstepB;
    S.a_ready(cur);
    if constexpr (SP2) {
        PG8_STAGE(PG8_SB(0, 0), cB, voffB); PG8_STAGE(PG8_SB(0, 1), cB + hstepB, voffB); PG8_STAGE_A(PG8_SA(0, 0), cA, voffA); PG8_STAGE_A(PG8_SA(0, 1), cA + hstepA, voffA);
        if (wr == 1) PG8_BAR;
        PG8_WAIT_V(2); PG8_BAR;
        PG8_STAGE(PG8_SB(1, 0), cB + kstepB, voffB); PG8_STAGE_A(PG8_SA(1, 0), cA + kstepA, voffA); PG8_STAGE(PG8_SB(1, 1), cB + hstepB + kstepB, voffB);
        PG8_WAIT_V(6); PG8_BAR;
    } else {
        PG8_STAGE(PG8_SB(0, 0), cB, voffB); PG8_STAGE_A(PG8_SA(0, 0), cA, voffA); PG8_STAGE(PG8_SB(0, 1), cB + hstepB, voffB); PG8_STAGE_A(PG8_SA(0, 1), cA + hstepA, voffA);
        if (wr == 1) PG8_BAR;
        PG8_WAIT_V(4); PG8_BAR;
        PG8_STAGE(PG8_SB(1, 0), cB + kstepB, voffB); PG8_STAGE_A(PG8_SA(1, 0), cA + kstepA, voffA); PG8_STAGE(PG8_SB(1, 1), cB + hstepB + kstepB, voffB);
        PG8_WAIT_V(6); PG8_BAR;
    }
    for (;;) {
        const bool has_next = S.next(ui + 1, nxt);
        const char* nA = has_next ? (const char*)g.A + (size_t)nxt.pm * tstepA : cA; const char* nB = has_next ? (const char*)g.Bt + (size_t)nxt.pn * tstepB : cB;
        for (int t = 0; t < nt; t += 2) {
            const bool last = (t == nt - 2);
            const char* a1 = cA + (size_t)(t + 1) * kstepA;
            const char* a2 = last ? nA : cA + (size_t)(t + 2) * kstepA; const char* b2 = last ? nB : cB + (size_t)(t + 2) * kstepB;
            const char* a3 = a2 + kstepA; const char* b3 = b2 + kstepB;
            if (last && has_next) S.a_ready(nxt);
            if constexpr (SP2) {
            if constexpr (Epi::HAS_PRE) { if (last && wid == 0) { int ln = fr | (fq << 4); asm volatile("" : "+v"(ln)); E.pre(cur, ln); } }
            PG8_LDB(B0, 0, 0); PG8_LDB(B1, 0, 1); PG8_SCHED; PG8_LDA(At, 0, 0); PG8_STAGE_A(PG8_SA(1, 1), a1 + hstepA, voffA);
            PG8_WAIT_V(8); PG8_WAIT_L(0); PG8_BAR; PG8_MMA(0, 0, At, B0); PG8_MMA(0, 1, At, B1); PG8_BAR; PG8_SCHED;
            PG8_LDA(At, 0, 1); PG8_STAGE(PG8_SB(0, 0), b2, voffB); PG8_STAGE(PG8_SB(0, 1), b2 + hstepB, voffB); PG8_STAGE_A(PG8_SA(0, 0), a2, voffA);
            PG8_WAIT_V(8); PG8_WAIT_L(0); PG8_BAR; PG8_MMA(1, 0, At, B0); PG8_MMA(1, 1, At, B1); PG8_BAR; PG8_SCHED;
            PG8_LDB(B0, 1, 0); PG8_LDB(B1, 1, 1); PG8_SCHED; PG8_LDA(At, 1, 0); PG8_STAGE_A(PG8_SA(0, 1), a2 + hstepA, voffA);
            PG8_WAIT_V(8); PG8_WAIT_L(0); PG8_BAR; PG8_MMA(0, 0, At, B0); PG8_MMA(0, 1, At, B1); PG8_BAR; PG8_SCHED;
            PG8_LDA(At, 1, 1); PG8_STAGE(PG8_SB(1, 0), b3, voffB); PG8_STAGE(PG8_SB(1, 1), b3 + hstepB, voffB); PG8_STAGE_A(PG8_SA(1, 0), a3, voffA);
            PG8_WAIT_V(8); PG8_WAIT_L(0); PG8_BAR; PG8_MMA(1, 0, At, B0); PG8_MMA(1, 1, At, B1); PG8_BAR; PG8_SCHED;
            } else {
            PG8_LDB(B0, 0, 0); PG8_SCHED; PG8_LDA(At, 0, 0); PG8_STAGE_A(PG8_SA(1, 1), a1 + hstepA, voffA);
            PG8_WAIT_L(8); PG8_BAR; PG8_WAIT_L(0); PG8_MMA(0, 0, At, B0); PG8_BAR; PG8_SCHED;
            PG8_LDB(B1, 0, 1); PG8_STAGE(PG8_SB(0, 0), b2, voffB);
            PG8_BAR; PG8_WAIT_L(0); PG8_MMA(0, 1, At, B1); PG8_BAR;
            PG8_LDA(At, 0, 1); PG8_STAGE_A(PG8_SA(0, 0), a2, voffA);
            PG8_BAR; PG8_WAIT_L(0); PG8_MMA(1, 0, At, B0); PG8_BAR; PG8_SCHED;
            PG8_STAGE(PG8_SB(0, 1), b2 + hstepB, voffB);
            PG8_WAIT_V(6); PG8_BAR; PG8_MMA(1, 1, At, B1); PG8_BAR;
            PG8_LDB(B0, 1, 0); PG8_SCHED; PG8_LDA(At, 1, 0); PG8_STAGE_A(PG8_SA(0, 1), a2 + hstepA, voffA);
            PG8_WAIT_L(8); PG8_BAR; PG8_WAIT_L(0); PG8_MMA(0, 0, At, B0); PG8_BAR; PG8_SCHED;
            PG8_LDB(B1, 1, 1); PG8_STAGE(PG8_SB(1, 0), b3, voffB);
            PG8_BAR; PG8_WAIT_L(0); PG8_MMA(0, 1, At, B1); PG8_BAR;
            PG8_LDA(At, 1, 1); PG8_STAGE_A(PG8_SA(1, 0), a3, voffA);
            PG8_BAR; PG8_WAIT_L(0); PG8_MMA(1, 0, At, B0); PG8_BAR; PG8_SCHED;
            PG8_STAGE(PG8_SB(1, 1), b3 + hstepB, voffB);
            PG8_WAIT_V(6); PG8_BAR; PG8_MMA(1, 1, At, B1); PG8_BAR;
            }
        }
        if constexpr (ALIGN_EPI) { if (wr == 0) PG8_BAR; }
        if constexpr (!Epi::AFTER_DRAIN) { E(acc, cur, wr, wc, fr, fq); S.done(cur); }
        if (!has_next) break;
#pragma unroll
        for (int a = 0; a < 2; ++a)
#pragma unroll
            for (int b = 0; b < 2; ++b)
#pragma unroll
                for (int m = 0; m < 4; ++m)
#pragma unroll
                    for (int n = 0; n < 2; ++n) acc[a][b][m][n] = (f32x4){0.f, 0.f, 0.f, 0.f};
        cur = nxt; cA = nA; cB = nB; ++ui;
        if constexpr (ALIGN_EPI) { if (wr == 1) PG8_BAR; }
    }
    PG8_WAIT_V(0);
    if constexpr (!ALIGN_EPI) { if (wr == 0) PG8_BAR; }
    PG8_BAR;
    if constexpr (Epi::AFTER_DRAIN) { E.fused(acc, cur, wr, wc, fr, fq, lds, wid, lane); S.done(cur); }
#undef PG8_SA
#undef PG8_SB
#undef PG8_STAGE
#undef PG8_STAGE_A
#undef PG8_LDA
#undef PG8_LDB
#undef PG8_MMA
#undef PG8_WAIT_V
#undef PG8_WAIT_L
#undef PG8_BAR
#undef PG8_SCHED
}
}
#define GAS __attribute__((address_space(1)))
#define LAS __attribute__((address_space(3)))
typedef unsigned short bf16;
typedef unsigned v4u __attribute__((ext_vector_type(4)));
typedef float f32x4 __attribute__((ext_vector_type(4)));
typedef short bf16x8 __attribute__((ext_vector_type(8)));
typedef GAS unsigned gu32;
typedef GAS unsigned long long gu64;
#define RLX_AGENT __ATOMIC_RELAXED, __HIP_MEMORY_SCOPE_AGENT
#define LDS_WAIT() asm volatile("s_waitcnt lgkmcnt(0)" ::: "memory")
#define VM_WAIT() asm volatile("s_waitcnt vmcnt(0)" ::: "memory")
__device__ __forceinline__ unsigned long long rt() { return __builtin_amdgcn_s_memrealtime(); }
#define XB_TMO      128
#define XB_XCNT(j)  (256  + 64 * (j))
#define XB_XSUB(j)  (1280 + 64 * (j))
#define XB_XGEN(j)  (2304 + 64 * (j))
#define XB_TOP      3328
#define XB_TOPGEN   3392
#define XCD_BAR_WORDS 3456
#define XB_SPIN_CAP (1u << 18)

__device__ __forceinline__ unsigned xb_ld(unsigned* p)              { return __hip_atomic_load(p, __ATOMIC_RELAXED, __HIP_MEMORY_SCOPE_AGENT); }
__device__ __forceinline__ unsigned xb_add(unsigned* p, unsigned v) { return __hip_atomic_fetch_add(p, v, __ATOMIC_RELAXED, __HIP_MEMORY_SCOPE_AGENT); }
__device__ __forceinline__ unsigned xb_xcc_id() { return (unsigned)__builtin_amdgcn_s_getreg((3 << 11) | 20) & 0xFu; }
#define XB_SPIN(cond, bar) do { unsigned _sp = 0; while (cond) { __builtin_amdgcn_s_sleep(1); \
    if ((++_sp & 255u) == 0u) { if (xb_ld(&(bar)[XB_TMO])) break; if (_sp > XB_SPIN_CAP) { atomicAdd(&(bar)[XB_TMO], 1u); break; } } } } while (0)

struct XcdBarrier {
    unsigned* bar; unsigned x;
    volatile LAS unsigned* st;
};

__device__ __forceinline__ XcdBarrier xcd_barrier_post(unsigned* bar, volatile LAS unsigned* st) {
    XcdBarrier b; b.bar = bar; b.x = xb_xcc_id(); b.st = st;
    if (threadIdx.x == 0) (void)xb_add(&bar[XB_XCNT(b.x)], 1u);
    return b;
}
__device__ __forceinline__ void xcd_barrier_complete(unsigned* bar, unsigned x, unsigned& nloc, unsigned& nx) {
    const unsigned G = gridDim.x * gridDim.y * gridDim.z;
    unsigned sum, cnt, mine, sp = 0u;
    for (;;) {
        sum = 0u; cnt = 0u; mine = 0u;
#pragma unroll
        for (unsigned j = 0; j < 16; ++j) { const unsigned c = xb_ld(&bar[XB_XCNT(j)]); sum += c; cnt += (c > 0u) ? 1u : 0u; mine = (j == x) ? c : mine; }
        if (sum == G) break;
        __builtin_amdgcn_s_sleep(1);
        if ((++sp & 255u) == 0u) { if (xb_ld(&bar[XB_TMO])) break; if (sp > XB_SPIN_CAP) { atomicAdd(&bar[XB_TMO], 1u); break; } }
    }
    nloc = mine > 0u ? mine : 1u; nx = cnt > 0u ? cnt : 1u;
}

__device__ __forceinline__ void xcd_barrier(const XcdBarrier& b) {
    asm volatile("s_waitcnt vmcnt(0)" ::: "memory");
    __syncthreads();
    if (threadIdx.x == 0) {
        unsigned* bar = b.bar;
        __builtin_amdgcn_s_waitcnt(0);
        unsigned nloc = b.st[0], nx = b.st[1];
        if (nloc == 0u) { xcd_barrier_complete(bar, b.x, nloc, nx); b.st[0] = nloc; b.st[1] = nx; }
        const unsigned old = xb_add(&bar[XB_XSUB(b.x)], 1u);
        const unsigned gen = old / nloc;
        if (old + 1u == (gen + 1u) * nloc) {
            __builtin_amdgcn_fence(__ATOMIC_RELEASE, "agent");
            asm volatile("s_waitcnt vmcnt(0)" ::: "memory");
            const unsigned og = xb_add(&bar[XB_TOP], 1u);
            const unsigned tg = og / nx;
            if (og + 1u == (tg + 1u) * nx) xb_add(&bar[XB_TOPGEN], 1u);
            else XB_SPIN(xb_ld(&bar[XB_TOPGEN]) == tg, bar);
            __builtin_amdgcn_fence(__ATOMIC_ACQUIRE, "agent");
            xb_add(&bar[XB_XGEN(b.x)], 1u);
            asm volatile("s_waitcnt vmcnt(0)" ::: "memory");
        } else {
            XB_SPIN(xb_ld(&bar[XB_XGEN(b.x)]) == gen, bar);
            __builtin_amdgcn_fence(__ATOMIC_ACQUIRE, "agent");
            asm volatile("s_waitcnt vmcnt(0)" ::: "memory");
        }
    }
    __syncthreads();
}
namespace att {
using bf16x8 = __attribute__((ext_vector_type(8))) short;
using s16x4  = __attribute__((ext_vector_type(4))) short;
using f32x16 = __attribute__((ext_vector_type(16))) float;
using u32x4  = __attribute__((ext_vector_type(4))) unsigned;
constexpr int SEQ_ = 8192, LDQ = 6144; constexpr size_t SHM_V = 16384, SHM_K = 16384;
#define KSWZ(row, colB) ((row) * 256 + ((colB) ^ (((row) & 7) << 4)))
#define SBAR() __builtin_amdgcn_sched_barrier(0)
__device__ __forceinline__ int crow(int r, int hi) { return (r & 3) + 8 * (r >> 2) + 4 * hi; }
__device__ __forceinline__ unsigned cvtpk(float lo, float hi) {
  unsigned r; asm volatile("v_cvt_pk_bf16_f32 %0, %1, %2" : "=v"(r) : "v"(lo), "v"(hi)); return r;
}
__device__ __forceinline__ void qkt(f32x16& p0, f32x16& p1, const bf16* Ks, const bf16x8* qr, int r32, int hi, int jmap, float dbase, float slope2, float negm, bool diag) {
  asm volatile("" : "+v"(negm));
  if (diag) {
#pragma unroll
    for (int r = 0; r < 16; ++r) { const float d = (float)((r & 3) + 8 * (r >> 2)) + dbase;
      p0[r] = fmaf(-slope2, fabsf(d), negm); p1[r] = fmaf(-slope2, fabsf(d + 32.f), negm); }
  } else {
    const float u0 = fmaf(slope2, dbase, negm), u1 = fmaf(slope2, dbase + 32.f, negm);
#pragma unroll
    for (int r = 0; r < 16; ++r) { p0[r] = fmaf(slope2, (float)((r & 3) + 8 * (r >> 2)), u0); p1[r] = fmaf(slope2, (float)((r & 3) + 8 * (r >> 2)), u1); }
  }
  const int cb0 = (jmap * 64 + hi * 8) * 2;
  bf16x8 b0 = *reinterpret_cast<const bf16x8*>((const char*)Ks + KSWZ(r32, cb0));
  bf16x8 b1 = *reinterpret_cast<const bf16x8*>((const char*)Ks + KSWZ(32 + r32, cb0));
#pragma unroll
  for (int d0 = 0; d0 < 4; ++d0) { const int cb = (jmap * 64 + (d0 + 1) * 16 + hi * 8) * 2;
    bf16x8 n0 = b0, n1 = b1;
    if (d0 < 3) { n0 = *reinterpret_cast<const bf16x8*>((const char*)Ks + KSWZ(r32, cb)); n1 = *reinterpret_cast<const bf16x8*>((const char*)Ks + KSWZ(32 + r32, cb)); }
    p0 = __builtin_amdgcn_mfma_f32_32x32x16_bf16(b0, qr[d0], p0, 0, 0, 0);
    p1 = __builtin_amdgcn_mfma_f32_32x32x16_bf16(b1, qr[d0], p1, 0, 0, 0);
    b0 = n0; b1 = n1; }
}
__device__ __forceinline__ void partialSM(f32x16& p0, f32x16& p1) {
#pragma unroll
  for (int r = 0; r < 16; ++r) p0[r] = __builtin_amdgcn_exp2f(p0[r]);
}
__device__ __forceinline__ void finishSM(f32x16& p0, f32x16& p1, float alpha, float& l_reg, bf16x8& pa0, bf16x8& pa1, bf16x8& pa2, bf16x8& pa3) {
  for (int r = 0; r < 16; ++r) p1[r] = __builtin_amdgcn_exp2f(p1[r]);
  float ps = 0; for (int r = 0; r < 16; ++r) ps += p0[r]; for (int r = 0; r < 16; ++r) ps += p1[r];
  { auto rr = __builtin_amdgcn_permlane32_swap(__float_as_uint(ps), __float_as_uint(ps), false, false);
    ps = __uint_as_float(rr[0]) + __uint_as_float(rr[1]); }
  l_reg = l_reg * alpha + ps;
#define PK4(P, BASE, OUT) do { unsigned a0 = cvtpk(P[BASE + 0], P[BASE + 1]), a1 = cvtpk(P[BASE + 2], P[BASE + 3]);   \
    unsigned b0 = cvtpk(P[BASE + 4], P[BASE + 5]), b1 = cvtpk(P[BASE + 6], P[BASE + 7]);                              \
    auto r0 = __builtin_amdgcn_permlane32_swap(a0, b0, false, false); auto r1 = __builtin_amdgcn_permlane32_swap(a1, b1, false, false); \
    u32x4 w = {r0[0], r1[0], r0[1], r1[1]}; OUT = *reinterpret_cast<bf16x8*>(&w); } while (0)
  PK4(p0, 0, pa0); PK4(p0, 8, pa1); PK4(p1, 0, pa2); PK4(p1, 8, pa3);
#undef PK4
}
__device__ __forceinline__ int v_st(int k, int c) { const int kk = (k & ~0xC) | ((k & 4) << 1) | ((k & 8) >> 1); return ((kk >> 3) * 4 + (c >> 5)) * 512 + ((kk & 7) * 32 + (c & 31)) * 2; }
__device__ __forceinline__ int v_rd_base(int lane) { return ((lane & 3) << 3) | (((lane >> 2) & 3) << 6) | (((lane >> 4) & 1) << 5) | (((lane >> 5) & 1) << 8); }
constexpr int v_rd_off(int d0, int ks, int half) { return d0 * 512 + ks * 4096 + half * 2048; }
template <int OFF> __device__ __forceinline__ s16x4 tr_read(int vb) {
  s16x4 r; asm volatile("ds_read_b64_tr_b16 %0, %1 offset:%2" : "=&v"(r) : "v"(vb), "i"(OFF) : "memory"); return r;
}
template <int D0> __device__ __forceinline__ void pv_one(f32x16& od, int vb, bf16x8 pa0, bf16x8 pa1, bf16x8 pa2, bf16x8 pa3) {
  const s16x4 l0 = tr_read<v_rd_off(D0, 0, 0)>(vb), h0 = tr_read<v_rd_off(D0, 0, 1)>(vb), l1 = tr_read<v_rd_off(D0, 1, 0)>(vb), h1 = tr_read<v_rd_off(D0, 1, 1)>(vb);
  const s16x4 l2 = tr_read<v_rd_off(D0, 2, 0)>(vb), h2 = tr_read<v_rd_off(D0, 2, 1)>(vb), l3 = tr_read<v_rd_off(D0, 3, 0)>(vb), h3 = tr_read<v_rd_off(D0, 3, 1)>(vb);
  asm volatile("s_waitcnt lgkmcnt(0)" ::: "memory"); SBAR();
#define PK(L, H) (bf16x8){L[0], L[1], L[2], L[3], H[0], H[1], H[2], H[3]}
  od = __builtin_amdgcn_mfma_f32_32x32x16_bf16(pa0, PK(l0, h0), od, 0, 0, 0);
  od = __builtin_amdgcn_mfma_f32_32x32x16_bf16(pa1, PK(l1, h1), od, 0, 0, 0);
  od = __builtin_amdgcn_mfma_f32_32x32x16_bf16(pa2, PK(l2, h2), od, 0, 0, 0);
  od = __builtin_amdgcn_mfma_f32_32x32x16_bf16(pa3, PK(l3, h3), od, 0, 0, 0);
#undef PK
}
#define PV_RD(S, D0) const s16x4 S##l0 = tr_read<v_rd_off(D0, 0, 0)>(vb), S##h0 = tr_read<v_rd_off(D0, 0, 1)>(vb), S##l1 = tr_read<v_rd_off(D0, 1, 0)>(vb), S##h1 = tr_read<v_rd_off(D0, 1, 1)>(vb), \
    S##l2 = tr_read<v_rd_off(D0, 2, 0)>(vb), S##h2 = tr_read<v_rd_off(D0, 2, 1)>(vb), S##l3 = tr_read<v_rd_off(D0, 3, 0)>(vb), S##h3 = tr_read<v_rd_off(D0, 3, 1)>(vb)
#define PV_PK(L, H) (bf16x8){L[0], L[1], L[2], L[3], H[0], H[1], H[2], H[3]}
#define PV_MM(S, OD) do { OD = __builtin_amdgcn_mfma_f32_32x32x16_bf16(pa0, PV_PK(S##l0, S##h0), OD, 0, 0, 0); OD = __builtin_amdgcn_mfma_f32_32x32x16_bf16(pa1, PV_PK(S##l1, S##h1), OD, 0, 0, 0); \
    OD = __builtin_amdgcn_mfma_f32_32x32x16_bf16(pa2, PV_PK(S##l2, S##h2), OD, 0, 0, 0); OD = __builtin_amdgcn_mfma_f32_32x32x16_bf16(pa3, PV_PK(S##l3, S##h3), OD, 0, 0, 0); } while (0)
__device__ __forceinline__ void pv_d0(f32x16* o, int vb, bf16x8 pa0, bf16x8 pa1, bf16x8 pa2, bf16x8 pa3) {
  PV_RD(a, 0); PV_RD(b, 1);
  asm volatile("s_waitcnt lgkmcnt(8)" ::: "memory"); SBAR();
  PV_MM(a, o[0]);
  PV_RD(c, 2);
  asm volatile("s_waitcnt lgkmcnt(8)" ::: "memory"); SBAR();
  PV_MM(b, o[1]);
  PV_RD(d, 3);
  asm volatile("s_waitcnt lgkmcnt(8)" ::: "memory"); SBAR();
  PV_MM(c, o[2]);
  asm volatile("s_waitcnt lgkmcnt(0)" ::: "memory"); SBAR();
  PV_MM(d, o[3]);
}
#undef PV_RD
#undef PV_PK
#undef PV_MM
__device__ __forceinline__ void attn_unit(int tid_in, int b, int h, int qb, int tb, const bf16* __restrict__ QKV, bf16* __restrict__ OB, float lam, float omli, float slope2, float m_ref, const float* __restrict__ subg, char* lds, gu32* qhead, volatile LAS unsigned* qslot) {
  int tid_o = tid_in; asm volatile("" : "+v"(tid_o));
  const int tid = tid_o, wid = __builtin_amdgcn_readfirstlane(tid >> 6), lane = tid & 63, r32 = lane & 31, hi = lane >> 5;
  const int jmap = wid >> 2, wq = wid & 3;
  constexpr int KR = 0, VR = 3 * 16384, WSO = 6 * 16384;
  float* ws = (float*)(lds + WSO) + wid * 64; float* li_l = ws;
  const long rowbase = (long)b * SEQ_; const int q0 = qb * 128 + wq * 32;
  float l_reg = 0.f; f32x16 o[4] = {}; bf16x8 qr[4];
  const bf16* Qw = QKV + (rowbase + q0 + r32) * LDQ + h * 128 + jmap * 64 + hi * 8;
#pragma unroll
  for (int d0 = 0; d0 < 4; ++d0) qr[d0] = *reinterpret_cast<const bf16x8*>(Qw + d0 * 16);
  const char* KVmid = (const char*)(QKV + (rowbase + 64 * tb) * LDQ + 2048 + h * 128 + 1024);
  unsigned koff[2], voff[2];
#pragma unroll
  for (int jb = 0; jb < 2; ++jb) { const int blk = 2 * wid + jb;
    { const int row = 4 * blk + (lane >> 4), chunk = (lane & 15) ^ (row & 7);
      koff[jb] = (unsigned)(row * LDQ * 2 + chunk * 16); }
    { const int sl = 64 * blk + lane, kk = 8 * (sl >> 7) + ((sl & 31) >> 2), c = 32 * ((sl >> 5) & 3) + 8 * (sl & 3);
      const int k = (kk & ~0xC) | ((kk & 4) << 1) | ((kk & 8) >> 1);
      voff[jb] = (unsigned)(k * LDQ * 2 + c * 2); } }
  const unsigned lds0 = (unsigned)(uintptr_t)lds;
  const int vb0 = (int)(lds0 + VR) + v_rd_base(lane);
  typedef __attribute__((address_space(3))) unsigned lds_u32;
#define DMA_K(t, slot) do { const char* t_ = KVmid + (size_t)(t) * (64 * LDQ * 2) - 2048; \
    __builtin_amdgcn_global_load_lds((const unsigned*)(t_ + koff[0]), (lds_u32*)(lds0 + KR + (slot) * 16384 + (2 * wid) * 1024), 16, 0, 0); \
    __builtin_amdgcn_global_load_lds((const unsigned*)(t_ + koff[1]), (lds_u32*)(lds0 + KR + (slot) * 16384 + (2 * wid + 1) * 1024), 16, 0, 0); } while (0)
#define DMA_V(t, slot) do { const char* t_ = KVmid + (size_t)(t) * (64 * LDQ * 2) + 2048; \
    __builtin_amdgcn_global_load_lds((const unsigned*)(t_ + voff[0]), (lds_u32*)(lds0 + VR + (slot) * 16384 + (2 * wid) * 1024), 16, 0, 0); \
    __builtin_amdgcn_global_load_lds((const unsigned*)(t_ + voff[1]), (lds_u32*)(lds0 + VR + (slot) * 16384 + (2 * wid + 1) * 1024), 16, 0, 0); } while (0)
#define WAIT_BAR(N) asm volatile("s_waitcnt vmcnt(" #N ") lgkmcnt(0)\n\ts_barrier" ::: "memory")
  f32x16 pA0, pA1, pB0, pB1; bf16x8 pa0, pa1, pa2, pa3;
  const int NT = 2 * qb + 2 - tb, cq = 2 * qb + (wq >> 1) - tb;
  const float dq = (float)(4 * hi - (q0 + r32) + 64 * tb);
#define QKT(P0, P1, kslot, t) qkt(P0, P1, (const bf16*)(lds + KR + (kslot) * 16384), qr, r32, hi, jmap, (float)(64 * (t)) + dq, slope2, ((t) > cq) ? -1e30f : -m_ref, (t) == cq)
  int sc = 0, sp = 2;
#define ROT() do { sp = sc; sc = (sc == 2) ? 0 : sc + 1; } while (0)
  asm volatile("" ::: "memory");
  DMA_K(0, 0); DMA_V(0, 0); DMA_K(1, 1);
  WAIT_BAR(4);
  asm volatile("" : "+v"(qr[0]), "+v"(qr[1]), "+v"(qr[2]), "+v"(qr[3]) :: "memory");
  if (2 < NT) DMA_K(2, 2);
  DMA_V(1, 1);
  QKT(pA0, pA1, 0, 0); partialSM(pA0, pA1);
#define STEP(ORD, PX0, PX1, PY0, PY1, t) do { ROT(); \
    if ((t) + 1 < NT) { WAIT_BAR(4); } else { WAIT_BAR(2); } \
    {   \
      if ((t) + 2 < NT) DMA_K((t) + 2, sp); \
      if ((t) + 1 < NT) DMA_V((t) + 1, (3 - sc - sp)); } \
    SBAR(); \
    if ((ORD) == 0) { QKT(PX0, PX1, sc, t); \
      finishSM(PY0, PY1, 1.f, l_reg, pa0, pa1, pa2, pa3); SBAR(); \
      pv_d0(o, vb0 + sp * 16384, pa0, pa1, pa2, pa3); partialSM(PX0, PX1); } \
    else { finishSM(PY0, PY1, 1.f, l_reg, pa0, pa1, pa2, pa3); SBAR(); \
      pv_d0(o, vb0 + sp * 16384, pa0, pa1, pa2, pa3); SBAR(); \
      QKT(PX0, PX1, sc, t); partialSM(PX0, PX1); } } while (0)
#define TILE_LOOP(ORD) do { \
    for (int t = 1; t + 1 < NT; t += 2) { STEP(ORD, pB0, pB1, pA0, pA1, t); STEP(ORD, pA0, pA1, pB0, pB1, t + 1); } \
    if ((NT & 1) == 0) { STEP(ORD, pB0, pB1, pA0, pA1, NT - 1); \
      WAIT_BAR(0);                                               \
      finishSM(pB0, pB1, 1.f, l_reg, pa0, pa1, pa2, pa3); SBAR(); \
    } else { WAIT_BAR(0); \
      finishSM(pA0, pA1, 1.f, l_reg, pa0, pa1, pa2, pa3); SBAR(); } } while (0)
  if (jmap == 0) TILE_LOOP(0); else TILE_LOOP(1);
  pv_d0(o, vb0 + sc * 16384, pa0, pa1, pa2, pa3);
  unsigned nxt_unit = 0u; if (tid == 0) nxt_unit = __hip_atomic_fetch_add(qhead, 1u, __ATOMIC_RELAXED, __HIP_MEMORY_SCOPE_AGENT);
  if (hi == 0) li_l[r32] = l_reg; asm volatile("s_waitcnt lgkmcnt(0)" ::: "memory");
#pragma unroll
  for (int r = 0; r < 16; ++r) { const float rl = __builtin_amdgcn_rcpf(li_l[crow(r, hi)]);
#pragma unroll
    for (int d0 = 0; d0 < 4; ++d0) o[d0][r] *= rl; }
  float* xch = (float*)lds + (size_t)wq * 4096 + lane;
  __syncthreads();
  if (jmap == 1) {
#pragma unroll
    for (int d0 = 0; d0 < 4; ++d0)
#pragma unroll
      for (int r = 0; r < 16; ++r) xch[(d0 * 16 + r) * 64] = o[d0][r];
  }
  __syncthreads();
  if (jmap == 0) {
    float ss[16];
#pragma unroll
    for (int r = 0; r < 16; ++r) { float s = 0.f;
#pragma unroll
      for (int d0 = 0; d0 < 4; ++d0) { const float df = o[d0][r] - lam * xch[(d0 * 16 + r) * 64]; o[d0][r] = df; s += df * df; }
      ss[r] = s; }
#pragma unroll
    for (int r = 0; r < 16; ++r) { float s = ss[r]; s += sx<1>(s); s += sx<2>(s); s += sx<4>(s); s += sx<8>(s); s += sx<16>(s);
      ss[r] = rsqrtf(s * (1.0f / 128.0f) + 1e-6f) * omli; }
    float gs[4]; int r32o = r32; asm volatile("" : "+v"(r32o));
#pragma unroll
    for (int d0 = 0; d0 < 4; ++d0) gs[d0] = subg[d0 * 32 + r32o];
    bf16* stg = (bf16*)(lds + 65536) + wq * 4096;
    int sto = 4 * hi * 128 + r32; asm volatile("" : "+v"(sto));
#pragma unroll
    for (int r = 0; r < 16; ++r) { const int orow = (r & 3) + 8 * (r >> 2);
#pragma unroll
      for (int d0 = 0; d0 < 4; ++d0) stg[sto + orow * 128 + d0 * 32] = (bf16)f2bf(o[d0][r] * ss[r] * gs[d0]); }
    asm volatile("s_waitcnt lgkmcnt(0)" ::: "memory");
    unsigned ooff = (unsigned)((q0 + (lane >> 4)) * 2048 + (lane & 15) * 8); asm volatile("" : "+v"(ooff));
    bf16* Ow = OB + rowbase * 2048 + h * 128 + ooff;
#pragma unroll
    for (int i = 0; i < 8; ++i) { const u32x4 v = *(const u32x4*)(stg + (4 * i + (lane >> 4)) * 128 + (lane & 15) * 8); *(u32x4*)(Ow + (4 * i) * 2048) = v; }
  }
  if (tid == 0) *qslot = nxt_unit;
  __syncthreads();
#undef DMA_K
#undef DMA_V
#undef WAIT_BAR
#undef ROT
#undef STEP
#undef TILE_LOOP
#undef QKT
}
#undef KSWZ
#undef SBAR
}
constexpr int DM = 2048, NB = 4, SEQ = 8192, MT = NB * SEQ, FF = 5632, NLAYER = 4, NH = 16, NMOD = 9 * DM;
constexpr float RMS_EPS = 1e-6f;
constexpr int NWAVES = 8;
#ifndef PROBE_MASK
#define PROBE_MASK 0
#endif
#ifndef PROBE_IDLE
#define PROBE_IDLE 0
#endif
#ifndef PROBE_ECHO
#define PROBE_ECHO 0
#endif
#ifndef FFN_SPLIT
#define FFN_SPLIT 1
#endif
#ifndef GU_WGM
#define GU_WGM 8
#endif
#ifndef OUT_A_AUX
#define OUT_A_AUX 0
#endif
#ifndef OUT_WGM
#define OUT_WGM 4
#endif
#ifndef MK_PER_PHASE
#define MK_PER_PHASE 0
#endif
constexpr int N_PHASES = 32 + 8 * 2 * (FFN_SPLIT - 1);
constexpr size_t MiB = 1u << 20;
constexpr size_t WS_CTL = 0, CTL_ZERO_BYTES = 3 * MiB;
constexpr size_t WS_MOD = 1696 * MiB;
constexpr size_t WS_EBL = 3 * MiB;
constexpr size_t WS_WGU = 8 * MiB;
constexpr size_t WS_WD  = 360 * MiB;
constexpr size_t WS_WAI = 536 * MiB;
constexpr size_t WS_WAO = 584 * MiB;
constexpr size_t WS_WCI = 600 * MiB, WS_WCO = 624 * MiB;
constexpr size_t WS_WHI = 632 * MiB, WS_WHO = 664 * MiB;
constexpr size_t WS_XN  = 672 * MiB;
constexpr size_t WS_BIG = 800 * MiB;
constexpr size_t WS_OB  = 1312 * MiB;
constexpr size_t WS_KLT = 1440 * MiB;
constexpr size_t WS_IT  = 1568 * MiB;
constexpr size_t WS_RSS = 1 * MiB, RSS_BYTES = 2 * MiB;
constexpr size_t WS_CB  = 1698 * MiB;
constexpr int CB_LD = 2 * 5632;
constexpr size_t WS_TAB = 1701 * MiB;
constexpr size_t WS_XH  = 1702 * MiB;
constexpr size_t WS_END = 1830 * MiB;
constexpr int CW_BAR = 4096;
constexpr int RING_OFF = 0, RING_BYTES = 131072;
constexpr int LDSCTL_OFF = RING_BYTES, MISC_OFF = LDSCTL_OFF + 320;
constexpr int PRE_OFF = LDSCTL_OFF + 1024;
constexpr int LDS_BYTES = 147456;

struct Args { const float* in[21]; float* out; unsigned char* ws; int ph_lo, ph_hi; };
struct Frame {
    LAS unsigned char* lds;
    volatile LAS unsigned* MISC;
    gu32* ctl;
    int tid, lane, wave, vcu, G;
    const struct Args* a; float* out; unsigned char* ws;
};
__device__ __forceinline__ float bf_lo(unsigned w) { return __uint_as_float(w << 16); }
__device__ __forceinline__ float bf_hi(unsigned w) { return __uint_as_float(w & 0xffff0000u); }
__device__ __forceinline__ float bf_f(bf16 x) { return __uint_as_float((unsigned)x << 16); }

__device__ __forceinline__ void unpack8(const v4u w, float (&x)[8]) { x[0] = bf_lo(w.x); x[1] = bf_hi(w.x); x[2] = bf_lo(w.y); x[3] = bf_hi(w.y); x[4] = bf_lo(w.z); x[5] = bf_hi(w.z); x[6] = bf_lo(w.w); x[7] = bf_hi(w.w); }
__device__ __forceinline__ void p0_mod(Frame& F) {
    LAS float* cond = (LAS float*)(F.lds);
    LAS float* part = (LAS float*)(F.lds + 32768);
    const float* c = F.a->in[1]; const float* aw = F.a->in[2]; const float* ab = F.a->in[3]; float* mod = (float*)(F.ws + WS_MOD);
    for (int i = F.tid; i < NB * DM; i += NWAVES * 64) { const float v = c[i]; cond[i] = v / (1.0f + __expf(-v)); }
    __syncthreads();
    const int cg = F.tid & 15, ks = F.tid >> 4;
    for (int it = F.vcu; it < NLAYER * (NMOD / 64); it += F.G) {
        const int L = it / (NMOD / 64), n0 = (it % (NMOD / 64)) * 64;
        f32x4 a0 = {0.f, 0.f, 0.f, 0.f}, a1 = a0, a2 = a0, a3 = a0;
        const float* wp = aw + ((size_t)L * DM + ks * 64) * NMOD + n0 + 4 * cg;
#pragma unroll 8
        for (int k = 0; k < 64; ++k) { const f32x4 w = *(const f32x4*)(wp + (size_t)k * NMOD); const int kk = ks * 64 + k;
            a0 += w * cond[kk]; a1 += w * cond[DM + kk]; a2 += w * cond[2 * DM + kk]; a3 += w * cond[3 * DM + kk]; }
        *(LAS f32x4*)(part + (ks * 4 + 0) * 64 + 4 * cg) = a0; *(LAS f32x4*)(part + (ks * 4 + 1) * 64 + 4 * cg) = a1;
        *(LAS f32x4*)(part + (ks * 4 + 2) * 64 + 4 * cg) = a2; *(LAS f32x4*)(part + (ks * 4 + 3) * 64 + 4 * cg) = a3;
        __syncthreads();
        if (F.tid < 256) { const int b = F.tid >> 6, col = F.tid & 63; float s = 0.f;
#pragma unroll 8
            for (int k2 = 0; k2 < 32; ++k2) s += part[(k2 * 4 + b) * 64 + col];
            mod[((size_t)L * NB + b) * NMOD + n0 + col] = s + ab[(size_t)L * NMOD + n0 + col]; }
        __syncthreads();
    }
}
struct CvItem { const float* W; bf16* WT; int K, N, mode, item; };
__device__ __forceinline__ CvItem cv_decode(Frame& F, int it) {
    constexpr int I_FFN = (DM / 64) * (FF / 32);
    constexpr int I_IN3 = (DM / 64) * (3 * DM / 32), I_SQ = (DM / 64) * (DM / 32), I_IN4 = (DM / 64) * (4 * DM / 32);
    int r = it;
    if (r < 24 * I_FFN) { const int m = r / I_FFN, ls = m / 3, which = m % 3; r -= m * I_FFN;
        if (which == 0) return CvItem{F.a->in[5] + (size_t)ls * DM * FF, (bf16*)(F.ws + WS_WGU) + (size_t)ls * 2 * FF * DM, DM, FF, 1, r};
        if (which == 1) return CvItem{F.a->in[6] + (size_t)ls * DM * FF, (bf16*)(F.ws + WS_WGU) + (size_t)ls * 2 * FF * DM, DM, FF, 2, r};
        return CvItem{F.a->in[7] + (size_t)ls * FF * DM, (bf16*)(F.ws + WS_WD) + (size_t)ls * DM * FF, FF, DM, 0, r}; }
    r -= 24 * I_FFN;
    if (r < 2 * I_IN3) { const int s = r / I_IN3; return CvItem{F.a->in[8] + (size_t)s * DM * 3 * DM, (bf16*)(F.ws + WS_WAI) + (size_t)s * 3 * DM * DM, DM, 3 * DM, 3, r - s * I_IN3}; } r -= 2 * I_IN3;
    if (r < 2 * I_SQ) { const int s = r / I_SQ; return CvItem{F.a->in[9] + (size_t)s * DM * DM, (bf16*)(F.ws + WS_WAO) + (size_t)s * DM * DM, DM, DM, 0, r - s * I_SQ}; } r -= 2 * I_SQ;
    if (r < I_IN3) return CvItem{F.a->in[14], (bf16*)(F.ws + WS_WCI), DM, 3 * DM, 0, r}; r -= I_IN3;
    if (r < I_SQ) return CvItem{F.a->in[16], (bf16*)(F.ws + WS_WCO), DM, DM, 0, r}; r -= I_SQ;
    if (r < I_IN4) return CvItem{F.a->in[17], (bf16*)(F.ws + WS_WHI), DM, 4 * DM, 0, r}; r -= I_IN4;
    return CvItem{F.a->in[18], (bf16*)(F.ws + WS_WHO), DM, DM, 0, r};
}
__device__ __forceinline__ void cv_load(const CvItem& c, float (&wv)[32], int lane) {
    const int nblk = c.N / 32, kb = c.item / nblk, nb = c.item % nblk;
    const float* wp = c.W + (size_t)(64 * kb + (lane >> 5)) * c.N + 32 * nb + (lane & 31);
#pragma unroll
    for (int i = 0; i < 32; ++i) wv[i] = wp[(size_t)(2 * i) * c.N];
}
__device__ __forceinline__ void cv_finish(const CvItem& c, const float (&wv)[32], LAS float* scr, int lane) {
    const int K = c.K, mode = c.mode, nblk = c.N / 32, kb = c.item / nblk, nb = c.item % nblk, n0 = 32 * nb;
    const int drow0 = (mode == 0 || (mode == 3 && n0 >= 2 * DM)) ? n0 : (mode == 3) ? ((n0 & ~255) + 128 * ((n0 >> 5) & 1) + 32 * ((n0 >> 6) & 3)) : ((n0 >> 7) * 256 + (mode - 1) * 128 + (n0 & 127));
#pragma unroll
    for (int i = 0; i < 32; ++i) scr[(2 * i + (lane >> 5)) * 33 + (lane & 31)] = wv[i];
    LDS_WAIT(); asm volatile("" ::: "memory");
    const int cc = lane & 7;
#pragma unroll
    for (int j = 0; j < 4; ++j) { const int n = (lane >> 3) + 8 * j; const LAS float* s = scr + (8 * cc) * 33 + n;
        v4u o; o.x = pk2(s[0 * 33], s[1 * 33]); o.y = pk2(s[2 * 33], s[3 * 33]); o.z = pk2(s[4 * 33], s[5 * 33]); o.w = pk2(s[6 * 33], s[7 * 33]);
        const int dr = drow0 + n;
        *(GAS v4u*)(c.WT + ((size_t)((dr >> 8) * (K >> 6) + kb) * 256 + (dr & 255)) * 64 + 8 * cc) = o; }
    LDS_WAIT(); asm volatile("" ::: "memory");
}
__device__ __forceinline__ void p0_convert(Frame& F) {
    LAS float* scr = (LAS float*)(F.lds + RING_OFF + F.wave * 16384);
    const int gw = F.vcu * NWAVES + F.wave, NGW = F.G * NWAVES;
    constexpr int NITEMS = 24 * ((DM / 64) * (FF / 32)) + 3 * ((DM / 64) * (3 * DM / 32)) + 4 * ((DM / 64) * (DM / 32)) + (DM / 64) * (4 * DM / 32);
    CvItem A, B; float wa[32], wb[32];
    int it = gw;
    if (it < NITEMS) { A = cv_decode(F, it); cv_load(A, wa, F.lane); }
    while (it < NITEMS) {
        int nx = it + NGW;
        if (nx < NITEMS) { B = cv_decode(F, nx); cv_load(B, wb, F.lane); }
        cv_finish(A, wa, scr, F.lane);
        it = nx; if (it >= NITEMS) break;
        nx = it + NGW;
        if (nx < NITEMS) { A = cv_decode(F, nx); cv_load(A, wa, F.lane); }
        cv_finish(B, wb, scr, F.lane);
        it = nx;
    }
}
__device__ __forceinline__ void xs0_phase(Frame& F, const float* xsrc, const float* g, const float* modL) {
    bf16* XN = (bf16*)(F.ws + WS_XN); float* rss = (float*)(F.ws + WS_RSS);
    const int gw = F.vcu * NWAVES + F.wave, NGW = F.G * NWAVES;
    for (int r0 = gw * 16; r0 < MT; r0 += NGW * 16) {
        const int b = r0 / SEQ;
        const float* sc = modL + (size_t)b * NMOD + DM;
        f32x4 a[8];
#pragma unroll
        for (int j = 0; j < 8; ++j) { const int col = 4 * F.lane + 256 * j; a[j] = *(const f32x4*)(g + col) * (*(const f32x4*)(sc + col) + 1.0f); }
#pragma unroll 2
        for (int r = 0; r < 16; ++r) {
            const GAS f32x4* xr = (const GAS f32x4*)(xsrc + (size_t)(r0 + r) * DM) + F.lane;
            f32x4 v[8]; float s = 0.f;
#pragma unroll
            for (int j = 0; j < 8; ++j) { v[j] = xr[64 * j]; s += (v[j].x * v[j].x + v[j].y * v[j].y) + (v[j].z * v[j].z + v[j].w * v[j].w); }
            s = wave_sum(s);
            if (F.lane == 0) rss[r0 + r] = s;
            bf16* o8 = XN + ((size_t)((r0 + r) >> 8) * 32 * 256 + ((r0 + r) & 255)) * 64 + (size_t)(F.lane >> 4) * (256 * 64) + 4 * (F.lane & 15);
#pragma unroll
            for (int j = 0; j < 8; ++j) { const f32x4 h = v[j] * a[j];
                *(GAS unsigned long long*)(o8 + (size_t)(4 * j) * (256 * 64)) = (unsigned long long)pk2(h.x, h.y) | ((unsigned long long)pk2(h.z, h.w) << 32); }
        }
    }
}
__device__ __forceinline__ void tables_phase(Frame& F) {
    const float* mod = (const float*)(F.ws + WS_MOD); float* TAB = (float*)(F.ws + WS_TAB); const float* ng = F.a->in[4];
    const int gt = F.vcu * (NWAVES * 64) + F.tid, NT = F.G * NWAVES * 64;
    for (int i = gt; i < 3 * NLAYER * NB * DM; i += NT) {
        const int col = i % DM, b = (i / DM) % NB, s = i / (DM * NB), L = s / 3, sub = s % 3, sn = s + 1, Ln = sn / 3, subn = sn % 3;
        TAB[((size_t)(s * 2 + 0) * NB + b) * DM + col] = ((sub == 1) ? 1.0f : 0.5f) * mod[((size_t)L * NB + b) * NMOD + (3 * sub + 2) * DM + col];
        TAB[((size_t)(s * 2 + 1) * NB + b) * DM + col] = (sn < 3 * NLAYER) ? ng[((size_t)Ln * 3 + subn) * DM + col] * (1.0f + mod[((size_t)Ln * NB + b) * NMOD + (3 * subn + 1) * DM + col]) : 0.f;
    }
}
__device__ __forceinline__ void bias_phase(Frame& F) {
    const float* mod = (const float*)(F.ws + WS_MOD); float* CB = (float*)(F.ws + WS_CB);
    const int gw = F.vcu * NWAVES + F.wave, NGW = F.G * NWAVES;
#pragma unroll 1
    for (int s = 0; s < 3 * NLAYER; ++s) {
        const int L = s / 3, sub = s % 3, kind = L % 3, slot = L / 3;
        const bf16* W; int N;
        if (sub != 1) { W = (const bf16*)(F.ws + WS_WGU) + (size_t)(L * 2 + (sub >> 1)) * 2 * FF * DM; N = 2 * FF; }
        else if (kind == 0) { W = (const bf16*)(F.ws + WS_WAI) + (size_t)slot * 3 * DM * DM; N = 3 * DM; }
        else if (kind == 1) { W = (const bf16*)(F.ws + WS_WCI); N = 3 * DM; }
        else { W = (const bf16*)(F.ws + WS_WHI); N = 4 * DM; }
        float sh[4][4][8];
#pragma unroll
        for (int b = 0; b < NB; ++b)
#pragma unroll
            for (int it = 0; it < 4; ++it) { const float* sp = mod + ((size_t)L * NB + b) * NMOD + (3 * sub) * DM + 8 * (64 * it + F.lane);
                const f32x4 s0 = *(const f32x4*)sp, s1 = *(const f32x4*)(sp + 4);
                sh[b][it][0] = s0.x; sh[b][it][1] = s0.y; sh[b][it][2] = s0.z; sh[b][it][3] = s0.w; sh[b][it][4] = s1.x; sh[b][it][5] = s1.y; sh[b][it][6] = s1.z; sh[b][it][7] = s1.w; }
        for (int n = gw; n < N; n += NGW) {
            const bf16* wrow = W + ((size_t)(n >> 8) * (DM >> 6) * 256 + (n & 255)) * 64 + (F.lane & 7) * 8;
            float d0 = 0.f, d1 = 0.f, d2 = 0.f, d3 = 0.f;
#pragma unroll
            for (int it = 0; it < 4; ++it) { float w[8]; unpack8(*(const GAS v4u*)(wrow + (size_t)(8 * it + (F.lane >> 3)) * 256 * 64), w);
#pragma unroll
                for (int i = 0; i < 8; ++i) { d0 += w[i] * sh[0][it][i]; d1 += w[i] * sh[1][it][i]; d2 += w[i] * sh[2][it][i]; d3 += w[i] * sh[3][it][i]; } }
            d0 = wave_sum(d0); d1 = wave_sum(d1); d2 = wave_sum(d2); d3 = wave_sum(d3);
            if (F.lane == 0) { float* cp = CB + (size_t)s * NB * CB_LD + n; cp[0] = d0; cp[CB_LD] = d1; cp[2 * CB_LD] = d2; cp[3 * CB_LD] = d3; }
        }
    }
}
constexpr int CW_ATTNQ = 8192;
__device__ __forceinline__ void attn_phase(Frame& F, int L, int slot, int qword = 0) {
    const bf16* QKV = (const bf16*)(F.ws + WS_BIG); bf16* OB = (bf16*)(F.ws + WS_OB);
    const float* lv = F.a->in[12] + (size_t)slot * 4 * 64;
    int ln = F.lane; asm volatile("" : "+v"(ln));
    const float sa = wave_sum(lv[ln] * lv[64 + ln]), sb = wave_sum(lv[128 + ln] * lv[192 + ln]);
    asm volatile("" : "+s"(L));
    const float lambda_init = (L == 0) ? 0.2f : (L == 1) ? 0.35550906f : (L == 2) ? 0.47071302f : 0.55605822f;
    const float lam = expf(sa) - expf(sb) + lambda_init;
    const float* subg = F.a->in[13] + (size_t)slot * 128;
    float gm = fabsf(F.a->in[10][slot * 64 + ln] * F.a->in[11][slot * 64 + ln]);
    gm = wave_max(gm);
    const float twoB24 = 16.0f * gm + 24.0f;
    const float m_ref = (8.0f * gm) * 1.4426950408889634f * 1.02f + 0.5f;
    gu32* qbase = F.ctl + CW_ATTNQ + 64 * slot + 256 * qword;
    int cur = (int)blockIdx.x & 7, tried = 0;
    if (F.tid == 0) F.MISC[16] = __hip_atomic_fetch_add(qbase + cur, 1u, RLX_AGENT);
    __syncthreads();
    int n = (int)F.MISC[16];
    for (;;) {
        const int grp = cur >> 2, cnt = grp ? 11 * 64 : 5 * 64;
        if (n >= cnt) {
            if (++tried == 8) break;
            cur = (cur + 1) & 7;
            __syncthreads();
            if (F.tid == 0) F.MISC[16] = __hip_atomic_fetch_add(qbase + cur, 1u, RLX_AGENT);
            __syncthreads();
            n = (int)F.MISC[16];
            continue;
        }
        const unsigned long long hl = grp ? 0x012456789CEull : 0x3ABDFull;
        const int qb = 63 - (n & 63), h = (int)((hl >> (4 * (n >> 6))) & 15ull), b = cur & 3;
        const float slope = exp2f(-0.5f * (float)(h + 1));
        const float W = (twoB24 - __logf(1.0f - __expf(-slope))) / slope;
        int tb = (int)floorf(((float)(128 * qb) - W) * (1.0f / 64.0f)); tb = (tb < 0 ? 0 : tb);
        att::attn_unit(F.tid, b, h, qb, tb, QKV, OB, lam, 1.0f - lambda_init, slope * 1.4426950408889634f, m_ref, subg, (char*)(F.lds + RING_OFF), qbase + cur, F.MISC + 16);
        n = (int)F.MISC[16];
    }
}
__device__ __forceinline__ void conv_phase(Frame& F) {
    const bf16* U = (const bf16*)(F.ws + WS_BIG); bf16* OB = (bf16*)(F.ws + WS_OB); const float* cw = F.a->in[15];
    const int gt = F.vcu * (NWAVES * 64) + F.tid, NT = F.G * NWAVES * 64;
    for (int item = gt; item < 256 * (MT / 16); item += NT) {
        int dg = item & 255; asm volatile("" : "+v"(dg));
        const int run = item >> 8, row0 = run * 16, d = dg * 8;
        float w0[8], w1[8], w2[8];
#pragma unroll
        for (int i = 0; i < 8; ++i) { w0[i] = cw[d + i]; w1[i] = cw[DM + d + i]; w2[i] = cw[2 * DM + d + i]; }
        float vm2[8], vm1[8];
        if ((row0 % SEQ) == 0) {
#pragma unroll
            for (int i = 0; i < 8; ++i) { vm2[i] = 0.f; vm1[i] = 0.f; }
        } else {
            float a[8], b[8];
            unpack8(*(const GAS v4u*)(U + (size_t)(row0 - 2) * 6144 + 2048 + d), a); unpack8(*(const GAS v4u*)(U + (size_t)(row0 - 2) * 6144 + 4096 + d), b);
#pragma unroll
            for (int i = 0; i < 8; ++i) vm2[i] = a[i] * b[i];
            unpack8(*(const GAS v4u*)(U + (size_t)(row0 - 1) * 6144 + 2048 + d), a); unpack8(*(const GAS v4u*)(U + (size_t)(row0 - 1) * 6144 + 4096 + d), b);
#pragma unroll
            for (int i = 0; i < 8; ++i) vm1[i] = a[i] * b[i];
        }
#pragma unroll 4
        for (int t = 0; t < 16; ++t) {
            const bf16* rp = U + (size_t)(row0 + t) * 6144 + d;
            float bg[8], cg[8], uu[8], y[8];
            unpack8(*(const GAS v4u*)(rp), bg); unpack8(*(const GAS v4u*)(rp + 2048), cg); unpack8(*(const GAS v4u*)(rp + 4096), uu);
#pragma unroll
            for (int i = 0; i < 8; ++i) { const float v = cg[i] * uu[i]; y[i] = bg[i] * (w0[i] * vm2[i] + w1[i] * vm1[i] + w2[i] * v); vm2[i] = vm1[i]; vm1[i] = v; }
            v4u o; o.x = pk2(y[0], y[1]); o.y = pk2(y[2], y[3]); o.z = pk2(y[4], y[5]); o.w = pk2(y[6], y[7]);
            *(GAS v4u*)(OB + (size_t)(row0 + t) * DM + d) = o;
        }
    }
}
#define LDS_BAR() asm volatile("s_waitcnt lgkmcnt(0)\n\ts_barrier" ::: "memory")
typedef short s16x4 __attribute__((ext_vector_type(4)));
typedef float f32x16 __attribute__((ext_vector_type(16)));
__device__ __forceinline__ int crow16(int r, int hi) { return (r & 3) + 8 * (r >> 2) + 4 * hi; }
constexpr int H_P256 = 272, H_P128 = 144;
__device__ __forceinline__ void hgrn_prep_phase(Frame& F, int layer, bf16* QBO, int qbld, bf16* OBO) {
    bf16* BIG = (bf16*)(F.ws + WS_BIG); bf16* KLT = (bf16*)(F.ws + WS_KLT); bf16* ITG = (bf16*)(F.ws + WS_IT); float* EBL = (float*)(F.ws + WS_EBL); bf16* OB = (bf16*)(F.ws + WS_OB);
    const float* lbl = F.a->in[20];
    LAS unsigned char* QS = F.lds; LAS unsigned char* KS = F.lds + 64 * H_P256; LAS unsigned char* ITL = F.lds + 2 * 64 * H_P256; LAS float* TOT = (LAS float*)(F.lds + 2 * 64 * H_P256 + 128 * H_P128);
    const int kp = F.lane, seg = F.wave, r32 = F.lane & 31, hi = F.lane >> 5;
    unsigned qw[8], fw[8], iw[8]; f32x2_cv lgt[4];
#define H1_LOAD(un) do { const int bh_ = (un) >> 7, c_ = (un) & 127; const size_t rb_ = (size_t)(bh_ >> 4) * SEQ + (size_t)c_ * 64; \
        _Pragma("unroll") for (int L_ = 0; L_ < 4; ++L_) lgt[L_] = *(const GAS f32x2_cv*)(lbl + L_ * DM + (bh_ & 15) * 128 + 2 * kp); \
        _Pragma("unroll") for (int tt = 0; tt < 8; ++tt) { const bf16* pq = BIG + (rb_ + 8 * seg + tt) * 8192 + (bh_ & 15) * 128 + 2 * kp; \
            qw[tt] = *(const GAS unsigned*)pq; fw[tt] = *(const GAS unsigned*)(pq + 2048); iw[tt] = *(const GAS unsigned*)(pq + 4096); } } while (0)
    for (int unit = F.vcu; unit < NB * NH * (SEQ / 64); unit += F.G) {
        const int bh = unit >> 7, c = unit & 127, b = bh >> 4, h = bh & 15; const size_t rowbase = (size_t)b * SEQ + (size_t)c * 64;
        if (unit == F.vcu) H1_LOAD(unit);
        float lb[2];
#pragma unroll
        for (int kk = 0; kk < 2; ++kk) { const float l0 = lgt[0][kk], l1 = lgt[1][kk], l2 = lgt[2][kk], l3 = lgt[3][kk];
            const float mx = fmaxf(fmaxf(l0, l1), fmaxf(l2, l3)); const float e0 = __expf(l0 - mx), e1 = __expf(l1 - mx), e2 = __expf(l2 - mx), e3 = __expf(l3 - mx);
            float cumv = 0.f; if (layer >= 1) cumv += e1; if (layer >= 2) cumv += e2; if (layer >= 3) cumv += e3;
            lb[kk] = cumv * __builtin_amdgcn_rcpf(e0 + e1 + e2 + e3); }
        float bcs[8][2], kv[8][2]; float cum[2] = {0.f, 0.f};
#pragma unroll
        for (int tt = 0; tt < 8; ++tt)
#pragma unroll
            for (int kk = 0; kk < 2; ++kk) { const float x = kk ? bf_hi(fw[tt]) : bf_lo(fw[tt]); const float sig = __builtin_amdgcn_rcpf(1.0f + __expf(-x));
                const float f = lb[kk] + (1.0f - lb[kk]) * sig; cum[kk] += __builtin_amdgcn_logf(f) * 0.6931471805599453f;     bcs[tt][kk] = cum[kk]; kv[tt][kk] = 1.0f - f; }
        TOT[seg * 128 + 2 * kp] = cum[0]; TOT[seg * 128 + 2 * kp + 1] = cum[1];
        LDS_BAR();
        float off[2] = {0.f, 0.f}, rb[2] = {0.f, 0.f}, bl[2] = {0.f, 0.f};
#pragma unroll
        for (int s = 0; s < 8; ++s)
#pragma unroll
            for (int kk = 0; kk < 2; ++kk) { const float tv = TOT[s * 128 + 2 * kp + kk]; if (s < seg) off[kk] += tv; if (s < 4) rb[kk] += tv; bl[kk] += tv; }
        float erb[2], enrb[2], ebl[2];
#pragma unroll
        for (int kk = 0; kk < 2; ++kk) { erb[kk] = __expf(rb[kk]); enrb[kk] = __expf(-rb[kk]); ebl[kk] = __expf(bl[kk]); }
        unsigned klw[2][4], itw[2][4];
#pragma unroll
        for (int tt = 0; tt < 8; ++tt) { float qb_[2], qs_[2], ks_[2], kl_[2];
#pragma unroll
            for (int kk = 0; kk < 2; ++kk) { const float bb = bcs[tt][kk] + off[kk]; const float q = kk ? bf_hi(qw[tt]) : bf_lo(qw[tt]);
                const float eb = __expf(bb), enb = __builtin_amdgcn_rcpf(eb);
                qb_[kk] = q * eb; qs_[kk] = qb_[kk] * enrb[kk]; ks_[kk] = kv[tt][kk] * (erb[kk] * enb); kl_[kk] = kv[tt][kk] * (ebl[kk] * enb); }
            *(GAS unsigned*)(QBO + (rowbase + 8 * seg + tt) * qbld + h * 128 + 2 * kp) = pk2(qb_[0], qb_[1]);
            *(LAS unsigned*)(QS + (8 * seg + tt) * H_P256 + 4 * kp) = pk2(qs_[0], qs_[1]);
            *(LAS unsigned*)(KS + (8 * seg + tt) * H_P256 + 4 * kp) = pk2(ks_[0], ks_[1]);
            if (tt & 1) { klw[0][tt >> 1] |= f2bf(kl_[0]) << 16; klw[1][tt >> 1] |= f2bf(kl_[1]) << 16; itw[0][tt >> 1] |= (iw[tt] & 0xffffu) << 16; itw[1][tt >> 1] |= (iw[tt] >> 16) << 16; }
            else { klw[0][tt >> 1] = f2bf(kl_[0]); klw[1][tt >> 1] = f2bf(kl_[1]); itw[0][tt >> 1] = iw[tt] & 0xffffu; itw[1][tt >> 1] = iw[tt] >> 16; }
        }
#pragma unroll
        for (int kk = 0; kk < 2; ++kk) { const v4u kw = {klw[kk][0], klw[kk][1], klw[kk][2], klw[kk][3]}, tw = {itw[kk][0], itw[kk][1], itw[kk][2], itw[kk][3]};
            *(GAS v4u*)(KLT + (size_t)unit * 8192 + (2 * kp + kk) * 64 + 8 * seg) = kw;
            *(GAS v4u*)(ITG + (size_t)unit * 8192 + (2 * kp + kk) * 64 + 8 * seg) = tw;
            *(LAS v4u*)(ITL + (2 * kp + kk) * H_P128 + 16 * seg) = tw; }
        if (seg == 0) { EBL[(size_t)unit * 128 + 2 * kp] = ebl[0]; EBL[(size_t)unit * 128 + 2 * kp + 1] = ebl[1]; }
        LDS_BAR();
        if (unit + F.G < NB * NH * (SEQ / 64)) H1_LOAD(unit + F.G);
        const int tt_ = F.wave & 1, vt = F.wave >> 1;
        f32x16 z = {};
        for (int st = 0; st <= tt_; ++st) {
            f32x16 x = {};
            bf16x8 af[8], bqf[8];
#pragma unroll
            for (int step = 0; step < 8; ++step) { af[step] = *(const LAS bf16x8*)(KS + (32 * st + r32) * H_P256 + (16 * step + 8 * hi) * 2);
                bqf[step] = *(const LAS bf16x8*)(QS + (32 * tt_ + r32) * H_P256 + (16 * step + 8 * hi) * 2); }
#pragma unroll
            for (int step = 0; step < 8; ++step) x = __builtin_amdgcn_mfma_f32_32x32x16_bf16(af[step], bqf[step], x, 0, 0, 0);
            if (st == tt_) {
#pragma unroll
                for (int r = 0; r < 16; ++r) if (crow16(r, hi) > r32) x[r] = 0.f;
            }
#pragma unroll
            for (int sp = 0; sp < 2; ++sp) {
                v4u pw; pw.x = pk2(x[8 * sp + 0], x[8 * sp + 1]); pw.y = pk2(x[8 * sp + 2], x[8 * sp + 3]); pw.z = pk2(x[8 * sp + 4], x[8 * sp + 5]); pw.w = pk2(x[8 * sp + 6], x[8 * sp + 7]);
                const bf16x8 xs = __builtin_bit_cast(bf16x8, pw);
                const LAS unsigned char* ip = ITL + (32 * vt + r32) * H_P128 + (32 * st + 16 * sp + 4 * hi) * 2;
                const s16x4 lo = *(const LAS s16x4*)ip, hh = *(const LAS s16x4*)(ip + 16);
                const bf16x8 pb = __builtin_shufflevector(lo, hh, 0, 1, 2, 3, 4, 5, 6, 7);
                z = __builtin_amdgcn_mfma_f32_32x32x16_bf16(xs, pb, z, 0, 0, 0);
            }
        }
        bf16* op = OBO + (rowbase + 32 * tt_) * DM + h * 128 + 32 * vt + r32;
#pragma unroll
        for (int r = 0; r < 16; ++r) op[(size_t)crow16(r, hi) * DM] = (bf16)f2bf(z[r]);
        LDS_BAR();
    }
}
#undef H1_LOAD
__device__ __forceinline__ void hgrn_scan_phase(Frame& F, bf16* OBO) {
    const bf16* BIG = (const bf16*)(F.ws + WS_BIG); const bf16* KLT = (const bf16*)(F.ws + WS_KLT); const bf16* ITG = (const bf16*)(F.ws + WS_IT); const float* EBL = (const float*)(F.ws + WS_EBL); const bf16* OB = (const bf16*)(F.ws + WS_OB);
    constexpr int TB = 64 * H_P256 + 128 * H_P128 + 32 * H_P128 + 512;
    constexpr int STB = 32 * H_P256;
    constexpr int IOB = 64 * 64;
    LAS unsigned char* TL = F.lds; LAS unsigned char* STL = F.lds + 2 * TB; LAS unsigned char* ISL = STL + 2 * STB; LAS unsigned char* OSL = ISL + 2 * IOB;
    const int tid = F.tid, r32 = F.lane & 31, hi = F.lane >> 5, w = F.wave;
    for (int unit = F.vcu; unit < NB * NH * 4; unit += F.G) {
        const int bh = unit >> 2, vq = unit & 3, b = bh >> 4, h = bh & 15;
        f32x16 acc = {};
        v4u q0[2], k0[2], i0, e0, q1[2], k1[2], i1, e1, ivr[2];
        i0 = i1 = e0 = e1 = ivr[0] = ivr[1] = (v4u){(unsigned)tid >> 31, 0u, 0u, 0u};
        const int ioq = (F.lane + 64 * (w & 1));
#define H2_LOAD(Q, K, I, E, c) do { const size_t rb_ = (size_t)b * SEQ + (size_t)(c) * 64; const size_t un_ = (size_t)bh * 128 + (c); \
        _Pragma("unroll") for (int i_ = 0; i_ < 2; ++i_) { const int p_ = tid + 512 * i_; \
            Q[i_] = *(const GAS v4u*)(BIG + (rb_ + (p_ >> 4)) * 8192 + h * 128 + (p_ & 15) * 8); K[i_] = *(const GAS v4u*)(KLT + un_ * 8192 + (size_t)p_ * 8); } \
        if (tid < 256) I = *(const GAS v4u*)(ITG + un_ * 8192 + (size_t)(32 * vq) * 64 + (size_t)tid * 8); \
        if (tid < 32) E = *(const GAS v4u*)(EBL + un_ * 128 + 4 * tid); } while (0)
#define H2_WRITE(Q, K, I, E, bufo) do { LAS unsigned char* tb_ = TL + (bufo); _Pragma("unroll") for (int i_ = 0; i_ < 2; ++i_) { const int p_ = tid + 512 * i_; \
            *(LAS v4u*)(tb_ + (p_ >> 4) * H_P256 + (p_ & 15) * 16) = Q[i_]; *(LAS v4u*)(tb_ + 64 * H_P256 + (p_ >> 3) * H_P128 + (p_ & 7) * 16) = K[i_]; } \
        if (tid < 256) *(LAS v4u*)(tb_ + 64 * H_P256 + 128 * H_P128 + (tid >> 3) * H_P128 + (tid & 7) * 16) = I; \
        if (tid < 32) *(LAS v4u*)(tb_ + 64 * H_P256 + 128 * H_P128 + 32 * H_P128 + 16 * tid) = E; } while (0)
#define H2_IVLD(c) do { _Pragma("unroll") for (int j_ = 0; j_ < 2; ++j_) { const int q_ = ioq + 128 * j_; \
            ivr[j_] = *(const GAS v4u*)(OB + ((size_t)b * SEQ + (size_t)(c) * 64 + (q_ >> 2)) * DM + h * 128 + 32 * vq + (q_ & 3) * 8); } } while (0)
#define H2_IVST(slot) do { _Pragma("unroll") for (int j_ = 0; j_ < 2; ++j_) { const int q_ = ioq + 128 * j_; *(LAS v4u*)(ISL + (slot) * IOB + (q_ >> 2) * 64 + (q_ & 3) * 16) = ivr[j_]; } } while (0)
#define H2_OST(c, slot) do { _Pragma("unroll") for (int j_ = 0; j_ < 2; ++j_) { const int q_ = ioq + 128 * j_; const v4u v_ = *(const LAS v4u*)(OSL + (slot) * IOB + (q_ >> 2) * 64 + (q_ & 3) * 16); \
            *(GAS v4u*)(OBO + ((size_t)b * SEQ + (size_t)(c) * 64 + (q_ >> 2)) * DM + h * 128 + 32 * vq + (q_ & 3) * 8) = v_; } } while (0)
#define H2_STEP(c, cur, Qn, Kn, In, En) do { LAS unsigned char* tb_ = TL + (cur) * TB; LAS unsigned char* st_ = STL + (cur) * STB; \
          \
          \
        if (w >= 6 && (c) + 1 < SEQ / 64) H2_IVST((cur) ^ 1);      \
        if ((c) + 1 < SEQ / 64) H2_WRITE(Qn, Kn, In, En, ((cur) ^ 1) * TB); \
        if (w >= 6) { if ((c) + 2 < SEQ / 64) H2_IVLD((c) + 2); \
            if ((c) >= 1) H2_OST((c) - 1, (cur) ^ 1); }             \
        if ((c) + 3 < SEQ / 64) H2_LOAD(Qn, Kn, In, En, (c) + 3); \
        if (w < 4) { const LAS float* eb_ = (const LAS float*)(tb_ + 64 * H_P256 + 128 * H_P128 + 32 * H_P128); \
            _Pragma("unroll") for (int r = 0; r < 16; ++r) acc[r] *= eb_[32 * w + crow16(r, hi)]; \
            _Pragma("unroll") for (int step = 0; step < 4; ++step) { const bf16x8 a_ = *(const LAS bf16x8*)(tb_ + 64 * H_P256 + (32 * w + r32) * H_P128 + (16 * step + 8 * hi) * 2); \
                const bf16x8 b_ = *(const LAS bf16x8*)(tb_ + 64 * H_P256 + 128 * H_P128 + r32 * H_P128 + (16 * step + 8 * hi) * 2); acc = __builtin_amdgcn_mfma_f32_32x32x16_bf16(a_, b_, acc, 0, 0, 0); } \
            LAS unsigned char* sn_ = STL + ((cur) ^ 1) * STB + r32 * H_P256 + (32 * w + 4 * hi) * 2; \
            _Pragma("unroll") for (int g = 0; g < 4; ++g) *(LAS unsigned long long*)(sn_ + 16 * g) = (unsigned long long)pk2(acc[4 * g], acc[4 * g + 1]) | ((unsigned long long)pk2(acc[4 * g + 2], acc[4 * g + 3]) << 32); \
        } else if (w < 6) { f32x16 o_ = {}; \
            _Pragma("unroll") for (int step = 0; step < 8; ++step) { const bf16x8 a_ = *(const LAS bf16x8*)(tb_ + (32 * (w - 4) + r32) * H_P256 + (16 * step + 8 * hi) * 2); \
                const bf16x8 b_ = *(const LAS bf16x8*)(st_ + r32 * H_P256 + (16 * step + 8 * hi) * 2); o_ = __builtin_amdgcn_mfma_f32_32x32x16_bf16(a_, b_, o_, 0, 0, 0); } \
            const int so_ = (32 * (w - 4) + 4 * hi) * 64 + r32 * 2; bf16 iv_[16]; \
            _Pragma("unroll") for (int r = 0; r < 16; ++r) iv_[r] = *(const LAS bf16*)(ISL + (cur) * IOB + so_ + ((r & 3) + 8 * (r >> 2)) * 64);     \
            _Pragma("unroll") for (int r = 0; r < 16; ++r) *(LAS bf16*)(OSL + (cur) * IOB + so_ + ((r & 3) + 8 * (r >> 2)) * 64) = (bf16)f2bf(o_[r] + bf_f(iv_[r])); } \
        LDS_BAR(); } while (0)
        { const unsigned zz = (unsigned)tid >> 31;
          for (int i = tid; i < STB / 16; i += NWAVES * 64) *(LAS v4u*)(STL + 16 * i) = (v4u){zz, zz, zz, zz}; }
        H2_LOAD(q0, k0, i0, e0, 0); H2_WRITE(q0, k0, i0, e0, 0);
        H2_LOAD(q1, k1, i1, e1, 1); H2_LOAD(q0, k0, i0, e0, 2);
        if (w >= 6) { H2_IVLD(0); H2_IVST(0); H2_IVLD(1); }
        LDS_BAR();
#pragma unroll 1
        for (int c = 0; c < SEQ / 64; c += 2) {
            H2_STEP(c, 0, q1, k1, i1, e1);
            H2_STEP(c + 1, 1, q0, k0, i0, e0);
        }
        if (w >= 6) H2_OST(SEQ / 64 - 1, 1);
        LDS_BAR();
#undef H2_LOAD
#undef H2_WRITE
#undef H2_IVLD
#undef H2_IVST
#undef H2_OST
#undef H2_STEP
    }
}
__device__ __forceinline__ void hgrn_final_phase(Frame& F, bf16* OBO) {
    const bf16* BIG = (const bf16*)(F.ws + WS_BIG); bf16* OB = (bf16*)(F.ws + WS_OB); const float* gn = F.a->in[19];
    const int gw = F.vcu * NWAVES + F.wave, NGW = F.G * NWAVES;
    const int dv = (F.lane & 15) * 8;
    const f32x4 g0 = *(const f32x4*)(gn + dv), g1 = *(const f32x4*)(gn + dv + 4);
    for (int row = gw; row < MT; row += NGW) {
        GAS v4u* po = (GAS v4u*)(OB + (size_t)row * DM) + F.lane; const GAS v4u* pg = (const GAS v4u*)(BIG + (size_t)row * 8192 + 6144) + F.lane;
        v4u wo[4], wg[4];
#pragma unroll
        for (int it = 0; it < 4; ++it) { wo[it] = po[64 * it]; wg[it] = pg[64 * it]; }
#pragma unroll
        for (int it = 0; it < 4; ++it) { float x[8], gg[8]; unpack8(wo[it], x); unpack8(wg[it], gg);
            float ss = 0.f;
#pragma unroll
            for (int i = 0; i < 8; ++i) ss += x[i] * x[i];
            ss += sx<1>(ss); ss += sx<2>(ss); ss += sx<4>(ss); ss += sx<8>(ss);
            const float rstd = rsqrtf(ss * (1.0f / 128.0f) + RMS_EPS);
            float y[8];
#pragma unroll
            for (int i = 0; i < 8; ++i) { const float gi = (i < 4) ? g0[i] : g1[i - 4]; y[i] = x[i] * rstd * gi * (gg[i] * __builtin_amdgcn_rcpf(1.0f + __expf(-gg[i]))); }
            v4u o; o.x = pk2(y[0], y[1]); o.y = pk2(y[2], y[3]); o.z = pk2(y[4], y[5]); o.w = pk2(y[6], y[7]);
            ((GAS v4u*)(OBO + (size_t)row * DM) + F.lane)[64 * it] = o; }
    }
}
__device__ __forceinline__ bool ph_refresh(Frame& F) { unsigned m = ~0u; asm volatile("" : "+s"(m));
    const int t = (F.wave << 6) | (int)__builtin_amdgcn_mbcnt_hi(m, __builtin_amdgcn_mbcnt_lo(m, 0u));
    F.tid = t; F.lane = t & 63; return true; }
__global__ void __launch_bounds__(NWAVES * 64, 2) trunk_fwd(Args args) {
    extern __shared__ __attribute__((aligned(16))) unsigned char lds[];
    Frame F;
    F.lds = (LAS unsigned char*)lds;
    F.MISC = (volatile LAS unsigned*)(F.lds + MISC_OFF);
    F.tid = threadIdx.x; F.lane = F.tid & 63; F.wave = __builtin_amdgcn_readfirstlane(F.tid >> 6);
    F.G = gridDim.x; { const int bx = blockIdx.x; F.vcu = (F.G % 8 == 0) ? (bx % 8) * (F.G / 8) + bx / 8 : bx; }
    F.ws = args.ws; F.ctl = (gu32*)(args.ws + WS_CTL); F.out = args.out;
    F.a = &args;
    for (int u = F.tid; u < (LDS_BYTES - LDSCTL_OFF) / 4; u += NWAVES * 64) ((LAS unsigned*)(F.lds + LDSCTL_OFF))[u] = 0u;
    __syncthreads();
    XcdBarrier bar; bar.bar = (unsigned*)(F.ctl + CW_BAR); bar.x = 0; bar.st = nullptr;
    if (!MK_PER_PHASE) bar = xcd_barrier_post((unsigned*)(F.ctl + CW_BAR), F.MISC + 8);
    const int lo = args.ph_lo, hi = args.ph_hi;
    int pc = 0;
    unsigned long long t_ph = PROBE_ECHO ? __builtin_amdgcn_s_memrealtime() : 0ull;
#define PH_ON (pc >= lo && pc < hi && ph_refresh(F))
#define PH_END_C(cls) do { if (!MK_PER_PHASE && pc >= lo && pc + 1 < hi) { const unsigned long long ta_ = (PROBE_IDLE && (PROBE_IDLE == 100 || PROBE_IDLE == (cls))) ? __builtin_amdgcn_s_memrealtime() : 0ull; xcd_barrier(bar); if (PROBE_MASK & 32) xcd_barrier(bar); \
        if (PROBE_IDLE && (PROBE_IDLE == 100 || PROBE_IDLE == (cls))) { const unsigned long long t1_ = __builtin_amdgcn_s_memrealtime(), d_ = t1_ - ta_; while (__builtin_amdgcn_s_memrealtime() - t1_ < d_) __builtin_amdgcn_s_sleep(8); xcd_barrier(bar); } \
        if (PROBE_ECHO == (cls)) { const unsigned long long t1_ = __builtin_amdgcn_s_memrealtime(), d_ = t1_ - t_ph; while (__builtin_amdgcn_s_memrealtime() - t1_ < d_) __builtin_amdgcn_s_sleep(8); xcd_barrier(bar); } \
        if (PROBE_ECHO) t_ph = __builtin_amdgcn_s_memrealtime(); } ++pc; } while (0)
#define PH_END PH_END_C(0)
    float* mod = (float*)(F.ws + WS_MOD);
    bf16* XN = (bf16*)(F.ws + WS_XN); bf16* BIG = (bf16*)(F.ws + WS_BIG); bf16* OB = (bf16*)(F.ws + WS_OB);
    float* RSS = (float*)(F.ws + WS_RSS); const float* CB = (const float*)(F.ws + WS_CB);
    if (PH_ON) { p0_mod(F); __syncthreads(); p0_convert(F); }
#if PROBE_MASK & 16
    if (PH_ON) { __syncthreads(); p0_mod(F); __syncthreads(); p0_convert(F); }
#endif
    PH_END_C(1);
    if (PH_ON) { tables_phase(F); bias_phase(F); xs0_phase(F, F.a->in[0], F.a->in[4], mod); }
#if PROBE_MASK & 16384
    if (PH_ON) { tables_phase(F); bias_phase(F); xs0_phase(F, F.a->in[0], F.a->in[4], mod); }
#endif
    PH_END_C(2);
#pragma unroll 1
    for (int L = 0; L < NLAYER; ++L) {
        const int kind = L % 3, slot = L / 3;
        const float* modL = mod + (size_t)L * NB * NMOD;
#pragma unroll 1
        for (int sub = 0; sub < 3; ++sub) {
            const int s = 3 * L + sub;
            const float* rss = RSS + (size_t)s * MT; const float* cb = CB + (size_t)s * NB * CB_LD;
            const bf16* outA; const bf16* outB; int outK;
            const int nhalf = (sub != 1) ? FFN_SPLIT : 1;
#pragma unroll 1
            for (int hf = 0; hf < nhalf; ++hf) {
            const int Mpart = MT / nhalf, pm_off = hf * (Mpart / 256);
            if (sub != 1) {
                const int ls = L * 2 + (sub >> 1);
                if (PH_ON) { pg8::Gemm g{XN, (const bf16*)(F.ws + WS_WGU) + (size_t)ls * 2 * FF * DM, Mpart, 2 * FF, DM, 1, 1}; pg8::StaticOrder S; S.init(Mpart, 2 * FF, F.G, (int)blockIdx.x, GU_WGM, pm_off);
                    pg8::EpiSwigluN E{BIG, FF, rss, cb, CB_LD, SEQ, F.lds + PRE_OFF};
#pragma unroll 1
                    for (int rep = 0; rep < ((PROBE_MASK & 1) ? 2 : 1); ++rep) { if (rep) __syncthreads(); pg8::gemm_phase<pg8::EpiSwigluN, pg8::StaticOrder, true, true>(F.lds + RING_OFF, g, S, E, F.tid); }
                    }
                PH_END_C(3);
                outA = BIG; outB = (const bf16*)(F.ws + WS_WD) + (size_t)ls * DM * FF; outK = FF;
            } else {
                const int nin = (kind == 2) ? 4 * DM : 3 * DM;
                const bf16* win = (kind == 0) ? (const bf16*)(F.ws + WS_WAI) + (size_t)slot * 3 * DM * DM : (kind == 1) ? (const bf16*)(F.ws + WS_WCI) : (const bf16*)(F.ws + WS_WHI);
                if (PH_ON) { pg8::Gemm g{XN, win, MT, nin, DM, 1, 1}; pg8::StaticOrder S; S.init(MT, nin, F.G, (int)blockIdx.x, GU_WGM);
                    pg8::EpiInN E{BIG, nin, rss, cb, CB_LD, SEQ, (kind == 0) ? 16 : 0, F.a->in[10] + (size_t)slot * 64, F.a->in[11] + (size_t)slot * 64, F.lds + PRE_OFF};
#pragma unroll 1
                    for (int rep = 0; rep < ((PROBE_MASK & 4) ? 2 : 1); ++rep) { if (rep) __syncthreads(); pg8::gemm_phase<pg8::EpiInN, pg8::StaticOrder, true, true>(F.lds + RING_OFF, g, S, E, F.tid); }
                    }
                PH_END_C(5);
                if (kind == 0) {
#if PROBE_MASK & 8192
                    if (PH_ON) { attn_phase(F, L, slot, 1); __syncthreads(); }
#endif
                    if (PH_ON) attn_phase(F, L, slot);
                    PH_END_C(7);
                } else if (kind == 1) {
                    if (PH_ON) conv_phase(F);
                    PH_END_C(8);
                } else {
#if PROBE_MASK & 64
                    if (PH_ON) { hgrn_prep_phase(F, L, XN, DM, XN); __syncthreads(); }
#endif
                    if (PH_ON) hgrn_prep_phase(F, L, BIG, 8192, OB);
                    PH_END_C(9);
#if PROBE_MASK & 128
                    if (PH_ON) { hgrn_scan_phase(F, XN); __syncthreads(); }
#endif
                    if (PH_ON) hgrn_scan_phase(F, OB);
                    PH_END_C(10);
                    if (PH_ON) hgrn_final_phase(F, OB);
                    PH_END_C(11);
                }
                outA = OB; outB = (kind == 0) ? (const bf16*)(F.ws + WS_WAO) + (size_t)slot * DM * DM : (kind == 1) ? (const bf16*)(F.ws + WS_WCO) : (const bf16*)(F.ws + WS_WHO); outK = DM;
            }
            if (PH_ON) { pg8::Gemm g{outA, outB, Mpart, DM, outK, (sub != 1) ? 1 : 0, 1};     pg8::StaticOrder S; S.init(Mpart, DM, F.G, (int)blockIdx.x, OUT_WGM, pm_off);
                const int sn = s + 1; const bool last = (s == 3 * NLAYER - 1);
                const float* TAB = (const float*)(F.ws + WS_TAB);
                pg8::EpiResN E{(s == 0) ? (const void*)F.a->in[0] : (const void*)(F.ws + WS_XH), last ? (void*)F.out : (void*)(F.ws + WS_XH), (s == 0) ? 1 : 0, last ? 1 : 0, DM, TAB + (size_t)(s * 2 + 0) * NB * DM, TAB + (size_t)(s * 2 + 1) * NB * DM, DM, SEQ, last ? (bf16*)nullptr : XN, RSS + (size_t)sn * MT, F.lds + PRE_OFF, 1.0f};
#pragma unroll 1
                for (int rep = (((PROBE_MASK & 2) || ((PROBE_MASK & 2048) && sub != 1) || ((PROBE_MASK & 4096) && sub == 1)) ? 0 : 1); rep < 2; ++rep) {
                    pg8::EpiResN E2 = E;
#if PROBE_MASK & (2 | 2048 | 4096)
                    { const bool dbl = (PROBE_MASK & 2) || ((PROBE_MASK & 2048) && sub != 1) || ((PROBE_MASK & 4096) && sub == 1);
                      if (dbl) { E2.gscale = 0.5f; if (rep == 0) { E2.rssn = RSS + (size_t)12 * MT; if (last) { E2.out = (void*)(F.ws + WS_XH); E2.out_f32 = 0; } } else if (s == 0) { E2.base = (const void*)(F.ws + WS_XH); E2.base_f32 = 0; } } }
#endif
                    if (rep == 0) __syncthreads();
                    pg8::gemm_phase<pg8::EpiResN, pg8::StaticOrder, true, true, OUT_A_AUX>(F.lds + RING_OFF, g, S, E2, F.tid); if (rep == 0) __syncthreads(); } }
            PH_END_C((sub != 1) ? 4 : 6);
            }
        }
    }
#undef PH_ON
#undef PH_END
#undef PH_END_C
}
extern "C" void kernel_launch(void* const* d_in, const int* in_sizes, int n_in, void* d_out, int out_size, void* d_ws, size_t ws_size, hipStream_t stream) {
    static int grid = 0;
    if (grid == 0) {
        if (n_in != 21 || in_sizes[0] != MT * DM || out_size != MT * DM || ws_size < WS_END) { fprintf(stderr, "kernel_launch: shape/workspace mismatch (n_in %d, in0 %d, out %d, ws %zu, need %zu); nothing launched\n", n_in, n_in > 0 ? in_sizes[0] : -1, out_size, ws_size, (size_t)WS_END); grid = -1; return; }
        int dev = 0, cus = 0, per_cu = 0;
        if (hipGetDevice(&dev) != hipSuccess || hipDeviceGetAttribute(&cus, hipDeviceAttributeMultiprocessorCount, dev) != hipSuccess) { fprintf(stderr, "kernel_launch: device query failed\n"); grid = -1; return; }
        if (hipFuncSetAttribute((const void*)trunk_fwd, hipFuncAttributeMaxDynamicSharedMemorySize, LDS_BYTES) != hipSuccess) { fprintf(stderr, "kernel_launch: hipFuncSetAttribute failed\n"); grid = -1; return; }
        if (hipOccupancyMaxActiveBlocksPerMultiprocessor(&per_cu, (const void*)trunk_fwd, NWAVES * 64, LDS_BYTES) != hipSuccess || per_cu < 1) fprintf(stderr, "kernel_launch: note: occupancy query reports %d workgroups per CU\n", per_cu);
        (void)hipGetLastError();
        grid = cus;
    }
    if (grid < 0) return;
    if (hipMemsetAsync((char*)d_ws + WS_CTL, 0, CTL_ZERO_BYTES, stream) != hipSuccess) { fprintf(stderr, "kernel_launch: memset failed\n"); return; }
    Args a{};
    for (int i = 0; i < 21; ++i) a.in[i] = (const float*)d_in[i];
    a.out = (float*)d_out; a.ws = (unsigned char*)d_ws;
#if MK_PER_PHASE
    for (int p = 0; p < N_PHASES; ++p) { a.ph_lo = p; a.ph_hi = p + 1; hipLaunchKernelGGL(trunk_fwd, dim3(grid), dim3(NWAVES * 64), LDS_BYTES, stream, a); }
#else
    a.ph_lo = 0; a.ph_hi = N_PHASES;
    hipLaunchKernelGGL(trunk_fwd, dim3(grid), dim3(NWAVES * 64), LDS_BYTES, stream, a);
#endif
    const hipError_t le = hipPeekAtLastError();
    if (le != hipSuccess) fprintf(stderr, "kernel_launch: launch failed: %s\n", hipGetErrorName(le));
}
```

```cpp
#include <hip/hip_runtime.h>
#include <cstdio>
#include <cstdint>
template <int X> __device__ __forceinline__ float sx(float v) { return __int_as_float(__builtin_amdgcn_ds_swizzle(__float_as_int(v), (X << 10) | 0x1f)); }
__device__ __forceinline__ float sum32(float v) { auto rr = __builtin_amdgcn_permlane32_swap(__float_as_uint(v), __float_as_uint(v), false, false); return __uint_as_float(rr[0]) + __uint_as_float(rr[1]); }
__device__ __forceinline__ float max32(float v) { auto rr = __builtin_amdgcn_permlane32_swap(__float_as_uint(v), __float_as_uint(v), false, false); return fmaxf(__uint_as_float(rr[0]), __uint_as_float(rr[1])); }
__device__ __forceinline__ float wave_sum(float v) { v += sx<1>(v); v += sx<2>(v); v += sx<4>(v); v += sx<8>(v); v += sx<16>(v); return sum32(v); }
__device__ __forceinline__ float wave_max(float v) { v = fmaxf(v, sx<1>(v)); v = fmaxf(v, sx<2>(v)); v = fmaxf(v, sx<4>(v)); v = fmaxf(v, sx<8>(v)); v = fmaxf(v, sx<16>(v)); return max32(v); }
typedef float f32x2_cv __attribute__((ext_vector_type(2))); typedef __bf16 bf16x2_cv __attribute__((ext_vector_type(2)));
__device__ __forceinline__ unsigned pk2(float lo, float hi) { const f32x2_cv v = {lo, hi}; const bf16x2_cv b = __builtin_convertvector(v, bf16x2_cv); return __builtin_bit_cast(unsigned, b); }
__device__ __forceinline__ unsigned f2bf(float f) { return pk2(f, 0.f) & 0xffffu; }
namespace pg8 {
#define PG8_LAS __attribute__((address_space(3)))
typedef unsigned short bf16_t;
typedef short bf16x8 __attribute__((ext_vector_type(8)));
typedef float f32x4 __attribute__((ext_vector_type(4)));
typedef unsigned u32x4 __attribute__((ext_vector_type(4)));
constexpr int BM = 256, BK = 64, HALF = 128, HTB = HALF * BK * 2  , STAGE_BYTES = 8 * HTB, NXCD = 8, WGM = 8;

__host__ __device__ __forceinline__ int lds_byte(int r, int c) { const int st = (r >> 4) * 2 + (c >> 5), rr = r & 15, cc = c & 31, ob = rr * 64 + cc * 2; return st * 1024 + (ob ^ (((ob >> 9) & 1) << 5)); }
__host__ __device__ __forceinline__ void stage_rc(int b, int& R, int& C) { const int st = b / 1024, sb = b % 1024, swz = sb ^ (((sb >> 9) & 1) << 5); R = (st >> 1) * 16 + swz / 64; C = (st & 1) * 32 + (swz % 64) / 2; }
__host__ __device__ __forceinline__ int perm32(int rho) { const int n = rho >> 4, i = rho & 15; return 8 * (i >> 2) + 4 * n + (i & 3); }

struct Unit { int pm, pn; };
struct Gemm { const bf16_t* A; const bf16_t* Bt; int M, N, K; int a_tiled = 0, b_tiled = 0; };

struct StaticOrder {
    int nM, nN, nwg, G, c, wgm, pm_off;
    __host__ __device__ void init(int M, int N, int G_, int c_, int wgm_ = WGM, int pm_off_ = 0) { nM = M / BM; nN = N / BM; nwg = nM * nN; G = G_; c = c_; wgm = wgm_; pm_off = pm_off_; }
    __host__ __device__ bool next(int i, Unit& u) const {
        const long L = (long)i * G + c; if (L >= nwg) return false;
        int wgid = (int)L; { const int q = nwg / NXCD, r = nwg % NXCD, xcd = wgid % NXCD, off = wgid / NXCD; wgid = (xcd < r ? xcd * (q + 1) : r * (q + 1) + (xcd - r) * q) + off; }
        const int nig = wgm * nN, gid = wgid / nig, fm = gid * wgm, gsz = (nM - fm) < wgm ? (nM - fm) : wgm;
        u.pm = pm_off + fm + ((wgid % nig) % gsz); u.pn = (wgid % nig) / gsz; return true;
    }
    __device__ __forceinline__ void a_ready(const Unit&) const {}
    __device__ __forceinline__ void done(const Unit&) const {}
};

__device__ __forceinline__ unsigned cvt_pk_bf16(float lo, float hi) { unsigned r; asm volatile("v_cvt_pk_bf16_f32 %0, %1, %2" : "=v"(r) : "v"(lo), "v"(hi)); return r; }
typedef float f32x2 __attribute__((ext_vector_type(2)));
typedef unsigned u32x2 __attribute__((ext_vector_type(2)));
struct EpiStore {
    static constexpr bool HAS_PRE = false;
    static constexpr bool PERM = true, AFTER_DRAIN = false;
    bf16_t* O; int ldc;
    __device__ __forceinline__ void operator()(const f32x4 (&acc)[2][2][4][2], const Unit& u, int wr, int wc, int fr, int fq) const {
        const int row0 = u.pm * BM + wr * 64 + fr, col0 = u.pn * BM + wc * 32 + 8 * fq;
#pragma unroll
        for (int ai = 0; ai < 2; ++ai)
#pragma unroll
            for (int m = 0; m < 4; ++m) { bf16_t* rowp = O + (size_t)(row0 + ai * HALF + m * 16) * ldc + col0;
#pragma unroll
                for (int bj = 0; bj < 2; ++bj) { const f32x4 v0 = acc[ai][bj][m][0], v1 = acc[ai][bj][m][1];
                    u32x4 w; w.x = cvt_pk_bf16(v0[0], v0[1]); w.y = cvt_pk_bf16(v0[2], v0[3]); w.z = cvt_pk_bf16(v1[0], v1[1]); w.w = cvt_pk_bf16(v1[2], v1[3]);
                    *(u32x4*)(rowp + bj * HALF) = w; } }
    }
};
__device__ __forceinline__ float swiglu1(float g, float u) { const float e = __builtin_amdgcn_exp2f(g * -1.4426950408889634f); return g * u * __builtin_amdgcn_rcpf(1.0f + e); }
struct EpiSwiglu {
    static constexpr bool HAS_PRE = false;
    static constexpr bool PERM = true, AFTER_DRAIN = false;
    bf16_t* O; int ldc;
    __device__ __forceinline__ void operator()(const f32x4 (&acc)[2][2][4][2], const Unit& u, int wr, int wc, int fr, int fq) const {
        const int row0 = u.pm * BM + wr * 64 + fr, col0 = u.pn * HALF + wc * 32 + 8 * fq;
#pragma unroll
        for (int ai = 0; ai < 2; ++ai)
#pragma unroll
            for (int m = 0; m < 4; ++m) { bf16_t* rowp = O + (size_t)(row0 + ai * HALF + m * 16) * ldc + col0;
                const f32x4 g0 = acc[ai][0][m][0], g1 = acc[ai][0][m][1], u0 = acc[ai][1][m][0], u1 = acc[ai][1][m][1];
                u32x4 w;
                w.x = cvt_pk_bf16(swiglu1(g0[0], u0[0]), swiglu1(g0[1], u0[1])); w.y = cvt_pk_bf16(swiglu1(g0[2], u0[2]), swiglu1(g0[3], u0[3]));
                w.z = cvt_pk_bf16(swiglu1(g1[0], u1[0]), swiglu1(g1[1], u1[1])); w.w = cvt_pk_bf16(swiglu1(g1[2], u1[2]), swiglu1(g1[3], u1[3]));
                *(u32x4*)rowp = w; }
    }
};
struct EpiRes {
    static constexpr bool HAS_PRE = false;
    static constexpr bool PERM = false, AFTER_DRAIN = false;
    const float* base; float* out; int ldc; const float* gate; int gstride; float coef; int rows_per_batch;
    __device__ __forceinline__ void operator()(const f32x4 (&acc)[2][2][4][2], const Unit& u, int wr, int wc, int fr, int fq) const {
        const int row0 = u.pm * BM + wr * 64 + fr, col0 = u.pn * BM + wc * 32 + 4 * fq;
        const float* gp = gate + (size_t)((u.pm * BM) / rows_per_batch) * gstride + col0;
        f32x4 gv[2][2];
#pragma unroll
        for (int bj = 0; bj < 2; ++bj)
#pragma unroll
            for (int n = 0; n < 2; ++n) gv[bj][n] = *(const f32x4*)(gp + bj * HALF + n * 16) * coef;
#pragma unroll
        for (int ai = 0; ai < 2; ++ai)
#pragma unroll
            for (int m = 0; m < 4; ++m) { const size_t off = (size_t)(row0 + ai * HALF + m * 16) * ldc + col0;
#pragma unroll
                for (int bj = 0; bj < 2; ++bj)
#pragma unroll
                    for (int n = 0; n < 2; ++n) { const f32x4 bs = *(const f32x4*)(base + off + bj * HALF + n * 16); *(f32x4*)(out + off + bj * HALF + n * 16) = bs + gv[bj][n] * acc[ai][bj][m][n]; }
                if (m & 1) asm volatile("" ::: "memory"); }
    }
};
__device__ __forceinline__ float rstd_of(const float* rss, int row) { return rsqrtf(rss[row] * (1.0f / 2048.0f) + 1e-6f); }
struct EpiSwigluN {
    static constexpr bool HAS_PRE = true;
    static constexpr bool PERM = true, AFTER_DRAIN = false;
    bf16_t* O; int ldc; const float* rss; const float* cb; int cbstride; int rows_per_batch; PG8_LAS unsigned char* pre_lds;
    __device__ __forceinline__ void pre(const Unit& u, int lane) const {
        __builtin_amdgcn_global_load_lds((const unsigned*)(cb + (size_t)((u.pm * BM) / rows_per_batch) * cbstride + u.pn * BM + 4 * lane), (PG8_LAS unsigned*)pre_lds, 16, 0, 0);
        __builtin_amdgcn_global_load_lds((const unsigned*)(rss + u.pm * BM + 4 * lane), (PG8_LAS unsigned*)(pre_lds + 1024), 16, 0, 0); }
    __device__ __forceinline__ void operator()(const f32x4 (&acc)[2][2][4][2], const Unit& u, int wr, int wc, int fr, int fq) const {
        const int col0 = u.pn * HALF + wc * 32 + 8 * fq;
        const PG8_LAS float* cbp = (const PG8_LAS float*)pre_lds + wc * 32 + 8 * fq; const PG8_LAS float* rp = (const PG8_LAS float*)(pre_lds + 1024) + wr * 64 + fr;
        constexpr float LC = 1.4426950408889634f, ILC = 0.6931471805599453f;
        const f32x4 cg0 = *(const PG8_LAS f32x4*)(cbp) * LC, cg1 = *(const PG8_LAS f32x4*)(cbp + 4) * LC, cu0 = *(const PG8_LAS f32x4*)(cbp + HALF) * ILC, cu1 = *(const PG8_LAS f32x4*)(cbp + HALF + 4) * ILC;
#pragma unroll
        for (int ai = 0; ai < 2; ++ai)
#pragma unroll
            for (int m = 0; m < 4; ++m) { const float rs = __builtin_amdgcn_rsqf(rp[ai * HALF + m * 16] * (1.0f / 2048.0f) + 1e-6f), rsg = rs * LC, rsu = rs * ILC;
                bf16_t* rowp = O + ((size_t)(u.pm * (ldc >> 6) + (col0 >> 6)) * BM + (wr * 64 + fr + ai * HALF + m * 16)) * 64 + (col0 & 63);
                const f32x4 h0 = acc[ai][0][m][0] * rsg + cg0, h1 = acc[ai][0][m][1] * rsg + cg1, u0 = acc[ai][1][m][0] * rsu + cu0, u1 = acc[ai][1][m][1] * rsu + cu1;
                f32x4 e0, e1;
#pragma unroll
                for (int i = 0; i < 4; ++i) { e0[i] = __builtin_amdgcn_exp2f(-h0[i]); e1[i] = __builtin_amdgcn_exp2f(-h1[i]); }
                e0 = e0 + 1.0f; e1 = e1 + 1.0f;
                f32x4 r0, r1;
#pragma unroll
                for (int i = 0; i < 4; ++i) { r0[i] = __builtin_amdgcn_rcpf(e0[i]); r1[i] = __builtin_amdgcn_rcpf(e1[i]); }
                const f32x4 o0 = (h0 * u0) * r0, o1 = (h1 * u1) * r1;
                u32x4 w;
                w.x = pk2(o0[0], o0[1]); w.y = pk2(o0[2], o0[3]); w.z = pk2(o1[0], o1[1]); w.w = pk2(o1[2], o1[3]);
                __builtin_nontemporal_store(w, (u32x4*)rowp); }
    }
};
struct EpiInN {
    static constexpr bool HAS_PRE = true;
    static constexpr bool PERM = true, AFTER_DRAIN = false;
    bf16_t* O; int ldc; const float* rss; const float* cb; int cbstride; int rows_per_batch; int nqk; const float* gq; const float* gk; PG8_LAS unsigned char* pre_lds;
    __device__ __forceinline__ void pre(const Unit& u, int lane) const {
        __builtin_amdgcn_global_load_lds((const unsigned*)(cb + (size_t)((u.pm * BM) / rows_per_batch) * cbstride + u.pn * BM + 4 * lane), (PG8_LAS unsigned*)pre_lds, 16, 0, 0);
        __builtin_amdgcn_global_load_lds((const unsigned*)(rss + u.pm * BM + 4 * lane), (PG8_LAS unsigned*)(pre_lds + 1024), 16, 0, 0); }
    __device__ __forceinline__ void operator()(const f32x4 (&acc)[2][2][4][2], const Unit& u, int wr, int wc, int fr, int fq) const {
        const int row0 = u.pm * BM + wr * 64 + fr, pc0 = u.pn * BM + wc * 32 + 8 * fq;
        const PG8_LAS float* cbp = (const PG8_LAS float*)pre_lds + wc * 32 + 8 * fq; const PG8_LAS float* rp = (const PG8_LAS float*)(pre_lds + 1024) + wr * 64 + fr;
        f32x4 cv[2][2];
#pragma unroll
        for (int bj = 0; bj < 2; ++bj)
#pragma unroll
            for (int n = 0; n < 2; ++n) cv[bj][n] = *(const PG8_LAS f32x4*)(cbp + bj * HALF + 4 * n);
        if (u.pn < nqk) {
            const bool isq = u.pn < (nqk >> 1); const float* gp = (isq ? gq : gk) + 8 * fq; const float gs = isq ? 0.125f * 1.4426950408889634f : 1.0f;
            f32x4 gv[2][2];
#pragma unroll
            for (int bj = 0; bj < 2; ++bj)
#pragma unroll
                for (int n = 0; n < 2; ++n) gv[bj][n] = *(const f32x4*)(gp + 32 * bj + 4 * n) * gs;
            const int lc0 = u.pn * BM + wc * 64 + 8 * fq;
#pragma unroll
            for (int ai = 0; ai < 2; ++ai)
#pragma unroll
                for (int m = 0; m < 4; ++m) { const int row = row0 + ai * HALF + m * 16; const float rs = rsqrtf(rp[ai * HALF + m * 16] * (1.0f / 2048.0f) + 1e-6f); bf16_t* rowp = O + (size_t)row * ldc + lc0;
                    f32x4 v[2][2]; float ss = 0.f;
#pragma unroll
                    for (int bj = 0; bj < 2; ++bj)
#pragma unroll
                        for (int n = 0; n < 2; ++n) { v[bj][n] = acc[ai][bj][m][n] * rs + cv[bj][n]; ss += (v[bj][n][0] * v[bj][n][0] + v[bj][n][1] * v[bj][n][1]) + (v[bj][n][2] * v[bj][n][2] + v[bj][n][3] * v[bj][n][3]); }
                    ss += sx<16>(ss); ss = sum32(ss);
                    const float rg = rsqrtf(ss * (1.0f / 64.0f) + 1e-6f);
#pragma unroll
                    for (int bj = 0; bj < 2; ++bj) { const f32x4 v0 = v[bj][0] * rg * gv[bj][0], v1 = v[bj][1] * rg * gv[bj][1];
                        u32x4 w; w.x = pk2(v0[0], v0[1]); w.y = pk2(v0[2], v0[3]); w.z = pk2(v1[0], v1[1]); w.w = pk2(v1[2], v1[3]);
                        if (isq) __builtin_nontemporal_store(w, (u32x4*)(rowp + 32 * bj)); else *(u32x4*)(rowp + 32 * bj) = w; } }
        } else {
#pragma unroll
            for (int ai = 0; ai < 2; ++ai)
#pragma unroll
                for (int m = 0; m < 4; ++m) { const int row = row0 + ai * HALF + m * 16; const float rs = rsqrtf(rp[ai * HALF + m * 16] * (1.0f / 2048.0f) + 1e-6f); bf16_t* rowp = O + (size_t)row * ldc + pc0;
#pragma unroll
                    for (int bj = 0; bj < 2; ++bj) { const f32x4 v0 = acc[ai][bj][m][0] * rs + cv[bj][0], v1 = acc[ai][bj][m][1] * rs + cv[bj][1];
                        u32x4 w; w.x = pk2(v0[0], v0[1]); w.y = pk2(v0[2], v0[3]); w.z = pk2(v1[0], v1[1]); w.w = pk2(v1[2], v1[3]);
                        *(u32x4*)(rowp + bj * HALF) = w; } }
        }
    }
};
typedef _Float16 f16x4 __attribute__((ext_vector_type(4)));
struct EpiResN {
    static constexpr bool HAS_PRE = true;
    static constexpr bool PERM = false, AFTER_DRAIN = false;
    const void* base; void* out; int base_f32, out_f32;
    int ldc; const float* gvt; const float* ant; int tstride; int rows_per_batch;
    bf16_t* xs; float* rssn; PG8_LAS unsigned char* pre_lds;
    float gscale;
    __device__ __forceinline__ void pre(const Unit& u, int lane) const {
        const size_t o = (size_t)((u.pm * BM) / rows_per_batch) * tstride + u.pn * BM + 4 * lane;
        __builtin_amdgcn_global_load_lds((const unsigned*)(gvt + o), (PG8_LAS unsigned*)pre_lds, 16, 0, 0);
        __builtin_amdgcn_global_load_lds((const unsigned*)(ant + o), (PG8_LAS unsigned*)(pre_lds + 1024), 16, 0, 0); }
    __device__ __forceinline__ void operator()(const f32x4 (&acc)[2][2][4][2], const Unit& u, int wr, int wc, int fr, int fq) const {
        const int col0 = u.pn * BM + wc * 32 + 4 * fq;
        const PG8_LAS float* gp = (const PG8_LAS float*)pre_lds + wc * 32 + 4 * fq;
        f32x4 gv[2][2], an[2][2];
#pragma unroll
        for (int bj = 0; bj < 2; ++bj)
#pragma unroll
            for (int n = 0; n < 2; ++n) { gv[bj][n] = *(const PG8_LAS f32x4*)(gp + bj * HALF + n * 16) * gscale; an[bj][n] = *(const PG8_LAS f32x4*)(gp + 256 + bj * HALF + n * 16); }
        if (base_f32) {
#pragma unroll
            for (int ai = 0; ai < 2; ++ai)
#pragma unroll
                for (int m = 0; m < 4; ++m) { const int rr = wr * 64 + fr + ai * HALF + m * 16; const unsigned off = (unsigned)((u.pm * BM + rr) * ldc + col0); float ss = 0.f;
                    const unsigned xso = ((unsigned)(u.pm * (ldc >> 6) + 4 * u.pn) * BM + rr) * 64u + 4u * fq;
#pragma unroll
                    for (int bj = 0; bj < 2; ++bj)
#pragma unroll
                        for (int n = 0; n < 2; ++n) { const unsigned o2 = off + bj * HALF + n * 16;
                            const f32x4 xn = *(const f32x4*)((const char*)base + 4u * o2) + gv[bj][n] * acc[ai][bj][m][n];
                            *(f16x4*)((char*)out + 2u * o2) = __builtin_convertvector(xn, f16x4);
                            ss += (xn[0] * xn[0] + xn[1] * xn[1]) + (xn[2] * xn[2] + xn[3] * xn[3]); const f32x4 h = xn * an[bj][n];
                            u32x2 w; w.x = pk2(h[0], h[1]); w.y = pk2(h[2], h[3]); *(u32x2*)((char*)xs + 2u * (xso + (unsigned)(2 * bj + (wc >> 1)) * (BM * 64) + (wc & 1) * 32 + n * 16)) = w; }
                    ss += sx<16>(ss); ss = sum32(ss); if (fq == 0) __hip_atomic_fetch_add(rssn + (u.pm * BM + rr), ss, __ATOMIC_RELAXED, __HIP_MEMORY_SCOPE_AGENT);
                    if (m & 1) asm volatile("" ::: "memory"); }
        } else {
            f16x4 bsv[2][4][2][2];
#pragma unroll
            for (int ai = 0; ai < 2; ++ai)
#pragma unroll
                for (int m = 0; m < 4; ++m)
#pragma unroll
                    for (int bj = 0; bj < 2; ++bj)
#pragma unroll
                        for (int n = 0; n < 2; ++n) bsv[ai][m][bj][n] = *(const f16x4*)((const char*)base + 2u * (unsigned)((u.pm * BM + wr * 64 + fr + ai * HALF + m * 16) * ldc + col0 + bj * HALF + n * 16));
            asm volatile("" ::: "memory");
#pragma unroll
            for (int ai = 0; ai < 2; ++ai) {
#pragma unroll
                for (int m = 0; m < 4; ++m) { const int rr = wr * 64 + fr + ai * HALF + m * 16; const unsigned off = (unsigned)((u.pm * BM + rr) * ldc + col0); float ss = 0.f;
                    const unsigned xso = ((unsigned)(u.pm * (ldc >> 6) + 4 * u.pn) * BM + rr) * 64u + 4u * fq;
#pragma unroll
                    for (int bj = 0; bj < 2; ++bj)
#pragma unroll
                        for (int n = 0; n < 2; ++n) { const unsigned o2 = off + bj * HALF + n * 16;
                            const f32x4 xn = __builtin_convertvector(bsv[ai][m][bj][n], f32x4) + gv[bj][n] * acc[ai][bj][m][n];
                            if (out_f32) *(f32x4*)((char*)out + 4u * o2) = xn; else *(f16x4*)((char*)out + 2u * o2) = __builtin_convertvector(xn, f16x4);
                            if (xs) { ss += (xn[0] * xn[0] + xn[1] * xn[1]) + (xn[2] * xn[2] + xn[3] * xn[3]); const f32x4 h = xn * *(const PG8_LAS f32x4*)(gp + 256 + bj * HALF + n * 16);
                                u32x2 w; w.x = pk2(h[0], h[1]); w.y = pk2(h[2], h[3]); *(u32x2*)((char*)xs + 2u * (xso + (unsigned)(2 * bj + (wc >> 1)) * (BM * 64) + (wc & 1) * 32 + n * 16)) = w; } }
                    if (xs) { ss += sx<16>(ss); ss = sum32(ss); if (fq == 0) __hip_atomic_fetch_add(rssn + (u.pm * BM + rr), ss, __ATOMIC_RELAXED, __HIP_MEMORY_SCOPE_AGENT); } }
                asm volatile("" ::: "memory"); }
        }
    }
};
template <class Epi, class Sched, bool ALIGN_EPI = false, bool SP2 = false, int A_AUX = 0>
__device__ __forceinline__ void gemm_phase(PG8_LAS unsigned char* lds, const Gemm g, const Sched& S, const Epi& E, int tid_in) {
    int tid_o = tid_in; asm volatile("" : "+v"(tid_o));
    const int tid = tid_o, wid = __builtin_amdgcn_readfirstlane(tid >> 6), lane = tid & 63, wr = wid >> 2, wc = wid & 3, fr = lane & 15, fq = lane >> 4;
    const int K = g.K, nt = K / BK;
    unsigned voffA[2], voffB[2];
#pragma unroll
    for (int i = 0; i < 2; ++i) { int R, C; stage_rc(tid * 16 + i * 8192, R, C); const int Rb = Epi::PERM ? ((R & ~31) + perm32(R & 31)) : R;
        voffA[i] = (unsigned)(R * (g.a_tiled ? BK : K) + C) * 2u; voffB[i] = (unsigned)(Rb * (g.b_tiled ? BK : K) + C) * 2u; }
    const size_t kstepA = g.a_tiled ? (size_t)(BM * BK * 2) : (size_t)(BK * 2), kstepB = g.b_tiled ? (size_t)(BM * BK * 2) : (size_t)(BK * 2);
    const size_t hstepA = g.a_tiled ? (size_t)(HALF * BK * 2) : (size_t)HALF * K * 2, hstepB = g.b_tiled ? (size_t)(HALF * BK * 2) : (size_t)HALF * K * 2;
    const size_t tstepA = (size_t)BM * K * 2, tstepB = tstepA;
    const unsigned ldsw = (unsigned)wid * 1024u;
    const int aoff = lds_byte(wr * 64 + fr, fq * 8), boff = lds_byte(wc * 32 + fr, fq * 8);
#define PG8_SA(b, h) (((b) * 2 + (h)) * HTB)
#define PG8_SB(b, h) ((4 + (b) * 2 + (h)) * HTB)
#define PG8_STAGE(bufoff, gbase, voff) do { _Pragma("unroll") for (int _i = 0; _i < 2; ++_i) \
        __builtin_amdgcn_global_load_lds((const unsigned*)((const char*)(gbase) + (voff)[_i]), (PG8_LAS unsigned*)(lds + (bufoff) + ldsw + _i * 8192), 16, 0, 0); } while (0)
#define PG8_STAGE_A(bufoff, gbase, voff) do { _Pragma("unroll") for (int _i = 0; _i < 2; ++_i) \
        __builtin_amdgcn_global_load_lds((const unsigned*)((const char*)(gbase) + (voff)[_i]), (PG8_LAS unsigned*)(lds + (bufoff) + ldsw + _i * 8192), 16, 0, A_AUX); } while (0)
#define PG8_LDA(dst, b, h) do { _Pragma("unroll") for (int m = 0; m < 4; ++m) _Pragma("unroll") for (int k = 0; k < 2; ++k) dst[m][k] = *(const PG8_LAS bf16x8*)(lds + PG8_SA(b, h) + aoff + m * 2048 + k * 1024); } while (0)
#define PG8_LDB(dst, b, h) do { _Pragma("unroll") for (int n = 0; n < 2; ++n) _Pragma("unroll") for (int k = 0; k < 2; ++k) dst[n][k] = *(const PG8_LAS bf16x8*)(lds + PG8_SB(b, h) + boff + n * 2048 + k * 1024); } while (0)
#define PG8_MMA(ai, bj, At, Bt) do { __builtin_amdgcn_s_setprio(1); _Pragma("unroll") for (int m = 0; m < 4; ++m) _Pragma("unroll") for (int n = 0; n < 2; ++n) _Pragma("unroll") for (int k = 0; k < 2; ++k) \
        acc[ai][bj][m][n] = __builtin_amdgcn_mfma_f32_16x16x32_bf16(Bt[n][k], At[m][k], acc[ai][bj][m][n], 0, 0, 0); __builtin_amdgcn_s_setprio(0); } while (0)
#define PG8_WAIT_V(n) asm volatile("s_waitcnt vmcnt(" #n ")" ::: "memory")
#define PG8_WAIT_L(n) asm volatile("s_waitcnt lgkmcnt(" #n ")" ::: "memory")
#define PG8_BAR __builtin_amdgcn_s_barrier()
#define PG8_SCHED __builtin_amdgcn_sched_barrier(0)
    Unit cur, nxt; int ui = 0;
    if (!S.next(0, cur)) return;
    f32x4 acc[2][2][4][2];
#pragma unroll
    for (int a = 0; a < 2; ++a)
#pragma unroll
        for (int b = 0; b < 2; ++b)
#pragma unroll
            for (int m = 0; m < 4; ++m)
#pragma unroll
                for (int n = 0; n < 2; ++n) acc[a][b][m][n] = (f32x4){0.f, 0.f, 0.f, 0.f};
    bf16x8 At[4][2], B0[2][2], B1[2][2];
    const char* cA = (const char*)g.A + (size_t)cur.pm * tstepA; const char* cB = (const char*)g.Bt + (size_t)cur.pn * tstepB;
    S.a_ready(cur);
    if constexpr (SP2) {
        PG8_STAGE(PG8_SB(0, 0), cB, voffB); PG8_STAGE(PG8_SB(0, 1), cB + hstepB, voffB); PG8_STAGE_A(PG8_SA(0, 0), cA, voffA); PG8_STAGE_A(PG8_SA(0, 1), cA + hstepA, voffA);
        if (wr == 1) PG8_BAR;
        PG8_WAIT_V(2); PG8_BAR;
        PG8_STAGE(PG8_SB(1, 0), cB + kstepB, voffB); PG8_STAGE_A(PG8_SA(1, 0), cA + kstepA, voffA); PG8_STAGE(PG8_SB(1, 1), cB + hstepB + kstepB, voffB);
        PG8_WAIT_V(6); PG8_BAR;
    } else {
        PG8_STAGE(PG8_SB(0, 0), cB, voffB); PG8_STAGE_A(PG8_SA(0, 0), cA, voffA); PG8_STAGE(PG8_SB(0, 1), cB + hstepB, voffB); PG8_STAGE_A(PG8_SA(0, 1), cA + hstepA, voffA);
        if (wr == 1) PG8_BAR;
        PG8_WAIT_V(4); PG8_BAR;
        PG8_STAGE(PG8_SB(1, 0), cB + kstepB, voffB); PG8_STAGE_A(PG8_SA(1, 0), cA + kstepA, voffA); PG8_STAGE(PG8_SB(1, 1), cB + hstepB + kstepB, voffB);
        PG8_WAIT_V(6); PG8_BAR;
    }
    for (;;) {
        const bool has_next = S.next(ui + 1, nxt);
        const char* nA = has_next ? (const char*)g.A + (size_t)nxt.pm * tstepA : cA; const char* nB = has_next ? (const char*)g.Bt + (size_t)nxt.pn * tstepB : cB;
        for (int t = 0; t < nt; t += 2) {
            const bool last = (t == nt - 2);
            const char* a1 = cA + (size_t)(t + 1) * kstepA;
            const char* a2 = last ? nA : cA + (size_t)(t + 2) * kstepA; const char* b2 = last ? nB : cB + (size_t)(t + 2) * kstepB;
            const char* a3 = a2 + kstepA; const char* b3 = b2 + kstepB;
            if (last && has_next) S.a_ready(nxt);
            if constexpr (SP2) {
            if constexpr (Epi::HAS_PRE) { if (last && wid == 0) { int ln = fr | (fq << 4); asm volatile("" : "+v"(ln)); E.pre(cur, ln); } }
            PG8_LDB(B0, 0, 0); PG8_LDB(B1, 0, 1); PG8_SCHED; PG8_LDA(At, 0, 0); PG8_STAGE_A(PG8_SA(1, 1), a1 + hstepA, voffA);
            PG8_WAIT_V(8); PG8_WAIT_L(0); PG8_BAR; PG8_MMA(0, 0, At, B0); PG8_MMA(0, 1, At, B1); PG8_BAR; PG8_SCHED;
            PG8_LDA(At, 0, 1); PG8_STAGE(PG8_SB(0, 0), b2, voffB); PG8_STAGE(PG8_SB(0, 1), b2 + hstepB, voffB); PG8_STAGE_A(PG8_SA(0, 0), a2, voffA);
            PG8_WAIT_V(8); PG8_WAIT_L(0); PG8_BAR; PG8_MMA(1, 0, At, B0); PG8_MMA(1, 1, At, B1); PG8_BAR; PG8_SCHED;
            PG8_LDB(B0, 1, 0); PG8_LDB(B1, 1, 1); PG8_SCHED; PG8_LDA(At, 1, 0); PG8_STAGE_A(PG8_SA(0, 1), a2 + hstepA, voffA);
            PG8_WAIT_V(8); PG8_WAIT_L(0); PG8_BAR; PG8_MMA(0, 0, At, B0); PG8_MMA(0, 1, At, B1); PG8_BAR; PG8_SCHED;
            PG8_LDA(At, 1, 1); PG8_STAGE(PG8_SB(1, 0), b3, voffB); PG8_STAGE(PG8_SB(1, 1), b3 + hstepB, voffB); PG8_STAGE_A(PG8_SA(1, 0), a3, voffA);
            PG8_WAIT_V(8); PG8_WAIT_L(0); PG8_BAR; PG8_MMA(1, 0, At, B0); PG8_MMA(1, 1, At, B1); PG8_BAR; PG8_SCHED;
            } else {
            PG8_LDB(B0, 0, 0); PG8_SCHED; PG8_LDA(At, 0, 0); PG8_STAGE_A(PG8_SA(1, 1), a1 + hstepA, voffA);
            PG8_WAIT_L(8); PG8_BAR; PG8_WAIT_L(0); PG8_MMA(0, 0, At, B0); PG8_BAR; PG8_SCHED;
            PG8_LDB(B1, 0, 1); PG8_STAGE(PG8_SB(0, 0), b2, voffB);
            PG8_BAR; PG8_WAIT_L(0); PG8_MMA(0, 1, At, B1); PG8_BAR;
            PG8_LDA(At, 0, 1); PG8_STAGE_A(PG8_SA(0, 0), a2, voffA);
            PG8_BAR; PG8_WAIT_L(0); PG8_MMA(1, 0, At, B0); PG8_BAR; PG8_SCHED;
            PG8_STAGE(PG8_SB(0, 1), b2 + hstepB, voffB);
            PG8_WAIT_V(6); PG8_BAR; PG8_MMA(1, 1, At, B1); PG8_BAR;
            PG8_LDB(B0, 1, 0); PG8_SCHED; PG8_LDA(At, 1, 0); PG8_STAGE_A(PG8_SA(0, 1), a2 + hstepA, voffA);
            PG8_WAIT_L(8); PG8_BAR; PG8_WAIT_L(0); PG8_MMA(0, 0, At, B0); PG8_BAR; PG8_SCHED;
            PG8_LDB(B1, 1, 1); PG8_STAGE(PG8_SB(1, 0), b3, voffB);
            PG8_BAR; PG8_WAIT_L(0); PG8_MMA(0, 1, At, B1); PG8_BAR;
            PG8_LDA(At, 1, 1); PG8_STAGE_A(PG8_SA(1, 0), a3, voffA);
            PG8_BAR; PG8_WAIT_L(0); PG8_MMA(1, 0, At, B0); PG8_BAR; PG8_SCHED;
            PG8_STAGE(PG8_SB(1, 1), b3 + hstepB, voffB);
            PG8_WAIT_V(6); PG8_BAR; PG8_MMA(1, 1, At, B1); PG8_BAR;
            }
        }
        if constexpr (ALIGN_EPI) { if (wr == 0) PG8_BAR; }
        if constexpr (!Epi::AFTER_DRAIN) { E(acc, cur, wr, wc, fr, fq); S.done(cur); }
        if (!has_next) break;
#pragma unroll
        for (int a = 0; a < 2; ++a)
#pragma unroll
            for (int b = 0; b < 2; ++b)
#pragma unroll
                for (int m = 0; m < 4; ++m)
#pragma unroll
                    for (int n = 0; n < 2; ++n) acc[a][b][m][n] = (f32x4){0.f, 0.f, 0.f, 0.f};
        cur = nxt; cA = nA; cB = nB; ++ui;
        if constexpr (ALIGN_EPI) { if (wr == 1) PG8_BAR; }
    }
    PG8_WAIT_V(0);
    if constexpr (!ALIGN_EPI) { if (wr == 0) PG8_BAR; }
    PG8_BAR;
    if constexpr (Epi::AFTER_DRAIN) { E.fused(acc, cur, wr, wc, fr, fq, lds, wid, lane); S.done(cur); }
#undef PG8_SA
#undef PG8_SB
#undef PG8_STAGE
#undef PG8_STAGE_A
#undef PG8_LDA
#undef PG8_LDB
#undef PG8_MMA
#undef PG8_WAIT_V
#undef PG8_WAIT_L
#undef PG8_BAR
#undef PG8_SCHED
}
}
#define GAS __attribute__((address_space(1)))
#define LAS __attribute__((address_space(3)))
typedef unsigned short bf16;
typedef unsigned v4u __attribute__((ext_vector_type(4)));
typedef float f32x4 __attribute__((ext_vector_type(4)));
typedef short bf16x8 __attribute__((ext_vector_type(8)));
typedef GAS unsigned gu32;
typedef GAS unsigned long long gu64;
#define RLX_AGENT __ATOMIC_RELAXED, __HIP_MEMORY_SCOPE_AGENT
#define LDS_WAIT() asm volatile("s_waitcnt lgkmcnt(0)" ::: "memory")
#define VM_WAIT() asm volatile("s_waitcnt vmcnt(0)" ::: "memory")
__device__ __forceinline__ unsigned long long rt() { return __builtin_amdgcn_s_memrealtime(); }
#define XB_TMO      128
#define XB_XCNT(j)  (256  + 64 * (j))
#define XB_XSUB(j)  (1280 + 64 * (j))
#define XB_XGEN(j)  (2304 + 64 * (j))
#define XB_TOP      3328
#define XB_TOPGEN   3392
#define XCD_BAR_WORDS 3456
#define XB_SPIN_CAP (1u << 18)

__device__ __forceinline__ unsigned xb_ld(unsigned* p)              { return __hip_atomic_load(p, __ATOMIC_RELAXED, __HIP_MEMORY_SCOPE_AGENT); }
__device__ __forceinline__ unsigned xb_add(unsigned* p, unsigned v) { return __hip_atomic_fetch_add(p, v, __ATOMIC_RELAXED, __HIP_MEMORY_SCOPE_AGENT); }
__device__ __forceinline__ unsigned xb_xcc_id() { return (unsigned)__builtin_amdgcn_s_getreg((3 << 11) | 20) & 0xFu; }
#define XB_SPIN(cond, bar) do { unsigned _sp = 0; while (cond) { __builtin_amdgcn_s_sleep(1); \
    if ((++_sp & 255u) == 0u) { if (xb_ld(&(bar)[XB_TMO])) break; if (_sp > XB_SPIN_CAP) { atomicAdd(&(bar)[XB_TMO], 1u); break; } } } } while (0)

struct XcdBarrier {
    unsigned* bar; unsigned x;
    volatile LAS unsigned* st;
};

__device__ __forceinline__ XcdBarrier xcd_barrier_post(unsigned* bar, volatile LAS unsigned* st) {
    XcdBarrier b; b.bar = bar; b.x = xb_xcc_id(); b.st = st;
    if (threadIdx.x == 0) (void)xb_add(&bar[XB_XCNT(b.x)], 1u);
    return b;
}
__device__ __forceinline__ void xcd_barrier_complete(unsigned* bar, unsigned x, unsigned& nloc, unsigned& nx) {
    const unsigned G = gridDim.x * gridDim.y * gridDim.z;
    unsigned sum, cnt, mine, sp = 0u;
    for (;;) {
        sum = 0u; cnt = 0u; mine = 0u;
#pragma unroll
        for (unsigned j = 0; j < 16; ++j) { const unsigned c = xb_ld(&bar[XB_XCNT(j)]); sum += c; cnt += (c > 0u) ? 1u : 0u; mine = (j == x) ? c : mine; }
        if (sum == G) break;
        __builtin_amdgcn_s_sleep(1);
        if ((++sp & 255u) == 0u) { if (xb_ld(&bar[XB_TMO])) break; if (sp > XB_SPIN_CAP) { atomicAdd(&bar[XB_TMO], 1u); break; } }
    }
    nloc = mine > 0u ? mine : 1u; nx = cnt > 0u ? cnt : 1u;
}

__device__ __forceinline__ void xcd_barrier(const XcdBarrier& b) {
    asm volatile("s_waitcnt vmcnt(0)" ::: "memory");
    __syncthreads();
    if (threadIdx.x == 0) {
        unsigned* bar = b.bar;
        __builtin_amdgcn_s_waitcnt(0);
        unsigned nloc = b.st[0], nx = b.st[1];
        if (nloc == 0u) { xcd_barrier_complete(bar, b.x, nloc, nx); b.st[0] = nloc; b.st[1] = nx; }
        const unsigned old = xb_add(&bar[XB_XSUB(b.x)], 1u);
        const unsigned gen = old / nloc;
        if (old + 1u == (gen + 1u) * nloc) {
            __builtin_amdgcn_fence(__ATOMIC_RELEASE, "agent");
            asm volatile("s_waitcnt vmcnt(0)" ::: "memory");
            const unsigned og = xb_add(&bar[XB_TOP], 1u);
            const unsigned tg = og / nx;
            if (og + 1u == (tg + 1u) * nx) xb_add(&bar[XB_TOPGEN], 1u);
            else XB_SPIN(xb_ld(&bar[XB_TOPGEN]) == tg, bar);
            __builtin_amdgcn_fence(__ATOMIC_ACQUIRE, "agent");
            xb_add(&bar[XB_XGEN(b.x)], 1u);
            asm volatile("s_waitcnt vmcnt(0)" ::: "memory");
        } else {
            XB_SPIN(xb_ld(&bar[XB_XGEN(b.x)]) == gen, bar);
            __builtin_amdgcn_fence(__ATOMIC_ACQUIRE, "agent");
            asm volatile("s_waitcnt vmcnt(0)" ::: "memory");
        }
    }
    __syncthreads();
}
namespace att {
using bf16x8 = __attribute__((ext_vector_type(8))) short;
using s16x4  = __attribute__((ext_vector_type(4))) short;
using f32x16 = __attribute__((ext_vector_type(16))) float;
using u32x4  = __attribute__((ext_vector_type(4))) unsigned;
constexpr int SEQ_ = 8192, LDQ = 6144; constexpr size_t SHM_V = 16384, SHM_K = 16384;
#define KSWZ(row, colB) ((row) * 256 + ((colB) ^ (((row) & 7) << 4)))
#define SBAR() __builtin_amdgcn_sched_barrier(0)
__device__ __forceinline__ int crow(int r, int hi) { return (r & 3) + 8 * (r >> 2) + 4 * hi; }
__device__ __forceinline__ unsigned cvtpk(float lo, float hi) {
  unsigned r; asm volatile("v_cvt_pk_bf16_f32 %0, %1, %2" : "=v"(r) : "v"(lo), "v"(hi)); return r;
}
__device__ __forceinline__ void qkt(f32x16& p0, f32x16& p1, const bf16* Ks, const bf16x8* qr, int r32, int hi, int jmap, float dbase, float slope2, float negm, bool diag) {
  asm volatile("" : "+v"(negm));
  if (diag) {
#pragma unroll
    for (int r = 0; r < 16; ++r) { const float d = (float)((r & 3) + 8 * (r >> 2)) + dbase;
      p0[r] = fmaf(-slope2, fabsf(d), negm); p1[r] = fmaf(-slope2, fabsf(d + 32.f), negm); }
  } else {
    const float u0 = fmaf(slope2, dbase, negm), u1 = fmaf(slope2, dbase + 32.f, negm);
#pragma unroll
    for (int r = 0; r < 16; ++r) { p0[r] = fmaf(slope2, (float)((r & 3) + 8 * (r >> 2)), u0); p1[r] = fmaf(slope2, (float)((r & 3) + 8 * (r >> 2)), u1); }
  }
  const int cb0 = (jmap * 64 + hi * 8) * 2;
  bf16x8 b0 = *reinterpret_cast<const bf16x8*>((const char*)Ks + KSWZ(r32, cb0));
  bf16x8 b1 = *reinterpret_cast<const bf16x8*>((const char*)Ks + KSWZ(32 + r32, cb0));
#pragma unroll
  for (int d0 = 0; d0 < 4; ++d0) { const int cb = (jmap * 64 + (d0 + 1) * 16 + hi * 8) * 2;
    bf16x8 n0 = b0, n1 = b1;
    if (d0 < 3) { n0 = *reinterpret_cast<const bf16x8*>((const char*)Ks + KSWZ(r32, cb)); n1 = *reinterpret_cast<const bf16x8*>((const char*)Ks + KSWZ(32 + r32, cb)); }
    p0 = __builtin_amdgcn_mfma_f32_32x32x16_bf16(b0, qr[d0], p0, 0, 0, 0);
    p1 = __builtin_amdgcn_mfma_f32_32x32x16_bf16(b1, qr[d0], p1, 0, 0, 0);
    b0 = n0; b1 = n1; }
}
__device__ __forceinline__ void partialSM(f32x16& p0, f32x16& p1) {
#pragma unroll
  for (int r = 0; r < 16; ++r) p0[r] = __builtin_amdgcn_exp2f(p0[r]);
}
__device__ __forceinline__ void finishSM(f32x16& p0, f32x16& p1, float alpha, float& l_reg, bf16x8& pa0, bf16x8& pa1, bf16x8& pa2, bf16x8& pa3) {
  for (int r = 0; r < 16; ++r) p1[r] = __builtin_amdgcn_exp2f(p1[r]);
  float ps = 0; for (int r = 0; r < 16; ++r) ps += p0[r]; for (int r = 0; r < 16; ++r) ps += p1[r];
  { auto rr = __builtin_amdgcn_permlane32_swap(__float_as_uint(ps), __float_as_uint(ps), false, false);
    ps = __uint_as_float(rr[0]) + __uint_as_float(rr[1]); }
  l_reg = l_reg * alpha + ps;
#define PK4(P, BASE, OUT) do { unsigned a0 = cvtpk(P[BASE + 0], P[BASE + 1]), a1 = cvtpk(P[BASE + 2], P[BASE + 3]);   \
    unsigned b0 = cvtpk(P[BASE + 4], P[BASE + 5]), b1 = cvtpk(P[BASE + 6], P[BASE + 7]);                              \
    auto r0 = __builtin_amdgcn_permlane32_swap(a0, b0, false, false); auto r1 = __builtin_amdgcn_permlane32_swap(a1, b1, false, false); \
    u32x4 w = {r0[0], r1[0], r0[1], r1[1]}; OUT = *reinterpret_cast<bf16x8*>(&w); } while (0)
  PK4(p0, 0, pa0); PK4(p0, 8, pa1); PK4(p1, 0, pa2); PK4(p1, 8, pa3);
#undef PK4
}
__device__ __forceinline__ int v_st(int k, int c) { const int kk = (k & ~0xC) | ((k & 4) << 1) | ((k & 8) >> 1); return ((kk >> 3) * 4 + (c >> 5)) * 512 + ((kk & 7) * 32 + (c & 31)) * 2; }
__device__ __forceinline__ int v_rd_base(int lane) { return ((lane & 3) << 3) | (((lane >> 2) & 3) << 6) | (((lane >> 4) & 1) << 5) | (((lane >> 5) & 1) << 8); }
constexpr int v_rd_off(int d0, int ks, int half) { return d0 * 512 + ks * 4096 + half * 2048; }
template <int OFF> __device__ __forceinline__ s16x4 tr_read(int vb) {
  s16x4 r; asm volatile("ds_read_b64_tr_b16 %0, %1 offset:%2" : "=&v"(r) : "v"(vb), "i"(OFF) : "memory"); return r;
}
template <int D0> __device__ __forceinline__ void pv_one(f32x16& od, int vb, bf16x8 pa0, bf16x8 pa1, bf16x8 pa2, bf16x8 pa3) {
  const s16x4 l0 = tr_read<v_rd_off(D0, 0, 0)>(vb), h0 = tr_read<v_rd_off(D0, 0, 1)>(vb), l1 = tr_read<v_rd_off(D0, 1, 0)>(vb), h1 = tr_read<v_rd_off(D0, 1, 1)>(vb);
  const s16x4 l2 = tr_read<v_rd_off(D0, 2, 0)>(vb), h2 = tr_read<v_rd_off(D0, 2, 1)>(vb), l3 = tr_read<v_rd_off(D0, 3, 0)>(vb), h3 = tr_read<v_rd_off(D0, 3, 1)>(vb);
  asm volatile("s_waitcnt lgkmcnt(0)" ::: "memory"); SBAR();
#define PK(L, H) (bf16x8){L[0], L[1], L[2], L[3], H[0], H[1], H[2], H[3]}
  od = __builtin_amdgcn_mfma_f32_32x32x16_bf16(pa0, PK(l0, h0), od, 0, 0, 0);
  od = __builtin_amdgcn_mfma_f32_32x32x16_bf16(pa1, PK(l1, h1), od, 0, 0, 0);
  od = __builtin_amdgcn_mfma_f32_32x32x16_bf16(pa2, PK(l2, h2), od, 0, 0, 0);
  od = __builtin_amdgcn_mfma_f32_32x32x16_bf16(pa3, PK(l3, h3), od, 0, 0, 0);
#undef PK
}
#define PV_RD(S, D0) const s16x4 S##l0 = tr_read<v_rd_off(D0, 0, 0)>(vb), S##h0 = tr_read<v_rd_off(D0, 0, 1)>(vb), S##l1 = tr_read<v_rd_off(D0, 1, 0)>(vb), S##h1 = tr_read<v_rd_off(D0, 1, 1)>(vb), \
    S##l2 = tr_read<v_rd_off(D0, 2, 0)>(vb), S##h2 = tr_read<v_rd_off(D0, 2, 1)>(vb), S##l3 = tr_read<v_rd_off(D0, 3, 0)>(vb), S##h3 = tr_read<v_rd_off(D0, 3, 1)>(vb)
#define PV_PK(L, H) (bf16x8){L[0], L[1], L[2], L[3], H[0], H[1], H[2], H[3]}
#define PV_MM(S, OD) do { OD = __builtin_amdgcn_mfma_f32_32x32x16_bf16(pa0, PV_PK(S##l0, S##h0), OD, 0, 0, 0); OD = __builtin_amdgcn_mfma_f32_32x32x16_bf16(pa1, PV_PK(S##l1, S##h1), OD, 0, 0, 0); \
    OD = __builtin_amdgcn_mfma_f32_32x32x16_bf16(pa2, PV_PK(S##l2, S##h2), OD, 0, 0, 0); OD = __builtin_amdgcn_mfma_f32_32x32x16_bf16(pa3, PV_PK(S##l3, S##h3), OD, 0, 0, 0); } while (0)
__device__ __forceinline__ void pv_d0(f32x16* o, int vb, bf16x8 pa0, bf16x8 pa1, bf16x8 pa2, bf16x8 pa3) {
  PV_RD(a, 0); PV_RD(b, 1);
  asm volatile("s_waitcnt lgkmcnt(8)" ::: "memory"); SBAR();
  PV_MM(a, o[0]);
  PV_RD(c, 2);
  asm volatile("s_waitcnt lgkmcnt(8)" ::: "memory"); SBAR();
  PV_MM(b, o[1]);
  PV_RD(d, 3);
  asm volatile("s_waitcnt lgkmcnt(8)" ::: "memory"); SBAR();
  PV_MM(c, o[2]);
  asm volatile("s_waitcnt lgkmcnt(0)" ::: "memory"); SBAR();
  PV_MM(d, o[3]);
}
#undef PV_RD
#undef PV_PK
#undef PV_MM
__device__ __forceinline__ void attn_unit(int tid_in, int b, int h, int qb, int tb, const bf16* __restrict__ QKV, bf16* __restrict__ OB, float lam, float omli, float slope2, float m_ref, const float* __restrict__ subg, char* lds, gu32* qhead, volatile LAS unsigned* qslot) {
  int tid_o = tid_in; asm volatile("" : "+v"(tid_o));
  const int tid = tid_o, wid = __builtin_amdgcn_readfirstlane(tid >> 6), lane = tid & 63, r32 = lane & 31, hi = lane >> 5;
  const int jmap = wid >> 2, wq = wid & 3;
  constexpr int KR = 0, VR = 3 * 16384, WSO = 6 * 16384;
  float* ws = (float*)(lds + WSO) + wid * 64; float* li_l = ws;
  const long rowbase = (long)b * SEQ_; const int q0 = qb * 128 + wq * 32;
  float l_reg = 0.f; f32x16 o[4] = {}; bf16x8 qr[4];
  const bf16* Qw = QKV + (rowbase + q0 + r32) * LDQ + h * 128 + jmap * 64 + hi * 8;
#pragma unroll
  for (int d0 = 0; d0 < 4; ++d0) qr[d0] = *reinterpret_cast<const bf16x8*>(Qw + d0 * 16);
  const char* KVmid = (const char*)(QKV + (rowbase + 64 * tb) * LDQ + 2048 + h * 128 + 1024);
  unsigned koff[2], voff[2];
#pragma unroll
  for (int jb = 0; jb < 2; ++jb) { const int blk = 2 * wid + jb;
    { const int row = 4 * blk + (lane >> 4), chunk = (lane & 15) ^ (row & 7);
      koff[jb] = (unsigned)(row * LDQ * 2 + chunk * 16); }
    { const int sl = 64 * blk + lane, kk = 8 * (sl >> 7) + ((sl & 31) >> 2), c = 32 * ((sl >> 5) & 3) + 8 * (sl & 3);
      const int k = (kk & ~0xC) | ((kk & 4) << 1) | ((kk & 8) >> 1);
      voff[jb] = (unsigned)(k * LDQ * 2 + c * 2); } }
  const unsigned lds0 = (unsigned)(uintptr_t)lds;
  const int vb0 = (int)(lds0 + VR) + v_rd_base(lane);
  typedef __attribute__((address_space(3))) unsigned lds_u32;
#define DMA_K(t, slot) do { const char* t_ = KVmid + (size_t)(t) * (64 * LDQ * 2) - 2048; \
    __builtin_amdgcn_global_load_lds((const unsigned*)(t_ + koff[0]), (lds_u32*)(lds0 + KR + (slot) * 16384 + (2 * wid) * 1024), 16, 0, 0); \
    __builtin_amdgcn_global_load_lds((const unsigned*)(t_ + koff[1]), (lds_u32*)(lds0 + KR + (slot) * 16384 + (2 * wid + 1) * 1024), 16, 0, 0); } while (0)
#define DMA_V(t, slot) do { const char* t_ = KVmid + (size_t)(t) * (64 * LDQ * 2) + 2048; \
    __builtin_amdgcn_global_load_lds((const unsigned*)(t_ + voff[0]), (lds_u32*)(lds0 + VR + (slot) * 16384 + (2 * wid) * 1024), 16, 0, 0); \
    __builtin_amdgcn_global_load_lds((const unsigned*)(t_ + voff[1]), (lds_u32*)(lds0 + VR + (slot) * 16384 + (2 * wid + 1) * 1024), 16, 0, 0); } while (0)
#define WAIT_BAR(N) asm volatile("s_waitcnt vmcnt(" #N ") lgkmcnt(0)\n\ts_barrier" ::: "memory")
  f32x16 pA0, pA1, pB0, pB1; bf16x8 pa0, pa1, pa2, pa3;
  const int NT = 2 * qb + 2 - tb, cq = 2 * qb + (wq >> 1) - tb;
  const float dq = (float)(4 * hi - (q0 + r32) + 64 * tb);
#define QKT(P0, P1, kslot, t) qkt(P0, P1, (const bf16*)(lds + KR + (kslot) * 16384), qr, r32, hi, jmap, (float)(64 * (t)) + dq, slope2, ((t) > cq) ? -1e30f : -m_ref, (t) == cq)
  int sc = 0, sp = 2;
#define ROT() do { sp = sc; sc = (sc == 2) ? 0 : sc + 1; } while (0)
  asm volatile("" ::: "memory");
  DMA_K(0, 0); DMA_V(0, 0); DMA_K(1, 1);
  WAIT_BAR(4);
  asm volatile("" : "+v"(qr[0]), "+v"(qr[1]), "+v"(qr[2]), "+v"(qr[3]) :: "memory");
  if (2 < NT) DMA_K(2, 2);
  DMA_V(1, 1);
  QKT(pA0, pA1, 0, 0); partialSM(pA0, pA1);
#define STEP(ORD, PX0, PX1, PY0, PY1, t) do { ROT(); \
    if ((t) + 1 < NT) { WAIT_BAR(4); } else { WAIT_BAR(2); } \
    {   \
      if ((t) + 2 < NT) DMA_K((t) + 2, sp); \
      if ((t) + 1 < NT) DMA_V((t) + 1, (3 - sc - sp)); } \
    SBAR(); \
    if ((ORD) == 0) { QKT(PX0, PX1, sc, t); \
      finishSM(PY0, PY1, 1.f, l_reg, pa0, pa1, pa2, pa3); SBAR(); \
      pv_d0(o, vb0 + sp * 16384, pa0, pa1, pa2, pa3); partialSM(PX0, PX1); } \
    else { finishSM(PY0, PY1, 1.f, l_reg, pa0, pa1, pa2, pa3); SBAR(); \
      pv_d0(o, vb0 + sp * 16384, pa0, pa1, pa2, pa3); SBAR(); \
      QKT(PX0, PX1, sc, t); partialSM(PX0, PX1); } } while (0)
#define TILE_LOOP(ORD) do { \
    for (int t = 1; t + 1 < NT; t += 2) { STEP(ORD, pB0, pB1, pA0, pA1, t); STEP(ORD, pA0, pA1, pB0, pB1, t + 1); } \
    if ((NT & 1) == 0) { STEP(ORD, pB0, pB1, pA0, pA1, NT - 1); \
      WAIT_BAR(0);                                               \
      finishSM(pB0, pB1, 1.f, l_reg, pa0, pa1, pa2, pa3); SBAR(); \
    } else { WAIT_BAR(0); \
      finishSM(pA0, pA1, 1.f, l_reg, pa0, pa1, pa2, pa3); SBAR(); } } while (0)
  if (jmap == 0) TILE_LOOP(0); else TILE_LOOP(1);
  pv_d0(o, vb0 + sc * 16384, pa0, pa1, pa2, pa3);
  unsigned nxt_unit = 0u; if (tid == 0) nxt_unit = __hip_atomic_fetch_add(qhead, 1u, __ATOMIC_RELAXED, __HIP_MEMORY_SCOPE_AGENT);
  if (hi == 0) li_l[r32] = l_reg; asm volatile("s_waitcnt lgkmcnt(0)" ::: "memory");
#pragma unroll
  for (int r = 0; r < 16; ++r) { const float rl = __builtin_amdgcn_rcpf(li_l[crow(r, hi)]);
#pragma unroll
    for (int d0 = 0; d0 < 4; ++d0) o[d0][r] *= rl; }
  float* xch = (float*)lds + (size_t)wq * 4096 + lane;
  __syncthreads();
  if (jmap == 1) {
#pragma unroll
    for (int d0 = 0; d0 < 4; ++d0)
#pragma unroll
      for (int r = 0; r < 16; ++r) xch[(d0 * 16 + r) * 64] = o[d0][r];
  }
  __syncthreads();
  if (jmap == 0) {
    float ss[16];
#pragma unroll
    for (int r = 0; r < 16; ++r) { float s = 0.f;
#pragma unroll
      for (int d0 = 0; d0 < 4; ++d0) { const float df = o[d0][r] - lam * xch[(d0 * 16 + r) * 64]; o[d0][r] = df; s += df * df; }
      ss[r] = s; }
#pragma unroll
    for (int r = 0; r < 16; ++r) { float s = ss[r]; s += sx<1>(s); s += sx<2>(s); s += sx<4>(s); s += sx<8>(s); s += sx<16>(s);
      ss[r] = rsqrtf(s * (1.0f / 128.0f) + 1e-6f) * omli; }
    float gs[4]; int r32o = r32; asm volatile("" : "+v"(r32o));
#pragma unroll
    for (int d0 = 0; d0 < 4; ++d0) gs[d0] = subg[d0 * 32 + r32o];
    bf16* stg = (bf16*)(lds + 65536) + wq * 4096;
    int sto = 4 * hi * 128 + r32; asm volatile("" : "+v"(sto));
#pragma unroll
    for (int r = 0; r < 16; ++r) { const int orow = (r & 3) + 8 * (r >> 2);
#pragma unroll
      for (int d0 = 0; d0 < 4; ++d0) stg[sto + orow * 128 + d0 * 32] = (bf16)f2bf(o[d0][r] * ss[r] * gs[d0]); }
    asm volatile("s_waitcnt lgkmcnt(0)" ::: "memory");
    unsigned ooff = (unsigned)((q0 + (lane >> 4)) * 2048 + (lane & 15) * 8); asm volatile("" : "+v"(ooff));
    bf16* Ow = OB + rowbase * 2048 + h * 128 + ooff;
#pragma unroll
    for (int i = 0; i < 8; ++i) { const u32x4 v = *(const u32x4*)(stg + (4 * i + (lane >> 4)) * 128 + (lane & 15) * 8); *(u32x4*)(Ow + (4 * i) * 2048) = v; }
  }
  if (tid == 0) *qslot = nxt_unit;
  __syncthreads();
#undef DMA_K
#undef DMA_V
#undef WAIT_BAR
#undef ROT
#undef STEP
#undef TILE_LOOP
#undef QKT
}
#undef KSWZ
#undef SBAR
}
constexpr int DM = 2048, NB = 4, SEQ = 8192, MT = NB * SEQ, FF = 5632, NLAYER = 4, NH = 16, NMOD = 9 * DM;
constexpr float RMS_EPS = 1e-6f;
constexpr int NWAVES = 8;
#ifndef PROBE_MASK
#define PROBE_MASK 0
#endif
#ifndef PROBE_IDLE
#define PROBE_IDLE 0
#endif
#ifndef PROBE_ECHO
#define PROBE_ECHO 0
#endif
#ifndef FFN_SPLIT
#define FFN_SPLIT 1
#endif
#ifndef GU_WGM
#define GU_WGM 8
#endif
#ifndef OUT_A_AUX
#define OUT_A_AUX 0
#endif
#ifndef OUT_WGM
#define OUT_WGM 4
#endif
#ifndef MK_PER_PHASE
#define MK_PER_PHASE 0
#endif
constexpr int N_PHASES = 32 + 8 * 2 * (FFN_SPLIT - 1);
constexpr size_t MiB = 1u << 20;
constexpr size_t WS_CTL = 0, CTL_ZERO_BYTES = 3 * MiB;
constexpr size_t WS_MOD = 1696 * MiB;
constexpr size_t WS_EBL = 3 * MiB;
constexpr size_t WS_WGU = 8 * MiB;
constexpr size_t WS_WD  = 360 * MiB;
constexpr size_t WS_WAI = 536 * MiB;
constexpr size_t WS_WAO = 584 * MiB;
constexpr size_t WS_WCI = 600 * MiB, WS_WCO = 624 * MiB;
constexpr size_t WS_WHI = 632 * MiB, WS_WHO = 664 * MiB;
constexpr size_t WS_XN  = 672 * MiB;
constexpr size_t WS_BIG = 800 * MiB;
constexpr size_t WS_OB  = 1312 * MiB;
constexpr size_t WS_KLT = 1440 * MiB;
constexpr size_t WS_IT  = 1568 * MiB;
constexpr size_t WS_RSS = 1 * MiB, RSS_BYTES = 2 * MiB;
constexpr size_t WS_CB  = 1698 * MiB;
constexpr int CB_LD = 2 * 5632;
constexpr size_t WS_TAB = 1701 * MiB;
constexpr size_t WS_XH  = 1702 * MiB;
constexpr size_t WS_END = 1830 * MiB;
constexpr int CW_BAR = 4096;
constexpr int RING_OFF = 0, RING_BYTES = 131072;
constexpr int LDSCTL_OFF = RING_BYTES, MISC_OFF = LDSCTL_OFF + 320;
constexpr int PRE_OFF = LDSCTL_OFF + 1024;
constexpr int LDS_BYTES = 147456;

struct Args { const float* in[21]; float* out; unsigned char* ws; int ph_lo, ph_hi; };
struct Frame {
    LAS unsigned char* lds;
    volatile LAS unsigned* MISC;
    gu32* ctl;
    int tid, lane, wave, vcu, G;
    const struct Args* a; float* out; unsigned char* ws;
};
__device__ __forceinline__ float bf_lo(unsigned w) { return __uint_as_float(w << 16); }
__device__ __forceinline__ float bf_hi(unsigned w) { return __uint_as_float(w & 0xffff0000u); }
__device__ __forceinline__ float bf_f(bf16 x) { return __uint_as_float((unsigned)x << 16); }

__device__ __forceinline__ void unpack8(const v4u w, float (&x)[8]) { x[0] = bf_lo(w.x); x[1] = bf_hi(w.x); x[2] = bf_lo(w.y); x[3] = bf_hi(w.y); x[4] = bf_lo(w.z); x[5] = bf_hi(w.z); x[6] = bf_lo(w.w); x[7] = bf_hi(w.w); }
__device__ __forceinline__ void p0_mod(Frame& F) {
    LAS float* cond = (LAS float*)(F.lds);
    LAS float* part = (LAS float*)(F.lds + 32768);
    const float* c = F.a->in[1]; const float* aw = F.a->in[2]; const float* ab = F.a->in[3]; float* mod = (float*)(F.ws + WS_MOD);
    for (int i = F.tid; i < NB * DM; i += NWAVES * 64) { const float v = c[i]; cond[i] = v / (1.0f + __expf(-v)); }
    __syncthreads();
    const int cg = F.tid & 15, ks = F.tid >> 4;
    for (int it = F.vcu; it < NLAYER * (NMOD / 64); it += F.G) {
        const int L = it / (NMOD / 64), n0 = (it % (NMOD / 64)) * 64;
        f32x4 a0 = {0.f, 0.f, 0.f, 0.f}, a1 = a0, a2 = a0, a3 = a0;
        const float* wp = aw + ((size_t)L * DM + ks * 64) * NMOD + n0 + 4 * cg;
#pragma unroll 8
        for (int k = 0; k < 64; ++k) { const f32x4 w = *(const f32x4*)(wp + (size_t)k * NMOD); const int kk = ks * 64 + k;
            a0 += w * cond[kk]; a1 += w * cond[DM + kk]; a2 += w * cond[2 * DM + kk]; a3 += w * cond[3 * DM + kk]; }
        *(LAS f32x4*)(part + (ks * 4 + 0) * 64 + 4 * cg) = a0; *(LAS f32x4*)(part + (ks * 4 + 1) * 64 + 4 * cg) = a1;
        *(LAS f32x4*)(part + (ks * 4 + 2) * 64 + 4 * cg) = a2; *(LAS f32x4*)(part + (ks * 4 + 3) * 64 + 4 * cg) = a3;
        __syncthreads();
        if (F.tid < 256) { const int b = F.tid >> 6, col = F.tid & 63; float s = 0.f;
#pragma unroll 8
            for (int k2 = 0; k2 < 32; ++k2) s += part[(k2 * 4 + b) * 64 + col];
            mod[((size_t)L * NB + b) * NMOD + n0 + col] = s + ab[(size_t)L * NMOD + n0 + col]; }
        __syncthreads();
    }
}
struct CvItem { const float* W; bf16* WT; int K, N, mode, item; };
__device__ __forceinline__ CvItem cv_decode(Frame& F, int it) {
    constexpr int I_FFN = (DM / 64) * (FF / 32);
    constexpr int I_IN3 = (DM / 64) * (3 * DM / 32), I_SQ = (DM / 64) * (DM / 32), I_IN4 = (DM / 64) * (4 * DM / 32);
    int r = it;
    if (r < 24 * I_FFN) { const int m = r / I_FFN, ls = m / 3, which = m % 3; r -= m * I_FFN;
        if (which == 0) return CvItem{F.a->in[5] + (size_t)ls * DM * FF, (bf16*)(F.ws + WS_WGU) + (size_t)ls * 2 * FF * DM, DM, FF, 1, r};
        if (which == 1) return CvItem{F.a->in[6] + (size_t)ls * DM * FF, (bf16*)(F.ws + WS_WGU) + (size_t)ls * 2 * FF * DM, DM, FF, 2, r};
        return CvItem{F.a->in[7] + (size_t)ls * FF * DM, (bf16*)(F.ws + WS_WD) + (size_t)ls * DM * FF, FF, DM, 0, r}; }
    r -= 24 * I_FFN;
    if (r < 2 * I_IN3) { const int s = r / I_IN3; return CvItem{F.a->in[8] + (size_t)s * DM * 3 * DM, (bf16*)(F.ws + WS_WAI) + (size_t)s * 3 * DM * DM, DM, 3 * DM, 3, r - s * I_IN3}; } r -= 2 * I_IN3;
    if (r < 2 * I_SQ) { const int s = r / I_SQ; return CvItem{F.a->in[9] + (size_t)s * DM * DM, (bf16*)(F.ws + WS_WAO) + (size_t)s * DM * DM, DM, DM, 0, r - s * I_SQ}; } r -= 2 * I_SQ;
    if (r < I_IN3) return CvItem{F.a->in[14], (bf16*)(F.ws + WS_WCI), DM, 3 * DM, 0, r}; r -= I_IN3;
    if (r < I_SQ) return CvItem{F.a->in[16], (bf16*)(F.ws + WS_WCO), DM, DM, 0, r}; r -= I_SQ;
    if (r < I_IN4) return CvItem{F.a->in[17], (bf16*)(F.ws + WS_WHI), DM, 4 * DM, 0, r}; r -= I_IN4;
    return CvItem{F.a->in[18], (bf16*)(F.ws + WS_WHO), DM, DM, 0, r};
}
__device__ __forceinline__ void cv_load(const CvItem& c, float (&wv)[32], int lane) {
    const int nblk = c.N / 32, kb = c.item / nblk, nb = c.item % nblk;
    const float* wp = c.W + (size_t)(64 * kb + (lane >> 5)) * c.N + 32 * nb + (lane & 31);
#pragma unroll
    for (int i = 0; i < 32; ++i) wv[i] = wp[(size_t)(2 * i) * c.N];
}
__device__ __forceinline__ void cv_finish(const CvItem& c, const float (&wv)[32], LAS float* scr, int lane) {
    const int K = c.K, mode = c.mode, nblk = c.N / 32, kb = c.item / nblk, nb = c.item % nblk, n0 = 32 * nb;
    const int drow0 = (mode == 0 || (mode == 3 && n0 >= 2 * DM)) ? n0 : (mode == 3) ? ((n0 & ~255) + 128 * ((n0 >> 5) & 1) + 32 * ((n0 >> 6) & 3)) : ((n0 >> 7) * 256 + (mode - 1) * 128 + (n0 & 127));
#pragma unroll
    for (int i = 0; i < 32; ++i) scr[(2 * i + (lane >> 5)) * 33 + (lane & 31)] = wv[i];
    LDS_WAIT(); asm volatile("" ::: "memory");
    const int cc = lane & 7;
#pragma unroll
    for (int j = 0; j < 4; ++j) { const int n = (lane >> 3) + 8 * j; const LAS float* s = scr + (8 * cc) * 33 + n;
        v4u o; o.x = pk2(s[0 * 33], s[1 * 33]); o.y = pk2(s[2 * 33], s[3 * 33]); o.z = pk2(s[4 * 33], s[5 * 33]); o.w = pk2(s[6 * 33], s[7 * 33]);
        const int dr = drow0 + n;
        *(GAS v4u*)(c.WT + ((size_t)((dr >> 8) * (K >> 6) + kb) * 256 + (dr & 255)) * 64 + 8 * cc) = o; }
    LDS_WAIT(); asm volatile("" ::: "memory");
}
__device__ __forceinline__ void p0_convert(Frame& F) {
    LAS float* scr = (LAS float*)(F.lds + RING_OFF + F.wave * 16384);
    const int gw = F.vcu * NWAVES + F.wave, NGW = F.G * NWAVES;
    constexpr int NITEMS = 24 * ((DM / 64) * (FF / 32)) + 3 * ((DM / 64) * (3 * DM / 32)) + 4 * ((DM / 64) * (DM / 32)) + (DM / 64) * (4 * DM / 32);
    CvItem A, B; float wa[32], wb[32];
    int it = gw;
    if (it < NITEMS) { A = cv_decode(F, it); cv_load(A, wa, F.lane); }
    while (it < NITEMS) {
        int nx = it + NGW;
        if (nx < NITEMS) { B = cv_decode(F, nx); cv_load(B, wb, F.lane); }
        cv_finish(A, wa, scr, F.lane);
        it = nx; if (it >= NITEMS) break;
        nx = it + NGW;
        if (nx < NITEMS) { A = cv_decode(F, nx); cv_load(A, wa, F.lane); }
        cv_finish(B, wb, scr, F.lane);
        it = nx;
    }
}
__device__ __forceinline__ void xs0_phase(Frame& F, const float* xsrc, const float* g, const float* modL) {
    bf16* XN = (bf16*)(F.ws + WS_XN); float* rss = (float*)(F.ws + WS_RSS);
    const int gw = F.vcu * NWAVES + F.wave, NGW = F.G * NWAVES;
    for (int r0 = gw * 16; r0 < MT; r0 += NGW * 16) {
        const int b = r0 / SEQ;
        const float* sc = modL + (size_t)b * NMOD + DM;
        f32x4 a[8];
#pragma unroll
        for (int j = 0; j < 8; ++j) { const int col = 4 * F.lane + 256 * j; a[j] = *(const f32x4*)(g + col) * (*(const f32x4*)(sc + col) + 1.0f); }
#pragma unroll 2
        for (int r = 0; r < 16; ++r) {
            const GAS f32x4* xr = (const GAS f32x4*)(xsrc + (size_t)(r0 + r) * DM) + F.lane;
            f32x4 v[8]; float s = 0.f;
#pragma unroll
            for (int j = 0; j < 8; ++j) { v[j] = xr[64 * j]; s += (v[j].x * v[j].x + v[j].y * v[j].y) + (v[j].z * v[j].z + v[j].w * v[j].w); }
            s = wave_sum(s);
            if (F.lane == 0) rss[r0 + r] = s;
            bf16* o8 = XN + ((size_t)((r0 + r) >> 8) * 32 * 256 + ((r0 + r) & 255)) * 64 + (size_t)(F.lane >> 4) * (256 * 64) + 4 * (F.lane & 15);
#pragma unroll
            for (int j = 0; j < 8; ++j) { const f32x4 h = v[j] * a[j];
                *(GAS unsigned long long*)(o8 + (size_t)(4 * j) * (256 * 64)) = (unsigned long long)pk2(h.x, h.y) | ((unsigned long long)pk2(h.z, h.w) << 32); }
        }
    }
}
__device__ __forceinline__ void tables_phase(Frame& F) {
    const float* mod = (const float*)(F.ws + WS_MOD); float* TAB = (float*)(F.ws + WS_TAB); const float* ng = F.a->in[4];
    const int gt = F.vcu * (NWAVES * 64) + F.tid, NT = F.G * NWAVES * 64;
    for (int i = gt; i < 3 * NLAYER * NB * DM; i += NT) {
        const int col = i % DM, b = (i / DM) % NB, s = i / (DM * NB), L = s / 3, sub = s % 3, sn = s + 1, Ln = sn / 3, subn = sn % 3;
        TAB[((size_t)(s * 2 + 0) * NB + b) * DM + col] = ((sub == 1) ? 1.0f : 0.5f) * mod[((size_t)L * NB + b) * NMOD + (3 * sub + 2) * DM + col];
        TAB[((size_t)(s * 2 + 1) * NB + b) * DM + col] = (sn < 3 * NLAYER) ? ng[((size_t)Ln * 3 + subn) * DM + col] * (1.0f + mod[((size_t)Ln * NB + b) * NMOD + (3 * subn + 1) * DM + col]) : 0.f;
    }
}
__device__ __forceinline__ void bias_phase(Frame& F) {
    const float* mod = (const float*)(F.ws + WS_MOD); float* CB = (float*)(F.ws + WS_CB);
    const int gw = F.vcu * NWAVES + F.wave, NGW = F.G * NWAVES;
#pragma unroll 1
    for (int s = 0; s < 3 * NLAYER; ++s) {
        const int L = s / 3, sub = s % 3, kind = L % 3, slot = L / 3;
        const bf16* W; int N;
        if (sub != 1) { W = (const bf16*)(F.ws + WS_WGU) + (size_t)(L * 2 + (sub >> 1)) * 2 * FF * DM; N = 2 * FF; }
        else if (kind == 0) { W = (const bf16*)(F.ws + WS_WAI) + (size_t)slot * 3 * DM * DM; N = 3 * DM; }
        else if (kind == 1) { W = (const bf16*)(F.ws + WS_WCI); N = 3 * DM; }
        else { W = (const bf16*)(F.ws + WS_WHI); N = 4 * DM; }
        float sh[4][4][8];
#pragma unroll
        for (int b = 0; b < NB; ++b)
#pragma unroll
            for (int it = 0; it < 4; ++it) { const float* sp = mod + ((size_t)L * NB + b) * NMOD + (3 * sub) * DM + 8 * (64 * it + F.lane);
                const f32x4 s0 = *(const f32x4*)sp, s1 = *(const f32x4*)(sp + 4);
                sh[b][it][0] = s0.x; sh[b][it][1] = s0.y; sh[b][it][2] = s0.z; sh[b][it][3] = s0.w; sh[b][it][4] = s1.x; sh[b][it][5] = s1.y; sh[b][it][6] = s1.z; sh[b][it][7] = s1.w; }
        for (int n = gw; n < N; n += NGW) {
            const bf16* wrow = W + ((size_t)(n >> 8) * (DM >> 6) * 256 + (n & 255)) * 64 + (F.lane & 7) * 8;
            float d0 = 0.f, d1 = 0.f, d2 = 0.f, d3 = 0.f;
#pragma unroll
            for (int it = 0; it < 4; ++it) { float w[8]; unpack8(*(const GAS v4u*)(wrow + (size_t)(8 * it + (F.lane >> 3)) * 256 * 64), w);
#pragma unroll
                for (int i = 0; i < 8; ++i) { d0 += w[i] * sh[0][it][i]; d1 += w[i] * sh[1][it][i]; d2 += w[i] * sh[2][it][i]; d3 += w[i] * sh[3][it][i]; } }
            d0 = wave_sum(d0); d1 = wave_sum(d1); d2 = wave_sum(d2); d3 = wave_sum(d3);
            if (F.lane == 0) { float* cp = CB + (size_t)s * NB * CB_LD + n; cp[0] = d0; cp[CB_LD] = d1; cp[2 * CB_LD] = d2; cp[3 * CB_LD] = d3; }
        }
    }
}
constexpr int CW_ATTNQ = 8192;
__device__ __forceinline__ void attn_phase(Frame& F, int L, int slot, int qword = 0) {
    const bf16* QKV = (const bf16*)(F.ws + WS_BIG); bf16* OB = (bf16*)(F.ws + WS_OB);
    const float* lv = F.a->in[12] + (size_t)slot * 4 * 64;
    int ln = F.lane; asm volatile("" : "+v"(ln));
    const float sa = wave_sum(lv[ln] * lv[64 + ln]), sb = wave_sum(lv[128 + ln] * lv[192 + ln]);
    asm volatile("" : "+s"(L));
    const float lambda_init = (L == 0) ? 0.2f : (L == 1) ? 0.35550906f : (L == 2) ? 0.47071302f : 0.55605822f;
    const float lam = expf(sa) - expf(sb) + lambda_init;
    const float* subg = F.a->in[13] + (size_t)slot * 128;
    float gm = fabsf(F.a->in[10][slot * 64 + ln] * F.a->in[11][slot * 64 + ln]);
    gm = wave_max(gm);
    const float twoB24 = 16.0f * gm + 17.0f;
    const float m_ref = (8.0f * gm) * 1.4426950408889634f * 1.02f + 0.5f;
    gu32* qbase = F.ctl + CW_ATTNQ + 64 * slot + 256 * qword;
    int cur = (int)blockIdx.x & 7, tried = 0;
    if (F.tid == 0) F.MISC[16] = __hip_atomic_fetch_add(qbase + cur, 1u, RLX_AGENT);
    __syncthreads();
    int n = (int)F.MISC[16];
    for (;;) {
        const int grp = cur >> 2, cnt = grp ? 11 * 64 : 5 * 64;
        if (n >= cnt) {
            if (++tried == 8) break;
            cur = (cur + 1) & 7;
            __syncthreads();
            if (F.tid == 0) F.MISC[16] = __hip_atomic_fetch_add(qbase + cur, 1u, RLX_AGENT);
            __syncthreads();
            n = (int)F.MISC[16];
            continue;
        }
        const unsigned long long hl = grp ? 0x012456789CEull : 0x3ABDFull;
        const int qb = 63 - (n & 63), h = (int)((hl >> (4 * (n >> 6))) & 15ull), b = cur & 3;
        const float slope = exp2f(-0.5f * (float)(h + 1));
        const float W = (twoB24 - __logf(1.0f - __expf(-slope))) / slope;
        int tb = (int)floorf(((float)(128 * qb) - W) * (1.0f / 64.0f)); tb = (tb < 0 ? 0 : tb);
        att::attn_unit(F.tid, b, h, qb, tb, QKV, OB, lam, 1.0f - lambda_init, slope * 1.4426950408889634f, m_ref, subg, (char*)(F.lds + RING_OFF), qbase + cur, F.MISC + 16);
        n = (int)F.MISC[16];
    }
}
__device__ __forceinline__ void conv_phase(Frame& F) {
    const bf16* U = (const bf16*)(F.ws + WS_BIG); bf16* OB = (bf16*)(F.ws + WS_OB); const float* cw = F.a->in[15];
    const int gt = F.vcu * (NWAVES * 64) + F.tid, NT = F.G * NWAVES * 64;
    for (int item = gt; item < 256 * (MT / 16); item += NT) {
        int dg = item & 255; asm volatile("" : "+v"(dg));
        const int run = item >> 8, row0 = run * 16, d = dg * 8;
        float w0[8], w1[8], w2[8];
#pragma unroll
        for (int i = 0; i < 8; ++i) { w0[i] = cw[d + i]; w1[i] = cw[DM + d + i]; w2[i] = cw[2 * DM + d + i]; }
        float vm2[8], vm1[8];
        if ((row0 % SEQ) == 0) {
#pragma unroll
            for (int i = 0; i < 8; ++i) { vm2[i] = 0.f; vm1[i] = 0.f; }
        } else {
            float a[8], b[8];
            unpack8(*(const GAS v4u*)(U + (size_t)(row0 - 2) * 6144 + 2048 + d), a); unpack8(*(const GAS v4u*)(U + (size_t)(row0 - 2) * 6144 + 4096 + d), b);
#pragma unroll
            for (int i = 0; i < 8; ++i) vm2[i] = a[i] * b[i];
            unpack8(*(const GAS v4u*)(U + (size_t)(row0 - 1) * 6144 + 2048 + d), a); unpack8(*(const GAS v4u*)(U + (size_t)(row0 - 1) * 6144 + 4096 + d), b);
#pragma unroll
            for (int i = 0; i < 8; ++i) vm1[i] = a[i] * b[i];
        }
#pragma unroll 4
        for (int t = 0; t < 16; ++t) {
            const bf16* rp = U + (size_t)(row0 + t) * 6144 + d;
            float bg[8], cg[8], uu[8], y[8];
            unpack8(*(const GAS v4u*)(rp), bg); unpack8(*(const GAS v4u*)(rp + 2048), cg); unpack8(*(const GAS v4u*)(rp + 4096), uu);
#pragma unroll
            for (int i = 0; i < 8; ++i) { const float v = cg[i] * uu[i]; y[i] = bg[i] * (w0[i] * vm2[i] + w1[i] * vm1[i] + w2[i] * v); vm2[i] = vm1[i]; vm1[i] = v; }
            v4u o; o.x = pk2(y[0], y[1]); o.y = pk2(y[2], y[3]); o.z = pk2(y[4], y[5]); o.w = pk2(y[6], y[7]);
            *(GAS v4u*)(OB + (size_t)(row0 + t) * DM + d) = o;
        }
    }
}
#define LDS_BAR() asm volatile("s_waitcnt lgkmcnt(0)\n\ts_barrier" ::: "memory")
typedef short s16x4 __attribute__((ext_vector_type(4)));
typedef float f32x16 __attribute__((ext_vector_type(16)));
__device__ __forceinline__ int crow16(int r, int hi) { return (r & 3) + 8 * (r >> 2) + 4 * hi; }
constexpr int H_P256 = 272, H_P128 = 144;
__device__ __forceinline__ void hgrn_prep_phase(Frame& F, int layer, bf16* QBO, int qbld, bf16* OBO) {
    bf16* BIG = (bf16*)(F.ws + WS_BIG); bf16* KLT = (bf16*)(F.ws + WS_KLT); bf16* ITG = (bf16*)(F.ws + WS_IT); float* EBL = (float*)(F.ws + WS_EBL); bf16* OB = (bf16*)(F.ws + WS_OB);
    const float* lbl = F.a->in[20];
    LAS unsigned char* QS = F.lds; LAS unsigned char* KS = F.lds + 64 * H_P256; LAS unsigned char* ITL = F.lds + 2 * 64 * H_P256; LAS float* TOT = (LAS float*)(F.lds + 2 * 64 * H_P256 + 128 * H_P128);
    const int kp = F.lane, seg = F.wave, r32 = F.lane & 31, hi = F.lane >> 5;
    unsigned qw[8], fw[8], iw[8]; f32x2_cv lgt[4];
#define H1_LOAD(un) do { const int bh_ = (un) >> 7, c_ = (un) & 127; const size_t rb_ = (size_t)(bh_ >> 4) * SEQ + (size_t)c_ * 64; \
        _Pragma("unroll") for (int L_ = 0; L_ < 4; ++L_) lgt[L_] = *(const GAS f32x2_cv*)(lbl + L_ * DM + (bh_ & 15) * 128 + 2 * kp); \
        _Pragma("unroll") for (int tt = 0; tt < 8; ++tt) { const bf16* pq = BIG + (rb_ + 8 * seg + tt) * 8192 + (bh_ & 15) * 128 + 2 * kp; \
            qw[tt] = *(const GAS unsigned*)pq; fw[tt] = *(const GAS unsigned*)(pq + 2048); iw[tt] = *(const GAS unsigned*)(pq + 4096); } } while (0)
    for (int unit = F.vcu; unit < NB * NH * (SEQ / 64); unit += F.G) {
        const int bh = unit >> 7, c = unit & 127, b = bh >> 4, h = bh & 15; const size_t rowbase = (size_t)b * SEQ + (size_t)c * 64;
        if (unit == F.vcu) H1_LOAD(unit);
        float lb[2];
#pragma unroll
        for (int kk = 0; kk < 2; ++kk) { const float l0 = lgt[0][kk], l1 = lgt[1][kk], l2 = lgt[2][kk], l3 = lgt[3][kk];
            const float mx = fmaxf(fmaxf(l0, l1), fmaxf(l2, l3)); const float e0 = __expf(l0 - mx), e1 = __expf(l1 - mx), e2 = __expf(l2 - mx), e3 = __expf(l3 - mx);
            float cumv = 0.f; if (layer >= 1) cumv += e1; if (layer >= 2) cumv += e2; if (layer >= 3) cumv += e3;
            lb[kk] = cumv * __builtin_amdgcn_rcpf(e0 + e1 + e2 + e3); }
        float bcs[8][2], kv[8][2]; float cum[2] = {0.f, 0.f};
#pragma unroll
        for (int tt = 0; tt < 8; ++tt)
#pragma unroll
            for (int kk = 0; kk < 2; ++kk) { const float x = kk ? bf_hi(fw[tt]) : bf_lo(fw[tt]); const float sig = __builtin_amdgcn_rcpf(1.0f + __expf(-x));
                const float f = lb[kk] + (1.0f - lb[kk]) * sig; cum[kk] += __builtin_amdgcn_logf(f) * 0.6931471805599453f;     bcs[tt][kk] = cum[kk]; kv[tt][kk] = 1.0f - f; }
        TOT[seg * 128 + 2 * kp] = cum[0]; TOT[seg * 128 + 2 * kp + 1] = cum[1];
        LDS_BAR();
        float off[2] = {0.f, 0.f}, rb[2] = {0.f, 0.f}, bl[2] = {0.f, 0.f};
#pragma unroll
        for (int s = 0; s < 8; ++s)
#pragma unroll
            for (int kk = 0; kk < 2; ++kk) { const float tv = TOT[s * 128 + 2 * kp + kk]; if (s < seg) off[kk] += tv; if (s < 4) rb[kk] += tv; bl[kk] += tv; }
        float erb[2], enrb[2], ebl[2];
#pragma unroll
        for (int kk = 0; kk < 2; ++kk) { erb[kk] = __expf(rb[kk]); enrb[kk] = __expf(-rb[kk]); ebl[kk] = __expf(bl[kk]); }
        unsigned klw[2][4], itw[2][4];
#pragma unroll
        for (int tt = 0; tt < 8; ++tt) { float qb_[2], qs_[2], ks_[2], kl_[2];
#pragma unroll
            for (int kk = 0; kk < 2; ++kk) { const float bb = bcs[tt][kk] + off[kk]; const float q = kk ? bf_hi(qw[tt]) : bf_lo(qw[tt]);
                const float eb = __expf(bb), enb = __builtin_amdgcn_rcpf(eb);
                qb_[kk] = q * eb; qs_[kk] = qb_[kk] * enrb[kk]; ks_[kk] = kv[tt][kk] * (erb[kk] * enb); kl_[kk] = kv[tt][kk] * (ebl[kk] * enb); }
            *(GAS unsigned*)(QBO + (rowbase + 8 * seg + tt) * qbld + h * 128 + 2 * kp) = pk2(qb_[0], qb_[1]);
            *(LAS unsigned*)(QS + (8 * seg + tt) * H_P256 + 4 * kp) = pk2(qs_[0], qs_[1]);
            *(LAS unsigned*)(KS + (8 * seg + tt) * H_P256 + 4 * kp) = pk2(ks_[0], ks_[1]);
            if (tt & 1) { klw[0][tt >> 1] |= f2bf(kl_[0]) << 16; klw[1][tt >> 1] |= f2bf(kl_[1]) << 16; itw[0][tt >> 1] |= (iw[tt] & 0xffffu) << 16; itw[1][tt >> 1] |= (iw[tt] >> 16) << 16; }
            else { klw[0][tt >> 1] = f2bf(kl_[0]); klw[1][tt >> 1] = f2bf(kl_[1]); itw[0][tt >> 1] = iw[tt] & 0xffffu; itw[1][tt >> 1] = iw[tt] >> 16; }
        }
#pragma unroll
        for (int kk = 0; kk < 2; ++kk) { const v4u kw = {klw[kk][0], klw[kk][1], klw[kk][2], klw[kk][3]}, tw = {itw[kk][0], itw[kk][1], itw[kk][2], itw[kk][3]};
            *(GAS v4u*)(KLT + (size_t)unit * 8192 + (2 * kp + kk) * 64 + 8 * seg) = kw;
            *(GAS v4u*)(ITG + (size_t)unit * 8192 + (2 * kp + kk) * 64 + 8 * seg) = tw;
            *(LAS v4u*)(ITL + (2 * kp + kk) * H_P128 + 16 * seg) = tw; }
        if (seg == 0) { EBL[(size_t)unit * 128 + 2 * kp] = ebl[0]; EBL[(size_t)unit * 128 + 2 * kp + 1] = ebl[1]; }
        LDS_BAR();
        if (unit + F.G < NB * NH * (SEQ / 64)) H1_LOAD(unit + F.G);
        const int tt_ = F.wave & 1, vt = F.wave >> 1;
        f32x16 z = {};
        for (int st = 0; st <= tt_; ++st) {
            f32x16 x = {};
            bf16x8 af[8], bqf[8];
#pragma unroll
            for (int step = 0; step < 8; ++step) { af[step] = *(const LAS bf16x8*)(KS + (32 * st + r32) * H_P256 + (16 * step + 8 * hi) * 2);
                bqf[step] = *(const LAS bf16x8*)(QS + (32 * tt_ + r32) * H_P256 + (16 * step + 8 * hi) * 2); }
#pragma unroll
            for (int step = 0; step < 8; ++step) x = __builtin_amdgcn_mfma_f32_32x32x16_bf16(af[step], bqf[step], x, 0, 0, 0);
            if (st == tt_) {
#pragma unroll
                for (int r = 0; r < 16; ++r) if (crow16(r, hi) > r32) x[r] = 0.f;
            }
#pragma unroll
            for (int sp = 0; sp < 2; ++sp) {
                v4u pw; pw.x = pk2(x[8 * sp + 0], x[8 * sp + 1]); pw.y = pk2(x[8 * sp + 2], x[8 * sp + 3]); pw.z = pk2(x[8 * sp + 4], x[8 * sp + 5]); pw.w = pk2(x[8 * sp + 6], x[8 * sp + 7]);
                const bf16x8 xs = __builtin_bit_cast(bf16x8, pw);
                const LAS unsigned char* ip = ITL + (32 * vt + r32) * H_P128 + (32 * st + 16 * sp + 4 * hi) * 2;
                const s16x4 lo = *(const LAS s16x4*)ip, hh = *(const LAS s16x4*)(ip + 16);
                const bf16x8 pb = __builtin_shufflevector(lo, hh, 0, 1, 2, 3, 4, 5, 6, 7);
                z = __builtin_amdgcn_mfma_f32_32x32x16_bf16(xs, pb, z, 0, 0, 0);
            }
        }
        bf16* op = OBO + (rowbase + 32 * tt_) * DM + h * 128 + 32 * vt + r32;
#pragma unroll
        for (int r = 0; r < 16; ++r) op[(size_t)crow16(r, hi) * DM] = (bf16)f2bf(z[r]);
        LDS_BAR();
    }
}
#undef H1_LOAD
__device__ __forceinline__ void hgrn_scan_phase(Frame& F, bf16* OBO) {
    const bf16* BIG = (const bf16*)(F.ws + WS_BIG); const bf16* KLT = (const bf16*)(F.ws + WS_KLT); const bf16* ITG = (const bf16*)(F.ws + WS_IT); const float* EBL = (const float*)(F.ws + WS_EBL); const bf16* OB = (const bf16*)(F.ws + WS_OB);
    constexpr int TB = 64 * H_P256 + 128 * H_P128 + 32 * H_P128 + 512;
    constexpr int STB = 32 * H_P256;
    constexpr int IOB = 64 * 64;
    LAS unsigned char* TL = F.lds; LAS unsigned char* STL = F.lds + 2 * TB; LAS unsigned char* ISL = STL + 2 * STB; LAS unsigned char* OSL = ISL + 2 * IOB;
    const int tid = F.tid, r32 = F.lane & 31, hi = F.lane >> 5, w = F.wave;
    for (int unit = F.vcu; unit < NB * NH * 4; unit += F.G) {
        const int bh = unit >> 2, vq = unit & 3, b = bh >> 4, h = bh & 15;
        f32x16 acc = {};
        v4u q0[2], k0[2], i0, e0, q1[2], k1[2], i1, e1, ivr[2];
        i0 = i1 = e0 = e1 = ivr[0] = ivr[1] = (v4u){(unsigned)tid >> 31, 0u, 0u, 0u};
        const int ioq = (F.lane + 64 * (w & 1));
#define H2_LOAD(Q, K, I, E, c) do { const size_t rb_ = (size_t)b * SEQ + (size_t)(c) * 64; const size_t un_ = (size_t)bh * 128 + (c); \
        _Pragma("unroll") for (int i_ = 0; i_ < 2; ++i_) { const int p_ = tid + 512 * i_; \
            Q[i_] = *(const GAS v4u*)(BIG + (rb_ + (p_ >> 4)) * 8192 + h * 128 + (p_ & 15) * 8); K[i_] = *(const GAS v4u*)(KLT + un_ * 8192 + (size_t)p_ * 8); } \
        if (tid < 256) I = *(const GAS v4u*)(ITG + un_ * 8192 + (size_t)(32 * vq) * 64 + (size_t)tid * 8); \
        if (tid < 32) E = *(const GAS v4u*)(EBL + un_ * 128 + 4 * tid); } while (0)
#define H2_WRITE(Q, K, I, E, bufo) do { LAS unsigned char* tb_ = TL + (bufo); _Pragma("unroll") for (int i_ = 0; i_ < 2; ++i_) { const int p_ = tid + 512 * i_; \
            *(LAS v4u*)(tb_ + (p_ >> 4) * H_P256 + (p_ & 15) * 16) = Q[i_]; *(LAS v4u*)(tb_ + 64 * H_P256 + (p_ >> 3) * H_P128 + (p_ & 7) * 16) = K[i_]; } \
        if (tid < 256) *(LAS v4u*)(tb_ + 64 * H_P256 + 128 * H_P128 + (tid >> 3) * H_P128 + (tid & 7) * 16) = I; \
        if (tid < 32) *(LAS v4u*)(tb_ + 64 * H_P256 + 128 * H_P128 + 32 * H_P128 + 16 * tid) = E; } while (0)
#define H2_IVLD(c) do { _Pragma("unroll") for (int j_ = 0; j_ < 2; ++j_) { const int q_ = ioq + 128 * j_; \
            ivr[j_] = *(const GAS v4u*)(OB + ((size_t)b * SEQ + (size_t)(c) * 64 + (q_ >> 2)) * DM + h * 128 + 32 * vq + (q_ & 3) * 8); } } while (0)
#define H2_IVST(slot) do { _Pragma("unroll") for (int j_ = 0; j_ < 2; ++j_) { const int q_ = ioq + 128 * j_; *(LAS v4u*)(ISL + (slot) * IOB + (q_ >> 2) * 64 + (q_ & 3) * 16) = ivr[j_]; } } while (0)
#define H2_OST(c, slot) do { _Pragma("unroll") for (int j_ = 0; j_ < 2; ++j_) { const int q_ = ioq + 128 * j_; const v4u v_ = *(const LAS v4u*)(OSL + (slot) * IOB + (q_ >> 2) * 64 + (q_ & 3) * 16); \
            *(GAS v4u*)(OBO + ((size_t)b * SEQ + (size_t)(c) * 64 + (q_ >> 2)) * DM + h * 128 + 32 * vq + (q_ & 3) * 8) = v_; } } while (0)
#define H2_STEP(c, cur, Qn, Kn, In, En) do { LAS unsigned char* tb_ = TL + (cur) * TB; LAS unsigned char* st_ = STL + (cur) * STB; \
          \
          \
        if (w >= 6 && (c) + 1 < SEQ / 64) H2_IVST((cur) ^ 1);      \
        if ((c) + 1 < SEQ / 64) H2_WRITE(Qn, Kn, In, En, ((cur) ^ 1) * TB); \
        if (w >= 6) { if ((c) + 2 < SEQ / 64) H2_IVLD((c) + 2); \
            if ((c) >= 1) H2_OST((c) - 1, (cur) ^ 1); }             \
        if ((c) + 3 < SEQ / 64) H2_LOAD(Qn, Kn, In, En, (c) + 3); \
        if (w < 4) { const LAS float* eb_ = (const LAS float*)(tb_ + 64 * H_P256 + 128 * H_P128 + 32 * H_P128); \
            _Pragma("unroll") for (int r = 0; r < 16; ++r) acc[r] *= eb_[32 * w + crow16(r, hi)]; \
            _Pragma("unroll") for (int step = 0; step < 4; ++step) { const bf16x8 a_ = *(const LAS bf16x8*)(tb_ + 64 * H_P256 + (32 * w + r32) * H_P128 + (16 * step + 8 * hi) * 2); \
                const bf16x8 b_ = *(const LAS bf16x8*)(tb_ + 64 * H_P256 + 128 * H_P128 + r32 * H_P128 + (16 * step + 8 * hi) * 2); acc = __builtin_amdgcn_mfma_f32_32x32x16_bf16(a_, b_, acc, 0, 0, 0); } \
            LAS unsigned char* sn_ = STL + ((cur) ^ 1) * STB + r32 * H_P256 + (32 * w + 4 * hi) * 2; \
            _Pragma("unroll") for (int g = 0; g < 4; ++g) *(LAS unsigned long long*)(sn_ + 16 * g) = (unsigned long long)pk2(acc[4 * g], acc[4 * g + 1]) | ((unsigned long long)pk2(acc[4 * g + 2], acc[4 * g + 3]) << 32); \
        } else if (w < 6) { f32x16 o_ = {}; \
            _Pragma("unroll") for (int step = 0; step < 8; ++step) { const bf16x8 a_ = *(const LAS bf16x8*)(tb_ + (32 * (w - 4) + r32) * H_P256 + (16 * step + 8 * hi) * 2); \
                const bf16x8 b_ = *(const LAS bf16x8*)(st_ + r32 * H_P256 + (16 * step + 8 * hi) * 2); o_ = __builtin_amdgcn_mfma_f32_32x32x16_bf16(a_, b_, o_, 0, 0, 0); } \
            const int so_ = (32 * (w - 4) + 4 * hi) * 64 + r32 * 2; bf16 iv_[16]; \
            _Pragma("unroll") for (int r = 0; r < 16; ++r) iv_[r] = *(const LAS bf16*)(ISL + (cur) * IOB + so_ + ((r & 3) + 8 * (r >> 2)) * 64);     \
            _Pragma("unroll") for (int r = 0; r < 16; ++r) *(LAS bf16*)(OSL + (cur) * IOB + so_ + ((r & 3) + 8 * (r >> 2)) * 64) = (bf16)f2bf(o_[r] + bf_f(iv_[r])); } \
        LDS_BAR(); } while (0)
        { const unsigned zz = (unsigned)tid >> 31;
          for (int i = tid; i < STB / 16; i += NWAVES * 64) *(LAS v4u*)(STL + 16 * i) = (v4u){zz, zz, zz, zz}; }
        H2_LOAD(q0, k0, i0, e0, 0); H2_WRITE(q0, k0, i0, e0, 0);
        H2_LOAD(q1, k1, i1, e1, 1); H2_LOAD(q0, k0, i0, e0, 2);
        if (w >= 6) { H2_IVLD(0); H2_IVST(0); H2_IVLD(1); }
        LDS_BAR();
#pragma unroll 1
        for (int c = 0; c < SEQ / 64; c += 2) {
            H2_STEP(c, 0, q1, k1, i1, e1);
            H2_STEP(c + 1, 1, q0, k0, i0, e0);
        }
        if (w >= 6) H2_OST(SEQ / 64 - 1, 1);
        LDS_BAR();
#undef H2_LOAD
#undef H2_WRITE
#undef H2_IVLD
#undef H2_IVST
#undef H2_OST
#undef H2_STEP
    }
}
__device__ __forceinline__ void hgrn_final_phase(Frame& F, bf16* OBO) {
    const bf16* BIG = (const bf16*)(F.ws + WS_BIG); bf16* OB = (bf16*)(F.ws + WS_OB); const float* gn = F.a->in[19];
    const int gw = F.vcu * NWAVES + F.wave, NGW = F.G * NWAVES;
    const int dv = (F.lane & 15) * 8;
    const f32x4 g0 = *(const f32x4*)(gn + dv), g1 = *(const f32x4*)(gn + dv + 4);
    for (int row = gw; row < MT; row += NGW) {
        GAS v4u* po = (GAS v4u*)(OB + (size_t)row * DM) + F.lane; const GAS v4u* pg = (const GAS v4u*)(BIG + (size_t)row * 8192 + 6144) + F.lane;
        v4u wo[4], wg[4];
#pragma unroll
        for (int it = 0; it < 4; ++it) { wo[it] = po[64 * it]; wg[it] = pg[64 * it]; }
#pragma unroll
        for (int it = 0; it < 4; ++it) { float x[8], gg[8]; unpack8(wo[it], x); unpack8(wg[it], gg);
            float ss = 0.f;
#pragma unroll
            for (int i = 0; i < 8; ++i) ss += x[i] * x[i];
            ss += sx<1>(ss); ss += sx<2>(ss); ss += sx<4>(ss); ss += sx<8>(ss);
            const float rstd = rsqrtf(ss * (1.0f / 128.0f) + RMS_EPS);
            float y[8];
#pragma unroll
            for (int i = 0; i < 8; ++i) { const float gi = (i < 4) ? g0[i] : g1[i - 4]; y[i] = x[i] * rstd * gi * (gg[i] * __builtin_amdgcn_rcpf(1.0f + __expf(-gg[i]))); }
            v4u o; o.x = pk2(y[0], y[1]); o.y = pk2(y[2], y[3]); o.z = pk2(y[4], y[5]); o.w = pk2(y[6], y[7]);
            ((GAS v4u*)(OBO + (size_t)row * DM) + F.lane)[64 * it] = o; }
    }
}
__device__ __forceinline__ bool ph_refresh(Frame& F) { unsigned m = ~0u; asm volatile("" : "+s"(m));
    const int t = (F.wave << 6) | (int)__builtin_amdgcn_mbcnt_hi(m, __builtin_amdgcn_mbcnt_lo(m, 0u));
    F.tid = t; F.lane = t & 63; return true; }
__global__ void __launch_bounds__(NWAVES * 64, 2) trunk_fwd(Args args) {
    extern __shared__ __attribute__((aligned(16))) unsigned char lds[];
    Frame F;
    F.lds = (LAS unsigned char*)lds;
    F.MISC = (volatile LAS unsigned*)(F.lds + MISC_OFF);
    F.tid = threadIdx.x; F.lane = F.tid & 63; F.wave = __builtin_amdgcn_readfirstlane(F.tid >> 6);
    F.G = gridDim.x; { const int bx = blockIdx.x; F.vcu = (F.G % 8 == 0) ? (bx % 8) * (F.G / 8) + bx / 8 : bx; }
    F.ws = args.ws; F.ctl = (gu32*)(args.ws + WS_CTL); F.out = args.out;
    F.a = &args;
    for (int u = F.tid; u < (LDS_BYTES - LDSCTL_OFF) / 4; u += NWAVES * 64) ((LAS unsigned*)(F.lds + LDSCTL_OFF))[u] = 0u;
    __syncthreads();
    XcdBarrier bar; bar.bar = (unsigned*)(F.ctl + CW_BAR); bar.x = 0; bar.st = nullptr;
    if (!MK_PER_PHASE) bar = xcd_barrier_post((unsigned*)(F.ctl + CW_BAR), F.MISC + 8);
    const int lo = args.ph_lo, hi = args.ph_hi;
    int pc = 0;
    unsigned long long t_ph = PROBE_ECHO ? __builtin_amdgcn_s_memrealtime() : 0ull;
#define PH_ON (pc >= lo && pc < hi && ph_refresh(F))
#define PH_END_C(cls) do { if (!MK_PER_PHASE && pc >= lo && pc + 1 < hi) { const unsigned long long ta_ = (PROBE_IDLE && (PROBE_IDLE == 100 || PROBE_IDLE == (cls))) ? __builtin_amdgcn_s_memrealtime() : 0ull; xcd_barrier(bar); if (PROBE_MASK & 32) xcd_barrier(bar); \
        if (PROBE_IDLE && (PROBE_IDLE == 100 || PROBE_IDLE == (cls))) { const unsigned long long t1_ = __builtin_amdgcn_s_memrealtime(), d_ = t1_ - ta_; while (__builtin_amdgcn_s_memrealtime() - t1_ < d_) __builtin_amdgcn_s_sleep(8); xcd_barrier(bar); } \
        if (PROBE_ECHO == (cls)) { const unsigned long long t1_ = __builtin_amdgcn_s_memrealtime(), d_ = t1_ - t_ph; while (__builtin_amdgcn_s_memrealtime() - t1_ < d_) __builtin_amdgcn_s_sleep(8); xcd_barrier(bar); } \
        if (PROBE_ECHO) t_ph = __builtin_amdgcn_s_memrealtime(); } ++pc; } while (0)
#define PH_END PH_END_C(0)
    float* mod = (float*)(F.ws + WS_MOD);
    bf16* XN = (bf16*)(F.ws + WS_XN); bf16* BIG = (bf16*)(F.ws + WS_BIG); bf16* OB = (bf16*)(F.ws + WS_OB);
    float* RSS = (float*)(F.ws + WS_RSS); const float* CB = (const float*)(F.ws + WS_CB);
    if (PH_ON) { p0_mod(F); __syncthreads(); p0_convert(F); }
#if PROBE_MASK & 16
    if (PH_ON) { __syncthreads(); p0_mod(F); __syncthreads(); p0_convert(F); }
#endif
    PH_END_C(1);
    if (PH_ON) { tables_phase(F); bias_phase(F); xs0_phase(F, F.a->in[0], F.a->in[4], mod); }
#if PROBE_MASK & 16384
    if (PH_ON) { tables_phase(F); bias_phase(F); xs0_phase(F, F.a->in[0], F.a->in[4], mod); }
#endif
    PH_END_C(2);
#pragma unroll 1
    for (int L = 0; L < NLAYER; ++L) {
        const int kind = L % 3, slot = L / 3;
        const float* modL = mod + (size_t)L * NB * NMOD;
#pragma unroll 1
        for (int sub = 0; sub < 3; ++sub) {
            const int s = 3 * L + sub;
            const float* rss = RSS + (size_t)s * MT; const float* cb = CB + (size_t)s * NB * CB_LD;
            const bf16* outA; const bf16* outB; int outK;
            const int nhalf = (sub != 1) ? FFN_SPLIT : 1;
#pragma unroll 1
            for (int hf = 0; hf < nhalf; ++hf) {
            const int Mpart = MT / nhalf, pm_off = hf * (Mpart / 256);
            if (sub != 1) {
                const int ls = L * 2 + (sub >> 1);
                if (PH_ON) { pg8::Gemm g{XN, (const bf16*)(F.ws + WS_WGU) + (size_t)ls * 2 * FF * DM, Mpart, 2 * FF, DM, 1, 1}; pg8::StaticOrder S; S.init(Mpart, 2 * FF, F.G, (int)blockIdx.x, GU_WGM, pm_off);
                    pg8::EpiSwigluN E{BIG, FF, rss, cb, CB_LD, SEQ, F.lds + PRE_OFF};
#pragma unroll 1
                    for (int rep = 0; rep < ((PROBE_MASK & 1) ? 2 : 1); ++rep) { if (rep) __syncthreads(); pg8::gemm_phase<pg8::EpiSwigluN, pg8::StaticOrder, true, true>(F.lds + RING_OFF, g, S, E, F.tid); }
                    }
                PH_END_C(3);
                outA = BIG; outB = (const bf16*)(F.ws + WS_WD) + (size_t)ls * DM * FF; outK = FF;
            } else {
                const int nin = (kind == 2) ? 4 * DM : 3 * DM;
                const bf16* win = (kind == 0) ? (const bf16*)(F.ws + WS_WAI) + (size_t)slot * 3 * DM * DM : (kind == 1) ? (const bf16*)(F.ws + WS_WCI) : (const bf16*)(F.ws + WS_WHI);
                if (PH_ON) { pg8::Gemm g{XN, win, MT, nin, DM, 1, 1}; pg8::StaticOrder S; S.init(MT, nin, F.G, (int)blockIdx.x, GU_WGM);
                    pg8::EpiInN E{BIG, nin, rss, cb, CB_LD, SEQ, (kind == 0) ? 16 : 0, F.a->in[10] + (size_t)slot * 64, F.a->in[11] + (size_t)slot * 64, F.lds + PRE_OFF};
#pragma unroll 1
                    for (int rep = 0; rep < ((PROBE_MASK & 4) ? 2 : 1); ++rep) { if (rep) __syncthreads(); pg8::gemm_phase<pg8::EpiInN, pg8::StaticOrder, true, true>(F.lds + RING_OFF, g, S, E, F.tid); }
                    }
                PH_END_C(5);
                if (kind == 0) {
#if PROBE_MASK & 8192
                    if (PH_ON) { attn_phase(F, L, slot, 1); __syncthreads(); }
#endif
                    if (PH_ON) attn_phase(F, L, slot);
                    PH_END_C(7);
                } else if (kind == 1) {
                    if (PH_ON) conv_phase(F);
                    PH_END_C(8);
                } else {
#if PROBE_MASK & 64
                    if (PH_ON) { hgrn_prep_phase(F, L, XN, DM, XN); __syncthreads(); }
#endif
                    if (PH_ON) hgrn_prep_phase(F, L, BIG, 8192, OB);
                    PH_END_C(9);
#if PROBE_MASK & 128
                    if (PH_ON) { hgrn_scan_phase(F, XN); __syncthreads(); }
#endif
                    if (PH_ON) hgrn_scan_phase(F, OB);
                    PH_END_C(10);
                    if (PH_ON) hgrn_final_phase(F, OB);
                    PH_END_C(11);
                }
                outA = OB; outB = (kind == 0) ? (const bf16*)(F.ws + WS_WAO) + (size_t)slot * DM * DM : (kind == 1) ? (const bf16*)(F.ws + WS_WCO) : (const bf16*)(F.ws + WS_WHO); outK = DM;
            }
            if (PH_ON) { pg8::Gemm g{outA, outB, Mpart, DM, outK, (sub != 1) ? 1 : 0, 1};     pg8::StaticOrder S; S.init(Mpart, DM, F.G, (int)blockIdx.x, OUT_WGM, pm_off);
                const int sn = s + 1; const bool last = (s == 3 * NLAYER - 1);
                const float* TAB = (const float*)(F.ws + WS_TAB);
                pg8::EpiResN E{(s == 0) ? (const void*)F.a->in[0] : (const void*)(F.ws + WS_XH), last ? (void*)F.out : (void*)(F.ws + WS_XH), (s == 0) ? 1 : 0, last ? 1 : 0, DM, TAB + (size_t)(s * 2 + 0) * NB * DM, TAB + (size_t)(s * 2 + 1) * NB * DM, DM, SEQ, last ? (bf16*)nullptr : XN, RSS + (size_t)sn * MT, F.lds + PRE_OFF, 1.0f};
#pragma unroll 1
                for (int rep = (((PROBE_MASK & 2) || ((PROBE_MASK & 2048) && sub != 1) || ((PROBE_MASK & 4096) && sub == 1)) ? 0 : 1); rep < 2; ++rep) {
                    pg8::EpiResN E2 = E;
#if PROBE_MASK & (2 | 2048 | 4096)
                    { const bool dbl = (PROBE_MASK & 2) || ((PROBE_MASK & 2048) && sub != 1) || ((PROBE_MASK & 4096) && sub == 1);
                      if (dbl) { E2.gscale = 0.5f; if (rep == 0) { E2.rssn = RSS + (size_t)12 * MT; if (last) { E2.out = (void*)(F.ws + WS_XH); E2.out_f32 = 0; } } else if (s == 0) { E2.base = (const void*)(F.ws + WS_XH); E2.base_f32 = 0; } } }
#endif
                    if (rep == 0) __syncthreads();
                    pg8::gemm_phase<pg8::EpiResN, pg8::StaticOrder, true, true, OUT_A_AUX>(F.lds + RING_OFF, g, S, E2, F.tid); if (rep == 0) __syncthreads(); } }
            PH_END_C((sub != 1) ? 4 : 6);
            }
        }
    }
#undef PH_ON
#undef PH_END
#undef PH_END_C
}
extern "C" void kernel_launch(void* const* d_in, const int* in_sizes, int n_in, void* d_out, int out_size, void* d_ws, size_t ws_size, hipStream_t stream) {
    static int grid = 0;
    if (grid == 0) {
        if (n_in != 21 || in_sizes[0] != MT * DM || out_size != MT * DM || ws_size < WS_END) { fprintf(stderr, "kernel_launch: shape/workspace mismatch (n_in %d, in0 %d, out %d, ws %zu, need %zu); nothing launched\n", n_in, n_in > 0 ? in_sizes[0] : -1, out_size, ws_size, (size_t)WS_END); grid = -1; return; }
        int dev = 0, cus = 0, per_cu = 0;
        if (hipGetDevice(&dev) != hipSuccess || hipDeviceGetAttribute(&cus, hipDeviceAttributeMultiprocessorCount, dev) != hipSuccess) { fprintf(stderr, "kernel_launch: device query failed\n"); grid = -1; return; }
        if (hipFuncSetAttribute((const void*)trunk_fwd, hipFuncAttributeMaxDynamicSharedMemorySize, LDS_BYTES) != hipSuccess) { fprintf(stderr, "kernel_launch: hipFuncSetAttribute failed\n"); grid = -1; return; }
        if (hipOccupancyMaxActiveBlocksPerMultiprocessor(&per_cu, (const void*)trunk_fwd, NWAVES * 64, LDS_BYTES) != hipSuccess || per_cu < 1) fprintf(stderr, "kernel_launch: note: occupancy query reports %d workgroups per CU\n", per_cu);
        (void)hipGetLastError();
        grid = cus;
    }
    if (grid < 0) return;
    if (hipMemsetAsync((char*)d_ws + WS_CTL, 0, CTL_ZERO_BYTES, stream) != hipSuccess) { fprintf(stderr, "kernel_launch: memset failed\n"); return; }
    Args a{};
    for (int i = 0; i < 21; ++i) a.in[i] = (const float*)d_in[i];
    a.out = (float*)d_out; a.ws = (unsigned char*)d_ws;
#if MK_PER_PHASE
    for (int p = 0; p < N_PHASES; ++p) { a.ph_lo = p; a.ph_hi = p + 1; hipLaunchKernelGGL(trunk_fwd, dim3(grid), dim3(NWAVES * 64), LDS_BYTES, stream, a); }
#else
    a.ph_lo = 0; a.ph_hi = N_PHASES;
    hipLaunchKernelGGL(trunk_fwd, dim3(grid), dim3(NWAVES * 64), LDS_BYTES, stream, a);
#endif
    const hipError_t le = hipPeekAtLastError();
    if (le != hipSuccess) fprintf(stderr, "kernel_launch: launch failed: %s\n", hipGetErrorName(le));
}
```

```cpp
#include <hip/hip_runtime.h>
#include <cstdio>
#include <cstdint>
template <int X> __device__ __forceinline__ float sx(float v) { return __int_as_float(__builtin_amdgcn_ds_swizzle(__float_as_int(v), (X << 10) | 0x1f)); }
__device__ __forceinline__ float sum32(float v) { auto rr = __builtin_amdgcn_permlane32_swap(__float_as_uint(v), __float_as_uint(v), false, false); return __uint_as_float(rr[0]) + __uint_as_float(rr[1]); }
__device__ __forceinline__ float max32(float v) { auto rr = __builtin_amdgcn_permlane32_swap(__float_as_uint(v), __float_as_uint(v), false, false); return fmaxf(__uint_as_float(rr[0]), __uint_as_float(rr[1])); }
__device__ __forceinline__ float wave_sum(float v) { v += sx<1>(v); v += sx<2>(v); v += sx<4>(v); v += sx<8>(v); v += sx<16>(v); return sum32(v); }
__device__ __forceinline__ float wave_max(float v) { v = fmaxf(v, sx<1>(v)); v = fmaxf(v, sx<2>(v)); v = fmaxf(v, sx<4>(v)); v = fmaxf(v, sx<8>(v)); v = fmaxf(v, sx<16>(v)); return max32(v); }
typedef float f32x2_cv __attribute__((ext_vector_type(2))); typedef __bf16 bf16x2_cv __attribute__((ext_vector_type(2)));
__device__ __forceinline__ unsigned pk2(float lo, float hi) { const f32x2_cv v = {lo, hi}; const bf16x2_cv b = __builtin_convertvector(v, bf16x2_cv); return __builtin_bit_cast(unsigned, b); }
__device__ __forceinline__ unsigned f2bf(float f) { return pk2(f, 0.f) & 0xffffu; }
namespace pg8 {
#define PG8_LAS __attribute__((address_space(3)))
typedef unsigned short bf16_t;
typedef short bf16x8 __attribute__((ext_vector_type(8)));
typedef float f32x4 __attribute__((ext_vector_type(4)));
typedef unsigned u32x4 __attribute__((ext_vector_type(4)));
constexpr int BM = 256, BK = 64, HALF = 128, HTB = HALF * BK * 2  , STAGE_BYTES = 8 * HTB, NXCD = 8, WGM = 8;

__host__ __device__ __forceinline__ int lds_byte(int r, int c) { const int st = (r >> 4) * 2 + (c >> 5), rr = r & 15, cc = c & 31, ob = rr * 64 + cc * 2; return st * 1024 + (ob ^ (((ob >> 9) & 1) << 5)); }
__host__ __device__ __forceinline__ void stage_rc(int b, int& R, int& C) { const int st = b / 1024, sb = b % 1024, swz = sb ^ (((sb >> 9) & 1) << 5); R = (st >> 1) * 16 + swz / 64; C = (st & 1) * 32 + (swz % 64) / 2; }
__host__ __device__ __forceinline__ int perm32(int rho) { const int n = rho >> 4, i = rho & 15; return 8 * (i >> 2) + 4 * n + (i & 3); }

struct Unit { int pm, pn; };
struct Gemm { const bf16_t* A; const bf16_t* Bt; int M, N, K; int a_tiled = 0, b_tiled = 0; };

struct StaticOrder {
    int nM, nN, nwg, G, c, wgm, pm_off;
    __host__ __device__ void init(int M, int N, int G_, int c_, int wgm_ = WGM, int pm_off_ = 0) { nM = M / BM; nN = N / BM; nwg = nM * nN; G = G_; c = c_; wgm = wgm_; pm_off = pm_off_; }
    __host__ __device__ bool next(int i, Unit& u) const {
        const long L = (long)i * G + c; if (L >= nwg) return false;
        int wgid = (int)L; { const int q = nwg / NXCD, r = nwg % NXCD, xcd = wgid % NXCD, off = wgid / NXCD; wgid = (xcd < r ? xcd * (q + 1) : r * (q + 1) + (xcd - r) * q) + off; }
        const int nig = wgm * nN, gid = wgid / nig, fm = gid * wgm, gsz = (nM - fm) < wgm ? (nM - fm) : wgm;
        u.pm = pm_off + fm + ((wgid % nig) % gsz); u.pn = (wgid % nig) / gsz; return true;
    }
    __device__ __forceinline__ void a_ready(const Unit&) const {}
    __device__ __forceinline__ void done(const Unit&) const {}
};

__device__ __forceinline__ unsigned cvt_pk_bf16(float lo, float hi) { unsigned r; asm volatile("v_cvt_pk_bf16_f32 %0, %1, %2" : "=v"(r) : "v"(lo), "v"(hi)); return r; }
typedef float f32x2 __attribute__((ext_vector_type(2)));
typedef unsigned u32x2 __attribute__((ext_vector_type(2)));
struct EpiStore {
    static constexpr bool HAS_PRE = false;
    static constexpr bool PERM = true, AFTER_DRAIN = false;
    bf16_t* O; int ldc;
    __device__ __forceinline__ void operator()(const f32x4 (&acc)[2][2][4][2], const Unit& u, int wr, int wc, int fr, int fq) const {
        const int row0 = u.pm * BM + wr * 64 + fr, col0 = u.pn * BM + wc * 32 + 8 * fq;
#pragma unroll
        for (int ai = 0; ai < 2; ++ai)
#pragma unroll
            for (int m = 0; m < 4; ++m) { bf16_t* rowp = O + (size_t)(row0 + ai * HALF + m * 16) * ldc + col0;
#pragma unroll
                for (int bj = 0; bj < 2; ++bj) { const f32x4 v0 = acc[ai][bj][m][0], v1 = acc[ai][bj][m][1];
                    u32x4 w; w.x = cvt_pk_bf16(v0[0], v0[1]); w.y = cvt_pk_bf16(v0[2], v0[3]); w.z = cvt_pk_bf16(v1[0], v1[1]); w.w = cvt_pk_bf16(v1[2], v1[3]);
                    *(u32x4*)(rowp + bj * HALF) = w; } }
    }
};
__device__ __forceinline__ float swiglu1(float g, float u) { const float e = __builtin_amdgcn_exp2f(g * -1.4426950408889634f); return g * u * __builtin_amdgcn_rcpf(1.0f + e); }
struct EpiSwiglu {
    static constexpr bool HAS_PRE = false;
    static constexpr bool PERM = true, AFTER_DRAIN = false;
    bf16_t* O; int ldc;
    __device__ __forceinline__ void operator()(const f32x4 (&acc)[2][2][4][2], const Unit& u, int wr, int wc, int fr, int fq) const {
        const int row0 = u.pm * BM + wr * 64 + fr, col0 = u.pn * HALF + wc * 32 + 8 * fq;
#pragma unroll
        for (int ai = 0; ai < 2; ++ai)
#pragma unroll
            for (int m = 0; m < 4; ++m) { bf16_t* rowp = O + (size_t)(row0 + ai * HALF + m * 16) * ldc + col0;
                const f32x4 g0 = acc[ai][0][m][0], g1 = acc[ai][0][m][1], u0 = acc[ai][1][m][0], u1 = acc[ai][1][m][1];
                u32x4 w;
                w.x = cvt_pk_bf16(swiglu1(g0[0], u0[0]), swiglu1(g0[1], u0[1])); w.y = cvt_pk_bf16(swiglu1(g0[2], u0[2]), swiglu1(g0[3], u0[3]));
                w.z = cvt_pk_bf16(swiglu1(g1[0], u1[0]), swiglu1(g1[1], u1[1])); w.w = cvt_pk_bf16(swiglu1(g1[2], u1[2]), swiglu1(g1[3], u1[3]));
                *(u32x4*)rowp = w; }
    }
};
struct EpiRes {
    static constexpr bool HAS_PRE = false;
    static constexpr bool PERM = false, AFTER_DRAIN = false;
    const float* base; float* out; int ldc; const float* gate; int gstride; float coef; int rows_per_batch;
    __device__ __forceinline__ void operator()(const f32x4 (&acc)[2][2][4][2], const Unit& u, int wr, int wc, int fr, int fq) const {
        const int row0 = u.pm * BM + wr * 64 + fr, col0 = u.pn * BM + wc * 32 + 4 * fq;
        const float* gp = gate + (size_t)((u.pm * BM) / rows_per_batch) * gstride + col0;
        f32x4 gv[2][2];
#pragma unroll
        for (int bj = 0; bj < 2; ++bj)
#pragma unroll
            for (int n = 0; n < 2; ++n) gv[bj][n] = *(const f32x4*)(gp + bj * HALF + n * 16) * coef;
#pragma unroll
        for (int ai = 0; ai < 2; ++ai)
#pragma unroll
            for (int m = 0; m < 4; ++m) { const size_t off = (size_t)(row0 + ai * HALF + m * 16) * ldc + col0;
#pragma unroll
                for (int bj = 0; bj < 2; ++bj)
#pragma unroll
                    for (int n = 0; n < 2; ++n) { const f32x4 bs = *(const f32x4*)(base + off + bj * HALF + n * 16); *(f32x4*)(out + off + bj * HALF + n * 16) = bs + gv[bj][n] * acc[ai][bj][m][n]; }
                if (m & 1) asm volatile("" ::: "memory"); }
    }
};
__device__ __forceinline__ float rstd_of(const float* rss, int row) { return rsqrtf(rss[row] * (1.0f / 2048.0f) + 1e-6f); }
struct EpiSwigluN {
    static constexpr bool HAS_PRE = true;
    static constexpr bool PERM = true, AFTER_DRAIN = false;
    bf16_t* O; int ldc; const float* rss; const float* cb; int cbstride; int rows_per_batch; PG8_LAS unsigned char* pre_lds;
    __device__ __forceinline__ void pre(const Unit& u, int lane) const {
        __builtin_amdgcn_global_load_lds((const unsigned*)(cb + (size_t)((u.pm * BM) / rows_per_batch) * cbstride + u.pn * BM + 4 * lane), (PG8_LAS unsigned*)pre_lds, 16, 0, 0);
        __builtin_amdgcn_global_load_lds((const unsigned*)(rss + u.pm * BM + 4 * lane), (PG8_LAS unsigned*)(pre_lds + 1024), 16, 0, 0); }
    __device__ __forceinline__ void operator()(const f32x4 (&acc)[2][2][4][2], const Unit& u, int wr, int wc, int fr, int fq) const {
        const int col0 = u.pn * HALF + wc * 32 + 8 * fq;
        const PG8_LAS float* cbp = (const PG8_LAS float*)pre_lds + wc * 32 + 8 * fq; const PG8_LAS float* rp = (const PG8_LAS float*)(pre_lds + 1024) + wr * 64 + fr;
        constexpr float LC = 1.4426950408889634f, ILC = 0.6931471805599453f;
        const f32x4 cg0 = *(const PG8_LAS f32x4*)(cbp) * LC, cg1 = *(const PG8_LAS f32x4*)(cbp + 4) * LC, cu0 = *(const PG8_LAS f32x4*)(cbp + HALF) * ILC, cu1 = *(const PG8_LAS f32x4*)(cbp + HALF + 4) * ILC;
#pragma unroll
        for (int ai = 0; ai < 2; ++ai)
#pragma unroll
            for (int m = 0; m < 4; ++m) { const float rs = __builtin_amdgcn_rsqf(rp[ai * HALF + m * 16] * (1.0f / 2048.0f) + 1e-6f), rsg = rs * LC, rsu = rs * ILC;
                bf16_t* rowp = O + ((size_t)(u.pm * (ldc >> 6) + (col0 >> 6)) * BM + (wr * 64 + fr + ai * HALF + m * 16)) * 64 + (col0 & 63);
                const f32x4 h0 = acc[ai][0][m][0] * rsg + cg0, h1 = acc[ai][0][m][1] * rsg + cg1, u0 = acc[ai][1][m][0] * rsu + cu0, u1 = acc[ai][1][m][1] * rsu + cu1;
                f32x4 e0, e1;
#pragma unroll
                for (int i = 0; i < 4; ++i) { e0[i] = __builtin_amdgcn_exp2f(-h0[i]); e1[i] = __builtin_amdgcn_exp2f(-h1[i]); }
                e0 = e0 + 1.0f; e1 = e1 + 1.0f;
                f32x4 r0, r1;
#pragma unroll
                for (int i = 0; i < 4; ++i) { r0[i] = __builtin_amdgcn_rcpf(e0[i]); r1[i] = __builtin_amdgcn_rcpf(e1[i]); }
                const f32x4 o0 = (h0 * u0) * r0, o1 = (h1 * u1) * r1;
                u32x4 w;
                w.x = pk2(o0[0], o0[1]); w.y = pk2(o0[2], o0[3]); w.z = pk2(o1[0], o1[1]); w.w = pk2(o1[2], o1[3]);
                __builtin_nontemporal_store(w, (u32x4*)rowp); }
    }
};
struct EpiInN {
    static constexpr bool HAS_PRE = true;
    static constexpr bool PERM = true, AFTER_DRAIN = false;
    bf16_t* O; int ldc; const float* rss; const float* cb; int cbstride; int rows_per_batch; int nqk; const float* gq; const float* gk; PG8_LAS unsigned char* pre_lds;
    __device__ __forceinline__ void pre(const Unit& u, int lane) const {
        __builtin_amdgcn_global_load_lds((const unsigned*)(cb + (size_t)((u.pm * BM) / rows_per_batch) * cbstride + u.pn * BM + 4 * lane), (PG8_LAS unsigned*)pre_lds, 16, 0, 0);
        __builtin_amdgcn_global_load_lds((const unsigned*)(rss + u.pm * BM + 4 * lane), (PG8_LAS unsigned*)(pre_lds + 1024), 16, 0, 0); }
    __device__ __forceinline__ void operator()(const f32x4 (&acc)[2][2][4][2], const Unit& u, int wr, int wc, int fr, int fq) const {
        const int row0 = u.pm * BM + wr * 64 + fr, pc0 = u.pn * BM + wc * 32 + 8 * fq;
        const PG8_LAS float* cbp = (const PG8_LAS float*)pre_lds + wc * 32 + 8 * fq; const PG8_LAS float* rp = (const PG8_LAS float*)(pre_lds + 1024) + wr * 64 + fr;
        f32x4 cv[2][2];
#pragma unroll
        for (int bj = 0; bj < 2; ++bj)
#pragma unroll
            for (int n = 0; n < 2; ++n) cv[bj][n] = *(const PG8_LAS f32x4*)(cbp + bj * HALF + 4 * n);
        if (u.pn < nqk) {
            const bool isq = u.pn < (nqk >> 1); const float* gp = (isq ? gq : gk) + 8 * fq; const float gs = isq ? 0.125f * 1.4426950408889634f : 1.0f;
            f32x4 gv[2][2];
#pragma unroll
            for (int bj = 0; bj < 2; ++bj)
#pragma unroll
                for (int n = 0; n < 2; ++n) gv[bj][n] = *(const f32x4*)(gp + 32 * bj + 4 * n) * gs;
            const int lc0 = u.pn * BM + wc * 64 + 8 * fq;
#pragma unroll
            for (int ai = 0; ai < 2; ++ai)
#pragma unroll
                for (int m = 0; m < 4; ++m) { const int row = row0 + ai * HALF + m * 16; const float rs = rsqrtf(rp[ai * HALF + m * 16] * (1.0f / 2048.0f) + 1e-6f); bf16_t* rowp = O + (size_t)row * ldc + lc0;
                    f32x4 v[2][2]; float ss = 0.f;
#pragma unroll
                    for (int bj = 0; bj < 2; ++bj)
#pragma unroll
                        for (int n = 0; n < 2; ++n) { v[bj][n] = acc[ai][bj][m][n] * rs + cv[bj][n]; ss += (v[bj][n][0] * v[bj][n][0] + v[bj][n][1] * v[bj][n][1]) + (v[bj][n][2] * v[bj][n][2] + v[bj][n][3] * v[bj][n][3]); }
                    ss += sx<16>(ss); ss = sum32(ss);
                    const float rg = rsqrtf(ss * (1.0f / 64.0f) + 1e-6f);
#pragma unroll
                    for (int bj = 0; bj < 2; ++bj) { const f32x4 v0 = v[bj][0] * rg * gv[bj][0], v1 = v[bj][1] * rg * gv[bj][1];
                        u32x4 w; w.x = pk2(v0[0], v0[1]); w.y = pk2(v0[2], v0[3]); w.z = pk2(v1[0], v1[1]); w.w = pk2(v1[2], v1[3]);
                        if (isq) __builtin_nontemporal_store(w, (u32x4*)(rowp + 32 * bj)); else *(u32x4*)(rowp + 32 * bj) = w; } }
        } else {
#pragma unroll
            for (int ai = 0; ai < 2; ++ai)
#pragma unroll
                for (int m = 0; m < 4; ++m) { const int row = row0 + ai * HALF + m * 16; const float rs = rsqrtf(rp[ai * HALF + m * 16] * (1.0f / 2048.0f) + 1e-6f); bf16_t* rowp = O + (size_t)row * ldc + pc0;
#pragma unroll
                    for (int bj = 0; bj < 2; ++bj) { const f32x4 v0 = acc[ai][bj][m][0] * rs + cv[bj][0], v1 = acc[ai][bj][m][1] * rs + cv[bj][1];
                        u32x4 w; w.x = pk2(v0[0], v0[1]); w.y = pk2(v0[2], v0[3]); w.z = pk2(v1[0], v1[1]); w.w = pk2(v1[2], v1[3]);
                        *(u32x4*)(rowp + bj * HALF) = w; } }
        }
    }
};
typedef _Float16 f16x4 __attribute__((ext_vector_type(4)));
struct EpiResN {
    static constexpr bool HAS_PRE = true;
    static constexpr bool PERM = false, AFTER_DRAIN = false;
    const void* base; void* out; int base_f32, out_f32;
    int ldc; const float* gvt; const float* ant; int tstride; int rows_per_batch;
    bf16_t* xs; float* rssn; PG8_LAS unsigned char* pre_lds;
    float gscale;
    __device__ __forceinline__ void pre(const Unit& u, int lane) const {
        const size_t o = (size_t)((u.pm * BM) / rows_per_batch) * tstride + u.pn * BM + 4 * lane;
        __builtin_amdgcn_global_load_lds((const unsigned*)(gvt + o), (PG8_LAS unsigned*)pre_lds, 16, 0, 0);
        __builtin_amdgcn_global_load_lds((const unsigned*)(ant + o), (PG8_LAS unsigned*)(pre_lds + 1024), 16, 0, 0); }
    __device__ __forceinline__ void operator()(const f32x4 (&acc)[2][2][4][2], const Unit& u, int wr, int wc, int fr, int fq) const {
        const int col0 = u.pn * BM + wc * 32 + 4 * fq;
        const PG8_LAS float* gp = (const PG8_LAS float*)pre_lds + wc * 32 + 4 * fq;
        f32x4 gv[2][2], an[2][2];
#pragma unroll
        for (int bj = 0; bj < 2; ++bj)
#pragma unroll
            for (int n = 0; n < 2; ++n) { gv[bj][n] = *(const PG8_LAS f32x4*)(gp + bj * HALF + n * 16) * gscale; an[bj][n] = *(const PG8_LAS f32x4*)(gp + 256 + bj * HALF + n * 16); }
        if (base_f32) {
#pragma unroll
            for (int ai = 0; ai < 2; ++ai)
#pragma unroll
                for (int m = 0; m < 4; ++m) { const int rr = wr * 64 + fr + ai * HALF + m * 16; const unsigned off = (unsigned)((u.pm * BM + rr) * ldc + col0); float ss = 0.f;
                    const unsigned xso = ((unsigned)(u.pm * (ldc >> 6) + 4 * u.pn) * BM + rr) * 64u + 4u * fq;
#pragma unroll
                    for (int bj = 0; bj < 2; ++bj)
#pragma unroll
                        for (int n = 0; n < 2; ++n) { const unsigned o2 = off + bj * HALF + n * 16;
                            const f32x4 xn = *(const f32x4*)((const char*)base + 4u * o2) + gv[bj][n] * acc[ai][bj][m][n];
                            *(f16x4*)((char*)out + 2u * o2) = __builtin_convertvector(xn, f16x4);
                            ss += (xn[0] * xn[0] + xn[1] * xn[1]) + (xn[2] * xn[2] + xn[3] * xn[3]); const f32x4 h = xn * an[bj][n];
                            u32x2 w; w.x = pk2(h[0], h[1]); w.y = pk2(h[2], h[3]); *(u32x2*)((char*)xs + 2u * (xso + (unsigned)(2 * bj + (wc >> 1)) * (BM * 64) + (wc & 1) * 32 + n * 16)) = w; }
                    ss += sx<16>(ss); ss = sum32(ss); if (fq == 0) __hip_atomic_fetch_add(rssn + (u.pm * BM + rr), ss, __ATOMIC_RELAXED, __HIP_MEMORY_SCOPE_AGENT);
                    if (m & 1) asm volatile("" ::: "memory"); }
        } else {
            f16x4 bsv[2][4][2][2];
#pragma unroll
            for (int ai = 0; ai < 2; ++ai)
#pragma unroll
                for (int m = 0; m < 4; ++m)
#pragma unroll
                    for (int bj = 0; bj < 2; ++bj)
#pragma unroll
                        for (int n = 0; n < 2; ++n) bsv[ai][m][bj][n] = *(const f16x4*)((const char*)base + 2u * (unsigned)((u.pm * BM + wr * 64 + fr + ai * HALF + m * 16) * ldc + col0 + bj * HALF + n * 16));
            asm volatile("" ::: "memory");
#pragma unroll
            for (int ai = 0; ai < 2; ++ai) {
#pragma unroll
                for (int m = 0; m < 4; ++m) { const int rr = wr * 64 + fr + ai * HALF + m * 16; const unsigned off = (unsigned)((u.pm * BM + rr) * ldc + col0); float ss = 0.f;
                    const unsigned xso = ((unsigned)(u.pm * (ldc >> 6) + 4 * u.pn) * BM + rr) * 64u + 4u * fq;
#pragma unroll
                    for (int bj = 0; bj < 2; ++bj)
#pragma unroll
                        for (int n = 0; n < 2; ++n) { const unsigned o2 = off + bj * HALF + n * 16;
                            const f32x4 xn = __builtin_convertvector(bsv[ai][m][bj][n], f32x4) + gv[bj][n] * acc[ai][bj][m][n];
                            if (out_f32) *(f32x4*)((char*)out + 4u * o2) = xn; else *(f16x4*)((char*)out + 2u * o2) = __builtin_convertvector(xn, f16x4);
                            if (xs) { ss += (xn[0] * xn[0] + xn[1] * xn[1]) + (xn[2] * xn[2] + xn[3] * xn[3]); const f32x4 h = xn * *(const PG8_LAS f32x4*)(gp + 256 + bj * HALF + n * 16);
                                u32x2 w; w.x = pk2(h[0], h[1]); w.y = pk2(h[2], h[3]); *(u32x2*)((char*)xs + 2u * (xso + (unsigned)(2 * bj + (wc >> 1)) * (BM * 64) + (wc & 1) * 32 + n * 16)) = w; } }
                    if (xs) { ss += sx<16>(ss); ss = sum32(ss); if (fq == 0) __hip_atomic_fetch_add(rssn + (u.pm * BM + rr), ss, __ATOMIC_RELAXED, __HIP_MEMORY_SCOPE_AGENT); } }
                asm volatile("" ::: "memory"); }
        }
    }
};
template <class Epi, class Sched, bool ALIGN_EPI = false, bool SP2 = false, int A_AUX = 0>
__device__ __forceinline__ void gemm_phase(PG8_LAS unsigned char* lds, const Gemm g, const Sched& S, const Epi& E, int tid_in) {
    int tid_o = tid_in; asm volatile("" : "+v"(tid_o));
    const int tid = tid_o, wid = __builtin_amdgcn_readfirstlane(tid >> 6), lane = tid & 63, wr = wid >> 2, wc = wid & 3, fr = lane & 15, fq = lane >> 4;
    const int K = g.K, nt = K / BK;
    unsigned voffA[2], voffB[2];
#pragma unroll
    for (int i = 0; i < 2; ++i) { int R, C; stage_rc(tid * 16 + i * 8192, R, C); const int Rb = Epi::PERM ? ((R & ~31) + perm32(R & 31)) : R;
        voffA[i] = (unsigned)(R * (g.a_tiled ? BK : K) + C) * 2u; voffB[i] = (unsigned)(Rb * (g.b_tiled ? BK : K) + C) * 2u; }
    const size_t kstepA = g.a_tiled ? (size_t)(BM * BK * 2) : (size_t)(BK * 2), kstepB = g.b_tiled ? (size_t)(BM * BK * 2) : (size_t)(BK * 2);
    const size_t hstepA = g.a_tiled ? (size_t)(HALF * BK * 2) : (size_t)HALF * K * 2, hstepB = g.b_tiled ? (size_t)(HALF * BK * 2) : (size_t)HALF * K * 2;
    const size_t tstepA = (size_t)BM * K * 2, tstepB = tstepA;
    const unsigned ldsw = (unsigned)wid * 1024u;
    const int aoff = lds_byte(wr * 64 + fr, fq * 8), boff = lds_byte(wc * 32 + fr, fq * 8);
#define PG8_SA(b, h) (((b) * 2 + (h)) * HTB)
#define PG8_SB(b, h) ((4 + (b) * 2 + (h)) * HTB)
#define PG8_STAGE(bufoff, gbase, voff) do { _Pragma("unroll") for (int _i = 0; _i < 2; ++_i) \
        __builtin_amdgcn_global_load_lds((const unsigned*)((const char*)(gbase) + (voff)[_i]), (PG8_LAS unsigned*)(lds + (bufoff) + ldsw + _i * 8192), 16, 0, 0); } while (0)
#define PG8_STAGE_A(bufoff, gbase, voff) do { _Pragma("unroll") for (int _i = 0; _i < 2; ++_i) \
        __builtin_amdgcn_global_load_lds((const unsigned*)((const char*)(gbase) + (voff)[_i]), (PG8_LAS unsigned*)(lds + (bufoff) + ldsw + _i * 8192), 16, 0, A_AUX); } while (0)
#define PG8_LDA(dst, b, h) do { _Pragma("unroll") for (int m = 0; m < 4; ++m) _Pragma("unroll") for (int k = 0; k < 2; ++k) dst[m][k] = *(const PG8_LAS bf16x8*)(lds + PG8_SA(b, h) + aoff + m * 2048 + k * 1024); } while (0)
#define PG8_LDB(dst, b, h) do { _Pragma("unroll") for (int n = 0; n < 2; ++n) _Pragma("unroll") for (int k = 0; k < 2; ++k) dst[n][k] = *(const PG8_LAS bf16x8*)(lds + PG8_SB(b, h) + boff + n * 2048 + k * 1024); } while (0)
#define PG8_MMA(ai, bj, At, Bt) do { __builtin_amdgcn_s_setprio(1); _Pragma("unroll") for (int m = 0; m < 4; ++m) _Pragma("unroll") for (int n = 0; n < 2; ++n) _Pragma("unroll") for (int k = 0; k < 2; ++k) \
        acc[ai][bj][m][n] = __builtin_amdgcn_mfma_f32_16x16x32_bf16(Bt[n][k], At[m][k], acc[ai][bj][m][n], 0, 0, 0); __builtin_amdgcn_s_setprio(0); } while (0)
#define PG8_WAIT_V(n) asm volatile("s_waitcnt vmcnt(" #n ")" ::: "memory")
#define PG8_WAIT_L(n) asm volatile("s_waitcnt lgkmcnt(" #n ")" ::: "memory")
#define PG8_BAR __builtin_amdgcn_s_barrier()
#define PG8_SCHED __builtin_amdgcn_sched_barrier(0)
    Unit cur, nxt; int ui = 0;
    if (!S.next(0, cur)) return;
    f32x4 acc[2][2][4][2];
#pragma unroll
    for (int a = 0; a < 2; ++a)
#pragma unroll
        for (int b = 0; b < 2; ++b)
#pragma unroll
            for (int m = 0; m < 4; ++m)
#pragma unroll
                for (int n = 0; n < 2; ++n) acc[a][b][m][n] = (f32x4){0.f, 0.f, 0.f, 0.f};
    bf16x8 At[4][2], B0[2][2], B1[2][2];
    const char* cA = (const char*)g.A + (size_t)cur.pm * tstepA; const char* cB = (const char*)g.Bt + (size_t)cur.pn * tstepB;
    S.a_ready(cur);
    if constexpr (SP2) {
        PG8_STAGE(PG8_SB(0, 0), cB, voffB); PG8_STAGE(PG8_SB(0, 1), cB + hstepB, voffB); PG8_STAGE_A(PG8_SA(0, 0), cA, voffA); PG8_STAGE_A(PG8_SA(0, 1), cA + hstepA, voffA);
        if (wr == 1) PG8_BAR;
        PG8_WAIT_V(2); PG8_BAR;
        PG8_STAGE(PG8_SB(1, 0), cB + kstepB, voffB); PG8_STAGE_A(PG8_SA(1, 0), cA + kstepA, voffA); PG8_STAGE(PG8_SB(1, 1), cB + hstepB + kstepB, voffB);
        PG8_WAIT_V(6); PG8_BAR;
    } else {
        PG8_STAGE(PG8_SB(0, 0), cB, voffB); PG8_STAGE_A(PG8_SA(0, 0), cA, voffA); PG8_STAGE(PG8_SB(0, 1), cB + hstepB, voffB); PG8_STAGE_A(PG8_SA(0, 1), cA + hstepA, voffA);
        if (wr == 1) PG8_BAR;
        PG8_WAIT_V(4); PG8_BAR;
        PG8_STAGE(PG8_SB(1, 0), cB + kstepB, voffB); PG8_STAGE_A(PG8_SA(1, 0), cA + kstepA, voffA); PG8_STAGE(PG8_SB(1, 1), cB + hstepB + kstepB, voffB);
        PG8_WAIT_V(6); PG8_BAR;
    }
    for (;;) {
        const bool has_next = S.next(ui + 1, nxt);
        const char* nA = has_next ? (const char*)g.A + (size_t)nxt.pm * tstepA : cA; const char* nB = has_next ? (const char*)g.Bt + (size_t)nxt.pn * tstepB : cB;
        for (int t = 0; t < nt; t += 2) {
            const bool last = (t == nt - 2);
            const char* a1 = cA + (size_t)(t + 1) * kstepA;
            const char* a2 = last ? nA : cA + (size_t)(t + 2) * kstepA; const char* b2 = last ? nB : cB + (size_t)(t + 2) * kstepB;
            const char* a3 = a2 + kstepA; const char* b3 = b2 + kstepB;
            if (last && has_next) S.a_ready(nxt);
            if constexpr (SP2) {
            if constexpr (Epi::HAS_PRE) { if (last && wid == 0) { int ln = fr | (fq << 4); asm volatile("" : "+v"(ln)); E.pre(cur, ln); } }
            PG8_LDB(B0, 0, 0); PG8_LDB(B1, 0, 1); PG8_SCHED; PG8_LDA(At, 0, 0); PG8_STAGE_A(PG8_SA(1, 1), a1 + hstepA, voffA);
            PG8_WAIT_V(8); PG8_WAIT_L(0); PG8_BAR; PG8_MMA(0, 0, At, B0); PG8_MMA(0, 1, At, B1); PG8_BAR; PG8_SCHED;
            PG8_LDA(At, 0, 1); PG8_STAGE(PG8_SB(0, 0), b2, voffB); PG8_STAGE(PG8_SB(0, 1), b2 + hstepB, voffB); PG8_STAGE_A(PG8_SA(0, 0), a2, voffA);
            PG8_WAIT_V(8); PG8_WAIT_L(0); PG8_BAR; PG8_MMA(1, 0, At, B0); PG8_MMA(1, 1, At, B1); PG8_BAR; PG8_SCHED;
            PG8_LDB(B0, 1, 0); PG8_LDB(B1, 1, 1); PG8_SCHED; PG8_LDA(At, 1, 0); PG8_STAGE_A(PG8_SA(0, 1), a2 + hstepA, voffA);
            PG8_WAIT_V(8); PG8_WAIT_L(0); PG8_BAR; PG8_MMA(0, 0, At, B0); PG8_MMA(0, 1, At, B1); PG8_BAR; PG8_SCHED;
            PG8_LDA(At, 1, 1); PG8_STAGE(PG8_SB(1, 0), b3, voffB); PG8_STAGE(PG8_SB(1, 1), b3 + hstepB, voffB); PG8_STAGE_A(PG8_SA(1, 0), a3, voffA);
            PG8_WAIT_V(8); PG8_WAIT_L(0); PG8_BAR; PG8_MMA(1, 0, At, B0); PG8_MMA(1, 1, At, B1); PG8_BAR; PG8_SCHED;
            } else {
            PG8_LDB(B0, 0, 0); PG8_SCHED; PG8_LDA(At, 0, 0); PG8_STAGE_A(PG8_SA(1, 1), a1 + hstepA, voffA);
            PG8_WAIT_L(8); PG8_BAR; PG8_WAIT_L(0); PG8_MMA(0, 0, At, B0); PG8_BAR; PG8_SCHED;
            PG8_LDB(B1, 0, 1); PG8_STAGE(PG8_SB(0, 0), b2, voffB);
            PG8_BAR; PG8_WAIT_L(0); PG8_MMA(0, 1, At, B1); PG8_BAR;
            PG8_LDA(At, 0, 1); PG8_STAGE_A(PG8_SA(0, 0), a2, voffA);
            PG8_BAR; PG8_WAIT_L(0); PG8_MMA(1, 0, At, B0); PG8_BAR; PG8_SCHED;
            PG8_STAGE(PG8_SB(0, 1), b2 + hstepB, voffB);
            PG8_WAIT_V(6); PG8_BAR; PG8_MMA(1, 1, At, B1); PG8_BAR;
            PG8_LDB(B0, 1, 0); PG8_SCHED; PG8_LDA(At, 1, 0); PG8_STAGE_A(PG8_SA(0, 1), a2 + hstepA, voffA);
            PG8_WAIT_L(8); PG8_BAR; PG8_WAIT_L(0); PG8_MMA(0, 0, At, B0); PG8_BAR; PG8_SCHED;
            PG8_LDB(B1, 1, 1); PG8_STAGE(PG8_SB(1, 0), b3, voffB);
            PG8_BAR; PG8_WAIT_L(0); PG8_MMA(0, 1, At, B1); PG8_BAR;
            PG8_LDA(At, 1, 1); PG8_STAGE_A(PG8_SA(1, 0), a3, voffA);
            PG8_BAR; PG8_WAIT_L(0); PG8_MMA(1, 0, At, B0); PG8_BAR; PG8_SCHED;
            PG8_STAGE(PG8_SB(1, 1), b3 + hstepB, voffB);
            PG8_WAIT_V(6); PG8_BAR; PG8_MMA(1, 1, At, B1); PG8_BAR;
            }
        }
        if constexpr (ALIGN_EPI) { if (wr == 0) PG8_BAR; }
        if constexpr (!Epi::AFTER_DRAIN) { E(acc, cur, wr, wc, fr, fq); S.done(cur); }
        if (!has_next) break;
#pragma unroll
        for (int a = 0; a < 2; ++a)
#pragma unroll
            for (int b = 0; b < 2; ++b)
#pragma unroll
                for (int m = 0; m < 4; ++m)
#pragma unroll
                    for (int n = 0; n < 2; ++n) acc[a][b][m][n] = (f32x4){0.f, 0.f, 0.f, 0.f};
        cur = nxt; cA = nA; cB = nB; ++ui;
        if constexpr (ALIGN_EPI) { if (wr == 1) PG8_BAR; }
    }
    PG8_WAIT_V(0);
    if constexpr (!ALIGN_EPI) { if (wr == 0) PG8_BAR; }
    PG8_BAR;
    if constexpr (Epi::AFTER_DRAIN) { E.fused(acc, cur, wr, wc, fr, fq, lds, wid, lane); S.done(cur); }
#undef PG8_SA
#undef PG8_SB
#undef PG8_STAGE
#undef PG8_STAGE_A
#undef PG8_LDA
#undef PG8_LDB
#undef PG8_MMA
#undef PG8_WAIT_V
#undef PG8_WAIT_L
#undef PG8_BAR
#undef PG8_SCHED
}
}
#define GAS __attribute__((address_space(1)))
#define LAS __attribute__((address_space(3)))
typedef unsigned short bf16;
typedef unsigned v4u __attribute__((ext_vector_type(4)));
typedef float f32x4 __attribute__((ext_vector_type(4)));
typedef short bf16x8 __attribute__((ext_vector_type(8)));
typedef GAS unsigned gu32;
typedef GAS unsigned long long gu64;
#define RLX_AGENT __ATOMIC_RELAXED, __HIP_MEMORY_SCOPE_AGENT
#define LDS_WAIT() asm volatile("s_waitcnt lgkmcnt(0)" ::: "memory")
#define VM_WAIT() asm volatile("s_waitcnt vmcnt(0)" ::: "memory")
__device__ __forceinline__ unsigned long long rt() { return __builtin_amdgcn_s_memrealtime(); }
#define XB_TMO      128
#define XB_XCNT(j)  (256  + 64 * (j))
#define XB_XSUB(j)  (1280 + 64 * (j))
#define XB_XGEN(j)  (2304 + 64 * (j))
#define XB_TOP      3328
#define XB_TOPGEN   3392
#define XCD_BAR_WORDS 3456
#define XB_SPIN_CAP (1u << 18)

__device__ __forceinline__ unsigned xb_ld(unsigned* p)              { return __hip_atomic_load(p, __ATOMIC_RELAXED, __HIP_MEMORY_SCOPE_AGENT); }
__device__ __forceinline__ unsigned xb_add(unsigned* p, unsigned v) { return __hip_atomic_fetch_add(p, v, __ATOMIC_RELAXED, __HIP_MEMORY_SCOPE_AGENT); }
__device__ __forceinline__ unsigned xb_xcc_id() { return (unsigned)__builtin_amdgcn_s_getreg((3 << 11) | 20) & 0xFu; }
#define XB_SPIN(cond, bar) do { unsigned _sp = 0; while (cond) { __builtin_amdgcn_s_sleep(1); \
    if ((++_sp & 255u) == 0u) { if (xb_ld(&(bar)[XB_TMO])) break; if (_sp > XB_SPIN_CAP) { atomicAdd(&(bar)[XB_TMO], 1u); break; } } } } while (0)

struct XcdBarrier {
    unsigned* bar; unsigned x;
    volatile LAS unsigned* st;
};

__device__ __forceinline__ XcdBarrier xcd_barrier_post(unsigned* bar, volatile LAS unsigned* st) {
    XcdBarrier b; b.bar = bar; b.x = xb_xcc_id(); b.st = st;
    if (threadIdx.x == 0) (void)xb_add(&bar[XB_XCNT(b.x)], 1u);
    return b;
}
__device__ __forceinline__ void xcd_barrier_complete(unsigned* bar, unsigned x, unsigned& nloc, unsigned& nx) {
    const unsigned G = gridDim.x * gridDim.y * gridDim.z;
    unsigned sum, cnt, mine, sp = 0u;
    for (;;) {
        sum = 0u; cnt = 0u; mine = 0u;
#pragma unroll
        for (unsigned j = 0; j < 16; ++j) { const unsigned c = xb_ld(&bar[XB_XCNT(j)]); sum += c; cnt += (c > 0u) ? 1u : 0u; mine = (j == x) ? c : mine; }
        if (sum == G) break;
        __builtin_amdgcn_s_sleep(1);
        if ((++sp & 255u) == 0u) { if (xb_ld(&bar[XB_TMO])) break; if (sp > XB_SPIN_CAP) { atomicAdd(&bar[XB_TMO], 1u); break; } }
    }
    nloc = mine > 0u ? mine : 1u; nx = cnt > 0u ? cnt : 1u;
}

__device__ __forceinline__ void xcd_barrier(const XcdBarrier& b) {
    asm volatile("s_waitcnt vmcnt(0)" ::: "memory");
    __syncthreads();
    if (threadIdx.x == 0) {
        unsigned* bar = b.bar;
        __builtin_amdgcn_s_waitcnt(0);
        unsigned nloc = b.st[0], nx = b.st[1];
        if (nloc == 0u) { xcd_barrier_complete(bar, b.x, nloc, nx); b.st[0] = nloc; b.st[1] = nx; }
        const unsigned old = xb_add(&bar[XB_XSUB(b.x)], 1u);
        const unsigned gen = old / nloc;
        if (old + 1u == (gen + 1u) * nloc) {
            __builtin_amdgcn_fence(__ATOMIC_RELEASE, "agent");
            asm volatile("s_waitcnt vmcnt(0)" ::: "memory");
            const unsigned og = xb_add(&bar[XB_TOP], 1u);
            const unsigned tg = og / nx;
            if (og + 1u == (tg + 1u) * nx) xb_add(&bar[XB_TOPGEN], 1u);
            else XB_SPIN(xb_ld(&bar[XB_TOPGEN]) == tg, bar);
            __builtin_amdgcn_fence(__ATOMIC_ACQUIRE, "agent");
            xb_add(&bar[XB_XGEN(b.x)], 1u);
            asm volatile("s_waitcnt vmcnt(0)" ::: "memory");
        } else {
            XB_SPIN(xb_ld(&bar[XB_XGEN(b.x)]) == gen, bar);
            __builtin_amdgcn_fence(__ATOMIC_ACQUIRE, "agent");
            asm volatile("s_waitcnt vmcnt(0)" ::: "memory");
        }
    }
    __syncthreads();
}
namespace att {
using bf16x8 = __attribute__((ext_vector_type(8))) short;
using s16x4  = __attribute__((ext_vector_type(4))) short;
using f32x16 = __attribute__((ext_vector_type(16))) float;
using u32x4  = __attribute__((ext_vector_type(4))) unsigned;
constexpr int SEQ_ = 8192, LDQ = 6144; constexpr size_t SHM_V = 16384, SHM_K = 16384;
#ifndef ATT_FUSED
#define ATT_FUSED 1
#endif
#define KSWZ(row, colB) ((row) * 256 + ((colB) ^ (((row) & 7) << 4)))
#define SBAR() __builtin_amdgcn_sched_barrier(0)
__device__ __forceinline__ int crow(int r, int hi) { return (r & 3) + 8 * (r >> 2) + 4 * hi; }
__device__ __forceinline__ unsigned cvtpk(float lo, float hi) {
  unsigned r; asm volatile("v_cvt_pk_bf16_f32 %0, %1, %2" : "=v"(r) : "v"(lo), "v"(hi)); return r;
}
__device__ __forceinline__ void qkt(f32x16& p0, f32x16& p1, const bf16* Ks, const bf16x8* qr, int r32, int hi, int jmap, float dbase, float slope2, float negm, bool diag) {
  asm volatile("" : "+v"(negm));
  if (diag) {
#pragma unroll
    for (int r = 0; r < 16; ++r) { const float d = (float)((r & 3) + 8 * (r >> 2)) + dbase;
      float a = fmaf(-slope2, fabsf(d), negm), b = fmaf(-slope2, fabsf(d + 32.f), negm); asm("" : "+v"(a)); asm("" : "+v"(b)); p0[r] = a; p1[r] = b; }
  } else {
    const float u0 = fmaf(slope2, dbase, negm), u1 = fmaf(slope2, dbase + 32.f, negm);
#pragma unroll
    for (int r = 0; r < 16; ++r) { float a = fmaf(slope2, (float)((r & 3) + 8 * (r >> 2)), u0), b = fmaf(slope2, (float)((r & 3) + 8 * (r >> 2)), u1); asm("" : "+v"(a)); asm("" : "+v"(b)); p0[r] = a; p1[r] = b; }
  }
  const int cb0 = (jmap * 64 + hi * 8) * 2;
  bf16x8 b0 = *reinterpret_cast<const bf16x8*>((const char*)Ks + KSWZ(r32, cb0));
  bf16x8 b1 = *reinterpret_cast<const bf16x8*>((const char*)Ks + KSWZ(32 + r32, cb0));
#pragma unroll
  for (int d0 = 0; d0 < 4; ++d0) { const int cb = (jmap * 64 + (d0 + 1) * 16 + hi * 8) * 2;
    bf16x8 n0 = b0, n1 = b1;
    if (d0 < 3) { n0 = *reinterpret_cast<const bf16x8*>((const char*)Ks + KSWZ(r32, cb)); n1 = *reinterpret_cast<const bf16x8*>((const char*)Ks + KSWZ(32 + r32, cb)); }
    p0 = __builtin_amdgcn_mfma_f32_32x32x16_bf16(b0, qr[d0], p0, 0, 0, 0);
    p1 = __builtin_amdgcn_mfma_f32_32x32x16_bf16(b1, qr[d0], p1, 0, 0, 0);
    b0 = n0; b1 = n1; }
}
__device__ __forceinline__ void partialSM(f32x16& p0, f32x16& p1) {
#pragma unroll
  for (int r = 0; r < 16; ++r) p0[r] = __builtin_amdgcn_exp2f(p0[r]);
}

__device__ __forceinline__ float krow_f(int r) { return (float)((r & 3) + 8 * (r >> 2)); }
template <int C> __device__ __forceinline__ void cinit_chunk(f32x16& p0, f32x16& p1, float slope2, float u0, float u1) {
#pragma unroll
  for (int r = 4 * C; r < 4 * C + 4; ++r) { float a = fmaf(slope2, krow_f(r), u0), b = fmaf(slope2, krow_f(r), u1); asm("" : "+v"(a)); asm("" : "+v"(b)); p0[r] = a; p1[r] = b; }
}
__device__ __forceinline__ void cinit_fix(f32x16& p0, f32x16& p1, float dbase, float slope2) {
#pragma unroll
  for (int r = 0; r < 16; ++r) { const float d = krow_f(r) + dbase; p0[r] = fmaf(-2.f * slope2, fmaxf(d, 0.f), p0[r]); p1[r] = fmaf(-2.f * slope2, fmaxf(d + 32.f, 0.f), p1[r]); }
}
template <int C> __device__ __forceinline__ void exp_chunk(f32x16& p0, f32x16& p1) {
#pragma unroll
  for (int r = 4 * C; r < 4 * C + 4; ++r) { p0[r] = __builtin_amdgcn_exp2f(p0[r]); p1[r] = __builtin_amdgcn_exp2f(p1[r]); }
}
__device__ __forceinline__ void qk_mfma(f32x16& p0, f32x16& p1, const bf16* Ks, const bf16x8* qr, int r32, int hi, int jmap) {
  const int cb0 = (jmap * 64 + hi * 8) * 2;
  bf16x8 b0 = *reinterpret_cast<const bf16x8*>((const char*)Ks + KSWZ(r32, cb0));
  bf16x8 b1 = *reinterpret_cast<const bf16x8*>((const char*)Ks + KSWZ(32 + r32, cb0));
#pragma unroll
  for (int d0 = 0; d0 < 4; ++d0) { const int cb = (jmap * 64 + (d0 + 1) * 16 + hi * 8) * 2;
    bf16x8 n0 = b0, n1 = b1;
    if (d0 < 3) { n0 = *reinterpret_cast<const bf16x8*>((const char*)Ks + KSWZ(r32, cb)); n1 = *reinterpret_cast<const bf16x8*>((const char*)Ks + KSWZ(32 + r32, cb)); }
    p0 = __builtin_amdgcn_mfma_f32_32x32x16_bf16(b0, qr[d0], p0, 0, 0, 0);
    p1 = __builtin_amdgcn_mfma_f32_32x32x16_bf16(b1, qr[d0], p1, 0, 0, 0);
    b0 = n0; b1 = n1; }
}
__device__ __forceinline__ void finishSM(f32x16& p0, f32x16& p1, float alpha, float& l_reg, bf16x8& pa0, bf16x8& pa1, bf16x8& pa2, bf16x8& pa3) {
  for (int r = 0; r < 16; ++r) p1[r] = __builtin_amdgcn_exp2f(p1[r]);
  float ps = p0[0], ps1 = p1[0];
  for (int r = 1; r < 16; ++r) { ps += p0[r]; asm("" : "+v"(ps)); ps1 += p1[r]; asm("" : "+v"(ps1)); }
  ps += ps1;
  { auto rr = __builtin_amdgcn_permlane32_swap(__float_as_uint(ps), __float_as_uint(ps), false, false);
    ps = __uint_as_float(rr[0]) + __uint_as_float(rr[1]); }
  l_reg = l_reg * alpha + ps;
#define PK4(P, BASE, OUT) do { unsigned a0 = cvtpk(P[BASE + 0], P[BASE + 1]), a1 = cvtpk(P[BASE + 2], P[BASE + 3]);   \
    unsigned b0 = cvtpk(P[BASE + 4], P[BASE + 5]), b1 = cvtpk(P[BASE + 6], P[BASE + 7]);                              \
    auto r0 = __builtin_amdgcn_permlane32_swap(a0, b0, false, false); auto r1 = __builtin_amdgcn_permlane32_swap(a1, b1, false, false); \
    u32x4 w = {r0[0], r1[0], r0[1], r1[1]}; OUT = *reinterpret_cast<bf16x8*>(&w); } while (0)
  PK4(p0, 0, pa0); PK4(p0, 8, pa1); PK4(p1, 0, pa2); PK4(p1, 8, pa3);
#undef PK4
}
__device__ __forceinline__ void sums_cvt(f32x16& p0, f32x16& p1, float& l_reg, bf16x8& pa0, bf16x8& pa1, bf16x8& pa2, bf16x8& pa3) {
  float ps = p0[0], ps1 = p1[0];
  for (int r = 1; r < 16; ++r) { ps += p0[r]; asm("" : "+v"(ps)); ps1 += p1[r]; asm("" : "+v"(ps1)); }
  ps += ps1;
  { auto rr = __builtin_amdgcn_permlane32_swap(__float_as_uint(ps), __float_as_uint(ps), false, false);
    ps = __uint_as_float(rr[0]) + __uint_as_float(rr[1]); }
  l_reg = l_reg + ps;
#define PK4(P, BASE, OUT) do { unsigned a0 = cvtpk(P[BASE + 0], P[BASE + 1]), a1 = cvtpk(P[BASE + 2], P[BASE + 3]);   \
    unsigned b0 = cvtpk(P[BASE + 4], P[BASE + 5]), b1 = cvtpk(P[BASE + 6], P[BASE + 7]);                              \
    auto r0 = __builtin_amdgcn_permlane32_swap(a0, b0, false, false); auto r1 = __builtin_amdgcn_permlane32_swap(a1, b1, false, false); \
    u32x4 w = {r0[0], r1[0], r0[1], r1[1]}; OUT = *reinterpret_cast<bf16x8*>(&w); } while (0)
  PK4(p0, 0, pa0); PK4(p0, 8, pa1); PK4(p1, 0, pa2); PK4(p1, 8, pa3);
#undef PK4
}
__device__ __forceinline__ int v_st(int k, int c) { const int kk = (k & ~0xC) | ((k & 4) << 1) | ((k & 8) >> 1); return ((kk >> 3) * 4 + (c >> 5)) * 512 + ((kk & 7) * 32 + (c & 31)) * 2; }
__device__ __forceinline__ int v_rd_base(int lane) { return ((lane & 3) << 3) | (((lane >> 2) & 3) << 6) | (((lane >> 4) & 1) << 5) | (((lane >> 5) & 1) << 8); }
constexpr int v_rd_off(int d0, int ks, int half) { return d0 * 512 + ks * 4096 + half * 2048; }
template <int OFF> __device__ __forceinline__ s16x4 tr_read(int vb) {
  s16x4 r; asm volatile("ds_read_b64_tr_b16 %0, %1 offset:%2" : "=&v"(r) : "v"(vb), "i"(OFF) : "memory"); return r;
}
template <int D0> __device__ __forceinline__ void pv_one(f32x16& od, int vb, bf16x8 pa0, bf16x8 pa1, bf16x8 pa2, bf16x8 pa3) {
  const s16x4 l0 = tr_read<v_rd_off(D0, 0, 0)>(vb), h0 = tr_read<v_rd_off(D0, 0, 1)>(vb), l1 = tr_read<v_rd_off(D0, 1, 0)>(vb), h1 = tr_read<v_rd_off(D0, 1, 1)>(vb);
  const s16x4 l2 = tr_read<v_rd_off(D0, 2, 0)>(vb), h2 = tr_read<v_rd_off(D0, 2, 1)>(vb), l3 = tr_read<v_rd_off(D0, 3, 0)>(vb), h3 = tr_read<v_rd_off(D0, 3, 1)>(vb);
  asm volatile("s_waitcnt lgkmcnt(0)" ::: "memory"); SBAR();
#define PK(L, H) (bf16x8){L[0], L[1], L[2], L[3], H[0], H[1], H[2], H[3]}
  od = __builtin_amdgcn_mfma_f32_32x32x16_bf16(pa0, PK(l0, h0), od, 0, 0, 0);
  od = __builtin_amdgcn_mfma_f32_32x32x16_bf16(pa1, PK(l1, h1), od, 0, 0, 0);
  od = __builtin_amdgcn_mfma_f32_32x32x16_bf16(pa2, PK(l2, h2), od, 0, 0, 0);
  od = __builtin_amdgcn_mfma_f32_32x32x16_bf16(pa3, PK(l3, h3), od, 0, 0, 0);
#undef PK
}
#define PV_RD(S, D0) const s16x4 S##l0 = tr_read<v_rd_off(D0, 0, 0)>(vb), S##h0 = tr_read<v_rd_off(D0, 0, 1)>(vb), S##l1 = tr_read<v_rd_off(D0, 1, 0)>(vb), S##h1 = tr_read<v_rd_off(D0, 1, 1)>(vb), \
    S##l2 = tr_read<v_rd_off(D0, 2, 0)>(vb), S##h2 = tr_read<v_rd_off(D0, 2, 1)>(vb), S##l3 = tr_read<v_rd_off(D0, 3, 0)>(vb), S##h3 = tr_read<v_rd_off(D0, 3, 1)>(vb)
#define PV_PK(L, H) (bf16x8){L[0], L[1], L[2], L[3], H[0], H[1], H[2], H[3]}
#define PV_MM(S, OD) do { OD = __builtin_amdgcn_mfma_f32_32x32x16_bf16(pa0, PV_PK(S##l0, S##h0), OD, 0, 0, 0); OD = __builtin_amdgcn_mfma_f32_32x32x16_bf16(pa1, PV_PK(S##l1, S##h1), OD, 0, 0, 0); \
    OD = __builtin_amdgcn_mfma_f32_32x32x16_bf16(pa2, PV_PK(S##l2, S##h2), OD, 0, 0, 0); OD = __builtin_amdgcn_mfma_f32_32x32x16_bf16(pa3, PV_PK(S##l3, S##h3), OD, 0, 0, 0); } while (0)
__device__ __forceinline__ void pv_d0(f32x16* o, int vb, bf16x8 pa0, bf16x8 pa1, bf16x8 pa2, bf16x8 pa3) {
  PV_RD(a, 0); PV_RD(b, 1);
  asm volatile("s_waitcnt lgkmcnt(8)" ::: "memory"); SBAR();
  PV_MM(a, o[0]);
  PV_RD(c, 2);
  asm volatile("s_waitcnt lgkmcnt(8)" ::: "memory"); SBAR();
  PV_MM(b, o[1]);
  PV_RD(d, 3);
  asm volatile("s_waitcnt lgkmcnt(8)" ::: "memory"); SBAR();
  PV_MM(c, o[2]);
  asm volatile("s_waitcnt lgkmcnt(0)" ::: "memory"); SBAR();
  PV_MM(d, o[3]);
}
__device__ __forceinline__ void pv_fused(f32x16* o, int vb, bf16x8 pa0, bf16x8 pa1, bf16x8 pa2, bf16x8 pa3, f32x16& x0, f32x16& x1) {
  PV_RD(a, 0); PV_RD(b, 1);
  asm volatile("s_waitcnt lgkmcnt(8)" ::: "memory"); SBAR();
  PV_MM(a, o[0]); exp_chunk<0>(x0, x1);
  PV_RD(c, 2);
  asm volatile("s_waitcnt lgkmcnt(8)" ::: "memory"); SBAR();
  PV_MM(b, o[1]); exp_chunk<1>(x0, x1);
  PV_RD(d, 3);
  asm volatile("s_waitcnt lgkmcnt(8)" ::: "memory"); SBAR();
  PV_MM(c, o[2]); exp_chunk<2>(x0, x1);
  asm volatile("s_waitcnt lgkmcnt(0)" ::: "memory"); SBAR();
  PV_MM(d, o[3]); exp_chunk<3>(x0, x1);
}
#undef PV_RD
#undef PV_PK
#undef PV_MM
__device__ __forceinline__ void attn_unit(int tid_in, int b, int h, int qb, int tb, const bf16* __restrict__ QKV, bf16* __restrict__ OB, float lam, float omli, float slope2, float m_ref, const float* __restrict__ subg, char* lds, gu32* qhead, volatile LAS unsigned* qslot) {
  int tid_o = tid_in; asm volatile("" : "+v"(tid_o));
  const int tid = tid_o, wid = __builtin_amdgcn_readfirstlane(tid >> 6), lane = tid & 63, r32 = lane & 31, hi = lane >> 5;
  const int jmap = wid >> 2, wq = wid & 3;
  constexpr int KR = 0, VR = 3 * 16384, WSO = 6 * 16384;
  float* ws = (float*)(lds + WSO) + wid * 64; float* li_l = ws;
  const long rowbase = (long)b * SEQ_; const int q0 = qb * 128 + wq * 32;
  float l_reg = 0.f; f32x16 o[4] = {}; bf16x8 qr[4];
  const bf16* Qw = QKV + (rowbase + q0 + r32) * LDQ + h * 128 + jmap * 64 + hi * 8;
#pragma unroll
  for (int d0 = 0; d0 < 4; ++d0) qr[d0] = *reinterpret_cast<const bf16x8*>(Qw + d0 * 16);
  const char* KVmid = (const char*)(QKV + (rowbase + 64 * tb) * LDQ + 2048 + h * 128 + 1024);
  unsigned koff[2], voff[2];
#pragma unroll
  for (int jb = 0; jb < 2; ++jb) { const int blk = 2 * wid + jb;
    { const int row = 4 * blk + (lane >> 4), chunk = (lane & 15) ^ (row & 7);
      koff[jb] = (unsigned)(row * LDQ * 2 + chunk * 16); }
    { const int sl = 64 * blk + lane, kk = 8 * (sl >> 7) + ((sl & 31) >> 2), c = 32 * ((sl >> 5) & 3) + 8 * (sl & 3);
      const int k = (kk & ~0xC) | ((kk & 4) << 1) | ((kk & 8) >> 1);
      voff[jb] = (unsigned)(k * LDQ * 2 + c * 2); } }
  const unsigned lds0 = (unsigned)(uintptr_t)lds;
  const int vb0 = (int)(lds0 + VR) + v_rd_base(lane);
  typedef __attribute__((address_space(3))) unsigned lds_u32;
#define DMA_K(t, slot) do { const char* t_ = KVmid + (size_t)(t) * (64 * LDQ * 2) - 2048; \
    __builtin_amdgcn_global_load_lds((const unsigned*)(t_ + koff[0]), (lds_u32*)(lds0 + KR + (slot) * 16384 + (2 * wid) * 1024), 16, 0, 0); \
    __builtin_amdgcn_global_load_lds((const unsigned*)(t_ + koff[1]), (lds_u32*)(lds0 + KR + (slot) * 16384 + (2 * wid + 1) * 1024), 16, 0, 0); } while (0)
#define DMA_V(t, slot) do { const char* t_ = KVmid + (size_t)(t) * (64 * LDQ * 2) + 2048; \
    __builtin_amdgcn_global_load_lds((const unsigned*)(t_ + voff[0]), (lds_u32*)(lds0 + VR + (slot) * 16384 + (2 * wid) * 1024), 16, 0, 0); \
    __builtin_amdgcn_global_load_lds((const unsigned*)(t_ + voff[1]), (lds_u32*)(lds0 + VR + (slot) * 16384 + (2 * wid + 1) * 1024), 16, 0, 0); } while (0)
#define WAIT_BAR(N) asm volatile("s_waitcnt vmcnt(" #N ") lgkmcnt(0)\n\ts_barrier" ::: "memory")
  f32x16 pA0, pA1, pB0, pB1; bf16x8 pa0, pa1, pa2, pa3;
  const int NT = 2 * qb + 2 - tb, cq = 2 * qb + (wq >> 1) - tb;
  const float dq = (float)(4 * hi - (q0 + r32) + 64 * tb);
#define QKT(P0, P1, kslot, t) qkt(P0, P1, (const bf16*)(lds + KR + (kslot) * 16384), qr, r32, hi, jmap, (float)(64 * (t)) + dq, slope2, ((t) > cq) ? -1e30f : -m_ref, (t) == cq)
  int sc = 0, sp = 2;
#define ROT() do { sp = sc; sc = (sc == 2) ? 0 : sc + 1; } while (0)
  asm volatile("" ::: "memory");
  DMA_K(0, 0); DMA_V(0, 0); DMA_K(1, 1);
  WAIT_BAR(4);
  asm volatile("" : "+v"(qr[0]), "+v"(qr[1]), "+v"(qr[2]), "+v"(qr[3]) :: "memory");
  if (2 < NT) DMA_K(2, 2);
  DMA_V(1, 1);
  if (jmap != 0 || !ATT_FUSED) { QKT(pA0, pA1, 0, 0); partialSM(pA0, pA1); }
#define STEP(ORD, PX0, PX1, PY0, PY1, t) do { ROT(); \
    if ((t) + 1 < NT) { WAIT_BAR(4); } else { WAIT_BAR(2); } \
    {   \
      if ((t) + 2 < NT) DMA_K((t) + 2, sp); \
      if ((t) + 1 < NT) DMA_V((t) + 1, (3 - sc - sp)); } \
    SBAR(); \
    if ((ORD) == 0) { QKT(PX0, PX1, sc, t); \
      finishSM(PY0, PY1, 1.f, l_reg, pa0, pa1, pa2, pa3); SBAR(); \
      pv_d0(o, vb0 + sp * 16384, pa0, pa1, pa2, pa3); partialSM(PX0, PX1); } \
    else { finishSM(PY0, PY1, 1.f, l_reg, pa0, pa1, pa2, pa3); SBAR(); \
      pv_d0(o, vb0 + sp * 16384, pa0, pa1, pa2, pa3); SBAR(); \
      QKT(PX0, PX1, sc, t); partialSM(PX0, PX1); } } while (0)
#define TILE_LOOP(ORD) do { \
    for (int t = 1; t + 1 < NT; t += 2) { STEP(ORD, pB0, pB1, pA0, pA1, t); STEP(ORD, pA0, pA1, pB0, pB1, t + 1); } \
    if ((NT & 1) == 0) { STEP(ORD, pB0, pB1, pA0, pA1, NT - 1); \
      WAIT_BAR(0);                                               \
      finishSM(pB0, pB1, 1.f, l_reg, pa0, pa1, pa2, pa3); SBAR(); \
    } else { WAIT_BAR(0); \
      finishSM(pA0, pA1, 1.f, l_reg, pa0, pa1, pa2, pa3); SBAR(); } } while (0)
#define STEPF(PX0, PX1, PY0, PY1, t) do { ROT(); \
    if ((t) + 1 < NT) { WAIT_BAR(4); } else { WAIT_BAR(2); } \
    { if ((t) + 2 < NT) DMA_K((t) + 2, sp); \
      if ((t) + 1 < NT) DMA_V((t) + 1, (3 - sc - sp)); } \
    SBAR(); \
    QKT(PX0, PX1, sc, t); \
    sums_cvt(PY0, PY1, l_reg, pa0, pa1, pa2, pa3); SBAR(); \
    pv_fused(o, vb0 + sp * 16384, pa0, pa1, pa2, pa3, PX0, PX1); } while (0)
  if (jmap != 0) __builtin_amdgcn_s_setprio(1);
  if (jmap == 0 && ATT_FUSED) {
    QKT(pA0, pA1, 0, 0);
    exp_chunk<0>(pA0, pA1); exp_chunk<1>(pA0, pA1); exp_chunk<2>(pA0, pA1); exp_chunk<3>(pA0, pA1);
    for (int t = 1; t + 1 < NT; t += 2) { STEPF(pB0, pB1, pA0, pA1, t); STEPF(pA0, pA1, pB0, pB1, t + 1); }
    if ((NT & 1) == 0) { STEPF(pB0, pB1, pA0, pA1, NT - 1);
      WAIT_BAR(0);
      sums_cvt(pB0, pB1, l_reg, pa0, pa1, pa2, pa3); SBAR();
    } else { WAIT_BAR(0);
      sums_cvt(pA0, pA1, l_reg, pa0, pa1, pa2, pa3); SBAR(); }
  } else if (jmap == 0) TILE_LOOP(0); else TILE_LOOP(1);
#undef STEPF
  pv_d0(o, vb0 + sc * 16384, pa0, pa1, pa2, pa3);
  __builtin_amdgcn_s_setprio(0);
  unsigned nxt_unit = 0u; if (tid == 0) nxt_unit = __hip_atomic_fetch_add(qhead, 1u, __ATOMIC_RELAXED, __HIP_MEMORY_SCOPE_AGENT);
  if (hi == 0) li_l[r32] = l_reg; asm volatile("s_waitcnt lgkmcnt(0)" ::: "memory");
#pragma unroll
  for (int r = 0; r < 16; ++r) { const float rl = __builtin_amdgcn_rcpf(li_l[crow(r, hi)]);
#pragma unroll
    for (int d0 = 0; d0 < 4; ++d0) o[d0][r] *= rl; }
  float* xch = (float*)lds + (size_t)wq * 4096 + lane;
  __syncthreads();
  if (jmap == 1) {
#pragma unroll
    for (int d0 = 0; d0 < 4; ++d0)
#pragma unroll
      for (int r = 0; r < 16; ++r) xch[(d0 * 16 + r) * 64] = o[d0][r];
  }
  __syncthreads();
  if (jmap == 0) {
    float ss[16];
#pragma unroll
    for (int r = 0; r < 16; ++r) { float s = 0.f;
#pragma unroll
      for (int d0 = 0; d0 < 4; ++d0) { const float df = o[d0][r] - lam * xch[(d0 * 16 + r) * 64]; o[d0][r] = df; s += df * df; }
      ss[r] = s; }
#pragma unroll
    for (int r = 0; r < 16; ++r) { float s = ss[r]; s += sx<1>(s); s += sx<2>(s); s += sx<4>(s); s += sx<8>(s); s += sx<16>(s);
      ss[r] = rsqrtf(s * (1.0f / 128.0f) + 1e-6f) * omli; }
    float gs[4]; int r32o = r32; asm volatile("" : "+v"(r32o));
#pragma unroll
    for (int d0 = 0; d0 < 4; ++d0) gs[d0] = subg[d0 * 32 + r32o];
    bf16* stg = (bf16*)(lds + 65536) + wq * 4096;
    int sto = 4 * hi * 128 + r32; asm volatile("" : "+v"(sto));
#pragma unroll
    for (int r = 0; r < 16; ++r) { const int orow = (r & 3) + 8 * (r >> 2);
#pragma unroll
      for (int d0 = 0; d0 < 4; ++d0) stg[sto + orow * 128 + d0 * 32] = (bf16)f2bf(o[d0][r] * ss[r] * gs[d0]); }
    asm volatile("s_waitcnt lgkmcnt(0)" ::: "memory");
    unsigned ooff = (unsigned)((q0 + (lane >> 4)) * 2048 + (lane & 15) * 8); asm volatile("" : "+v"(ooff));
    bf16* Ow = OB + rowbase * 2048 + h * 128 + ooff;
#pragma unroll
    for (int i = 0; i < 8; ++i) { const u32x4 v = *(const u32x4*)(stg + (4 * i + (lane >> 4)) * 128 + (lane & 15) * 8); *(u32x4*)(Ow + (4 * i) * 2048) = v; }
  }
  if (tid == 0) *qslot = nxt_unit;
  __syncthreads();
#undef DMA_K
#undef DMA_V
#undef WAIT_BAR
#undef ROT
#undef STEP
#undef TILE_LOOP
#undef QKT
}
#undef KSWZ
#undef SBAR
}
constexpr int DM = 2048, NB = 4, SEQ = 8192, MT = NB * SEQ, FF = 5632, NLAYER = 4, NH = 16, NMOD = 9 * DM;
constexpr float RMS_EPS = 1e-6f;
constexpr int NWAVES = 8;
#ifndef PROBE_MASK
#define PROBE_MASK 0
#endif
#ifndef PROBE_IDLE
#define PROBE_IDLE 0
#endif
#ifndef PROBE_ECHO
#define PROBE_ECHO 0
#endif
#ifndef FFN_SPLIT
#define FFN_SPLIT 1
#endif
#ifndef GU_WGM
#define GU_WGM 8
#endif
#ifndef OUT_A_AUX
#define OUT_A_AUX 0
#endif
#ifndef OUT_WGM
#define OUT_WGM 4
#endif
#ifndef MK_PER_PHASE
#define MK_PER_PHASE 0
#endif
constexpr int N_PHASES = 32 + 8 * 2 * (FFN_SPLIT - 1);
constexpr size_t MiB = 1u << 20;
constexpr size_t WS_CTL = 0, CTL_ZERO_BYTES = 3 * MiB;
constexpr size_t WS_MOD = 1696 * MiB;
constexpr size_t WS_EBL = 3 * MiB;
constexpr size_t WS_WGU = 8 * MiB;
constexpr size_t WS_WD  = 360 * MiB;
constexpr size_t WS_WAI = 536 * MiB;
constexpr size_t WS_WAO = 584 * MiB;
constexpr size_t WS_WCI = 600 * MiB, WS_WCO = 624 * MiB;
constexpr size_t WS_WHI = 632 * MiB, WS_WHO = 664 * MiB;
constexpr size_t WS_XN  = 672 * MiB;
constexpr size_t WS_BIG = 800 * MiB;
constexpr size_t WS_OB  = 1312 * MiB;
constexpr size_t WS_KLT = 1440 * MiB;
constexpr size_t WS_IT  = 1568 * MiB;
constexpr size_t WS_RSS = 1 * MiB, RSS_BYTES = 2 * MiB;
constexpr size_t WS_CB  = 1698 * MiB;
constexpr int CB_LD = 2 * 5632;
constexpr size_t WS_TAB = 1701 * MiB;
constexpr size_t WS_XH  = 1702 * MiB;
constexpr size_t WS_END = 1830 * MiB;
constexpr int CW_BAR = 4096;
constexpr int RING_OFF = 0, RING_BYTES = 131072;
constexpr int LDSCTL_OFF = RING_BYTES, MISC_OFF = LDSCTL_OFF + 320;
constexpr int PRE_OFF = LDSCTL_OFF + 1024;
constexpr int LDS_BYTES = 147456;

struct Args { const float* in[21]; float* out; unsigned char* ws; int ph_lo, ph_hi; };
struct Frame {
    LAS unsigned char* lds;
    volatile LAS unsigned* MISC;
    gu32* ctl;
    int tid, lane, wave, vcu, G;
    const struct Args* a; float* out; unsigned char* ws;
};
__device__ __forceinline__ float bf_lo(unsigned w) { return __uint_as_float(w << 16); }
__device__ __forceinline__ float bf_hi(unsigned w) { return __uint_as_float(w & 0xffff0000u); }
__device__ __forceinline__ float bf_f(bf16 x) { return __uint_as_float((unsigned)x << 16); }

__device__ __forceinline__ void unpack8(const v4u w, float (&x)[8]) { x[0] = bf_lo(w.x); x[1] = bf_hi(w.x); x[2] = bf_lo(w.y); x[3] = bf_hi(w.y); x[4] = bf_lo(w.z); x[5] = bf_hi(w.z); x[6] = bf_lo(w.w); x[7] = bf_hi(w.w); }
__device__ __forceinline__ void p0_mod(Frame& F) {
    LAS float* cond = (LAS float*)(F.lds);
    LAS float* part = (LAS float*)(F.lds + 32768);
    const float* c = F.a->in[1]; const float* aw = F.a->in[2]; const float* ab = F.a->in[3]; float* mod = (float*)(F.ws + WS_MOD);
    for (int i = F.tid; i < NB * DM; i += NWAVES * 64) { const float v = c[i]; cond[i] = v / (1.0f + __expf(-v)); }
    __syncthreads();
    const int cg = F.tid & 15, ks = F.tid >> 4;
    for (int it = F.vcu; it < NLAYER * (NMOD / 64); it += F.G) {
        const int L = it / (NMOD / 64), n0 = (it % (NMOD / 64)) * 64;
        f32x4 a0 = {0.f, 0.f, 0.f, 0.f}, a1 = a0, a2 = a0, a3 = a0;
        const float* wp = aw + ((size_t)L * DM + ks * 64) * NMOD + n0 + 4 * cg;
#pragma unroll 8
        for (int k = 0; k < 64; ++k) { const f32x4 w = *(const f32x4*)(wp + (size_t)k * NMOD); const int kk = ks * 64 + k;
            a0 += w * cond[kk]; a1 += w * cond[DM + kk]; a2 += w * cond[2 * DM + kk]; a3 += w * cond[3 * DM + kk]; }
        *(LAS f32x4*)(part + (ks * 4 + 0) * 64 + 4 * cg) = a0; *(LAS f32x4*)(part + (ks * 4 + 1) * 64 + 4 * cg) = a1;
        *(LAS f32x4*)(part + (ks * 4 + 2) * 64 + 4 * cg) = a2; *(LAS f32x4*)(part + (ks * 4 + 3) * 64 + 4 * cg) = a3;
        __syncthreads();
        if (F.tid < 256) { const int b = F.tid >> 6, col = F.tid & 63; float s = 0.f;
#pragma unroll 8
            for (int k2 = 0; k2 < 32; ++k2) s += part[(k2 * 4 + b) * 64 + col];
            mod[((size_t)L * NB + b) * NMOD + n0 + col] = s + ab[(size_t)L * NMOD + n0 + col]; }
        __syncthreads();
    }
}
struct CvItem { const float* W; bf16* WT; int K, N, mode, item; };
__device__ __forceinline__ CvItem cv_decode(Frame& F, int it) {
    constexpr int I_FFN = (DM / 64) * (FF / 32);
    constexpr int I_IN3 = (DM / 64) * (3 * DM / 32), I_SQ = (DM / 64) * (DM / 32), I_IN4 = (DM / 64) * (4 * DM / 32);
    int r = it;
    if (r < 24 * I_FFN) { const int m = r / I_FFN, ls = m / 3, which = m % 3; r -= m * I_FFN;
        if (which == 0) return CvItem{F.a->in[5] + (size_t)ls * DM * FF, (bf16*)(F.ws + WS_WGU) + (size_t)ls * 2 * FF * DM, DM, FF, 1, r};
        if (which == 1) return CvItem{F.a->in[6] + (size_t)ls * DM * FF, (bf16*)(F.ws + WS_WGU) + (size_t)ls * 2 * FF * DM, DM, FF, 2, r};
        return CvItem{F.a->in[7] + (size_t)ls * FF * DM, (bf16*)(F.ws + WS_WD) + (size_t)ls * DM * FF, FF, DM, 0, r}; }
    r -= 24 * I_FFN;
    if (r < 2 * I_IN3) { const int s = r / I_IN3; return CvItem{F.a->in[8] + (size_t)s * DM * 3 * DM, (bf16*)(F.ws + WS_WAI) + (size_t)s * 3 * DM * DM, DM, 3 * DM, 3, r - s * I_IN3}; } r -= 2 * I_IN3;
    if (r < 2 * I_SQ) { const int s = r / I_SQ; return CvItem{F.a->in[9] + (size_t)s * DM * DM, (bf16*)(F.ws + WS_WAO) + (size_t)s * DM * DM, DM, DM, 0, r - s * I_SQ}; } r -= 2 * I_SQ;
    if (r < I_IN3) return CvItem{F.a->in[14], (bf16*)(F.ws + WS_WCI), DM, 3 * DM, 0, r}; r -= I_IN3;
    if (r < I_SQ) return CvItem{F.a->in[16], (bf16*)(F.ws + WS_WCO), DM, DM, 0, r}; r -= I_SQ;
    if (r < I_IN4) return CvItem{F.a->in[17], (bf16*)(F.ws + WS_WHI), DM, 4 * DM, 0, r}; r -= I_IN4;
    return CvItem{F.a->in[18], (bf16*)(F.ws + WS_WHO), DM, DM, 0, r};
}
__device__ __forceinline__ void cv_load(const CvItem& c, float (&wv)[32], int lane) {
    const int nblk = c.N / 32, kb = c.item / nblk, nb = c.item % nblk;
    const float* wp = c.W + (size_t)(64 * kb + (lane >> 5)) * c.N + 32 * nb + (lane & 31);
#pragma unroll
    for (int i = 0; i < 32; ++i) wv[i] = wp[(size_t)(2 * i) * c.N];
}
__device__ __forceinline__ void cv_finish(const CvItem& c, const float (&wv)[32], LAS float* scr, int lane) {
    const int K = c.K, mode = c.mode, nblk = c.N / 32, kb = c.item / nblk, nb = c.item % nblk, n0 = 32 * nb;
    const int drow0 = (mode == 0 || (mode == 3 && n0 >= 2 * DM)) ? n0 : (mode == 3) ? ((n0 & ~255) + 128 * ((n0 >> 5) & 1) + 32 * ((n0 >> 6) & 3)) : ((n0 >> 7) * 256 + (mode - 1) * 128 + (n0 & 127));
#pragma unroll
    for (int i = 0; i < 32; ++i) scr[(2 * i + (lane >> 5)) * 33 + (lane & 31)] = wv[i];
    LDS_WAIT(); asm volatile("" ::: "memory");
    const int cc = lane & 7;
#pragma unroll
    for (int j = 0; j < 4; ++j) { const int n = (lane >> 3) + 8 * j; const LAS float* s = scr + (8 * cc) * 33 + n;
        v4u o; o.x = pk2(s[0 * 33], s[1 * 33]); o.y = pk2(s[2 * 33], s[3 * 33]); o.z = pk2(s[4 * 33], s[5 * 33]); o.w = pk2(s[6 * 33], s[7 * 33]);
        const int dr = drow0 + n;
        *(GAS v4u*)(c.WT + ((size_t)((dr >> 8) * (K >> 6) + kb) * 256 + (dr & 255)) * 64 + 8 * cc) = o; }
    LDS_WAIT(); asm volatile("" ::: "memory");
}
__device__ __forceinline__ void p0_convert(Frame& F) {
    LAS float* scr = (LAS float*)(F.lds + RING_OFF + F.wave * 16384);
    const int gw = F.vcu * NWAVES + F.wave, NGW = F.G * NWAVES;
    constexpr int NITEMS = 24 * ((DM / 64) * (FF / 32)) + 3 * ((DM / 64) * (3 * DM / 32)) + 4 * ((DM / 64) * (DM / 32)) + (DM / 64) * (4 * DM / 32);
    CvItem A, B; float wa[32], wb[32];
    int it = gw;
    if (it < NITEMS) { A = cv_decode(F, it); cv_load(A, wa, F.lane); }
    while (it < NITEMS) {
        int nx = it + NGW;
        if (nx < NITEMS) { B = cv_decode(F, nx); cv_load(B, wb, F.lane); }
        cv_finish(A, wa, scr, F.lane);
        it = nx; if (it >= NITEMS) break;
        nx = it + NGW;
        if (nx < NITEMS) { A = cv_decode(F, nx); cv_load(A, wa, F.lane); }
        cv_finish(B, wb, scr, F.lane);
        it = nx;
    }
}
__device__ __forceinline__ void xs0_phase(Frame& F, const float* xsrc, const float* g, const float* modL) {
    bf16* XN = (bf16*)(F.ws + WS_XN); float* rss = (float*)(F.ws + WS_RSS);
    const int gw = F.vcu * NWAVES + F.wave, NGW = F.G * NWAVES;
    for (int r0 = gw * 16; r0 < MT; r0 += NGW * 16) {
        const int b = r0 / SEQ;
        const float* sc = modL + (size_t)b * NMOD + DM;
        f32x4 a[8];
#pragma unroll
        for (int j = 0; j < 8; ++j) { const int col = 4 * F.lane + 256 * j; a[j] = *(const f32x4*)(g + col) * (*(const f32x4*)(sc + col) + 1.0f); }
#pragma unroll 2
        for (int r = 0; r < 16; ++r) {
            const GAS f32x4* xr = (const GAS f32x4*)(xsrc + (size_t)(r0 + r) * DM) + F.lane;
            f32x4 v[8]; float s = 0.f;
#pragma unroll
            for (int j = 0; j < 8; ++j) { v[j] = xr[64 * j]; s += (v[j].x * v[j].x + v[j].y * v[j].y) + (v[j].z * v[j].z + v[j].w * v[j].w); }
            s = wave_sum(s);
            if (F.lane == 0) rss[r0 + r] = s;
            bf16* o8 = XN + ((size_t)((r0 + r) >> 8) * 32 * 256 + ((r0 + r) & 255)) * 64 + (size_t)(F.lane >> 4) * (256 * 64) + 4 * (F.lane & 15);
#pragma unroll
            for (int j = 0; j < 8; ++j) { const f32x4 h = v[j] * a[j];
                *(GAS unsigned long long*)(o8 + (size_t)(4 * j) * (256 * 64)) = (unsigned long long)pk2(h.x, h.y) | ((unsigned long long)pk2(h.z, h.w) << 32); }
        }
    }
}
__device__ __forceinline__ void tables_phase(Frame& F) {
    const float* mod = (const float*)(F.ws + WS_MOD); float* TAB = (float*)(F.ws + WS_TAB); const float* ng = F.a->in[4];
    const int gt = F.vcu * (NWAVES * 64) + F.tid, NT = F.G * NWAVES * 64;
    for (int i = gt; i < 3 * NLAYER * NB * DM; i += NT) {
        const int col = i % DM, b = (i / DM) % NB, s = i / (DM * NB), L = s / 3, sub = s % 3, sn = s + 1, Ln = sn / 3, subn = sn % 3;
        TAB[((size_t)(s * 2 + 0) * NB + b) * DM + col] = ((sub == 1) ? 1.0f : 0.5f) * mod[((size_t)L * NB + b) * NMOD + (3 * sub + 2) * DM + col];
        TAB[((size_t)(s * 2 + 1) * NB + b) * DM + col] = (sn < 3 * NLAYER) ? ng[((size_t)Ln * 3 + subn) * DM + col] * (1.0f + mod[((size_t)Ln * NB + b) * NMOD + (3 * subn + 1) * DM + col]) : 0.f;
    }
}
__device__ __forceinline__ void bias_phase(Frame& F) {
    const float* mod = (const float*)(F.ws + WS_MOD); float* CB = (float*)(F.ws + WS_CB);
    const int gw = F.vcu * NWAVES + F.wave, NGW = F.G * NWAVES;
#pragma unroll 1
    for (int s = 0; s < 3 * NLAYER; ++s) {
        const int L = s / 3, sub = s % 3, kind = L % 3, slot = L / 3;
        const bf16* W; int N;
        if (sub != 1) { W = (const bf16*)(F.ws + WS_WGU) + (size_t)(L * 2 + (sub >> 1)) * 2 * FF * DM; N = 2 * FF; }
        else if (kind == 0) { W = (const bf16*)(F.ws + WS_WAI) + (size_t)slot * 3 * DM * DM; N = 3 * DM; }
        else if (kind == 1) { W = (const bf16*)(F.ws + WS_WCI); N = 3 * DM; }
        else { W = (const bf16*)(F.ws + WS_WHI); N = 4 * DM; }
        float sh[4][4][8];
#pragma unroll
        for (int b = 0; b < NB; ++b)
#pragma unroll
            for (int it = 0; it < 4; ++it) { const float* sp = mod + ((size_t)L * NB + b) * NMOD + (3 * sub) * DM + 8 * (64 * it + F.lane);
                const f32x4 s0 = *(const f32x4*)sp, s1 = *(const f32x4*)(sp + 4);
                sh[b][it][0] = s0.x; sh[b][it][1] = s0.y; sh[b][it][2] = s0.z; sh[b][it][3] = s0.w; sh[b][it][4] = s1.x; sh[b][it][5] = s1.y; sh[b][it][6] = s1.z; sh[b][it][7] = s1.w; }
        for (int n = gw; n < N; n += NGW) {
            const bf16* wrow = W + ((size_t)(n >> 8) * (DM >> 6) * 256 + (n & 255)) * 64 + (F.lane & 7) * 8;
            float d0 = 0.f, d1 = 0.f, d2 = 0.f, d3 = 0.f;
#pragma unroll
            for (int it = 0; it < 4; ++it) { float w[8]; unpack8(*(const GAS v4u*)(wrow + (size_t)(8 * it + (F.lane >> 3)) * 256 * 64), w);
#pragma unroll
                for (int i = 0; i < 8; ++i) { d0 += w[i] * sh[0][it][i]; d1 += w[i] * sh[1][it][i]; d2 += w[i] * sh[2][it][i]; d3 += w[i] * sh[3][it][i]; } }
            d0 = wave_sum(d0); d1 = wave_sum(d1); d2 = wave_sum(d2); d3 = wave_sum(d3);
            if (F.lane == 0) { float* cp = CB + (size_t)s * NB * CB_LD + n; cp[0] = d0; cp[CB_LD] = d1; cp[2 * CB_LD] = d2; cp[3 * CB_LD] = d3; }
        }
    }
}
constexpr int CW_ATTNQ = 8192;
__device__ __forceinline__ void attn_phase(Frame& F, int L, int slot, int qword = 0) {
    const bf16* QKV = (const bf16*)(F.ws + WS_BIG); bf16* OB = (bf16*)(F.ws + WS_OB);
    const float* lv = F.a->in[12] + (size_t)slot * 4 * 64;
    int ln = F.lane; asm volatile("" : "+v"(ln));
    const float sa = wave_sum(lv[ln] * lv[64 + ln]), sb = wave_sum(lv[128 + ln] * lv[192 + ln]);
    asm volatile("" : "+s"(L));
    const float lambda_init = (L == 0) ? 0.2f : (L == 1) ? 0.35550906f : (L == 2) ? 0.47071302f : 0.55605822f;
    const float lam = expf(sa) - expf(sb) + lambda_init;
    const float* subg = F.a->in[13] + (size_t)slot * 128;
    float gm = fabsf(F.a->in[10][slot * 64 + ln] * F.a->in[11][slot * 64 + ln]);
    gm = wave_max(gm);
    const float twoB24 = 16.0f * gm + 17.0f;
    const float m_ref = (8.0f * gm) * 1.4426950408889634f * 1.02f + 0.5f;
    gu32* qbase = F.ctl + CW_ATTNQ + 64 * slot + 256 * qword;
    int cur = (int)blockIdx.x & 7, tried = 0;
    if (F.tid == 0) F.MISC[16] = __hip_atomic_fetch_add(qbase + cur, 1u, RLX_AGENT);
    __syncthreads();
    int n = (int)F.MISC[16];
    for (;;) {
        const int grp = cur >> 2, cnt = grp ? 11 * 64 : 5 * 64;
        if (n >= cnt) {
            if (++tried == 8) break;
            cur = (cur + 1) & 7;
            __syncthreads();
            if (F.tid == 0) F.MISC[16] = __hip_atomic_fetch_add(qbase + cur, 1u, RLX_AGENT);
            __syncthreads();
            n = (int)F.MISC[16];
            continue;
        }
        const unsigned long long hl = grp ? 0x012456789CEull : 0x3ABDFull;
        const int qb = 63 - (n & 63), h = (int)((hl >> (4 * (n >> 6))) & 15ull), b = cur & 3;
        const float slope = exp2f(-0.5f * (float)(h + 1));
        const float W = (twoB24 - __logf(1.0f - __expf(-slope))) / slope;
        int tb = (int)floorf(((float)(128 * qb) - W) * (1.0f / 64.0f)); tb = (tb < 0 ? 0 : tb);
        att::attn_unit(F.tid, b, h, qb, tb, QKV, OB, lam, 1.0f - lambda_init, slope * 1.4426950408889634f, m_ref, subg, (char*)(F.lds + RING_OFF), qbase + cur, F.MISC + 16);
        n = (int)F.MISC[16];
    }
}
__device__ __forceinline__ void conv_phase(Frame& F) {
    const bf16* U = (const bf16*)(F.ws + WS_BIG); bf16* OB = (bf16*)(F.ws + WS_OB); const float* cw = F.a->in[15];
    const int gt = F.vcu * (NWAVES * 64) + F.tid, NT = F.G * NWAVES * 64;
    for (int item = gt; item < 256 * (MT / 16); item += NT) {
        int dg = item & 255; asm volatile("" : "+v"(dg));
        const int run = item >> 8, row0 = run * 16, d = dg * 8;
        float w0[8], w1[8], w2[8];
#pragma unroll
        for (int i = 0; i < 8; ++i) { w0[i] = cw[d + i]; w1[i] = cw[DM + d + i]; w2[i] = cw[2 * DM + d + i]; }
        float vm2[8], vm1[8];
        if ((row0 % SEQ) == 0) {
#pragma unroll
            for (int i = 0; i < 8; ++i) { vm2[i] = 0.f; vm1[i] = 0.f; }
        } else {
            float a[8], b[8];
            unpack8(*(const GAS v4u*)(U + (size_t)(row0 - 2) * 6144 + 2048 + d), a); unpack8(*(const GAS v4u*)(U + (size_t)(row0 - 2) * 6144 + 4096 + d), b);
#pragma unroll
            for (int i = 0; i < 8; ++i) vm2[i] = a[i] * b[i];
            unpack8(*(const GAS v4u*)(U + (size_t)(row0 - 1) * 6144 + 2048 + d), a); unpack8(*(const GAS v4u*)(U + (size_t)(row0 - 1) * 6144 + 4096 + d), b);
#pragma unroll
            for (int i = 0; i < 8; ++i) vm1[i] = a[i] * b[i];
        }
#pragma unroll 4
        for (int t = 0; t < 16; ++t) {
            const bf16* rp = U + (size_t)(row0 + t) * 6144 + d;
            float bg[8], cg[8], uu[8], y[8];
            unpack8(*(const GAS v4u*)(rp), bg); unpack8(*(const GAS v4u*)(rp + 2048), cg); unpack8(*(const GAS v4u*)(rp + 4096), uu);
#pragma unroll
            for (int i = 0; i < 8; ++i) { const float v = cg[i] * uu[i]; y[i] = bg[i] * (w0[i] * vm2[i] + w1[i] * vm1[i] + w2[i] * v); vm2[i] = vm1[i]; vm1[i] = v; }
            v4u o; o.x = pk2(y[0], y[1]); o.y = pk2(y[2], y[3]); o.z = pk2(y[4], y[5]); o.w = pk2(y[6], y[7]);
            *(GAS v4u*)(OB + (size_t)(row0 + t) * DM + d) = o;
        }
    }
}
#define LDS_BAR() asm volatile("s_waitcnt lgkmcnt(0)\n\ts_barrier" ::: "memory")
typedef short s16x4 __attribute__((ext_vector_type(4)));
typedef float f32x16 __attribute__((ext_vector_type(16)));
__device__ __forceinline__ int crow16(int r, int hi) { return (r & 3) + 8 * (r >> 2) + 4 * hi; }
constexpr int H_P256 = 272, H_P128 = 144;
__device__ __forceinline__ void hgrn_prep_phase(Frame& F, int layer, bf16* QBO, int qbld, bf16* OBO) {
    bf16* BIG = (bf16*)(F.ws + WS_BIG); bf16* KLT = (bf16*)(F.ws + WS_KLT); bf16* ITG = (bf16*)(F.ws + WS_IT); float* EBL = (float*)(F.ws + WS_EBL); bf16* OB = (bf16*)(F.ws + WS_OB);
    const float* lbl = F.a->in[20];
    LAS unsigned char* QS = F.lds; LAS unsigned char* KS = F.lds + 64 * H_P256; LAS unsigned char* ITL = F.lds + 2 * 64 * H_P256; LAS float* TOT = (LAS float*)(F.lds + 2 * 64 * H_P256 + 128 * H_P128);
    const int kp = F.lane, seg = F.wave, r32 = F.lane & 31, hi = F.lane >> 5;
    unsigned qw[8], fw[8], iw[8]; f32x2_cv lgt[4];
#define H1_LOAD(un) do { const int bh_ = (un) >> 7, c_ = (un) & 127; const size_t rb_ = (size_t)(bh_ >> 4) * SEQ + (size_t)c_ * 64; \
        _Pragma("unroll") for (int L_ = 0; L_ < 4; ++L_) lgt[L_] = *(const GAS f32x2_cv*)(lbl + L_ * DM + (bh_ & 15) * 128 + 2 * kp); \
        _Pragma("unroll") for (int tt = 0; tt < 8; ++tt) { const bf16* pq = BIG + (rb_ + 8 * seg + tt) * 8192 + (bh_ & 15) * 128 + 2 * kp; \
            qw[tt] = *(const GAS unsigned*)pq; fw[tt] = *(const GAS unsigned*)(pq + 2048); iw[tt] = *(const GAS unsigned*)(pq + 4096); } } while (0)
    for (int unit = F.vcu; unit < NB * NH * (SEQ / 64); unit += F.G) {
        const int bh = unit >> 7, c = unit & 127, b = bh >> 4, h = bh & 15; const size_t rowbase = (size_t)b * SEQ + (size_t)c * 64;
        if (unit == F.vcu) H1_LOAD(unit);
        float lb[2];
#pragma unroll
        for (int kk = 0; kk < 2; ++kk) { const float l0 = lgt[0][kk], l1 = lgt[1][kk], l2 = lgt[2][kk], l3 = lgt[3][kk];
            const float mx = fmaxf(fmaxf(l0, l1), fmaxf(l2, l3)); const float e0 = __expf(l0 - mx), e1 = __expf(l1 - mx), e2 = __expf(l2 - mx), e3 = __expf(l3 - mx);
            float cumv = 0.f; if (layer >= 1) cumv += e1; if (layer >= 2) cumv += e2; if (layer >= 3) cumv += e3;
            lb[kk] = cumv * __builtin_amdgcn_rcpf(e0 + e1 + e2 + e3); }
        float bcs[8][2], kv[8][2]; float cum[2] = {0.f, 0.f};
#pragma unroll
        for (int tt = 0; tt < 8; ++tt)
#pragma unroll
            for (int kk = 0; kk < 2; ++kk) { const float x = kk ? bf_hi(fw[tt]) : bf_lo(fw[tt]); const float sig = __builtin_amdgcn_rcpf(1.0f + __expf(-x));
                const float f = lb[kk] + (1.0f - lb[kk]) * sig; cum[kk] += __builtin_amdgcn_logf(f) * 0.6931471805599453f;     bcs[tt][kk] = cum[kk]; kv[tt][kk] = 1.0f - f; }
        TOT[seg * 128 + 2 * kp] = cum[0]; TOT[seg * 128 + 2 * kp + 1] = cum[1];
        LDS_BAR();
        float off[2] = {0.f, 0.f}, rb[2] = {0.f, 0.f}, bl[2] = {0.f, 0.f};
#pragma unroll
        for (int s = 0; s < 8; ++s)
#pragma unroll
            for (int kk = 0; kk < 2; ++kk) { const float tv = TOT[s * 128 + 2 * kp + kk]; if (s < seg) off[kk] += tv; if (s < 4) rb[kk] += tv; bl[kk] += tv; }
        float erb[2], enrb[2], ebl[2];
#pragma unroll
        for (int kk = 0; kk < 2; ++kk) { erb[kk] = __expf(rb[kk]); enrb[kk] = __expf(-rb[kk]); ebl[kk] = __expf(bl[kk]); }
        unsigned klw[2][4], itw[2][4];
#pragma unroll
        for (int tt = 0; tt < 8; ++tt) { float qb_[2], qs_[2], ks_[2], kl_[2];
#pragma unroll
            for (int kk = 0; kk < 2; ++kk) { const float bb = bcs[tt][kk] + off[kk]; const float q = kk ? bf_hi(qw[tt]) : bf_lo(qw[tt]);
                const float eb = __expf(bb), enb = __builtin_amdgcn_rcpf(eb);
                qb_[kk] = q * eb; qs_[kk] = qb_[kk] * enrb[kk]; ks_[kk] = kv[tt][kk] * (erb[kk] * enb); kl_[kk] = kv[tt][kk] * (ebl[kk] * enb); }
            *(GAS unsigned*)(QBO + (rowbase + 8 * seg + tt) * qbld + h * 128 + 2 * kp) = pk2(qb_[0], qb_[1]);
            *(LAS unsigned*)(QS + (8 * seg + tt) * H_P256 + 4 * kp) = pk2(qs_[0], qs_[1]);
            *(LAS unsigned*)(KS + (8 * seg + tt) * H_P256 + 4 * kp) = pk2(ks_[0], ks_[1]);
            if (tt & 1) { klw[0][tt >> 1] |= f2bf(kl_[0]) << 16; klw[1][tt >> 1] |= f2bf(kl_[1]) << 16; itw[0][tt >> 1] |= (iw[tt] & 0xffffu) << 16; itw[1][tt >> 1] |= (iw[tt] >> 16) << 16; }
            else { klw[0][tt >> 1] = f2bf(kl_[0]); klw[1][tt >> 1] = f2bf(kl_[1]); itw[0][tt >> 1] = iw[tt] & 0xffffu; itw[1][tt >> 1] = iw[tt] >> 16; }
        }
#pragma unroll
        for (int kk = 0; kk < 2; ++kk) { const v4u kw = {klw[kk][0], klw[kk][1], klw[kk][2], klw[kk][3]}, tw = {itw[kk][0], itw[kk][1], itw[kk][2], itw[kk][3]};
            *(GAS v4u*)(KLT + (size_t)unit * 8192 + (2 * kp + kk) * 64 + 8 * seg) = kw;
            *(GAS v4u*)(ITG + (size_t)unit * 8192 + (2 * kp + kk) * 64 + 8 * seg) = tw;
            *(LAS v4u*)(ITL + (2 * kp + kk) * H_P128 + 16 * seg) = tw; }
        if (seg == 0) { EBL[(size_t)unit * 128 + 2 * kp] = ebl[0]; EBL[(size_t)unit * 128 + 2 * kp + 1] = ebl[1]; }
        LDS_BAR();
        if (unit + F.G < NB * NH * (SEQ / 64)) H1_LOAD(unit + F.G);
        const int tt_ = F.wave & 1, vt = F.wave >> 1;
        f32x16 z = {};
        for (int st = 0; st <= tt_; ++st) {
            f32x16 x = {};
            bf16x8 af[8], bqf[8];
#pragma unroll
            for (int step = 0; step < 8; ++step) { af[step] = *(const LAS bf16x8*)(KS + (32 * st + r32) * H_P256 + (16 * step + 8 * hi) * 2);
                bqf[step] = *(const LAS bf16x8*)(QS + (32 * tt_ + r32) * H_P256 + (16 * step + 8 * hi) * 2); }
#pragma unroll
            for (int step = 0; step < 8; ++step) x = __builtin_amdgcn_mfma_f32_32x32x16_bf16(af[step], bqf[step], x, 0, 0, 0);
            if (st == tt_) {
#pragma unroll
                for (int r = 0; r < 16; ++r) if (crow16(r, hi) > r32) x[r] = 0.f;
            }
#pragma unroll
            for (int sp = 0; sp < 2; ++sp) {
                v4u pw; pw.x = pk2(x[8 * sp + 0], x[8 * sp + 1]); pw.y = pk2(x[8 * sp + 2], x[8 * sp + 3]); pw.z = pk2(x[8 * sp + 4], x[8 * sp + 5]); pw.w = pk2(x[8 * sp + 6], x[8 * sp + 7]);
                const bf16x8 xs = __builtin_bit_cast(bf16x8, pw);
                const LAS unsigned char* ip = ITL + (32 * vt + r32) * H_P128 + (32 * st + 16 * sp + 4 * hi) * 2;
                const s16x4 lo = *(const LAS s16x4*)ip, hh = *(const LAS s16x4*)(ip + 16);
                const bf16x8 pb = __builtin_shufflevector(lo, hh, 0, 1, 2, 3, 4, 5, 6, 7);
                z = __builtin_amdgcn_mfma_f32_32x32x16_bf16(xs, pb, z, 0, 0, 0);
            }
        }
        bf16* op = OBO + (rowbase + 32 * tt_) * DM + h * 128 + 32 * vt + r32;
#pragma unroll
        for (int r = 0; r < 16; ++r) op[(size_t)crow16(r, hi) * DM] = (bf16)f2bf(z[r]);
        LDS_BAR();
    }
}
#undef H1_LOAD
__device__ __forceinline__ void hgrn_scan_phase(Frame& F, bf16* OBO) {
    const bf16* BIG = (const bf16*)(F.ws + WS_BIG); const bf16* KLT = (const bf16*)(F.ws + WS_KLT); const bf16* ITG = (const bf16*)(F.ws + WS_IT); const float* EBL = (const float*)(F.ws + WS_EBL); const bf16* OB = (const bf16*)(F.ws + WS_OB);
    constexpr int TB = 64 * H_P256 + 128 * H_P128 + 32 * H_P128 + 512;
    constexpr int STB = 32 * H_P256;
    constexpr int IOB = 64 * 64;
    LAS unsigned char* TL = F.lds; LAS unsigned char* STL = F.lds + 2 * TB; LAS unsigned char* ISL = STL + 2 * STB; LAS unsigned char* OSL = ISL + 2 * IOB;
    const int tid = F.tid, r32 = F.lane & 31, hi = F.lane >> 5, w = F.wave;
    for (int unit = F.vcu; unit < NB * NH * 4; unit += F.G) {
        const int bh = unit >> 2, vq = unit & 3, b = bh >> 4, h = bh & 15;
        f32x16 acc = {};
        v4u q0[2], k0[2], i0, e0, q1[2], k1[2], i1, e1, ivr[2];
        i0 = i1 = e0 = e1 = ivr[0] = ivr[1] = (v4u){(unsigned)tid >> 31, 0u, 0u, 0u};
        const int ioq = (F.lane + 64 * (w & 1));
#define H2_LOAD(Q, K, I, E, c) do { const size_t rb_ = (size_t)b * SEQ + (size_t)(c) * 64; const size_t un_ = (size_t)bh * 128 + (c); \
        _Pragma("unroll") for (int i_ = 0; i_ < 2; ++i_) { const int p_ = tid + 512 * i_; \
            Q[i_] = *(const GAS v4u*)(BIG + (rb_ + (p_ >> 4)) * 8192 + h * 128 + (p_ & 15) * 8); K[i_] = *(const GAS v4u*)(KLT + un_ * 8192 + (size_t)p_ * 8); } \
        if (tid < 256) I = *(const GAS v4u*)(ITG + un_ * 8192 + (size_t)(32 * vq) * 64 + (size_t)tid * 8); \
        if (tid < 32) E = *(const GAS v4u*)(EBL + un_ * 128 + 4 * tid); } while (0)
#define H2_WRITE(Q, K, I, E, bufo) do { LAS unsigned char* tb_ = TL + (bufo); _Pragma("unroll") for (int i_ = 0; i_ < 2; ++i_) { const int p_ = tid + 512 * i_; \
            *(LAS v4u*)(tb_ + (p_ >> 4) * H_P256 + (p_ & 15) * 16) = Q[i_]; *(LAS v4u*)(tb_ + 64 * H_P256 + (p_ >> 3) * H_P128 + (p_ & 7) * 16) = K[i_]; } \
        if (tid < 256) *(LAS v4u*)(tb_ + 64 * H_P256 + 128 * H_P128 + (tid >> 3) * H_P128 + (tid & 7) * 16) = I; \
        if (tid < 32) *(LAS v4u*)(tb_ + 64 * H_P256 + 128 * H_P128 + 32 * H_P128 + 16 * tid) = E; } while (0)
#define H2_IVLD(c) do { _Pragma("unroll") for (int j_ = 0; j_ < 2; ++j_) { const int q_ = ioq + 128 * j_; \
            ivr[j_] = *(const GAS v4u*)(OB + ((size_t)b * SEQ + (size_t)(c) * 64 + (q_ >> 2)) * DM + h * 128 + 32 * vq + (q_ & 3) * 8); } } while (0)
#define H2_IVST(slot) do { _Pragma("unroll") for (int j_ = 0; j_ < 2; ++j_) { const int q_ = ioq + 128 * j_; *(LAS v4u*)(ISL + (slot) * IOB + (q_ >> 2) * 64 + (q_ & 3) * 16) = ivr[j_]; } } while (0)
#define H2_OST(c, slot) do { _Pragma("unroll") for (int j_ = 0; j_ < 2; ++j_) { const int q_ = ioq + 128 * j_; const v4u v_ = *(const LAS v4u*)(OSL + (slot) * IOB + (q_ >> 2) * 64 + (q_ & 3) * 16); \
            *(GAS v4u*)(OBO + ((size_t)b * SEQ + (size_t)(c) * 64 + (q_ >> 2)) * DM + h * 128 + 32 * vq + (q_ & 3) * 8) = v_; } } while (0)
#define H2_STEP(c, cur, Qn, Kn, In, En) do { LAS unsigned char* tb_ = TL + (cur) * TB; LAS unsigned char* st_ = STL + (cur) * STB; \
          \
          \
        if (w >= 6 && (c) + 1 < SEQ / 64) H2_IVST((cur) ^ 1);      \
        if ((c) + 1 < SEQ / 64) H2_WRITE(Qn, Kn, In, En, ((cur) ^ 1) * TB); \
        if (w >= 6) { if ((c) + 2 < SEQ / 64) H2_IVLD((c) + 2); \
            if ((c) >= 1) H2_OST((c) - 1, (cur) ^ 1); }             \
        if ((c) + 3 < SEQ / 64) H2_LOAD(Qn, Kn, In, En, (c) + 3); \
        if (w < 4) { const LAS float* eb_ = (const LAS float*)(tb_ + 64 * H_P256 + 128 * H_P128 + 32 * H_P128); \
            _Pragma("unroll") for (int r = 0; r < 16; ++r) acc[r] *= eb_[32 * w + crow16(r, hi)]; \
            _Pragma("unroll") for (int step = 0; step < 4; ++step) { const bf16x8 a_ = *(const LAS bf16x8*)(tb_ + 64 * H_P256 + (32 * w + r32) * H_P128 + (16 * step + 8 * hi) * 2); \
                const bf16x8 b_ = *(const LAS bf16x8*)(tb_ + 64 * H_P256 + 128 * H_P128 + r32 * H_P128 + (16 * step + 8 * hi) * 2); acc = __builtin_amdgcn_mfma_f32_32x32x16_bf16(a_, b_, acc, 0, 0, 0); } \
            LAS unsigned char* sn_ = STL + ((cur) ^ 1) * STB + r32 * H_P256 + (32 * w + 4 * hi) * 2; \
            _Pragma("unroll") for (int g = 0; g < 4; ++g) *(LAS unsigned long long*)(sn_ + 16 * g) = (unsigned long long)pk2(acc[4 * g], acc[4 * g + 1]) | ((unsigned long long)pk2(acc[4 * g + 2], acc[4 * g + 3]) << 32); \
        } else if (w < 6) { f32x16 o_ = {}; \
            _Pragma("unroll") for (int step = 0; step < 8; ++step) { const bf16x8 a_ = *(const LAS bf16x8*)(tb_ + (32 * (w - 4) + r32) * H_P256 + (16 * step + 8 * hi) * 2); \
                const bf16x8 b_ = *(const LAS bf16x8*)(st_ + r32 * H_P256 + (16 * step + 8 * hi) * 2); o_ = __builtin_amdgcn_mfma_f32_32x32x16_bf16(a_, b_, o_, 0, 0, 0); } \
            const int so_ = (32 * (w - 4) + 4 * hi) * 64 + r32 * 2; bf16 iv_[16]; \
            _Pragma("unroll") for (int r = 0; r < 16; ++r) iv_[r] = *(const LAS bf16*)(ISL + (cur) * IOB + so_ + ((r & 3) + 8 * (r >> 2)) * 64);     \
            _Pragma("unroll") for (int r = 0; r < 16; ++r) *(LAS bf16*)(OSL + (cur) * IOB + so_ + ((r & 3) + 8 * (r >> 2)) * 64) = (bf16)f2bf(o_[r] + bf_f(iv_[r])); } \
        LDS_BAR(); } while (0)
        { const unsigned zz = (unsigned)tid >> 31;
          for (int i = tid; i < STB / 16; i += NWAVES * 64) *(LAS v4u*)(STL + 16 * i) = (v4u){zz, zz, zz, zz}; }
        H2_LOAD(q0, k0, i0, e0, 0); H2_WRITE(q0, k0, i0, e0, 0);
        H2_LOAD(q1, k1, i1, e1, 1); H2_LOAD(q0, k0, i0, e0, 2);
        if (w >= 6) { H2_IVLD(0); H2_IVST(0); H2_IVLD(1); }
        LDS_BAR();
#pragma unroll 1
        for (int c = 0; c < SEQ / 64; c += 2) {
            H2_STEP(c, 0, q1, k1, i1, e1);
            H2_STEP(c + 1, 1, q0, k0, i0, e0);
        }
        if (w >= 6) H2_OST(SEQ / 64 - 1, 1);
        LDS_BAR();
#undef H2_LOAD
#undef H2_WRITE
#undef H2_IVLD
#undef H2_IVST
#undef H2_OST
#undef H2_STEP
    }
}
__device__ __forceinline__ void hgrn_final_phase(Frame& F, bf16* OBO) {
    const bf16* BIG = (const bf16*)(F.ws + WS_BIG); bf16* OB = (bf16*)(F.ws + WS_OB); const float* gn = F.a->in[19];
    const int gw = F.vcu * NWAVES + F.wave, NGW = F.G * NWAVES;
    const int dv = (F.lane & 15) * 8;
    const f32x4 g0 = *(const f32x4*)(gn + dv), g1 = *(const f32x4*)(gn + dv + 4);
    for (int row = gw; row < MT; row += NGW) {
        GAS v4u* po = (GAS v4u*)(OB + (size_t)row * DM) + F.lane; const GAS v4u* pg = (const GAS v4u*)(BIG + (size_t)row * 8192 + 6144) + F.lane;
        v4u wo[4], wg[4];
#pragma unroll
        for (int it = 0; it < 4; ++it) { wo[it] = po[64 * it]; wg[it] = pg[64 * it]; }
#pragma unroll
        for (int it = 0; it < 4; ++it) { float x[8], gg[8]; unpack8(wo[it], x); unpack8(wg[it], gg);
            float ss = 0.f;
#pragma unroll
            for (int i = 0; i < 8; ++i) ss += x[i] * x[i];
            ss += sx<1>(ss); ss += sx<2>(ss); ss += sx<4>(ss); ss += sx<8>(ss);
            const float rstd = rsqrtf(ss * (1.0f / 128.0f) + RMS_EPS);
            float y[8];
#pragma unroll
            for (int i = 0; i < 8; ++i) { const float gi = (i < 4) ? g0[i] : g1[i - 4]; y[i] = x[i] * rstd * gi * (gg[i] * __builtin_amdgcn_rcpf(1.0f + __expf(-gg[i]))); }
            v4u o; o.x = pk2(y[0], y[1]); o.y = pk2(y[2], y[3]); o.z = pk2(y[4], y[5]); o.w = pk2(y[6], y[7]);
            ((GAS v4u*)(OBO + (size_t)row * DM) + F.lane)[64 * it] = o; }
    }
}
__device__ __forceinline__ bool ph_refresh(Frame& F) { unsigned m = ~0u; asm volatile("" : "+s"(m));
    const int t = (F.wave << 6) | (int)__builtin_amdgcn_mbcnt_hi(m, __builtin_amdgcn_mbcnt_lo(m, 0u));
    F.tid = t; F.lane = t & 63; return true; }
__global__ void __launch_bounds__(NWAVES * 64, 2) trunk_fwd(Args args) {
    extern __shared__ __attribute__((aligned(16))) unsigned char lds[];
    Frame F;
    F.lds = (LAS unsigned char*)lds;
    F.MISC = (volatile LAS unsigned*)(F.lds + MISC_OFF);
    F.tid = threadIdx.x; F.lane = F.tid & 63; F.wave = __builtin_amdgcn_readfirstlane(F.tid >> 6);
    F.G = gridDim.x; { const int bx = blockIdx.x; F.vcu = (F.G % 8 == 0) ? (bx % 8) * (F.G / 8) + bx / 8 : bx; }
    F.ws = args.ws; F.ctl = (gu32*)(args.ws + WS_CTL); F.out = args.out;
    F.a = &args;
    for (int u = F.tid; u < (LDS_BYTES - LDSCTL_OFF) / 4; u += NWAVES * 64) ((LAS unsigned*)(F.lds + LDSCTL_OFF))[u] = 0u;
    __syncthreads();
    XcdBarrier bar; bar.bar = (unsigned*)(F.ctl + CW_BAR); bar.x = 0; bar.st = nullptr;
    if (!MK_PER_PHASE) bar = xcd_barrier_post((unsigned*)(F.ctl + CW_BAR), F.MISC + 8);
    const int lo = args.ph_lo, hi = args.ph_hi;
    int pc = 0;
    unsigned long long t_ph = PROBE_ECHO ? __builtin_amdgcn_s_memrealtime() : 0ull;
#define PH_ON (pc >= lo && pc < hi && ph_refresh(F))
#define PH_END_C(cls) do { if (!MK_PER_PHASE && pc >= lo && pc + 1 < hi) { const unsigned long long ta_ = (PROBE_IDLE && (PROBE_IDLE == 100 || PROBE_IDLE == (cls))) ? __builtin_amdgcn_s_memrealtime() : 0ull; xcd_barrier(bar); if (PROBE_MASK & 32) xcd_barrier(bar); \
        if (PROBE_IDLE && (PROBE_IDLE == 100 || PROBE_IDLE == (cls))) { const unsigned long long t1_ = __builtin_amdgcn_s_memrealtime(), d_ = t1_ - ta_; while (__builtin_amdgcn_s_memrealtime() - t1_ < d_) __builtin_amdgcn_s_sleep(8); xcd_barrier(bar); } \
        if (PROBE_ECHO == (cls)) { const unsigned long long t1_ = __builtin_amdgcn_s_memrealtime(), d_ = t1_ - t_ph; while (__builtin_amdgcn_s_memrealtime() - t1_ < d_) __builtin_amdgcn_s_sleep(8); xcd_barrier(bar); } \
        if (PROBE_ECHO) t_ph = __builtin_amdgcn_s_memrealtime(); } ++pc; } while (0)
#define PH_END PH_END_C(0)
    float* mod = (float*)(F.ws + WS_MOD);
    bf16* XN = (bf16*)(F.ws + WS_XN); bf16* BIG = (bf16*)(F.ws + WS_BIG); bf16* OB = (bf16*)(F.ws + WS_OB);
    float* RSS = (float*)(F.ws + WS_RSS); const float* CB = (const float*)(F.ws + WS_CB);
    if (PH_ON) { p0_mod(F); __syncthreads(); p0_convert(F); }
#if PROBE_MASK & 16
    if (PH_ON) { __syncthreads(); p0_mod(F); __syncthreads(); p0_convert(F); }
#endif
    PH_END_C(1);
    if (PH_ON) { tables_phase(F); bias_phase(F); xs0_phase(F, F.a->in[0], F.a->in[4], mod); }
#if PROBE_MASK & 16384
    if (PH_ON) { tables_phase(F); bias_phase(F); xs0_phase(F, F.a->in[0], F.a->in[4], mod); }
#endif
    PH_END_C(2);
#pragma unroll 1
    for (int L = 0; L < NLAYER; ++L) {
        const int kind = L % 3, slot = L / 3;
        const float* modL = mod + (size_t)L * NB * NMOD;
#pragma unroll 1
        for (int sub = 0; sub < 3; ++sub) {
            const int s = 3 * L + sub;
            const float* rss = RSS + (size_t)s * MT; const float* cb = CB + (size_t)s * NB * CB_LD;
            const bf16* outA; const bf16* outB; int outK;
            const int nhalf = (sub != 1) ? FFN_SPLIT : 1;
#pragma unroll 1
            for (int hf = 0; hf < nhalf; ++hf) {
            const int Mpart = MT / nhalf, pm_off = hf * (Mpart / 256);
            if (sub != 1) {
                const int ls = L * 2 + (sub >> 1);
                if (PH_ON) { pg8::Gemm g{XN, (const bf16*)(F.ws + WS_WGU) + (size_t)ls * 2 * FF * DM, Mpart, 2 * FF, DM, 1, 1}; pg8::StaticOrder S; S.init(Mpart, 2 * FF, F.G, (int)blockIdx.x, GU_WGM, pm_off);
                    pg8::EpiSwigluN E{BIG, FF, rss, cb, CB_LD, SEQ, F.lds + PRE_OFF};
#pragma unroll 1
                    for (int rep = 0; rep < ((PROBE_MASK & 1) ? 2 : 1); ++rep) { if (rep) __syncthreads(); pg8::gemm_phase<pg8::EpiSwigluN, pg8::StaticOrder, true, true>(F.lds + RING_OFF, g, S, E, F.tid); }
                    }
                PH_END_C(3);
                outA = BIG; outB = (const bf16*)(F.ws + WS_WD) + (size_t)ls * DM * FF; outK = FF;
            } else {
                const int nin = (kind == 2) ? 4 * DM : 3 * DM;
                const bf16* win = (kind == 0) ? (const bf16*)(F.ws + WS_WAI) + (size_t)slot * 3 * DM * DM : (kind == 1) ? (const bf16*)(F.ws + WS_WCI) : (const bf16*)(F.ws + WS_WHI);
                if (PH_ON) { pg8::Gemm g{XN, win, MT, nin, DM, 1, 1}; pg8::StaticOrder S; S.init(MT, nin, F.G, (int)blockIdx.x, GU_WGM);
                    pg8::EpiInN E{BIG, nin, rss, cb, CB_LD, SEQ, (kind == 0) ? 16 : 0, F.a->in[10] + (size_t)slot * 64, F.a->in[11] + (size_t)slot * 64, F.lds + PRE_OFF};
#pragma unroll 1
                    for (int rep = 0; rep < ((PROBE_MASK & 4) ? 2 : 1); ++rep) { if (rep) __syncthreads(); pg8::gemm_phase<pg8::EpiInN, pg8::StaticOrder, true, true>(F.lds + RING_OFF, g, S, E, F.tid); }
                    }
                PH_END_C(5);
                if (kind == 0) {
#if PROBE_MASK & 8192
                    if (PH_ON) { attn_phase(F, L, slot, 1); __syncthreads(); }
#endif
                    if (PH_ON) attn_phase(F, L, slot);
                    PH_END_C(7);
                } else if (kind == 1) {
                    if (PH_ON) conv_phase(F);
                    PH_END_C(8);
                } else {
#if PROBE_MASK & 64
                    if (PH_ON) { hgrn_prep_phase(F, L, XN, DM, XN); __syncthreads(); }
#endif
                    if (PH_ON) hgrn_prep_phase(F, L, BIG, 8192, OB);
                    PH_END_C(9);
#if PROBE_MASK & 128
                    if (PH_ON) { hgrn_scan_phase(F, XN); __syncthreads(); }
#endif
                    if (PH_ON) hgrn_scan_phase(F, OB);
                    PH_END_C(10);
                    if (PH_ON) hgrn_final_phase(F, OB);
                    PH_END_C(11);
                }
                outA = OB; outB = (kind == 0) ? (const bf16*)(F.ws + WS_WAO) + (size_t)slot * DM * DM : (kind == 1) ? (const bf16*)(F.ws + WS_WCO) : (const bf16*)(F.ws + WS_WHO); outK = DM;
            }
            if (PH_ON) { pg8::Gemm g{outA, outB, Mpart, DM, outK, (sub != 1) ? 1 : 0, 1};     pg8::StaticOrder S; S.init(Mpart, DM, F.G, (int)blockIdx.x, OUT_WGM, pm_off);
                const int sn = s + 1; const bool last = (s == 3 * NLAYER - 1);
                const float* TAB = (const float*)(F.ws + WS_TAB);
                pg8::EpiResN E{(s == 0) ? (const void*)F.a->in[0] : (const void*)(F.ws + WS_XH), last ? (void*)F.out : (void*)(F.ws + WS_XH), (s == 0) ? 1 : 0, last ? 1 : 0, DM, TAB + (size_t)(s * 2 + 0) * NB * DM, TAB + (size_t)(s * 2 + 1) * NB * DM, DM, SEQ, last ? (bf16*)nullptr : XN, RSS + (size_t)sn * MT, F.lds + PRE_OFF, 1.0f};
#pragma unroll 1
                for (int rep = (((PROBE_MASK & 2) || ((PROBE_MASK & 2048) && sub != 1) || ((PROBE_MASK & 4096) && sub == 1)) ? 0 : 1); rep < 2; ++rep) {
                    pg8::EpiResN E2 = E;
#if PROBE_MASK & (2 | 2048 | 4096)
                    { const bool dbl = (PROBE_MASK & 2) || ((PROBE_MASK & 2048) && sub != 1) || ((PROBE_MASK & 4096) && sub == 1);
                      if (dbl) { E2.gscale = 0.5f; if (rep == 0) { E2.rssn = RSS + (size_t)12 * MT; if (last) { E2.out = (void*)(F.ws + WS_XH); E2.out_f32 = 0; } } else if (s == 0) { E2.base = (const void*)(F.ws + WS_XH); E2.base_f32 = 0; } } }
#endif
                    if (rep == 0) __syncthreads();
                    pg8::gemm_phase<pg8::EpiResN, pg8::StaticOrder, true, true, OUT_A_AUX>(F.lds + RING_OFF, g, S, E2, F.tid); if (rep == 0) __syncthreads(); } }
            PH_END_C((sub != 1) ? 4 : 6);
            }
        }
    }
#undef PH_ON
#undef PH_END
#undef PH_END_C
}
extern "C" void kernel_launch(void* const* d_in, const int* in_sizes, int n_in, void* d_out, int out_size, void* d_ws, size_t ws_size, hipStream_t stream) {
    static int grid = 0;
    if (grid == 0) {
        if (n_in != 21 || in_sizes[0] != MT * DM || out_size != MT * DM || ws_size < WS_END) { fprintf(stderr, "kernel_launch: shape/workspace mismatch (n_in %d, in0 %d, out %d, ws %zu, need %zu); nothing launched\n", n_in, n_in > 0 ? in_sizes[0] : -1, out_size, ws_size, (size_t)WS_END); grid = -1; return; }
        int dev = 0, cus = 0, per_cu = 0;
        if (hipGetDevice(&dev) != hipSuccess || hipDeviceGetAttribute(&cus, hipDeviceAttributeMultiprocessorCount, dev) != hipSuccess) { fprintf(stderr, "kernel_launch: device query failed\n"); grid = -1; return; }
        if (hipFuncSetAttribute((const void*)trunk_fwd, hipFuncAttributeMaxDynamicSharedMemorySize, LDS_BYTES) != hipSuccess) { fprintf(stderr, "kernel_launch: hipFuncSetAttribute failed\n"); grid = -1; return; }
        if (hipOccupancyMaxActiveBlocksPerMultiprocessor(&per_cu, (const void*)trunk_fwd, NWAVES * 64, LDS_BYTES) != hipSuccess || per_cu < 1) fprintf(stderr, "kernel_launch: note: occupancy query reports %d workgroups per CU\n", per_cu);
        (void)hipGetLastError();
        grid = cus;
    }
    if (grid < 0) return;
    if (hipMemsetAsync((char*)d_ws + WS_CTL, 0, CTL_ZERO_BYTES, stream) != hipSuccess) { fprintf(stderr, "kernel_launch: memset failed\n"); return; }
    Args a{};
    for (int i = 0; i < 21; ++i) a.in[i] = (const float*)d_in[i];
    a.out = (float*)d_out; a.ws = (unsigned char*)d_ws;
#if MK_PER_PHASE
    for (int p = 0; p < N_PHASES; ++p) { a.ph_lo = p; a.ph_hi = p + 1; hipLaunchKernelGGL(trunk_fwd, dim3(grid), dim3(NWAVES * 64), LDS_BYTES, stream, a); }
#else
    a.ph_lo = 0; a.ph_hi = N_PHASES;
    hipLaunchKernelGGL(trunk_fwd, dim3(grid), dim3(NWAVES * 64), LDS_BYTES, stream, a);
#endif
    const hipError_t le = hipPeekAtLastError();
    if (le != hipSuccess) fprintf(stderr, "kernel_launch: launch failed: %s\n", hipGetErrorName(le));
}
```
